# Optimizing an MI355X kernel written in HIP

```python
import math
import jax, jax.numpy as jnp
from jax import lax
import numpy as np

D_MODEL = 2048
BATCH = 32
SEQ = 256
DEPTH = 2
DEC_BATCH = 8
DEC_SEQ = 4096
PAST_LEN = 256

GRID_W = 64
D_FF = 4 * D_MODEL
N_MOD = 6
NORM_EPS = 1e-6

GLA_HEADS = 4
GLA_DK = 128
GLA_DV = 256
GLA_KEY_W = GLA_HEADS * GLA_DK
GLA_VAL_W = GLA_HEADS * GLA_DV
GLA_LOWRANK = 16
GLA_TAU = 16.0
GLA_CHUNK = 64
ROPE_BASE = 10000.0

NA_HEADS = 8
NA_HD = 128
NA_W = NA_HEADS * NA_HD
NA_KH = 8
NA_KW = 16
Q_BLOCK = 128

HY_W = 1024
HY_ORDER = 2
HY_SHORT = 3
HY_BANDS = 16
HY_POS_DIM = 1 + 2 * HY_BANDS
HY_HIDDEN = 64
HY_DECAY_TARGET = 1e-2
HY_DECAY_PCT_SHORT = 0.3
HY_DECAY_PCT_LONG = 1.5

N_BRANCH = 3
IN_SIZES = (GLA_KEY_W, GLA_KEY_W, GLA_VAL_W, GLA_VAL_W, 2 * GLA_LOWRANK,
            NA_W, NA_W, NA_W, (HY_ORDER + 1) * HY_W, N_BRANCH * D_MODEL)
IN_TOTAL = 2 * GLA_KEY_W + 2 * GLA_VAL_W + 2 * GLA_LOWRANK + 3 * NA_W + (HY_ORDER + 1) * HY_W + N_BRANCH * D_MODEL

kernel_name = 'hybrid_gla_natten_hyena_prefix_dit_step'

F32 = jnp.float32


def in_offsets():
    return [int(o) for o in np.cumsum(IN_SIZES)[:-1]]


def rms_norm(x, g):
    xf = x.astype(F32)
    y = xf * lax.rsqrt(jnp.mean(xf * xf, axis=-1, keepdims=True) + NORM_EPS)
    return (y * g.astype(F32)).astype(x.dtype)


def adaln(cond, w_mod, b_mod):
    m = jax.nn.silu(cond) @ w_mod + b_mod
    return jnp.split(m[:, None, :], N_MOD, axis=-1)


def to_heads(t, n_heads):
    B, L, W = t.shape
    return t.reshape(B, L, n_heads, W // n_heads).transpose(0, 2, 1, 3)


def from_heads(t):
    B, H, L, d = t.shape
    return t.transpose(0, 2, 1, 3).reshape(B, L, H * d)


def axial_rope(t):
    L, d = t.shape[2], t.shape[3]
    n_freq = d // 4
    pos = jnp.arange(L)
    row = (pos // GRID_W).astype(F32)
    col = (pos % GRID_W).astype(F32)
    inv = ROPE_BASE ** (-jnp.arange(n_freq, dtype=F32) / n_freq)
    ang = jnp.concatenate([row[:, None] * inv, col[:, None] * inv], axis=-1)
    cos, sin = jnp.cos(ang), jnp.sin(ang)
    t1, t2 = t[..., : d // 2], t[..., d // 2:]
    return jnp.concatenate([t1 * cos - t2 * sin, t1 * sin + t2 * cos], axis=-1)


def gla_scan(q, k, v, log_a, s0):
    B, H, L, _ = q.shape
    C = GLA_CHUNK
    n = L // C

    def to_chunks(t):
        return jnp.moveaxis(t.reshape(B, H, n, C, t.shape[-1]), 2, 0)

    causal = jnp.tril(jnp.ones((C, C), dtype=bool))[None, None, :, :, None]

    def step(s, inp):
        qi, ki, vi, ai = inp
        b = jnp.cumsum(ai, axis=2)
        o_inter = jnp.einsum('bhtd,bhde->bhte', qi * jnp.exp(b), s)
        diff = b[:, :, :, None, :] - b[:, :, None, :, :]
        decay = jnp.exp(jnp.where(causal, diff, -jnp.inf))
        attn = jnp.einsum('bhtd,bhsd,bhtsd->bhts', qi, ki, decay)
        o = o_inter + jnp.einsum('bhts,bhse->bhte', attn, vi)
        b_last = b[:, :, -1]
        s_new = jnp.exp(b_last)[..., None] * s + jnp.einsum(
            'bhsd,bhse->bhde', ki * jnp.exp(b_last[:, :, None, :] - b), vi)
        return s_new, o

    s_fin, o = lax.scan(step, s0, (to_chunks(q), to_chunks(k), to_chunks(v), to_chunks(log_a)))
    o = jnp.moveaxis(o, 0, 2).reshape(B, H, L, v.shape[-1])
    return o, s_fin


def gla_bidirectional(q, k, v, la_f, la_b, s0_f, s0_b):
    o_f, s_f = gla_scan(q, k, v, la_f, s0_f)
    rev = lambda t: jnp.flip(t, axis=2)
    o_b, s_b = gla_scan(rev(q), rev(k), rev(v), rev(la_b), s0_b)
    return o_f + rev(o_b), s_f, s_b


def dense_attention(q, k, v):
    B, H, L, hd = q.shape
    scale = hd ** -0.5
    qb = jnp.moveaxis(q.reshape(B, H, L // Q_BLOCK, Q_BLOCK, hd), 2, 0)

    def block(qi):
        s = jnp.einsum('bhqd,bhkd->bhqk', qi, k).astype(F32) * scale
        p = jax.nn.softmax(s, axis=-1).astype(v.dtype)
        return jnp.einsum('bhqk,bhkd->bhqd', p, v)

    o = lax.map(block, qb)
    return jnp.moveaxis(o, 0, 2).reshape(B, H, L, hd)


def neighbourhood_attention(q, k, v, k_ctx, v_ctx, rpb):
    B, H, L, hd = q.shape
    rows = L // GRID_W
    kh, kw = min(NA_KH, rows), NA_KW
    scale = hd ** -0.5
    qg = q.reshape(B, H, rows, GRID_W, hd)
    kg = k.reshape(B, H, rows, GRID_W, hd)
    vg = v.reshape(B, H, rows, GRID_W, hd)
    col = jnp.arange(GRID_W)
    c_start = jnp.clip(col - kw // 2, 0, GRID_W - kw)
    col_in = (col[None, :] >= c_start[:, None]) & (col[None, :] < c_start[:, None] + kw)
    col_idx = jnp.clip(col[None, :] - col[:, None] + kw - 1, 0, 2 * kw - 2)
    rpb_cols = rpb[:, :, col_idx]
    mask = col_in[None, None, :, None, :]

    def row_block(r):
        r_start = jnp.clip(r - kh // 2, 0, rows - kh)
        q_r = lax.dynamic_index_in_dim(qg, r, axis=2, keepdims=False)
        k_b = lax.dynamic_slice_in_dim(kg, r_start, kh, axis=2)
        v_b = lax.dynamic_slice_in_dim(vg, r_start, kh, axis=2)
        row_off = r_start + jnp.arange(kh) - r + (NA_KH - 1)
        bias = jnp.transpose(jnp.take(rpb_cols, row_off, axis=1), (0, 2, 1, 3))
        s_loc = jnp.einsum('bhqd,bhrkd->bhqrk', q_r, k_b).astype(F32) * scale + bias[None].astype(F32)
        s_loc = jnp.where(mask, s_loc, -jnp.inf)
        s_ctx = jnp.einsum('bhqd,bhcd->bhqc', q_r, k_ctx).astype(F32) * scale
        s = jnp.concatenate([s_loc.reshape(B, H, GRID_W, kh * GRID_W), s_ctx], axis=-1)
        p = jax.nn.softmax(s, axis=-1).astype(v.dtype)
        p_loc = p[..., : kh * GRID_W].reshape(B, H, GRID_W, kh, GRID_W)
        p_ctx = p[..., kh * GRID_W:]
        return (jnp.einsum('bhqrk,bhrkd->bhqd', p_loc, v_b)
                + jnp.einsum('bhqc,bhcd->bhqd', p_ctx, v_ctx))

    out = lax.map(row_block, jnp.arange(rows))
    return jnp.moveaxis(out, 0, 2).reshape(B, H, L, hd)


def hyena_filters(L, f1_w, f1_b, f2_w, f2_b, f3_w, freq):
    t = jnp.arange(L, dtype=F32)
    tn = t / L
    bands = jnp.arange(1, HY_BANDS + 1, dtype=F32)
    ang = 2.0 * jnp.pi * tn[:, None] * bands[None, :]
    z = jnp.concatenate([tn[:, None], jnp.cos(ang), jnp.sin(ang)], axis=-1)
    fr = freq.astype(F32)
    h = jnp.sin(fr * (z @ f1_w.astype(F32) + f1_b.astype(F32)))
    h = jnp.sin(fr * (h @ f2_w.astype(F32) + f2_b.astype(F32)))
    h = (h @ f3_w.astype(F32)).reshape(L, HY_ORDER, HY_W)
    dist = jnp.abs(t - L // 2) * (2.0 / L)
    deltas = jnp.abs(jnp.linspace(math.log(HY_DECAY_TARGET) / HY_DECAY_PCT_LONG,
                                  math.log(HY_DECAY_TARGET) / HY_DECAY_PCT_SHORT, HY_W, dtype=F32))
    h = h * jnp.exp(-dist[:, None, None] * deltas[None, None, :])
    return h * lax.rsqrt(jnp.sum(h * h, axis=0, keepdims=True) + NORM_EPS)


def hyena_operator(u, conv_w, conv_b, filters, bias):
    B, L, _ = u.shape
    pad = HY_SHORT // 2
    up = jnp.pad(u, ((0, 0), (pad, pad), (0, 0)))
    uc = conv_b + sum(up[:, j:j + L] * conv_w[j] for j in range(HY_SHORT))
    parts = jnp.split(uc.astype(F32), HY_ORDER + 1, axis=-1)
    gates, z = parts[:HY_ORDER], parts[HY_ORDER]
    h_f = jnp.fft.rfft(filters, n=2 * L, axis=0)
    for o in range(HY_ORDER):
        z_f = jnp.fft.rfft(z, n=2 * L, axis=1)
        conv = jnp.fft.irfft(z_f * h_f[None, :, o], n=2 * L, axis=1)[:, L // 2: L // 2 + L]
        z = gates[o] * (conv + bias[o].astype(F32) * z)
    return z


def token_mixing(x, shift, scale, p, latent_ctx):
    B, L, _ = x.shape
    h = rms_norm(x, p['norm1_g']) * (1 + scale) + shift
    gq, gk, gv, gg, ga, nq, nk, nv, hy, gates = jnp.split(h @ p['w_in'], in_offsets(), axis=-1)

    q = to_heads(gq, GLA_HEADS).astype(F32) * GLA_DK ** -0.5
    k = to_heads(gk, GLA_HEADS).astype(F32)
    v = to_heads(gv, GLA_HEADS).astype(F32)
    la = jnp.einsum('blir,ird->blid', ga.reshape(B, L, 2, GLA_LOWRANK), p['gla_wa2']) + p['gla_ba2']
    la = jax.nn.log_sigmoid(la.astype(F32)) / GLA_TAU
    la_f, la_b = to_heads(la[:, :, 0], GLA_HEADS), to_heads(la[:, :, 1], GLA_HEADS)
    if latent_ctx is None:
        s0_f = s0_b = jnp.zeros((B, GLA_HEADS, GLA_DK, GLA_DV), F32)
    else:
        s0_f, s0_b, k_ctx, v_ctx = latent_ctx
        q, k = axial_rope(q), axial_rope(k)
    o_a, s_f, s_b = gla_bidirectional(q, k, v, la_f, la_b, s0_f.astype(F32), s0_b.astype(F32))
    out_a = from_heads(rms_norm(o_a, p['gla_norm_g'])).astype(x.dtype) * jax.nn.silu(gg)

    qn = rms_norm(to_heads(nq, NA_HEADS), p['na_qnorm_g'])
    kn = rms_norm(to_heads(nk, NA_HEADS), p['na_knorm_g'])
    vn = to_heads(nv, NA_HEADS)
    if latent_ctx is None:
        o_b = dense_attention(qn, kn, vn)
    else:
        o_b = neighbourhood_attention(qn, kn, vn, k_ctx.astype(x.dtype), v_ctx.astype(x.dtype), p['na_rpb'])
    out_b = from_heads(o_b)

    filters = hyena_filters(L, p['hy_f1_w'], p['hy_f1_b'], p['hy_f2_w'], p['hy_f2_b'], p['hy_f3_w'], p['hy_freq'])
    out_c = hyena_operator(hy, p['hy_conv_w'], p['hy_conv_b'], filters, p['hy_bias']).astype(x.dtype)

    g_a, g_b, g_c = jnp.split(jax.nn.sigmoid(gates), N_BRANCH, axis=-1)
    merged = g_a * (out_a @ p['w_br_a']) + g_b * (out_b @ p['w_br_b']) + g_c * (out_c @ p['w_br_c'])
    y = merged @ p['w_out']
    new_ctx = (jnp.stack([s_f, s_b], axis=1), kn, vn) if latent_ctx is None else None
    return y, new_ctx


def trunk_layer(x, cond, p, latent_ctx):
    sh1, sc1, g1, sh2, sc2, g2 = adaln(cond, p['w_mod'], p['b_mod'])
    y, new_ctx = token_mixing(x, sh1, sc1, p, latent_ctx)
    x = x + g1 * y
    h = rms_norm(x, p['norm2_g']) * (1 + sc2) + sh2
    x = x + g2 * (jnp.square(jax.nn.relu(h @ p['w_mlp1'])) @ p['w_mlp2'])
    return x, new_ctx


def setup_inputs(seed: int = 0) -> dict:
    key = jax.random.key(seed)
    ks = iter(jax.random.split(key, 40))

    def nrm(shape, scale):
        return jax.random.normal(next(ks), shape, F32) * scale

    def gain(shape):
        return 1.0 + nrm(shape, 0.02)

    return {
        'x_prompt': nrm((BATCH, SEQ, D_MODEL), 1.0),
        'x_sample': nrm((DEC_BATCH, DEC_SEQ, D_MODEL), 1.0),
        'state_gla': nrm((DEC_BATCH, DEPTH, 2, GLA_HEADS, GLA_DK, GLA_DV), 0.5),
        'cache_na_k': nrm((DEC_BATCH, DEPTH, NA_HEADS, PAST_LEN, NA_HD), 1.0),
        'cache_na_v': nrm((DEC_BATCH, DEPTH, NA_HEADS, PAST_LEN, NA_HD), 1.0),
        'c': nrm((DEC_BATCH, D_MODEL), 1.0),
        'c_ctx': nrm((D_MODEL,), 1.0),
        'w_mod': nrm((DEPTH, D_MODEL, N_MOD * D_MODEL), D_MODEL ** -0.5),
        'b_mod': nrm((DEPTH, N_MOD * D_MODEL), 0.02),
        'norm1_g': gain((DEPTH, D_MODEL)),
        'norm2_g': gain((DEPTH, D_MODEL)),
        'w_in': nrm((DEPTH, D_MODEL, IN_TOTAL), D_MODEL ** -0.5),
        'gla_wa2': nrm((DEPTH, 2, GLA_LOWRANK, GLA_KEY_W), GLA_LOWRANK ** -0.5),
        'gla_ba2': nrm((DEPTH, 2, GLA_KEY_W), 0.02),
        'gla_norm_g': gain((DEPTH, GLA_DV)),
        'na_qnorm_g': gain((DEPTH, NA_HD)),
        'na_knorm_g': gain((DEPTH, NA_HD)),
        'na_rpb': nrm((DEPTH, NA_HEADS, 2 * NA_KH - 1, 2 * NA_KW - 1), 0.1),
        'hy_conv_w': nrm((DEPTH, HY_SHORT, (HY_ORDER + 1) * HY_W), HY_SHORT ** -0.5),
        'hy_conv_b': nrm((DEPTH, (HY_ORDER + 1) * HY_W), 0.02),
        'hy_f1_w': nrm((DEPTH, HY_POS_DIM, HY_HIDDEN), HY_POS_DIM ** -0.5),
        'hy_f1_b': nrm((DEPTH, HY_HIDDEN), 0.02),
        'hy_f2_w': nrm((DEPTH, HY_HIDDEN, HY_HIDDEN), HY_HIDDEN ** -0.5),
        'hy_f2_b': nrm((DEPTH, HY_HIDDEN), 0.02),
        'hy_f3_w': nrm((DEPTH, HY_HIDDEN, HY_ORDER * HY_W), HY_HIDDEN ** -0.5),
        'hy_freq': gain((DEPTH, HY_HIDDEN)),
        'hy_bias': nrm((DEPTH, HY_ORDER, HY_W), 0.1),
        'w_br_a': nrm((DEPTH, GLA_VAL_W, D_MODEL), GLA_VAL_W ** -0.5),
        'w_br_b': nrm((DEPTH, NA_W, D_MODEL), NA_W ** -0.5),
        'w_br_c': nrm((DEPTH, HY_W, D_MODEL), HY_W ** -0.5),
        'w_out': nrm((DEPTH, D_MODEL, D_MODEL), D_MODEL ** -0.5),
        'w_mlp1': nrm((DEPTH, D_MODEL, D_FF), D_MODEL ** -0.5),
        'w_mlp2': nrm((DEPTH, D_FF, D_MODEL), D_FF ** -0.5),
    }


def reference(x_prompt, x_sample, state_gla, cache_na_k, cache_na_v, c, c_ctx,
              w_mod, b_mod, norm1_g, norm2_g, w_in, gla_wa2, gla_ba2, gla_norm_g,
              na_qnorm_g, na_knorm_g, na_rpb, hy_conv_w, hy_conv_b, hy_f1_w, hy_f1_b,
              hy_f2_w, hy_f2_b, hy_f3_w, hy_freq, hy_bias, w_br_a, w_br_b, w_br_c,
              w_out, w_mlp1, w_mlp2):
    xp, xs = x_prompt, x_sample
    ctx_cond = c_ctx[None, :]
    new_gla, new_k, new_v = [], [], []
    for l in range(DEPTH):
        p = dict(w_mod=w_mod[l], b_mod=b_mod[l], norm1_g=norm1_g[l], norm2_g=norm2_g[l],
                 w_in=w_in[l], gla_wa2=gla_wa2[l], gla_ba2=gla_ba2[l], gla_norm_g=gla_norm_g[l],
                 na_qnorm_g=na_qnorm_g[l], na_knorm_g=na_knorm_g[l], na_rpb=na_rpb[l],
                 hy_conv_w=hy_conv_w[l], hy_conv_b=hy_conv_b[l], hy_f1_w=hy_f1_w[l],
                 hy_f1_b=hy_f1_b[l], hy_f2_w=hy_f2_w[l], hy_f2_b=hy_f2_b[l],
                 hy_f3_w=hy_f3_w[l], hy_freq=hy_freq[l], hy_bias=hy_bias[l],
                 w_br_a=w_br_a[l], w_br_b=w_br_b[l], w_br_c=w_br_c[l], w_out=w_out[l],
                 w_mlp1=w_mlp1[l], w_mlp2=w_mlp2[l])
        xp, (s_gla, k_ctx, v_ctx) = trunk_layer(xp, ctx_cond, p, None)
        new_gla.append(s_gla)
        new_k.append(k_ctx)
        new_v.append(v_ctx)
        latent_ctx = (state_gla[:, l, 0], state_gla[:, l, 1], cache_na_k[:, l], cache_na_v[:, l])
        xs, _ = trunk_layer(xs, c, p, latent_ctx)
    new_state_gla = jnp.stack(new_gla, axis=1)
    new_cache_na_k = jnp.stack(new_k, axis=1)
    new_cache_na_v = jnp.stack(new_v, axis=1)
    return (xp, xs, new_state_gla, new_cache_na_k, new_cache_na_v)
```

```cpp
#include <hip/hip_runtime.h>
#include <stdint.h>
#include <stdio.h>

constexpr int DM = 2048, DFF = 8192, NMOD = 6, NCOND = 9;
constexpr int GT = 8192;
constexpr int NGRP = 5, DEPTH = 2;
constexpr int C_GQ = 0, C_GK = 512, C_GV = 1024, C_GG = 2048, C_GA = 3072, C_NQ = 3328, C_NK = 4352, C_NV = 5376, C_HY = 6400, C_GATE = 9472, NP = 15616;
constexpr int IN_TOTAL = 15392;
constexpr float EPS = 1e-6f;

typedef unsigned short bf16_t;
typedef float f32x4 __attribute__((ext_vector_type(4)));
typedef float f32x2 __attribute__((ext_vector_type(2)));
typedef unsigned u32x4 __attribute__((ext_vector_type(4)));
typedef unsigned u32x2 __attribute__((ext_vector_type(2)));
#define DI __device__ __forceinline__

DI float bf2f(bf16_t b) { return __uint_as_float(((unsigned)b) << 16); }
DI float bflo(unsigned w) { return __uint_as_float(w << 16); }
DI float bfhi(unsigned w) { return __uint_as_float(w & 0xffff0000u); }
DI bf16_t f2bf(float f) { unsigned u = __float_as_uint(f); u += 0x7FFFu + ((u >> 16) & 1u); return (bf16_t)(u >> 16); }
DI unsigned pk2(float lo, float hi) { return (unsigned)f2bf(lo) | ((unsigned)f2bf(hi) << 16); }
DI float sigmoidf_(float x) { return 1.0f / (1.0f + __expf(-x)); }
DI float wave_sum(float v) { for (int o = 32; o >= 1; o >>= 1) v += __shfl_xor(v, o); return v; }
DI float wave_max(float v) { for (int o = 32; o >= 1; o >>= 1) v = fmaxf(v, __shfl_xor(v, o)); return v; }

constexpr size_t al256(size_t x) { return (x + 255) & ~(size_t)255; }
constexpr size_t OFF_BAR  = 0;
constexpr size_t OFF_MOD  = 65536;
constexpr size_t OFF_HID  = OFF_MOD  + al256((size_t)DEPTH * NCOND * 12288 * 4);
constexpr size_t OFF_FILT = OFF_HID  + (size_t)DEPTH * 2 * 4096 * 64 * 4;
constexpr size_t FILT_L   = (size_t)2 * 1024 * (256 + 4096) * 4;
constexpr size_t OFF_WIN  = OFF_FILT + DEPTH * FILT_L;
constexpr size_t OFF_WBR  = OFF_WIN  + (size_t)DEPTH * NP * DM * 2;
constexpr size_t OFF_WOUT = OFF_WBR  + (size_t)DEPTH * 3 * DM * 1024 * 2;
constexpr size_t OFF_W1   = OFF_WOUT + (size_t)DEPTH * DM * DM * 2;
constexpr size_t OFF_W2   = OFF_W1   + (size_t)DEPTH * DFF * DM * 2;
constexpr size_t OFF_H    = OFF_W2   + (size_t)DEPTH * DFF * DM * 2;
constexpr size_t OFF_P    = OFF_H    + (size_t)GT * DM * 2;
constexpr size_t OFF_OF   = OFF_P    + (size_t)GT * NP * 2;
constexpr size_t OFF_OB   = OFF_OF   + (size_t)GT * 1024 * 4;
constexpr size_t OFF_OABC = OFF_OB   + (size_t)GT * 1024 * 4;
constexpr size_t OFF_M32  = OFF_OABC + (size_t)3 * GT * 1024 * 2;
constexpr size_t OFF_MBF  = OFF_M32  + (size_t)GT * DM * 4;
constexpr size_t OFF_QN   = OFF_MBF  + (size_t)GT * DM * 2;
constexpr size_t OFF_KN   = OFF_QN   + (size_t)GT * 1024 * 2;
constexpr size_t WS_END   = OFF_KN   + (size_t)GT * 1024 * 2;
static_assert(WS_END < (size_t)1190000000, "workspace too large");

constexpr size_t OUT_YP = 0, OUT_YS = (size_t)32 * 256 * DM, OUT_ST = OUT_YS + (size_t)8 * 4096 * DM,
                 OUT_CK = OUT_ST + (size_t)32 * 2 * 2 * 4 * 128 * 256, OUT_CV = OUT_CK + (size_t)32 * 2 * 8 * 256 * 128;

struct Params {
    const float *x_prompt, *x_sample, *state_gla, *cache_k, *cache_v, *c, *c_ctx, *w_mod, *b_mod, *norm1_g, *norm2_g, *w_in, *gla_wa2, *gla_ba2, *gla_norm_g,
                *na_qnorm_g, *na_knorm_g, *na_rpb, *hy_conv_w, *hy_conv_b, *hy_f1_w, *hy_f1_b, *hy_f2_w, *hy_f2_b, *hy_f3_w, *hy_freq, *hy_bias,
                *w_br_a, *w_br_b, *w_br_c, *w_out, *w_mlp1, *w_mlp2;
    float* out; unsigned char* ws;
};
namespace pg8 {
#define PG8_LAS __attribute__((address_space(3)))
typedef unsigned short bf16_t;
typedef short bf16x8 __attribute__((ext_vector_type(8)));
typedef float f32x4 __attribute__((ext_vector_type(4)));
typedef unsigned u32x4 __attribute__((ext_vector_type(4)));
constexpr int BM = 256, BK = 64, HALF = 128, HTB = HALF * BK * 2  , STAGE_BYTES = 8 * HTB, NXCD = 8, WGM = 8;
__host__ __device__ __forceinline__ int lds_byte(int r, int c) { const int st = (r >> 4) * 2 + (c >> 5), rr = r & 15, cc = c & 31, ob = rr * 64 + cc * 2; return st * 1024 + (ob ^ (((ob >> 9) & 1) << 5)); }
__host__ __device__ __forceinline__ void stage_rc(int b, int& R, int& C) { const int st = b / 1024, sb = b % 1024, swz = sb ^ (((sb >> 9) & 1) << 5); R = (st >> 1) * 16 + swz / 64; C = (st & 1) * 32 + (swz % 64) / 2; }
__host__ __device__ __forceinline__ int perm32(int rho) { const int n = rho >> 4, i = rho & 15; return 8 * (i >> 2) + 4 * n + (i & 3); }
struct Unit { int pm, pn; };
struct Gemm { const bf16_t* A; const bf16_t* Bt; int M, N, K, pad; };
struct StaticOrder {
    int nM, nN, nwg, G, c;
    __host__ __device__ void init(int M, int N, int G_, int c_) { nM = M / BM; nN = N / BM; nwg = nM * nN; G = G_; c = c_; }
    __host__ __device__ bool next(int i, Unit& u) const {
        const long L = (long)i * G + c; if (L >= nwg) return false;
        int wgid = (int)L; { const int q = nwg / NXCD, r = nwg % NXCD, xcd = wgid % NXCD, off = wgid / NXCD; wgid = (xcd < r ? xcd * (q + 1) : r * (q + 1) + (xcd - r) * q) + off; }
        const int nig = WGM * nN, gid = wgid / nig, fm = gid * WGM, gsz = (nM - fm) < WGM ? (nM - fm) : WGM;
        u.pm = fm + ((wgid % nig) % gsz); u.pn = (wgid % nig) / gsz; return true;
    }
    __device__ __forceinline__ void a_ready(const Unit&) const {}
    __device__ __forceinline__ void done(const Unit&) const {}
};
__device__ __forceinline__ unsigned cvt_pk_bf16(float lo, float hi) { unsigned r; asm volatile("v_cvt_pk_bf16_f32 %0, %1, %2" : "=v"(r) : "v"(lo), "v"(hi)); return r; }
template <class Epi, class Sched, bool STAMP = false>
__device__ __forceinline__ void gemm_phase(PG8_LAS unsigned char* lds, const Gemm g, const Sched& S, const Epi& E, unsigned long long* stamps) {
    const int tid = threadIdx.x, wid = __builtin_amdgcn_readfirstlane(tid >> 6), lane = tid & 63, wr = wid >> 2, wc = wid & 3, fr = lane & 15, fq = lane >> 4;
    const int K = g.K, nt = K / BK;
    int ts_lo = 0, ts_hi = 0, nts = 0; const unsigned long long rt_entry = STAMP ? (unsigned long long)wall_clock64() : 0ull;
#define PG8_STAMP() do { if (STAMP && wid == 0 && nts < 64) { const unsigned long long _c = (unsigned long long)clock64(); \
        ts_lo = (lane == nts) ? (int)(unsigned)_c : ts_lo; ts_hi = (lane == nts) ? (int)(unsigned)(_c >> 32) : ts_hi; ++nts; } } while (0)
    PG8_STAMP();
    unsigned voffA[2], voffB[2];
#pragma unroll
    for (int i = 0; i < 2; ++i) { int R, C; stage_rc(tid * 16 + i * 8192, R, C); const int Rb = Epi::PERM ? ((R & ~31) + perm32(R & 31)) : R;
        voffA[i] = (unsigned)(R * K + C) * 2u; voffB[i] = (unsigned)(Rb * K + C) * 2u; }
    const size_t kstep = (size_t)(BK * 2);
    const size_t hstep = (size_t)HALF * K * 2;
    const size_t tstep = 2 * hstep;
    const unsigned ldsw = (unsigned)wid * 1024u;
    const int aoff = lds_byte(wr * 64 + fr, fq * 8), boff = lds_byte(wc * 32 + fr, fq * 8);
#define PG8_SA(b, h) (((b) * 2 + (h)) * HTB)
#define PG8_SB(b, h) ((4 + (b) * 2 + (h)) * HTB)
#define PG8_STAGE(bufoff, gbase, voff) do { _Pragma("unroll") for (int _i = 0; _i < 2; ++_i) \
        __builtin_amdgcn_global_load_lds((const unsigned*)((const char*)(gbase) + (voff)[_i]), (PG8_LAS unsigned*)(lds + (bufoff) + ldsw + _i * 8192), 16, 0, 0); } while (0)
#define PG8_LDA(dst, b, h) do { _Pragma("unroll") for (int m = 0; m < 4; ++m) _Pragma("unroll") for (int k = 0; k < 2; ++k) dst[m][k] = *(const PG8_LAS bf16x8*)(lds + PG8_SA(b, h) + aoff + m * 2048 + k * 1024); } while (0)
#define PG8_LDB(dst, b, h) do { _Pragma("unroll") for (int n = 0; n < 2; ++n) _Pragma("unroll") for (int k = 0; k < 2; ++k) dst[n][k] = *(const PG8_LAS bf16x8*)(lds + PG8_SB(b, h) + boff + n * 2048 + k * 1024); } while (0)
#define PG8_MMA(ai, bj, At, Bt) do { __builtin_amdgcn_s_setprio(1); _Pragma("unroll") for (int m = 0; m < 4; ++m) _Pragma("unroll") for (int n = 0; n < 2; ++n) _Pragma("unroll") for (int k = 0; k < 2; ++k) \
        acc[ai][bj][m][n] = __builtin_amdgcn_mfma_f32_16x16x32_bf16(Bt[n][k], At[m][k], acc[ai][bj][m][n], 0, 0, 0); __builtin_amdgcn_s_setprio(0); } while (0)
#define PG8_WAIT_V(n) asm volatile("s_waitcnt vmcnt(" #n ")" ::: "memory")
#define PG8_WAIT_L(n) asm volatile("s_waitcnt lgkmcnt(" #n ")" ::: "memory")
#define PG8_BAR __builtin_amdgcn_s_barrier()
#define PG8_SCHED __builtin_amdgcn_sched_barrier(0)
    Unit cur, nxt; int ui = 0;
    if (!S.next(0, cur)) return;
    f32x4 acc[2][2][4][2];
#pragma unroll
    for (int a = 0; a < 2; ++a)
#pragma unroll
        for (int b = 0; b < 2; ++b)
#pragma unroll
            for (int m = 0; m < 4; ++m)
#pragma unroll
                for (int n = 0; n < 2; ++n) acc[a][b][m][n] = (f32x4){0.f, 0.f, 0.f, 0.f};
    bf16x8 At[4][2], B0[2][2], B1[2][2];
    const char* cA = (const char*)g.A + (size_t)cur.pm * tstep; const char* cB = (const char*)g.Bt + (size_t)cur.pn * tstep;
    S.a_ready(cur);
    PG8_STAGE(PG8_SB(0, 0), cB, voffB); PG8_STAGE(PG8_SA(0, 0), cA, voffA); PG8_STAGE(PG8_SB(0, 1), cB + hstep, voffB); PG8_STAGE(PG8_SA(0, 1), cA + hstep, voffA);
    if (wr == 1) PG8_BAR;
    PG8_WAIT_V(4); PG8_BAR;
    PG8_STAGE(PG8_SB(1, 0), cB + kstep, voffB); PG8_STAGE(PG8_SA(1, 0), cA + kstep, voffA); PG8_STAGE(PG8_SB(1, 1), cB + hstep + kstep, voffB);
    PG8_WAIT_V(6); PG8_BAR;
    PG8_STAMP();
    for (;;) {
        const bool has_next = S.next(ui + 1, nxt);
        const char* nA = has_next ? (const char*)g.A + (size_t)nxt.pm * tstep : cA; const char* nB = has_next ? (const char*)g.Bt + (size_t)nxt.pn * tstep : cB;
        for (int t = 0; t < nt; t += 2) {
            const bool last = (t == nt - 2);
            const char* a1 = cA + (size_t)(t + 1) * kstep;
            const char* a2 = last ? nA : cA + (size_t)(t + 2) * kstep; const char* b2 = last ? nB : cB + (size_t)(t + 2) * kstep;
            const char* a3 = a2 + kstep; const char* b3 = b2 + kstep;
            if (last && has_next) S.a_ready(nxt);
            PG8_LDB(B0, 0, 0); PG8_SCHED; PG8_LDA(At, 0, 0); PG8_STAGE(PG8_SA(1, 1), a1 + hstep, voffA);
            PG8_WAIT_L(8); PG8_BAR; PG8_WAIT_L(0); PG8_MMA(0, 0, At, B0); PG8_BAR; PG8_SCHED;
            PG8_LDB(B1, 0, 1); PG8_STAGE(PG8_SB(0, 0), b2, voffB);
            PG8_BAR; PG8_WAIT_L(0); PG8_MMA(0, 1, At, B1); PG8_BAR;
            PG8_LDA(At, 0, 1); PG8_STAGE(PG8_SA(0, 0), a2, voffA);
            PG8_BAR; PG8_WAIT_L(0); PG8_MMA(1, 0, At, B0); PG8_BAR; PG8_SCHED;
            PG8_STAGE(PG8_SB(0, 1), b2 + hstep, voffB);
            PG8_WAIT_V(6); PG8_BAR; PG8_MMA(1, 1, At, B1); PG8_BAR;
            PG8_LDB(B0, 1, 0); PG8_SCHED; PG8_LDA(At, 1, 0); PG8_STAGE(PG8_SA(0, 1), a2 + hstep, voffA);
            PG8_WAIT_L(8); PG8_BAR; PG8_WAIT_L(0); PG8_MMA(0, 0, At, B0); PG8_BAR; PG8_SCHED;
            PG8_LDB(B1, 1, 1); PG8_STAGE(PG8_SB(1, 0), b3, voffB);
            PG8_BAR; PG8_WAIT_L(0); PG8_MMA(0, 1, At, B1); PG8_BAR;
            PG8_LDA(At, 1, 1); PG8_STAGE(PG8_SA(1, 0), a3, voffA);
            PG8_BAR; PG8_WAIT_L(0); PG8_MMA(1, 0, At, B0); PG8_BAR; PG8_SCHED;
            PG8_STAGE(PG8_SB(1, 1), b3 + hstep, voffB);
            PG8_WAIT_V(6); PG8_BAR; PG8_MMA(1, 1, At, B1); PG8_BAR;
        }
        PG8_STAMP();
        if constexpr (!Epi::AFTER_DRAIN) { E(acc, cur, wr, wc, fr, fq); S.done(cur); }
        PG8_STAMP();
        if (!has_next) break;
#pragma unroll
        for (int a = 0; a < 2; ++a)
#pragma unroll
            for (int b = 0; b < 2; ++b)
#pragma unroll
                for (int m = 0; m < 4; ++m)
#pragma unroll
                    for (int n = 0; n < 2; ++n) acc[a][b][m][n] = (f32x4){0.f, 0.f, 0.f, 0.f};
        cur = nxt; cA = nA; cB = nB; ++ui;
    }
    PG8_WAIT_V(0);
    if (wr == 0) PG8_BAR;
    PG8_BAR;
    if constexpr (Epi::AFTER_DRAIN) { E.fused(acc, cur, wr, wc, fr, fq, lds, wid, lane); S.done(cur); }
    PG8_STAMP();
    if (STAMP && wid == 0) { stamps[lane] = lane < nts ? (((unsigned long long)(unsigned)ts_hi << 32) | (unsigned)ts_lo) : 0ull;
        if (lane == 62) stamps[62] = rt_entry; if (lane == 63) stamps[63] = (unsigned long long)wall_clock64(); }
#undef PG8_STAMP
#undef PG8_SA
#undef PG8_SB
#undef PG8_STAGE
#undef PG8_LDA
#undef PG8_LDB
#undef PG8_MMA
#undef PG8_WAIT_V
#undef PG8_WAIT_L
#undef PG8_BAR
#undef PG8_SCHED
}
}
extern __shared__ __attribute__((aligned(16))) unsigned char smem[];

DI void convT_tile(const float* __restrict__ src, int ldsrc, bf16_t* __restrict__ dst, int K, int tile, int ntn, bool inmap) {
    float* t = (float*)smem;
    const int tid = threadIdx.x, tk = tile / ntn, tn = tile % ntn, k0 = tk * 64, n0 = tn * 64;
    __syncthreads();
#pragma unroll
    for (int r = 0; r < 8; ++r) {
        const int i = (tid >> 6) + 8 * r, j = tid & 63, n = n0 + j;
        int sn = n; bool z = false;
        if (inmap) { if (n >= 3104 && n < C_NQ) z = true; else if (n >= C_NQ) sn = n - 224; }
        t[i * 65 + j] = z ? 0.f : src[(size_t)(k0 + i) * ldsrc + sn];
    }
    __syncthreads();
    const int j = tid >> 3, i8 = (tid & 7) * 8;
    u32x4 w;
    w.x = pk2(t[(i8 + 0) * 65 + j], t[(i8 + 1) * 65 + j]); w.y = pk2(t[(i8 + 2) * 65 + j], t[(i8 + 3) * 65 + j]);
    w.z = pk2(t[(i8 + 4) * 65 + j], t[(i8 + 5) * 65 + j]); w.w = pk2(t[(i8 + 6) * 65 + j], t[(i8 + 7) * 65 + j]);
    *(u32x4*)(dst + (size_t)(n0 + j) * K + k0 + i8) = w;
}
DI void phase_convert(const Params& p, int bid, int nb) {
    for (int l = 0; l < DEPTH; ++l) {
        { const int ntn = NP / 64, nt = (DM / 64) * ntn; bf16_t* d = (bf16_t*)(p.ws + OFF_WIN) + (size_t)l * NP * DM;
          for (int t = bid; t < nt; t += nb) convT_tile(p.w_in + (size_t)l * DM * IN_TOTAL, IN_TOTAL, d, DM, t, ntn, true); }
        for (int br = 0; br < 3; ++br) { const float* s = (br == 0 ? p.w_br_a : br == 1 ? p.w_br_b : p.w_br_c) + (size_t)l * 1024 * DM;
          const int ntn = DM / 64, nt = (1024 / 64) * ntn; bf16_t* d = (bf16_t*)(p.ws + OFF_WBR) + ((size_t)l * 3 + br) * DM * 1024;
          for (int t = bid; t < nt; t += nb) convT_tile(s, DM, d, 1024, t, ntn, false); }
        { const int ntn = DM / 64, nt = (DM / 64) * ntn; bf16_t* d = (bf16_t*)(p.ws + OFF_WOUT) + (size_t)l * DM * DM;
          for (int t = bid; t < nt; t += nb) convT_tile(p.w_out + (size_t)l * DM * DM, DM, d, DM, t, ntn, false); }
        { const int ntn = DFF / 64, nt = (DM / 64) * ntn; bf16_t* d = (bf16_t*)(p.ws + OFF_W1) + (size_t)l * DFF * DM;
          for (int t = bid; t < nt; t += nb) convT_tile(p.w_mlp1 + (size_t)l * DM * DFF, DFF, d, DM, t, ntn, false); }
        { const int ntn = DM / 64, nt = (DFF / 64) * ntn; bf16_t* d = (bf16_t*)(p.ws + OFF_W2) + (size_t)l * DM * DFF;
          for (int t = bid; t < nt; t += nb) convT_tile(p.w_mlp2 + (size_t)l * DFF * DM, DM, d, DFF, t, ntn, false); }
    }
}

DI void phase_adaln(const Params& p, int bid, int nb) {
    float* sc = (float*)smem;
    float* red = sc + NCOND * DM;
    const int tid = threadIdx.x;
    __syncthreads();
    for (int i = tid; i < NCOND * DM; i += 512) { const int r = i / DM, k = i % DM; const float v = r == 0 ? p.c_ctx[k] : p.c[(size_t)(r - 1) * DM + k]; sc[i] = v * sigmoidf_(v); }
    __syncthreads();
    const int nun = DEPTH * (NMOD * DM / 64);
    for (int u = bid; u < nun; u += nb) {
        const int l = u / (NMOD * DM / 64), j0 = (u % (NMOD * DM / 64)) * 64, j = tid & 63, ks = tid >> 6;
        const float* w = p.w_mod + (size_t)l * DM * (NMOD * DM) + j0 + j;
        float acc[NCOND];
#pragma unroll
        for (int r = 0; r < NCOND; ++r) acc[r] = 0.f;
        for (int k = ks * 256; k < ks * 256 + 256; ++k) { const float wv = w[(size_t)k * (NMOD * DM)];
#pragma unroll
            for (int r = 0; r < NCOND; ++r) acc[r] += sc[r * DM + k] * wv; }
#pragma unroll
        for (int r = 0; r < NCOND; ++r) red[(ks * NCOND + r) * 64 + j] = acc[r];
        __syncthreads();
        for (int i = tid; i < NCOND * 64; i += 512) { const int r = i / 64, jj = i % 64; float s = p.b_mod[(size_t)l * NMOD * DM + j0 + jj];
#pragma unroll
            for (int q = 0; q < 8; ++q) s += red[(q * NCOND + r) * 64 + jj];
            ((float*)(p.ws + OFF_MOD))[((size_t)l * NCOND + r) * (NMOD * DM) + j0 + jj] = s; }
        __syncthreads();
    }
}

DI void phase_hyena_hid(const Params& p, int bid, int nb) {
    float* zf = (float*)smem;
    float* h1 = zf + 8 * 36;
    const int tid = threadIdx.x, tt = tid >> 6, j = tid & 63;
    const int nun = DEPTH * (256 / 8 + 4096 / 8);
    for (int u = bid; u < nun; u += nb) {
        const int l = u / 544, r = u % 544, ls = r < 32 ? 0 : 1, tb = ls ? r - 32 : r, L = ls ? 4096 : 256, t = tb * 8 + tt;
        const float tn = (float)t / (float)L;
        __syncthreads();
        if (j < 33) { float v; if (j == 0) v = tn; else { const int band = j <= 16 ? j : j - 16; const float ang = 6.283185307179586f * tn * (float)band; v = j <= 16 ? cosf(ang) : sinf(ang); } zf[tt * 36 + j] = v; }
        __syncthreads();
        const float fr = p.hy_freq[l * 64 + j];
        float a = p.hy_f1_b[l * 64 + j];
        for (int i = 0; i < 33; ++i) a += zf[tt * 36 + i] * p.hy_f1_w[((size_t)l * 33 + i) * 64 + j];
        h1[tt * 64 + j] = sinf(fr * a);
        __syncthreads();
        float b = p.hy_f2_b[l * 64 + j];
        for (int i = 0; i < 64; ++i) b += h1[tt * 64 + i] * p.hy_f2_w[((size_t)l * 64 + i) * 64 + j];
        ((float*)(p.ws + OFF_HID))[(((size_t)l * 2 + ls) * 4096 + t) * 64 + j] = sinf(fr * b);
    }
}
DI const float* filt_ptr(const unsigned char* ws, int l, int ls) { return (const float*)(ws + OFF_FILT + (size_t)l * FILT_L) + (ls ? (size_t)2 * 1024 * 256 : 0); }
DI void phase_filters(const Params& p, int bid, int nb) {
    float* f3s = (float*)smem;
    float* red = f3s + 256;
    const int tid = threadIdx.x, lane = tid & 63, wid = tid >> 6;
    const int nun = DEPTH * 2 * 512;
    for (int u = bid; u < nun; u += nb) {
        const int l = u / 1024, ls = (u / 512) & 1, cg = u % 512, L = ls ? 4096 : 256, col0 = cg * 4;
        __syncthreads();
        if (tid < 256) f3s[tid] = p.hy_f3_w[((size_t)l * 64 + (tid >> 2)) * 2048 + col0 + (tid & 3)];
        __syncthreads();
        const float* hid = (const float*)(p.ws + OFF_HID) + ((size_t)l * 2 + ls) * 4096 * 64;
        float val[8][4]; float ss[4] = {0.f, 0.f, 0.f, 0.f};
        float delta[4];
#pragma unroll
        for (int cc = 0; cc < 4; ++cc) { const int c = (col0 + cc) & 1023; const float a = -3.0701134573253943f, b = -15.350567286626972f; delta[cc] = fabsf(a + (b - a) * ((float)c / 1023.0f)); }
#pragma unroll
        for (int i = 0; i < 8; ++i) {
            const int t = tid + 512 * i;
#pragma unroll
            for (int cc = 0; cc < 4; ++cc) val[i][cc] = 0.f;
            if (t < L) {
                const f32x4* hr = (const f32x4*)(hid + (size_t)t * 64);
                float a0 = 0.f, a1 = 0.f, a2 = 0.f, a3 = 0.f;
#pragma unroll
                for (int q = 0; q < 16; ++q) { const f32x4 hv = hr[q];
#pragma unroll
                    for (int e = 0; e < 4; ++e) { const f32x4 w = *(const f32x4*)(f3s + (q * 4 + e) * 4); a0 += hv[e] * w[0]; a1 += hv[e] * w[1]; a2 += hv[e] * w[2]; a3 += hv[e] * w[3]; } }
                const float dist = fabsf((float)t - (float)(L / 2)) * (2.0f / (float)L);
                val[i][0] = a0 * expf(-dist * delta[0]); val[i][1] = a1 * expf(-dist * delta[1]); val[i][2] = a2 * expf(-dist * delta[2]); val[i][3] = a3 * expf(-dist * delta[3]);
#pragma unroll
                for (int cc = 0; cc < 4; ++cc) ss[cc] += val[i][cc] * val[i][cc];
            }
        }
#pragma unroll
        for (int cc = 0; cc < 4; ++cc) { ss[cc] = wave_sum(ss[cc]); if (lane == 0) red[wid * 4 + cc] = ss[cc]; }
        __syncthreads();
        float sc[4];
#pragma unroll
        for (int cc = 0; cc < 4; ++cc) { float s = 0.f;
#pragma unroll
            for (int q = 0; q < 8; ++q) s += red[q * 4 + cc]; sc[cc] = rsqrtf(s + EPS); }
        float* fo = (float*)filt_ptr(p.ws, l, ls);
#pragma unroll
        for (int i = 0; i < 8; ++i) { const int t = tid + 512 * i; if (t < L) {
#pragma unroll
            for (int cc = 0; cc < 4; ++cc) { const int col = col0 + cc; fo[((size_t)(col >> 10) * 1024 + (col & 1023)) * L + t] = val[i][cc] * sc[cc]; } } }
    }
}

DI int cond_row(int grp, int row) { return grp == 0 ? 0 : 1 + 2 * (grp - 1) + (row >> 12); }
DI void phase_norm(const Params& p, const float* x, const float* g, int l, int grp, int shoff, int scoff, int bid, int nb) {
    const int tid = threadIdx.x, lane = tid & 63, wid = tid >> 6;
    bf16_t* h = (bf16_t*)(p.ws + OFF_H);
    for (int row = bid * 8 + wid; row < GT; row += nb * 8) {
        const float* xr = x + (size_t)row * DM;
        f32x4 v[8]; float ss = 0.f;
#pragma unroll
        for (int i = 0; i < 8; ++i) { v[i] = *(const f32x4*)(xr + i * 256 + lane * 4); ss += v[i][0] * v[i][0] + v[i][1] * v[i][1] + v[i][2] * v[i][2] + v[i][3] * v[i][3]; }
        ss = wave_sum(ss);
        const float rs = rsqrtf(ss * (1.0f / DM) + EPS);
        const float* md = (const float*)(p.ws + OFF_MOD) + ((size_t)l * NCOND + cond_row(grp, row)) * (NMOD * DM);
#pragma unroll
        for (int i = 0; i < 8; ++i) { const int c = i * 256 + lane * 4; const f32x4 gv = *(const f32x4*)(g + c), sh = *(const f32x4*)(md + shoff + c), sc = *(const f32x4*)(md + scoff + c);
            f32x4 o = v[i] * rs * gv * (sc + 1.0f) + sh; u32x2 w; w.x = pk2(o[0], o[1]); w.y = pk2(o[2], o[3]); *(u32x2*)(h + (size_t)row * DM + c) = w; }
    }
}
using pg8::Unit; using pg8::cvt_pk_bf16;
template <int ACT> struct EpiStoreBf16 {
    static constexpr bool PERM = true, AFTER_DRAIN = false;
    bf16_t* O; int ldc; int pad;
    __device__ __forceinline__ void operator()(const f32x4 (&acc)[2][2][4][2], const Unit& u, int wr, int wc, int fr, int fq) const {
        const int row0 = u.pm * 256 + wr * 64 + fr, col0 = u.pn * 256 + wc * 32 + 8 * fq;
#pragma unroll
        for (int ai = 0; ai < 2; ++ai)
#pragma unroll
            for (int m = 0; m < 4; ++m) { bf16_t* rowp = O + (size_t)(row0 + ai * 128 + m * 16) * ldc + col0;
#pragma unroll
                for (int bj = 0; bj < 2; ++bj) { f32x4 v0 = acc[ai][bj][m][0], v1 = acc[ai][bj][m][1];
                    if (ACT == 1) {
#pragma unroll
                        for (int j = 0; j < 4; ++j) { const float a = fmaxf(v0[j], 0.f), b = fmaxf(v1[j], 0.f); v0[j] = a * a; v1[j] = b * b; } }
                    u32x4 w; w.x = cvt_pk_bf16(v0[0], v0[1]); w.y = cvt_pk_bf16(v0[2], v0[3]); w.z = cvt_pk_bf16(v1[0], v1[1]); w.w = cvt_pk_bf16(v1[2], v1[3]);
                    *(u32x4*)(rowp + bj * 128) = w; } }
    }
};
template <int MODE> struct EpiGate {
    static constexpr bool PERM = true, AFTER_DRAIN = false;
    const bf16_t* gate; float* m32; bf16_t* mbf; int ldg; int pad;
    __device__ __forceinline__ void operator()(const f32x4 (&acc)[2][2][4][2], const Unit& u, int wr, int wc, int fr, int fq) const {
        const int row0 = u.pm * 256 + wr * 64 + fr, col0 = u.pn * 256 + wc * 32 + 8 * fq;
#pragma unroll
        for (int ai = 0; ai < 2; ++ai)
#pragma unroll
            for (int m = 0; m < 4; ++m) { const size_t row = (size_t)(row0 + ai * 128 + m * 16);
#pragma unroll
                for (int bj = 0; bj < 2; ++bj) { const int col = col0 + bj * 128;
                    const u32x4 gw = *(const u32x4*)(gate + row * ldg + col);
                    f32x4 s0, s1;
                    s0[0] = sigmoidf_(bflo(gw.x)); s0[1] = sigmoidf_(bfhi(gw.x)); s0[2] = sigmoidf_(bflo(gw.y)); s0[3] = sigmoidf_(bfhi(gw.y));
                    s1[0] = sigmoidf_(bflo(gw.z)); s1[1] = sigmoidf_(bfhi(gw.z)); s1[2] = sigmoidf_(bflo(gw.w)); s1[3] = sigmoidf_(bfhi(gw.w));
                    f32x4 v0 = acc[ai][bj][m][0] * s0, v1 = acc[ai][bj][m][1] * s1;
                    float* mp = m32 + row * DM + col;
                    if (MODE >= 1) { v0 += *(const f32x4*)mp; v1 += *(const f32x4*)(mp + 4); }
                    if (MODE <= 1) { *(f32x4*)mp = v0; *(f32x4*)(mp + 4) = v1; }
                    else { u32x4 w; w.x = cvt_pk_bf16(v0[0], v0[1]); w.y = cvt_pk_bf16(v0[2], v0[3]); w.z = cvt_pk_bf16(v1[0], v1[1]); w.w = cvt_pk_bf16(v1[2], v1[3]);
                           *(u32x4*)(mbf + row * DM + col) = w; } } }
    }
};
struct EpiResid {
    static constexpr bool PERM = true, AFTER_DRAIN = false;
    const float* xin; float* xout; const float* gA; const float* gB;
    __device__ __forceinline__ void operator()(const f32x4 (&acc)[2][2][4][2], const Unit& u, int wr, int wc, int fr, int fq) const {
        const int row0 = u.pm * 256 + wr * 64 + fr, col0 = u.pn * 256 + wc * 32 + 8 * fq;
        const float* gv = (u.pm * 256 < 4096) ? gA : gB;
#pragma unroll
        for (int bj = 0; bj < 2; ++bj) { const int col = col0 + bj * 128; const f32x4 g0 = *(const f32x4*)(gv + col), g1 = *(const f32x4*)(gv + col + 4);
#pragma unroll
            for (int ai = 0; ai < 2; ++ai)
#pragma unroll
                for (int m = 0; m < 4; ++m) { const size_t o = (size_t)(row0 + ai * 128 + m * 16) * DM + col;
                    const f32x4 a0 = *(const f32x4*)(xin + o), a1 = *(const f32x4*)(xin + o + 4);
                    *(f32x4*)(xout + o) = a0 + g0 * acc[ai][bj][m][0]; *(f32x4*)(xout + o + 4) = a1 + g1 * acc[ai][bj][m][1]; } }
    }
};

struct GrpInfo { int grp, l, L, nseq, latent; };
DI GrpInfo grp_info(int grp, int l) { GrpInfo g; g.grp = grp; g.l = l; g.latent = grp > 0; g.L = grp ? 4096 : 256; g.nseq = grp ? 2 : 32; return g; }

DI void phase_na_prep(const Params& p, GrpInfo gi, int bid, int nb) {
    const int tid = threadIdx.x, lane = tid & 63, wid = tid >> 6;
    const bf16_t* P = (const bf16_t*)(p.ws + OFF_P);
    bf16_t* QN = (bf16_t*)(p.ws + OFF_QN); bf16_t* KN = (bf16_t*)(p.ws + OFF_KN);
    const float gq0 = p.na_qnorm_g[gi.l * 128 + 2 * lane], gq1 = p.na_qnorm_g[gi.l * 128 + 2 * lane + 1];
    const float gk0 = p.na_knorm_g[gi.l * 128 + 2 * lane], gk1 = p.na_knorm_g[gi.l * 128 + 2 * lane + 1];
    for (int u = bid * 8 + wid; u < GT * 8; u += nb * 8) {
        const int row = u >> 3, h = u & 7;
        const unsigned qw = *(const unsigned*)(P + (size_t)row * NP + C_NQ + h * 128 + 2 * lane);
        const unsigned kw = *(const unsigned*)(P + (size_t)row * NP + C_NK + h * 128 + 2 * lane);
        const float q0 = bflo(qw), q1 = bfhi(qw), k0 = bflo(kw), k1 = bfhi(kw);
        const float qs = rsqrtf(wave_sum(q0 * q0 + q1 * q1) * (1.0f / 128) + EPS), ks = rsqrtf(wave_sum(k0 * k0 + k1 * k1) * (1.0f / 128) + EPS);
        const float a0 = q0 * qs * gq0, a1 = q1 * qs * gq1, b0 = k0 * ks * gk0, b1 = k1 * ks * gk1;
        *(unsigned*)(QN + (size_t)row * 1024 + h * 128 + 2 * lane) = pk2(a0, a1);
        *(unsigned*)(KN + (size_t)row * 1024 + h * 128 + 2 * lane) = pk2(b0, b1);
        if (!gi.latent) { const int b = row >> 8, t = row & 255; const size_t o = ((((size_t)b * DEPTH + gi.l) * 8 + h) * 256 + t) * 128 + 2 * lane;
            const unsigned vw = *(const unsigned*)(P + (size_t)row * NP + C_NV + h * 128 + 2 * lane);
            *(f32x2*)(p.out + OUT_CK + o) = (f32x2){b0, b1}; *(f32x2*)(p.out + OUT_CV + o) = (f32x2){bflo(vw), bfhi(vw)}; }
    }
}
DI void phase_na_naive(const Params& p, GrpInfo gi, int bid, int nb) {
    const int tid = threadIdx.x, lane = tid & 63, wid = tid >> 6;
    float* qs = (float*)smem + wid * 512;
    float* ps = qs + 128;
    const bf16_t* P = (const bf16_t*)(p.ws + OFF_P);
    const bf16_t* QN = (const bf16_t*)(p.ws + OFF_QN); const bf16_t* KN = (const bf16_t*)(p.ws + OFF_KN);
    bf16_t* OB = (bf16_t*)(p.ws + OFF_OABC) + (size_t)GT * 1024;
    const float scale = 0.08838834764831845f;
    for (int u = bid * 8 + wid; u < GT * 8; u += nb * 8) {
        const int row = u >> 3, h = u & 7;
        { const unsigned qw = *(const unsigned*)(QN + (size_t)row * 1024 + h * 128 + 2 * lane); qs[2 * lane] = bflo(qw); qs[2 * lane + 1] = bfhi(qw); }
        asm volatile("s_waitcnt lgkmcnt(0)" ::: "memory");
        const int nkeys = gi.latent ? 384 : 256;
        const int sl = gi.latent ? (row >> 12) : (row >> 8), t = gi.latent ? (row & 4095) : (row & 255);
        const int r = t >> 6, c = t & 63, rs = min(max(r - 4, 0), 56), cs = min(max(c - 8, 0), 48);
        const int bs = 2 * (gi.grp - 1) + sl;
        float mx = -3.0e38f;
#pragma unroll 1
        for (int s = 0; s < 6; ++s) {
            const int kk = s * 64 + lane;
            if (kk < nkeys) {
                float dot = 0.f; float bias = 0.f;
                if (gi.latent && kk >= 128) { const float* kp = p.cache_k + ((((size_t)bs * DEPTH + gi.l) * 8 + h) * 256 + (kk - 128)) * 128;
#pragma unroll 4
                    for (int d = 0; d < 128; d += 4) { const f32x4 kv = *(const f32x4*)(kp + d); const f32x4 qv = *(const f32x4*)(qs + d); dot += kv[0] * qv[0] + kv[1] * qv[1] + kv[2] * qv[2] + kv[3] * qv[3]; } }
                else { int krow;
                    if (gi.latent) { const int i = kk >> 4, j = kk & 15; krow = sl * 4096 + (rs + i) * 64 + cs + j;
                        bias = p.na_rpb[(((size_t)gi.l * 8 + h) * 15 + (rs + i - r + 7)) * 31 + min(max(cs + j - c + 15, 0), 30)]; }
                    else krow = sl * 256 + kk;
                    const bf16_t* kp = KN + (size_t)krow * 1024 + h * 128;
#pragma unroll 4
                    for (int d = 0; d < 128; d += 8) { const u32x4 kw = *(const u32x4*)(kp + d); const f32x4 qa = *(const f32x4*)(qs + d), qb = *(const f32x4*)(qs + d + 4);
                        dot += bflo(kw.x) * qa[0] + bfhi(kw.x) * qa[1] + bflo(kw.y) * qa[2] + bfhi(kw.y) * qa[3] + bflo(kw.z) * qb[0] + bfhi(kw.z) * qb[1] + bflo(kw.w) * qb[2] + bfhi(kw.w) * qb[3]; } }
                const float sc = dot * scale + bias; mx = fmaxf(mx, sc); ps[kk] = sc;
            }
        }
        mx = wave_max(mx);
        float sum = 0.f;
#pragma unroll 1
        for (int s = 0; s < 6; ++s) { const int kk = s * 64 + lane; if (kk < nkeys) { const float e = __expf(ps[kk] - mx); ps[kk] = e; sum += e; } }
        sum = wave_sum(sum); const float inv = 1.0f / sum;
        asm volatile("s_waitcnt lgkmcnt(0)" ::: "memory");
        float o0 = 0.f, o1 = 0.f;
        for (int kk = 0; kk < nkeys; ++kk) {
            const float pv = ps[kk]; float v0, v1;
            if (gi.latent && kk >= 128) { const f32x2 vv = *(const f32x2*)(p.cache_v + ((((size_t)bs * DEPTH + gi.l) * 8 + h) * 256 + (kk - 128)) * 128 + 2 * lane); v0 = vv[0]; v1 = vv[1]; }
            else { const int krow = gi.latent ? sl * 4096 + (rs + (kk >> 4)) * 64 + cs + (kk & 15) : sl * 256 + kk;
                const unsigned vw = *(const unsigned*)(P + (size_t)krow * NP + C_NV + h * 128 + 2 * lane); v0 = bflo(vw); v1 = bfhi(vw); }
            o0 += pv * v0; o1 += pv * v1;
        }
        *(unsigned*)(OB + (size_t)row * 1024 + h * 128 + 2 * lane) = pk2(o0 * inv, o1 * inv);
        asm volatile("s_waitcnt lgkmcnt(0)" ::: "memory");
    }
}

DI float log_sigmoid_(float x) { return fminf(x, 0.f) - log1pf(expf(-fabsf(x))); }
DI void phase_gla_naive(const Params& p, GrpInfo gi, int bid, int nb) {
    const int tid = threadIdx.x, e = tid & 255, dh = tid >> 8, L = gi.L;
    float* qs = (float*)smem; float* ks = qs + 16 * 128; float* as_ = ks + 16 * 128; float* vs = as_ + 16 * 128; float* op = vs + 16 * 256;
    const bf16_t* P = (const bf16_t*)(p.ws + OFF_P);
    for (int u = bid; u < gi.nseq * 8; u += nb) {
        const int sl = u >> 3, h = (u >> 1) & 3, dir = u & 1;
        float* O = (float*)(p.ws + (dir ? OFF_OB : OFF_OF));
        float S[64];
        if (gi.latent) { const int bs = 2 * (gi.grp - 1) + sl; const float* s0 = p.state_gla + (((((size_t)bs * DEPTH + gi.l) * 2 + dir) * 4 + h) * 128 + dh * 64) * 256 + e;
#pragma unroll
            for (int j = 0; j < 64; ++j) S[j] = s0[(size_t)j * 256]; }
        else {
#pragma unroll
            for (int j = 0; j < 64; ++j) S[j] = 0.f; }
        const float* wa = p.gla_wa2 + (((size_t)gi.l * 2 + dir) * 16) * 512 + h * 128;
        const float* ba = p.gla_ba2 + ((size_t)gi.l * 2 + dir) * 512 + h * 128;
        for (int bt = 0; bt < L / 16; ++bt) {
            __syncthreads();
#pragma unroll
            for (int i = 0; i < 4; ++i) {
                const int idx = tid + 512 * i, tt = idx >> 7, d = idx & 127, ts = bt * 16 + tt, t = dir ? L - 1 - ts : ts, row = sl * L + t;
                const bf16_t* pr = P + (size_t)row * NP;
                float q = bf2f(pr[C_GQ + h * 128 + d]) * 0.08838834764831845f, k = bf2f(pr[C_GK + h * 128 + d]);
                if (gi.latent) {
                    const float q2 = bf2f(pr[C_GQ + h * 128 + (d ^ 64)]) * 0.08838834764831845f, k2 = bf2f(pr[C_GK + h * 128 + (d ^ 64)]);
                    const int ii = d & 63, f = ii & 31; const float pos = (float)(ii < 32 ? (t >> 6) : (t & 63));
                    const float ang = pos * powf(10000.0f, -(float)f / 32.0f); float sn, cs; sincosf(ang, &sn, &cs);
                    if (d < 64) { q = q * cs - q2 * sn; k = k * cs - k2 * sn; } else { q = q2 * sn + q * cs; k = k2 * sn + k * cs; }
                }
                float xg = ba[d];
#pragma unroll
                for (int r = 0; r < 16; ++r) xg += bf2f(pr[C_GA + dir * 16 + r]) * wa[(size_t)r * 512 + d];
                qs[tt * 128 + d] = q; ks[tt * 128 + d] = k; as_[tt * 128 + d] = expf(log_sigmoid_(xg) * (1.0f / 16.0f));
            }
#pragma unroll
            for (int i = 0; i < 8; ++i) { const int idx = tid + 512 * i, tt = idx >> 8, ee = idx & 255, ts = bt * 16 + tt, t = dir ? L - 1 - ts : ts, row = sl * L + t;
                vs[tt * 256 + ee] = bf2f(P[(size_t)row * NP + C_GV + h * 256 + ee]); }
            __syncthreads();
            for (int tt = 0; tt < 16; ++tt) {
                const float v = vs[tt * 256 + e]; float acc = 0.f;
#pragma unroll
                for (int j4 = 0; j4 < 16; ++j4) {
                    const f32x4 a4 = *(const f32x4*)(as_ + tt * 128 + dh * 64 + j4 * 4), k4 = *(const f32x4*)(ks + tt * 128 + dh * 64 + j4 * 4), q4 = *(const f32x4*)(qs + tt * 128 + dh * 64 + j4 * 4);
#pragma unroll
                    for (int jj = 0; jj < 4; ++jj) { const int j = j4 * 4 + jj; S[j] = a4[jj] * S[j] + k4[jj] * v; acc += q4[jj] * S[j]; }
                }
                op[(tt * 2 + dh) * 256 + e] = acc;
            }
            __syncthreads();
#pragma unroll
            for (int i = 0; i < 8; ++i) { const int idx = tid + 512 * i, tt = idx >> 8, ee = idx & 255, ts = bt * 16 + tt, t = dir ? L - 1 - ts : ts, row = sl * L + t;
                O[(size_t)row * 1024 + h * 256 + ee] = op[(tt * 2) * 256 + ee] + op[(tt * 2 + 1) * 256 + ee]; }
        }
        if (!gi.latent) { float* so = p.out + OUT_ST + (((((size_t)sl * DEPTH + gi.l) * 2 + dir) * 4 + h) * 128 + dh * 64) * 256 + e;
#pragma unroll
            for (int j = 0; j < 64; ++j) so[(size_t)j * 256] = S[j]; }
    }
}
DI void phase_gla_post(const Params& p, GrpInfo gi, int bid, int nb) {
    const int tid = threadIdx.x, lane = tid & 63, wid = tid >> 6;
    const bf16_t* P = (const bf16_t*)(p.ws + OFF_P);
    const float* Of = (const float*)(p.ws + OFF_OF); const float* Ob = (const float*)(p.ws + OFF_OB);
    bf16_t* OA = (bf16_t*)(p.ws + OFF_OABC);
    const f32x4 g = *(const f32x4*)(p.gla_norm_g + gi.l * 256 + lane * 4);
    for (int u = bid * 8 + wid; u < GT * 4; u += nb * 8) {
        const int row = u >> 2, h = u & 3; const size_t o = (size_t)row * 1024 + h * 256 + lane * 4;
        const f32x4 v = *(const f32x4*)(Of + o) + *(const f32x4*)(Ob + o);
        const float rs = rsqrtf(wave_sum(v[0] * v[0] + v[1] * v[1] + v[2] * v[2] + v[3] * v[3]) * (1.0f / 256) + EPS);
        const u32x2 gw = *(const u32x2*)(P + (size_t)row * NP + C_GG + h * 256 + lane * 4);
        const float g0 = bflo(gw.x), g1 = bfhi(gw.x), g2 = bflo(gw.y), g3 = bfhi(gw.y);
        u32x2 w; w.x = pk2(v[0] * rs * g[0] * (g0 * sigmoidf_(g0)), v[1] * rs * g[1] * (g1 * sigmoidf_(g1)));
        w.y = pk2(v[2] * rs * g[2] * (g2 * sigmoidf_(g2)), v[3] * rs * g[3] * (g3 * sigmoidf_(g3)));
        *(u32x2*)(OA + o) = w;
    }
}

DI void phase_hyena_naive(const Params& p, GrpInfo gi, int bid, int nb) {
    const int tid = threadIdx.x, L = gi.L, TPC = L / 8, CH = 4096 / L, ci = tid / TPC, tg = tid % TPC, t0 = tg * 8;
    float* z = (float*)smem;
    float* hp = z + 4096;
    const bf16_t* P = (const bf16_t*)(p.ws + OFF_P);
    bf16_t* OC = (bf16_t*)(p.ws + OFF_OABC) + (size_t)2 * GT * 1024;
    const int nun = gi.nseq * (1024 / CH);
    for (int u = bid; u < nun; u += nb) {
        const int sl = u / (1024 / CH), c = (u % (1024 / CH)) * CH + ci;
        float x1[8], x2[8], zr[8], cv[8];
        const float* cw = p.hy_conv_w + (size_t)gi.l * 3 * 3072; const float* cb = p.hy_conv_b + (size_t)gi.l * 3072;
        __syncthreads();
#pragma unroll
        for (int i = 0; i < 8; ++i) {
            const int t = t0 + i; const size_t rb = (size_t)(sl * L + t) * NP + C_HY;
            float r[3];
#pragma unroll
            for (int part = 0; part < 3; ++part) { const int j = part * 1024 + c;
                const float um = t > 0 ? bf2f(P[rb - NP + j]) : 0.f, u0 = bf2f(P[rb + j]), up = t < L - 1 ? bf2f(P[rb + NP + j]) : 0.f;
                r[part] = cb[j] + cw[j] * um + cw[3072 + j] * u0 + cw[2 * 3072 + j] * up; }
            x1[i] = r[0]; x2[i] = r[1]; zr[i] = r[2]; z[ci * L + t] = r[2];
        }
#pragma unroll
        for (int o = 0; o < 2; ++o) {
            const float* f = filt_ptr(p.ws, gi.l, gi.latent ? 1 : 0) + ((size_t)o * 1024 + c) * L;
#pragma unroll
            for (int i = 0; i < 8; ++i) { hp[ci * 2 * L + L / 2 + t0 + i] = f[t0 + i]; const int zi = t0 + i; hp[ci * 2 * L + (zi < L / 2 ? zi : L + zi)] = 0.f; }
            __syncthreads();
#pragma unroll
            for (int i = 0; i < 8; ++i) cv[i] = 0.f;
            const float* hb = hp + ci * 2 * L; const float* zb = z + ci * L;
            f32x4 hi0 = *(const f32x4*)(hb + t0 + L), hi1 = *(const f32x4*)(hb + t0 + L + 4);
            for (int s = 0; s < L; s += 8) {
                const int idx0 = t0 + L - s;
                const f32x4 lo0 = *(const f32x4*)(hb + idx0 - 8), lo1 = *(const f32x4*)(hb + idx0 - 4);
                const f32x4 z0 = *(const f32x4*)(zb + s), z1 = *(const f32x4*)(zb + s + 4);
                const float hbuf[16] = {lo0[0], lo0[1], lo0[2], lo0[3], lo1[0], lo1[1], lo1[2], lo1[3], hi0[0], hi0[1], hi0[2], hi0[3], hi1[0], hi1[1], hi1[2], hi1[3]};
                const float zz[8] = {z0[0], z0[1], z0[2], z0[3], z1[0], z1[1], z1[2], z1[3]};
#pragma unroll
                for (int ss = 0; ss < 8; ++ss)
#pragma unroll
                    for (int i = 0; i < 8; ++i) cv[i] += zz[ss] * hbuf[8 - ss + i];
                hi0 = lo0; hi1 = lo1;
            }
            const float bo = p.hy_bias[((size_t)gi.l * 2 + o) * 1024 + c];
            __syncthreads();
            if (o == 0) {
#pragma unroll
                for (int i = 0; i < 8; ++i) { zr[i] = x1[i] * (cv[i] + bo * zr[i]); z[ci * L + t0 + i] = zr[i]; }
            } else {
#pragma unroll
                for (int i = 0; i < 8; ++i) OC[(size_t)(sl * L + t0 + i) * 1024 + c] = f2bf(x2[i] * (cv[i] + bo * zr[i]));
            }
        }
    }
}
#define LAS3 __attribute__((address_space(3)))
constexpr int LDS_BYTES = 131072;
enum { PH_CONVERT = 0, PH_ADALN, PH_HID, PH_FILT, PH_NORM1, PH_NORM2, PH_NAPREP, PH_NA, PH_GLA, PH_GLAPOST, PH_HYENA };

DI const float* x_in_ptr(const Params& p, int grp, int l) {
    if (l == 0) return grp == 0 ? p.x_prompt : p.x_sample + (size_t)(grp - 1) * GT * DM;
    return grp == 0 ? p.out + OUT_YP : p.out + OUT_YS + (size_t)(grp - 1) * GT * DM;
}
DI float* x_out_ptr(const Params& p, int grp) { return grp == 0 ? p.out + OUT_YP : p.out + OUT_YS + (size_t)(grp - 1) * GT * DM; }

template <int PH> __global__ __launch_bounds__(512, 2) void k_ph(Params p, int grp, int l) {
    const int bid = blockIdx.x, nb = gridDim.x;
    const GrpInfo gi = grp_info(grp, l);
    if (PH == PH_CONVERT) phase_convert(p, bid, nb);
    if (PH == PH_ADALN) phase_adaln(p, bid, nb);
    if (PH == PH_HID) phase_hyena_hid(p, bid, nb);
    if (PH == PH_FILT) phase_filters(p, bid, nb);
    if (PH == PH_NORM1) phase_norm(p, x_in_ptr(p, grp, l), p.norm1_g + l * DM, l, grp, 0, DM, bid, nb);
    if (PH == PH_NORM2) phase_norm(p, x_out_ptr(p, grp), p.norm2_g + l * DM, l, grp, 3 * DM, 4 * DM, bid, nb);
    if (PH == PH_NAPREP) phase_na_prep(p, gi, bid, nb);
    if (PH == PH_NA) phase_na_naive(p, gi, bid, nb);
    if (PH == PH_GLA) phase_gla_naive(p, gi, bid, nb);
    if (PH == PH_GLAPOST) phase_gla_post(p, gi, bid, nb);
    if (PH == PH_HYENA) phase_hyena_naive(p, gi, bid, nb);
}
template <class Epi> __global__ __launch_bounds__(512, 2) void k_gemm(pg8::Gemm g, Epi E) {
    pg8::StaticOrder S; S.init(g.M, g.N, (int)gridDim.x, (int)blockIdx.x);
    pg8::gemm_phase<Epi, pg8::StaticOrder, false>((LAS3 unsigned char*)smem, g, S, E, nullptr);
}

template <int PH> static void launch_ph(const Params& p, int grp, int l, hipStream_t st) {
    (void)hipFuncSetAttribute((const void*)k_ph<PH>, hipFuncAttributeMaxDynamicSharedMemorySize, LDS_BYTES);
    hipLaunchKernelGGL((k_ph<PH>), dim3(256), dim3(512), LDS_BYTES, st, p, grp, l);
}
template <class Epi> static void launch_gemm(const pg8::Gemm& g, const Epi& E, hipStream_t st) {
    (void)hipFuncSetAttribute((const void*)k_gemm<Epi>, hipFuncAttributeMaxDynamicSharedMemorySize, LDS_BYTES);
    hipLaunchKernelGGL((k_gemm<Epi>), dim3(256), dim3(512), LDS_BYTES, st, g, E);
}

extern "C" void kernel_launch(void* const* d_in, const int* in_sizes, int n_in, void* d_out, int out_size, void* d_ws, size_t ws_size, hipStream_t stream) {
    Params p{};
    const float** f = (const float**)&p;
    for (int i = 0; i < 33; ++i) f[i] = (const float*)d_in[i];
    p.out = (float*)d_out; p.ws = (unsigned char*)d_ws;
    if (ws_size < WS_END) { fprintf(stderr, "workspace too small: %zu < %zu\n", ws_size, (size_t)WS_END); return; }
    unsigned char* ws = p.ws;
    launch_ph<PH_CONVERT>(p, 0, 0, stream);
    launch_ph<PH_ADALN>(p, 0, 0, stream);
    launch_ph<PH_HID>(p, 0, 0, stream);
    launch_ph<PH_FILT>(p, 0, 0, stream);
    const float* mod = (const float*)(ws + OFF_MOD);
    for (int l = 0; l < DEPTH; ++l) for (int grp = 0; grp < NGRP; ++grp) {
        const float* xin = (l == 0) ? (grp == 0 ? p.x_prompt : p.x_sample + (size_t)(grp - 1) * GT * DM) : (grp == 0 ? p.out + OUT_YP : p.out + OUT_YS + (size_t)(grp - 1) * GT * DM);
        float* xout = grp == 0 ? p.out + OUT_YP : p.out + OUT_YS + (size_t)(grp - 1) * GT * DM;
        const int crA = grp == 0 ? 0 : 1 + 2 * (grp - 1), crB = grp == 0 ? 0 : crA + 1;
        const float* mA = mod + ((size_t)l * NCOND + crA) * (NMOD * DM); const float* mB = mod + ((size_t)l * NCOND + crB) * (NMOD * DM);
        bf16_t* H = (bf16_t*)(ws + OFF_H); bf16_t* P = (bf16_t*)(ws + OFF_P); bf16_t* OABC = (bf16_t*)(ws + OFF_OABC); bf16_t* MBF = (bf16_t*)(ws + OFF_MBF); float* M32 = (float*)(ws + OFF_M32);
        launch_ph<PH_NORM1>(p, grp, l, stream);
        launch_gemm(pg8::Gemm{H, (const bf16_t*)(ws + OFF_WIN) + (size_t)l * NP * DM, GT, NP, DM, 0}, EpiStoreBf16<0>{P, NP, 0}, stream);
        launch_ph<PH_NAPREP>(p, grp, l, stream);
        launch_ph<PH_NA>(p, grp, l, stream);
        launch_ph<PH_GLA>(p, grp, l, stream);
        launch_ph<PH_GLAPOST>(p, grp, l, stream);
        launch_ph<PH_HYENA>(p, grp, l, stream);
        const bf16_t* wbr = (const bf16_t*)(ws + OFF_WBR) + (size_t)l * 3 * DM * 1024;
        launch_gemm(pg8::Gemm{OABC, wbr, GT, DM, 1024, 0}, EpiGate<0>{P + C_GATE, M32, MBF, NP, 0}, stream);
        launch_gemm(pg8::Gemm{OABC + (size_t)GT * 1024, wbr + (size_t)DM * 1024, GT, DM, 1024, 0}, EpiGate<1>{P + C_GATE + DM, M32, MBF, NP, 0}, stream);
        launch_gemm(pg8::Gemm{OABC + (size_t)2 * GT * 1024, wbr + (size_t)2 * DM * 1024, GT, DM, 1024, 0}, EpiGate<2>{P + C_GATE + 2 * DM, M32, MBF, NP, 0}, stream);
        launch_gemm(pg8::Gemm{MBF, (const bf16_t*)(ws + OFF_WOUT) + (size_t)l * DM * DM, GT, DM, DM, 0}, EpiResid{xin, xout, mA + 2 * DM, mB + 2 * DM}, stream);
        launch_ph<PH_NORM2>(p, grp, l, stream);
        launch_gemm(pg8::Gemm{H, (const bf16_t*)(ws + OFF_W1) + (size_t)l * DFF * DM, GT, DFF, DM, 0}, EpiStoreBf16<1>{P, DFF, 0}, stream);
        launch_gemm(pg8::Gemm{P, (const bf16_t*)(ws + OFF_W2) + (size_t)l * DM * DFF, GT, DM, DFF, 0}, EpiResid{xout, xout, mA + 5 * DM, mB + 5 * DM}, stream);
    }
}
```

```cpp
#include <hip/hip_runtime.h>
#include <stdint.h>
#include <stdio.h>

constexpr int DM = 2048, DFF = 8192, NMOD = 6, NCOND = 9;
constexpr int GT = 8192;
constexpr int NGRP = 5, DEPTH = 2;
constexpr int C_GQ = 0, C_GK = 512, C_GV = 1024, C_GG = 2048, C_GA = 3072, C_NQ = 3328, C_NK = 4352, C_NV = 5376, C_HY = 6400, C_GATE = 9472, NP = 15616;
constexpr int IN_TOTAL = 15392;
constexpr float EPS = 1e-6f;

typedef unsigned short bf16_t;
typedef float f32x4 __attribute__((ext_vector_type(4)));
typedef float f32x2 __attribute__((ext_vector_type(2)));
typedef unsigned u32x4 __attribute__((ext_vector_type(4)));
typedef unsigned u32x2 __attribute__((ext_vector_type(2)));
#define DI __device__ __forceinline__

DI int ltid() { int t = threadIdx.x; asm volatile("" : "+v"(t)); return t; }
DI float bf2f(bf16_t b) { return __uint_as_float(((unsigned)b) << 16); }
DI float bflo(unsigned w) { return __uint_as_float(w << 16); }
DI float bfhi(unsigned w) { return __uint_as_float(w & 0xffff0000u); }
DI bf16_t f2bf(float f) { unsigned u = __float_as_uint(f); u += 0x7FFFu + ((u >> 16) & 1u); return (bf16_t)(u >> 16); }
DI unsigned pk2(float lo, float hi) { return (unsigned)f2bf(lo) | ((unsigned)f2bf(hi) << 16); }
DI float sigmoidf_(float x) { return 1.0f / (1.0f + __expf(-x)); }
DI float wave_sum(float v) { for (int o = 32; o >= 1; o >>= 1) v += __shfl_xor(v, o); return v; }
DI float wave_max(float v) { for (int o = 32; o >= 1; o >>= 1) v = fmaxf(v, __shfl_xor(v, o)); return v; }

constexpr size_t al256(size_t x) { return (x + 255) & ~(size_t)255; }
constexpr size_t OFF_BAR  = 0;
constexpr size_t OFF_MOD  = 65536;
constexpr size_t OFF_HID  = OFF_MOD  + al256((size_t)DEPTH * NCOND * 12288 * 4);
constexpr size_t OFF_FILT = OFF_HID  + (size_t)DEPTH * 2 * 4096 * 64 * 4;
constexpr size_t FILT_L   = (size_t)2 * 1024 * (256 + 4096) * 4;
constexpr size_t OFF_WIN  = OFF_FILT + DEPTH * FILT_L;
constexpr size_t OFF_WBR  = OFF_WIN  + (size_t)DEPTH * NP * DM * 2;
constexpr size_t OFF_WOUT = OFF_WBR  + (size_t)DEPTH * 3 * DM * 1024 * 2;
constexpr size_t OFF_W1   = OFF_WOUT + (size_t)DEPTH * DM * DM * 2;
constexpr size_t OFF_W2   = OFF_W1   + (size_t)DEPTH * DFF * DM * 2;
constexpr size_t OFF_H    = OFF_W2   + (size_t)DEPTH * DFF * DM * 2;
constexpr size_t OFF_P    = OFF_H    + (size_t)GT * DM * 2;
constexpr size_t OFF_OF   = OFF_P    + (size_t)GT * NP * 2;
constexpr size_t OFF_OB   = OFF_OF   + (size_t)GT * 1024 * 4;
constexpr size_t OFF_OABC = OFF_OB   + (size_t)GT * 1024 * 4;
constexpr size_t OFF_M32  = OFF_OABC + (size_t)3 * GT * 1024 * 2;
constexpr size_t OFF_MBF  = OFF_M32  + (size_t)GT * DM * 4;
constexpr size_t OFF_QN   = OFF_MBF  + (size_t)GT * DM * 2;
constexpr size_t OFF_KN   = OFF_QN   + (size_t)GT * 1024 * 2;
constexpr size_t WS_END   = OFF_KN   + (size_t)GT * 1024 * 2;
static_assert(WS_END < (size_t)1190000000, "workspace too large");

constexpr size_t OUT_YP = 0, OUT_YS = (size_t)32 * 256 * DM, OUT_ST = OUT_YS + (size_t)8 * 4096 * DM,
                 OUT_CK = OUT_ST + (size_t)32 * 2 * 2 * 4 * 128 * 256, OUT_CV = OUT_CK + (size_t)32 * 2 * 8 * 256 * 128;

struct Params {
    const float *x_prompt, *x_sample, *state_gla, *cache_k, *cache_v, *c, *c_ctx, *w_mod, *b_mod, *norm1_g, *norm2_g, *w_in, *gla_wa2, *gla_ba2, *gla_norm_g,
                *na_qnorm_g, *na_knorm_g, *na_rpb, *hy_conv_w, *hy_conv_b, *hy_f1_w, *hy_f1_b, *hy_f2_w, *hy_f2_b, *hy_f3_w, *hy_freq, *hy_bias,
                *w_br_a, *w_br_b, *w_br_c, *w_out, *w_mlp1, *w_mlp2;
    float* out; unsigned char* ws;
};
namespace pg8 {
#define PG8_LAS __attribute__((address_space(3)))
typedef unsigned short bf16_t;
typedef short bf16x8 __attribute__((ext_vector_type(8)));
typedef float f32x4 __attribute__((ext_vector_type(4)));
typedef unsigned u32x4 __attribute__((ext_vector_type(4)));
constexpr int BM = 256, BK = 64, HALF = 128, HTB = HALF * BK * 2  , STAGE_BYTES = 8 * HTB, NXCD = 8, WGM = 8;
__host__ __device__ __forceinline__ int lds_byte(int r, int c) { const int st = (r >> 4) * 2 + (c >> 5), rr = r & 15, cc = c & 31, ob = rr * 64 + cc * 2; return st * 1024 + (ob ^ (((ob >> 9) & 1) << 5)); }
__host__ __device__ __forceinline__ void stage_rc(int b, int& R, int& C) { const int st = b / 1024, sb = b % 1024, swz = sb ^ (((sb >> 9) & 1) << 5); R = (st >> 1) * 16 + swz / 64; C = (st & 1) * 32 + (swz % 64) / 2; }
__host__ __device__ __forceinline__ int perm32(int rho) { const int n = rho >> 4, i = rho & 15; return 8 * (i >> 2) + 4 * n + (i & 3); }
struct Unit { int pm, pn; };
struct Gemm { const bf16_t* A; const bf16_t* Bt; int M, N, K, pad; };
struct StaticOrder {
    int nM, nN, nwg, G, c;
    __host__ __device__ void init(int M, int N, int G_, int c_) { nM = M / BM; nN = N / BM; nwg = nM * nN; G = G_; c = c_; }
    __host__ __device__ bool next(int i, Unit& u) const {
        const long L = (long)i * G + c; if (L >= nwg) return false;
        int wgid = (int)L; { const int q = nwg / NXCD, r = nwg % NXCD, xcd = wgid % NXCD, off = wgid / NXCD; wgid = (xcd < r ? xcd * (q + 1) : r * (q + 1) + (xcd - r) * q) + off; }
        const int nig = WGM * nN, gid = wgid / nig, fm = gid * WGM, gsz = (nM - fm) < WGM ? (nM - fm) : WGM;
        u.pm = fm + ((wgid % nig) % gsz); u.pn = (wgid % nig) / gsz; return true;
    }
    __device__ __forceinline__ void a_ready(const Unit&) const {}
    __device__ __forceinline__ void done(const Unit&) const {}
};
__device__ __forceinline__ unsigned cvt_pk_bf16(float lo, float hi) { unsigned r; asm volatile("v_cvt_pk_bf16_f32 %0, %1, %2" : "=v"(r) : "v"(lo), "v"(hi)); return r; }
template <class Epi, class Sched, bool STAMP = false>
__device__ __forceinline__ void gemm_phase(PG8_LAS unsigned char* lds, const Gemm g, const Sched& S, const Epi& E, unsigned long long* stamps) {
    int tid_ = threadIdx.x; asm volatile("" : "+v"(tid_));
    const int tid = tid_, wid = __builtin_amdgcn_readfirstlane(tid >> 6), lane = tid & 63, wr = wid >> 2, wc = wid & 3, fr = lane & 15, fq = lane >> 4;
    const int K = g.K, nt = K / BK;
    int ts_lo = 0, ts_hi = 0, nts = 0; const unsigned long long rt_entry = STAMP ? (unsigned long long)wall_clock64() : 0ull;
#define PG8_STAMP() do { if (STAMP && wid == 0 && nts < 64) { const unsigned long long _c = (unsigned long long)clock64(); \
        ts_lo = (lane == nts) ? (int)(unsigned)_c : ts_lo; ts_hi = (lane == nts) ? (int)(unsigned)(_c >> 32) : ts_hi; ++nts; } } while (0)
    PG8_STAMP();
    unsigned voffA[2], voffB[2];
#pragma unroll
    for (int i = 0; i < 2; ++i) { int R, C; stage_rc(tid * 16 + i * 8192, R, C); const int Rb = Epi::PERM ? ((R & ~31) + perm32(R & 31)) : R;
        voffA[i] = (unsigned)(R * K + C) * 2u; voffB[i] = (unsigned)(Rb * K + C) * 2u; }
    const size_t kstep = (size_t)(BK * 2);
    const size_t hstep = (size_t)HALF * K * 2;
    const size_t tstep = 2 * hstep;
    const unsigned ldsw = (unsigned)wid * 1024u;
    const int aoff = lds_byte(wr * 64 + fr, fq * 8), boff = lds_byte(wc * 32 + fr, fq * 8);
#define PG8_SA(b, h) (((b) * 2 + (h)) * HTB)
#define PG8_SB(b, h) ((4 + (b) * 2 + (h)) * HTB)
#define PG8_STAGE(bufoff, gbase, voff) do { _Pragma("unroll") for (int _i = 0; _i < 2; ++_i) \
        __builtin_amdgcn_global_load_lds((const unsigned*)((const char*)(gbase) + (voff)[_i]), (PG8_LAS unsigned*)(lds + (bufoff) + ldsw + _i * 8192), 16, 0, 0); } while (0)
#define PG8_LDA(dst, b, h) do { _Pragma("unroll") for (int m = 0; m < 4; ++m) _Pragma("unroll") for (int k = 0; k < 2; ++k) dst[m][k] = *(const PG8_LAS bf16x8*)(lds + PG8_SA(b, h) + aoff + m * 2048 + k * 1024); } while (0)
#define PG8_LDB(dst, b, h) do { _Pragma("unroll") for (int n = 0; n < 2; ++n) _Pragma("unroll") for (int k = 0; k < 2; ++k) dst[n][k] = *(const PG8_LAS bf16x8*)(lds + PG8_SB(b, h) + boff + n * 2048 + k * 1024); } while (0)
#define PG8_MMA(ai, bj, At, Bt) do { __builtin_amdgcn_s_setprio(1); _Pragma("unroll") for (int m = 0; m < 4; ++m) _Pragma("unroll") for (int n = 0; n < 2; ++n) _Pragma("unroll") for (int k = 0; k < 2; ++k) \
        acc[ai][bj][m][n] = __builtin_amdgcn_mfma_f32_16x16x32_bf16(Bt[n][k], At[m][k], acc[ai][bj][m][n], 0, 0, 0); __builtin_amdgcn_s_setprio(0); } while (0)
#define PG8_WAIT_V(n) asm volatile("s_waitcnt vmcnt(" #n ")" ::: "memory")
#define PG8_WAIT_L(n) asm volatile("s_waitcnt lgkmcnt(" #n ")" ::: "memory")
#define PG8_BAR __builtin_amdgcn_s_barrier()
#define PG8_SCHED __builtin_amdgcn_sched_barrier(0)
    Unit cur, nxt; int ui = 0;
    if (!S.next(0, cur)) return;
    f32x4 acc[2][2][4][2];
#pragma unroll
    for (int a = 0; a < 2; ++a)
#pragma unroll
        for (int b = 0; b < 2; ++b)
#pragma unroll
            for (int m = 0; m < 4; ++m)
#pragma unroll
                for (int n = 0; n < 2; ++n) acc[a][b][m][n] = (f32x4){0.f, 0.f, 0.f, 0.f};
    bf16x8 At[4][2], B0[2][2], B1[2][2];
    const char* cA = (const char*)g.A + (size_t)cur.pm * tstep; const char* cB = (const char*)g.Bt + (size_t)cur.pn * tstep;
    S.a_ready(cur);
    PG8_STAGE(PG8_SB(0, 0), cB, voffB); PG8_STAGE(PG8_SA(0, 0), cA, voffA); PG8_STAGE(PG8_SB(0, 1), cB + hstep, voffB); PG8_STAGE(PG8_SA(0, 1), cA + hstep, voffA);
    if (wr == 1) PG8_BAR;
    PG8_WAIT_V(4); PG8_BAR;
    PG8_STAGE(PG8_SB(1, 0), cB + kstep, voffB); PG8_STAGE(PG8_SA(1, 0), cA + kstep, voffA); PG8_STAGE(PG8_SB(1, 1), cB + hstep + kstep, voffB);
    PG8_WAIT_V(6); PG8_BAR;
    PG8_STAMP();
    for (;;) {
        const bool has_next = S.next(ui + 1, nxt);
        const char* nA = has_next ? (const char*)g.A + (size_t)nxt.pm * tstep : cA; const char* nB = has_next ? (const char*)g.Bt + (size_t)nxt.pn * tstep : cB;
        for (int t = 0; t < nt; t += 2) {
            const bool last = (t == nt - 2);
            const char* a1 = cA + (size_t)(t + 1) * kstep;
            const char* a2 = last ? nA : cA + (size_t)(t + 2) * kstep; const char* b2 = last ? nB : cB + (size_t)(t + 2) * kstep;
            const char* a3 = a2 + kstep; const char* b3 = b2 + kstep;
            if (last && has_next) S.a_ready(nxt);
            PG8_LDB(B0, 0, 0); PG8_SCHED; PG8_LDA(At, 0, 0); PG8_STAGE(PG8_SA(1, 1), a1 + hstep, voffA);
            PG8_WAIT_L(8); PG8_BAR; PG8_WAIT_L(0); PG8_MMA(0, 0, At, B0); PG8_BAR; PG8_SCHED;
            PG8_LDB(B1, 0, 1); PG8_STAGE(PG8_SB(0, 0), b2, voffB);
            PG8_BAR; PG8_WAIT_L(0); PG8_MMA(0, 1, At, B1); PG8_BAR;
            PG8_LDA(At, 0, 1); PG8_STAGE(PG8_SA(0, 0), a2, voffA);
            PG8_BAR; PG8_WAIT_L(0); PG8_MMA(1, 0, At, B0); PG8_BAR; PG8_SCHED;
            PG8_STAGE(PG8_SB(0, 1), b2 + hstep, voffB);
            PG8_WAIT_V(6); PG8_BAR; PG8_MMA(1, 1, At, B1); PG8_BAR;
            PG8_LDB(B0, 1, 0); PG8_SCHED; PG8_LDA(At, 1, 0); PG8_STAGE(PG8_SA(0, 1), a2 + hstep, voffA);
            PG8_WAIT_L(8); PG8_BAR; PG8_WAIT_L(0); PG8_MMA(0, 0, At, B0); PG8_BAR; PG8_SCHED;
            PG8_LDB(B1, 1, 1); PG8_STAGE(PG8_SB(1, 0), b3, voffB);
            PG8_BAR; PG8_WAIT_L(0); PG8_MMA(0, 1, At, B1); PG8_BAR;
            PG8_LDA(At, 1, 1); PG8_STAGE(PG8_SA(1, 0), a3, voffA);
            PG8_BAR; PG8_WAIT_L(0); PG8_MMA(1, 0, At, B0); PG8_BAR; PG8_SCHED;
            PG8_STAGE(PG8_SB(1, 1), b3 + hstep, voffB);
            PG8_WAIT_V(6); PG8_BAR; PG8_MMA(1, 1, At, B1); PG8_BAR;
        }
        PG8_STAMP();
        if constexpr (!Epi::AFTER_DRAIN) { E(acc, cur, wr, wc, fr, fq); S.done(cur); }
        PG8_STAMP();
        if (!has_next) break;
#pragma unroll
        for (int a = 0; a < 2; ++a)
#pragma unroll
            for (int b = 0; b < 2; ++b)
#pragma unroll
                for (int m = 0; m < 4; ++m)
#pragma unroll
                    for (int n = 0; n < 2; ++n) acc[a][b][m][n] = (f32x4){0.f, 0.f, 0.f, 0.f};
        cur = nxt; cA = nA; cB = nB; ++ui;
    }
    PG8_WAIT_V(0);
    if (wr == 0) PG8_BAR;
    PG8_BAR;
    if constexpr (Epi::AFTER_DRAIN) { E.fused(acc, cur, wr, wc, fr, fq, lds, wid, lane); S.done(cur); }
    PG8_STAMP();
    if (STAMP && wid == 0) { stamps[lane] = lane < nts ? (((unsigned long long)(unsigned)ts_hi << 32) | (unsigned)ts_lo) : 0ull;
        if (lane == 62) stamps[62] = rt_entry; if (lane == 63) stamps[63] = (unsigned long long)wall_clock64(); }
#undef PG8_STAMP
#undef PG8_SA
#undef PG8_SB
#undef PG8_STAGE
#undef PG8_LDA
#undef PG8_LDB
#undef PG8_MMA
#undef PG8_WAIT_V
#undef PG8_WAIT_L
#undef PG8_BAR
#undef PG8_SCHED
}
}
#define XB_TMO      128
#define XB_XCNT(j)  (256  + 64 * (j))
#define XB_XSUB(j)  (1280 + 64 * (j))
#define XB_XGEN(j)  (2304 + 64 * (j))
#define XB_TOP      3328
#define XB_TOPGEN   3392
#define XCD_BAR_WORDS 3456
#define XB_SPIN_CAP (1u << 18)
#define LAS __attribute__((address_space(3)))

__device__ __forceinline__ unsigned xb_ld(unsigned* p)              { return __hip_atomic_load(p, __ATOMIC_RELAXED, __HIP_MEMORY_SCOPE_AGENT); }
__device__ __forceinline__ unsigned xb_add(unsigned* p, unsigned v) { return __hip_atomic_fetch_add(p, v, __ATOMIC_RELAXED, __HIP_MEMORY_SCOPE_AGENT); }
__device__ __forceinline__ unsigned xb_xcc_id() { return (unsigned)__builtin_amdgcn_s_getreg((3 << 11) | 20) & 0xFu; }
#define XB_SPIN(cond, bar) do { unsigned _sp = 0; while (cond) { __builtin_amdgcn_s_sleep(1); \
    if ((++_sp & 255u) == 0u) { if (xb_ld(&(bar)[XB_TMO])) break; if (_sp > XB_SPIN_CAP) { atomicAdd(&(bar)[XB_TMO], 1u); break; } } } } while (0)

struct XcdBarrier {
    unsigned* bar; unsigned x;
    volatile LAS unsigned* st;
};

__device__ __forceinline__ XcdBarrier xcd_barrier_post(unsigned* bar, volatile LAS unsigned* st) {
    XcdBarrier b; b.bar = bar; b.x = (unsigned)__builtin_amdgcn_readfirstlane((int)xb_xcc_id()); b.st = st;
    if (threadIdx.x == 0) (void)xb_add(&bar[XB_XCNT(b.x)], 1u);
    return b;
}
__device__ __forceinline__ void xcd_barrier_complete(unsigned* bar, unsigned x, unsigned& nloc, unsigned& nx) {
    const unsigned G = gridDim.x * gridDim.y * gridDim.z;
    unsigned sum, cnt, mine, sp = 0u;
    for (;;) {
        sum = 0u; cnt = 0u; mine = 0u;
#pragma unroll
        for (unsigned j = 0; j < 16; ++j) { const unsigned c = xb_ld(&bar[XB_XCNT(j)]); sum += c; cnt += (c > 0u) ? 1u : 0u; mine = (j == x) ? c : mine; }
        if (sum == G) break;
        __builtin_amdgcn_s_sleep(1);
        if ((++sp & 255u) == 0u) { if (xb_ld(&bar[XB_TMO])) break; if (sp > XB_SPIN_CAP) { atomicAdd(&bar[XB_TMO], 1u); break; } }
    }
    nloc = mine > 0u ? mine : 1u; nx = cnt > 0u ? cnt : 1u;
}

__device__ __forceinline__ void xcd_barrier(const XcdBarrier& b) {
    asm volatile("s_waitcnt vmcnt(0)" ::: "memory");
    __syncthreads();
    if (threadIdx.x == 0) {
        unsigned* bar = b.bar; unsigned bx = b.x; asm volatile("" : "+s"(bx));
        __builtin_amdgcn_s_waitcnt(0);
        unsigned nloc = b.st[0], nx = b.st[1];
        if (nloc == 0u) { xcd_barrier_complete(bar, bx, nloc, nx); b.st[0] = nloc; b.st[1] = nx; }
        const unsigned old = xb_add(&bar[XB_XSUB(bx)], 1u);
        const unsigned gen = old / nloc;
        if (old + 1u == (gen + 1u) * nloc) {
            __builtin_amdgcn_fence(__ATOMIC_RELEASE, "agent");
            asm volatile("s_waitcnt vmcnt(0)" ::: "memory");
            const unsigned og = xb_add(&bar[XB_TOP], 1u);
            const unsigned tg = og / nx;
            if (og + 1u == (tg + 1u) * nx) xb_add(&bar[XB_TOPGEN], 1u);
            else XB_SPIN(xb_ld(&bar[XB_TOPGEN]) == tg, bar);
            __builtin_amdgcn_fence(__ATOMIC_ACQUIRE, "agent");
            xb_add(&bar[XB_XGEN(bx)], 1u);
            asm volatile("s_waitcnt vmcnt(0)" ::: "memory");
        } else {
            XB_SPIN(xb_ld(&bar[XB_XGEN(bx)]) == gen, bar);
            __builtin_amdgcn_fence(__ATOMIC_ACQUIRE, "agent");
            asm volatile("s_waitcnt vmcnt(0)" ::: "memory");
        }
    }
    __syncthreads();
}

extern __shared__ __attribute__((aligned(16))) unsigned char smem[];

DI void convT_tile(const float* __restrict__ src, int ldsrc, bf16_t* __restrict__ dst, int K, int tile, int ntn, bool inmap) {
    float* t = (float*)smem;
    const int tid = ltid(), tk = tile / ntn, tn = tile % ntn, k0 = tk * 64, n0 = tn * 64;
    __syncthreads();
#pragma unroll
    for (int r = 0; r < 8; ++r) {
        const int i = (tid >> 6) + 8 * r, j = tid & 63, n = n0 + j;
        int sn = n; bool z = false;
        if (inmap) { if (n >= 3104 && n < C_NQ) z = true; else if (n >= C_NQ) sn = n - 224; }
        t[i * 65 + j] = z ? 0.f : src[(size_t)(k0 + i) * ldsrc + sn];
    }
    __syncthreads();
    const int j = tid >> 3, i8 = (tid & 7) * 8;
    u32x4 w;
    w.x = pk2(t[(i8 + 0) * 65 + j], t[(i8 + 1) * 65 + j]); w.y = pk2(t[(i8 + 2) * 65 + j], t[(i8 + 3) * 65 + j]);
    w.z = pk2(t[(i8 + 4) * 65 + j], t[(i8 + 5) * 65 + j]); w.w = pk2(t[(i8 + 6) * 65 + j], t[(i8 + 7) * 65 + j]);
    *(u32x4*)(dst + (size_t)(n0 + j) * K + k0 + i8) = w;
}
DI void phase_convert(const Params& p, int bid, int nb) {
    for (int l = 0; l < DEPTH; ++l) {
        { const int ntn = NP / 64, nt = (DM / 64) * ntn; bf16_t* d = (bf16_t*)(p.ws + OFF_WIN) + (size_t)l * NP * DM;
          for (int t = bid; t < nt; t += nb) convT_tile(p.w_in + (size_t)l * DM * IN_TOTAL, IN_TOTAL, d, DM, t, ntn, true); }
        for (int br = 0; br < 3; ++br) { const float* s = (br == 0 ? p.w_br_a : br == 1 ? p.w_br_b : p.w_br_c) + (size_t)l * 1024 * DM;
          const int ntn = DM / 64, nt = (1024 / 64) * ntn; bf16_t* d = (bf16_t*)(p.ws + OFF_WBR) + ((size_t)l * 3 + br) * DM * 1024;
          for (int t = bid; t < nt; t += nb) convT_tile(s, DM, d, 1024, t, ntn, false); }
        { const int ntn = DM / 64, nt = (DM / 64) * ntn; bf16_t* d = (bf16_t*)(p.ws + OFF_WOUT) + (size_t)l * DM * DM;
          for (int t = bid; t < nt; t += nb) convT_tile(p.w_out + (size_t)l * DM * DM, DM, d, DM, t, ntn, false); }
        { const int ntn = DFF / 64, nt = (DM / 64) * ntn; bf16_t* d = (bf16_t*)(p.ws + OFF_W1) + (size_t)l * DFF * DM;
          for (int t = bid; t < nt; t += nb) convT_tile(p.w_mlp1 + (size_t)l * DM * DFF, DFF, d, DM, t, ntn, false); }
        { const int ntn = DM / 64, nt = (DFF / 64) * ntn; bf16_t* d = (bf16_t*)(p.ws + OFF_W2) + (size_t)l * DM * DFF;
          for (int t = bid; t < nt; t += nb) convT_tile(p.w_mlp2 + (size_t)l * DFF * DM, DM, d, DFF, t, ntn, false); }
    }
}

DI void phase_adaln(const Params& p, int bid, int nb) {
    float* sc = (float*)smem;
    float* red = sc + NCOND * DM;
    const int tid = ltid();
    __syncthreads();
    for (int i = tid; i < NCOND * DM; i += 512) { const int r = i / DM, k = i % DM; const float v = r == 0 ? p.c_ctx[k] : p.c[(size_t)(r - 1) * DM + k]; sc[i] = v * sigmoidf_(v); }
    __syncthreads();
    const int nun = DEPTH * (NMOD * DM / 64);
    for (int u = bid; u < nun; u += nb) {
        const int l = u / (NMOD * DM / 64), j0 = (u % (NMOD * DM / 64)) * 64, j = tid & 63, ks = tid >> 6;
        const float* w = p.w_mod + (size_t)l * DM * (NMOD * DM) + j0 + j;
        float acc[NCOND];
#pragma unroll
        for (int r = 0; r < NCOND; ++r) acc[r] = 0.f;
        for (int k = ks * 256; k < ks * 256 + 256; ++k) { const float wv = w[(size_t)k * (NMOD * DM)];
#pragma unroll
            for (int r = 0; r < NCOND; ++r) acc[r] += sc[r * DM + k] * wv; }
#pragma unroll
        for (int r = 0; r < NCOND; ++r) red[(ks * NCOND + r) * 64 + j] = acc[r];
        __syncthreads();
        for (int i = tid; i < NCOND * 64; i += 512) { const int r = i / 64, jj = i % 64; float s = p.b_mod[(size_t)l * NMOD * DM + j0 + jj];
#pragma unroll
            for (int q = 0; q < 8; ++q) s += red[(q * NCOND + r) * 64 + jj];
            ((float*)(p.ws + OFF_MOD))[((size_t)l * NCOND + r) * (NMOD * DM) + j0 + jj] = s; }
        __syncthreads();
    }
}

DI void phase_hyena_hid(const Params& p, int bid, int nb) {
    float* zf = (float*)smem;
    float* h1 = zf + 8 * 36;
    const int tid = ltid(), tt = tid >> 6, j = tid & 63;
    const int nun = DEPTH * (256 / 8 + 4096 / 8);
    for (int u = bid; u < nun; u += nb) {
        const int l = u / 544, r = u % 544, ls = r < 32 ? 0 : 1, tb = ls ? r - 32 : r, L = ls ? 4096 : 256, t = tb * 8 + tt;
        const float tn = (float)t / (float)L;
        __syncthreads();
        if (j < 33) { float v; if (j == 0) v = tn; else { const int band = j <= 16 ? j : j - 16; const float ang = 6.283185307179586f * tn * (float)band; v = j <= 16 ? cosf(ang) : sinf(ang); } zf[tt * 36 + j] = v; }
        __syncthreads();
        const float fr = p.hy_freq[l * 64 + j];
        float a = p.hy_f1_b[l * 64 + j];
        for (int i = 0; i < 33; ++i) a += zf[tt * 36 + i] * p.hy_f1_w[((size_t)l * 33 + i) * 64 + j];
        h1[tt * 64 + j] = sinf(fr * a);
        __syncthreads();
        float b = p.hy_f2_b[l * 64 + j];
        for (int i = 0; i < 64; ++i) b += h1[tt * 64 + i] * p.hy_f2_w[((size_t)l * 64 + i) * 64 + j];
        ((float*)(p.ws + OFF_HID))[(((size_t)l * 2 + ls) * 4096 + t) * 64 + j] = sinf(fr * b);
    }
}
DI const float* filt_ptr(const unsigned char* ws, int l, int ls) { return (const float*)(ws + OFF_FILT + (size_t)l * FILT_L) + (ls ? (size_t)2 * 1024 * 256 : 0); }
DI void phase_filters(const Params& p, int bid, int nb) {
    float* f3s = (float*)smem;
    float* red = f3s + 256;
    const int tid = ltid(), lane = tid & 63, wid = tid >> 6;
    const int nun = DEPTH * 2 * 512;
    for (int u = bid; u < nun; u += nb) {
        const int l = u / 1024, ls = (u / 512) & 1, cg = u % 512, L = ls ? 4096 : 256, col0 = cg * 4;
        __syncthreads();
        if (tid < 256) f3s[tid] = p.hy_f3_w[((size_t)l * 64 + (tid >> 2)) * 2048 + col0 + (tid & 3)];
        __syncthreads();
        const float* hid = (const float*)(p.ws + OFF_HID) + ((size_t)l * 2 + ls) * 4096 * 64;
        float val[8][4]; float ss[4] = {0.f, 0.f, 0.f, 0.f};
        float delta[4];
#pragma unroll
        for (int cc = 0; cc < 4; ++cc) { const int c = (col0 + cc) & 1023; const float a = -3.0701134573253943f, b = -15.350567286626972f; delta[cc] = fabsf(a + (b - a) * ((float)c / 1023.0f)); }
#pragma unroll
        for (int i = 0; i < 8; ++i) {
            const int t = tid + 512 * i;
#pragma unroll
            for (int cc = 0; cc < 4; ++cc) val[i][cc] = 0.f;
            if (t < L) {
                const f32x4* hr = (const f32x4*)(hid + (size_t)t * 64);
                float a0 = 0.f, a1 = 0.f, a2 = 0.f, a3 = 0.f;
#pragma unroll
                for (int q = 0; q < 16; ++q) { const f32x4 hv = hr[q];
#pragma unroll
                    for (int e = 0; e < 4; ++e) { const f32x4 w = *(const f32x4*)(f3s + (q * 4 + e) * 4); a0 += hv[e] * w[0]; a1 += hv[e] * w[1]; a2 += hv[e] * w[2]; a3 += hv[e] * w[3]; } }
                const float dist = fabsf((float)t - (float)(L / 2)) * (2.0f / (float)L);
                val[i][0] = a0 * expf(-dist * delta[0]); val[i][1] = a1 * expf(-dist * delta[1]); val[i][2] = a2 * expf(-dist * delta[2]); val[i][3] = a3 * expf(-dist * delta[3]);
#pragma unroll
                for (int cc = 0; cc < 4; ++cc) ss[cc] += val[i][cc] * val[i][cc];
            }
        }
#pragma unroll
        for (int cc = 0; cc < 4; ++cc) { ss[cc] = wave_sum(ss[cc]); if (lane == 0) red[wid * 4 + cc] = ss[cc]; }
        __syncthreads();
        float sc[4];
#pragma unroll
        for (int cc = 0; cc < 4; ++cc) { float s = 0.f;
#pragma unroll
            for (int q = 0; q < 8; ++q) s += red[q * 4 + cc]; sc[cc] = rsqrtf(s + EPS); }
        float* fo = (float*)filt_ptr(p.ws, l, ls);
#pragma unroll
        for (int i = 0; i < 8; ++i) { const int t = tid + 512 * i; if (t < L) {
#pragma unroll
            for (int cc = 0; cc < 4; ++cc) { const int col = col0 + cc; fo[((size_t)(col >> 10) * 1024 + (col & 1023)) * L + t] = val[i][cc] * sc[cc]; } } }
    }
}

DI int cond_row(int grp, int row) { return grp == 0 ? 0 : 1 + 2 * (grp - 1) + (row >> 12); }
DI void phase_norm(const Params& p, const float* x, const float* g, int l, int grp, int shoff, int scoff, int bid, int nb) {
    const int tid = ltid(), lane = tid & 63, wid = tid >> 6;
    bf16_t* h = (bf16_t*)(p.ws + OFF_H);
    for (int row = bid * 8 + wid; row < GT; row += nb * 8) {
        const float* xr = x + (size_t)row * DM;
        f32x4 v[8]; float ss = 0.f;
#pragma unroll
        for (int i = 0; i < 8; ++i) { v[i] = *(const f32x4*)(xr + i * 256 + lane * 4); ss += v[i][0] * v[i][0] + v[i][1] * v[i][1] + v[i][2] * v[i][2] + v[i][3] * v[i][3]; }
        ss = wave_sum(ss);
        const float rs = rsqrtf(ss * (1.0f / DM) + EPS);
        const float* md = (const float*)(p.ws + OFF_MOD) + ((size_t)l * NCOND + cond_row(grp, row)) * (NMOD * DM);
#pragma unroll
        for (int i = 0; i < 8; ++i) { const int c = i * 256 + lane * 4; const f32x4 gv = *(const f32x4*)(g + c), sh = *(const f32x4*)(md + shoff + c), sc = *(const f32x4*)(md + scoff + c);
            f32x4 o = v[i] * rs * gv * (sc + 1.0f) + sh; u32x2 w; w.x = pk2(o[0], o[1]); w.y = pk2(o[2], o[3]); *(u32x2*)(h + (size_t)row * DM + c) = w; }
    }
}
using pg8::Unit; using pg8::cvt_pk_bf16;
template <int ACT> struct EpiStoreBf16 {
    static constexpr bool PERM = true, AFTER_DRAIN = false;
    bf16_t* O; int ldc; int pad;
    __device__ __forceinline__ void operator()(const f32x4 (&acc)[2][2][4][2], const Unit& u, int wr, int wc, int fr, int fq) const {
        const int row0 = u.pm * 256 + wr * 64 + fr, col0 = u.pn * 256 + wc * 32 + 8 * fq;
#pragma unroll
        for (int ai = 0; ai < 2; ++ai)
#pragma unroll
            for (int m = 0; m < 4; ++m) { bf16_t* rowp = O + (size_t)(row0 + ai * 128 + m * 16) * ldc + col0;
#pragma unroll
                for (int bj = 0; bj < 2; ++bj) { f32x4 v0 = acc[ai][bj][m][0], v1 = acc[ai][bj][m][1];
                    if (ACT == 1) {
#pragma unroll
                        for (int j = 0; j < 4; ++j) { const float a = fmaxf(v0[j], 0.f), b = fmaxf(v1[j], 0.f); v0[j] = a * a; v1[j] = b * b; } }
                    u32x4 w; w.x = cvt_pk_bf16(v0[0], v0[1]); w.y = cvt_pk_bf16(v0[2], v0[3]); w.z = cvt_pk_bf16(v1[0], v1[1]); w.w = cvt_pk_bf16(v1[2], v1[3]);
                    *(u32x4*)(rowp + bj * 128) = w; } }
    }
};
template <int MODE> struct EpiGate {
    static constexpr bool PERM = true, AFTER_DRAIN = false;
    const bf16_t* gate; float* m32; bf16_t* mbf; int ldg; int pad;
    __device__ __forceinline__ void operator()(const f32x4 (&acc)[2][2][4][2], const Unit& u, int wr, int wc, int fr, int fq) const {
        const int row0 = u.pm * 256 + wr * 64 + fr, col0 = u.pn * 256 + wc * 32 + 8 * fq;
#pragma unroll
        for (int ai = 0; ai < 2; ++ai)
#pragma unroll
            for (int m = 0; m < 4; ++m) { const size_t row = (size_t)(row0 + ai * 128 + m * 16);
#pragma unroll
                for (int bj = 0; bj < 2; ++bj) { const int col = col0 + bj * 128;
                    const u32x4 gw = *(const u32x4*)(gate + row * ldg + col);
                    f32x4 s0, s1;
                    s0[0] = sigmoidf_(bflo(gw.x)); s0[1] = sigmoidf_(bfhi(gw.x)); s0[2] = sigmoidf_(bflo(gw.y)); s0[3] = sigmoidf_(bfhi(gw.y));
                    s1[0] = sigmoidf_(bflo(gw.z)); s1[1] = sigmoidf_(bfhi(gw.z)); s1[2] = sigmoidf_(bflo(gw.w)); s1[3] = sigmoidf_(bfhi(gw.w));
                    f32x4 v0 = acc[ai][bj][m][0] * s0, v1 = acc[ai][bj][m][1] * s1;
                    float* mp = m32 + row * DM + col;
                    if (MODE >= 1) { v0 += *(const f32x4*)mp; v1 += *(const f32x4*)(mp + 4); }
                    if (MODE <= 1) { *(f32x4*)mp = v0; *(f32x4*)(mp + 4) = v1; }
                    else { u32x4 w; w.x = cvt_pk_bf16(v0[0], v0[1]); w.y = cvt_pk_bf16(v0[2], v0[3]); w.z = cvt_pk_bf16(v1[0], v1[1]); w.w = cvt_pk_bf16(v1[2], v1[3]);
                           *(u32x4*)(mbf + row * DM + col) = w; } } }
    }
};
struct EpiResid {
    static constexpr bool PERM = true, AFTER_DRAIN = false;
    const float* xin; float* xout; const float* gA; const float* gB;
    __device__ __forceinline__ void operator()(const f32x4 (&acc)[2][2][4][2], const Unit& u, int wr, int wc, int fr, int fq) const {
        const int row0 = u.pm * 256 + wr * 64 + fr, col0 = u.pn * 256 + wc * 32 + 8 * fq;
        const float* gv = (u.pm * 256 < 4096) ? gA : gB;
#pragma unroll
        for (int bj = 0; bj < 2; ++bj) { const int col = col0 + bj * 128; const f32x4 g0 = *(const f32x4*)(gv + col), g1 = *(const f32x4*)(gv + col + 4);
#pragma unroll
            for (int ai = 0; ai < 2; ++ai)
#pragma unroll
                for (int m = 0; m < 4; ++m) { const size_t o = (size_t)(row0 + ai * 128 + m * 16) * DM + col;
                    const f32x4 a0 = *(const f32x4*)(xin + o), a1 = *(const f32x4*)(xin + o + 4);
                    *(f32x4*)(xout + o) = a0 + g0 * acc[ai][bj][m][0]; *(f32x4*)(xout + o + 4) = a1 + g1 * acc[ai][bj][m][1]; } }
    }
};

struct GrpInfo { int grp, l, L, nseq, latent; };
DI GrpInfo grp_info(int grp, int l) { GrpInfo g; g.grp = grp; g.l = l; g.latent = grp > 0; g.L = grp ? 4096 : 256; g.nseq = grp ? 2 : 32; return g; }

DI void phase_na_prep(const Params& p, GrpInfo gi, int bid, int nb) {
    const int tid = ltid(), lane = tid & 63, wid = tid >> 6;
    const bf16_t* P = (const bf16_t*)(p.ws + OFF_P);
    bf16_t* QN = (bf16_t*)(p.ws + OFF_QN); bf16_t* KN = (bf16_t*)(p.ws + OFF_KN);
    const float gq0 = p.na_qnorm_g[gi.l * 128 + 2 * lane], gq1 = p.na_qnorm_g[gi.l * 128 + 2 * lane + 1];
    const float gk0 = p.na_knorm_g[gi.l * 128 + 2 * lane], gk1 = p.na_knorm_g[gi.l * 128 + 2 * lane + 1];
    for (int u = bid * 8 + wid; u < GT * 8; u += nb * 8) {
        const int row = u >> 3, h = u & 7;
        const unsigned qw = *(const unsigned*)(P + (size_t)row * NP + C_NQ + h * 128 + 2 * lane);
        const unsigned kw = *(const unsigned*)(P + (size_t)row * NP + C_NK + h * 128 + 2 * lane);
        const float q0 = bflo(qw), q1 = bfhi(qw), k0 = bflo(kw), k1 = bfhi(kw);
        const float qs = rsqrtf(wave_sum(q0 * q0 + q1 * q1) * (1.0f / 128) + EPS), ks = rsqrtf(wave_sum(k0 * k0 + k1 * k1) * (1.0f / 128) + EPS);
        const float a0 = q0 * qs * gq0, a1 = q1 * qs * gq1, b0 = k0 * ks * gk0, b1 = k1 * ks * gk1;
        *(unsigned*)(QN + (size_t)row * 1024 + h * 128 + 2 * lane) = pk2(a0, a1);
        *(unsigned*)(KN + (size_t)row * 1024 + h * 128 + 2 * lane) = pk2(b0, b1);
        if (!gi.latent) { const int b = row >> 8, t = row & 255; const size_t o = ((((size_t)b * DEPTH + gi.l) * 8 + h) * 256 + t) * 128 + 2 * lane;
            const unsigned vw = *(const unsigned*)(P + (size_t)row * NP + C_NV + h * 128 + 2 * lane);
            *(f32x2*)(p.out + OUT_CK + o) = (f32x2){b0, b1}; *(f32x2*)(p.out + OUT_CV + o) = (f32x2){bflo(vw), bfhi(vw)}; }
    }
}
DI void phase_na_naive(const Params& p, GrpInfo gi, int bid, int nb) {
    const int tid = ltid(), lane = tid & 63, wid = tid >> 6;
    float* qs = (float*)smem + wid * 512;
    float* ps = qs + 128;
    const bf16_t* P = (const bf16_t*)(p.ws + OFF_P);
    const bf16_t* QN = (const bf16_t*)(p.ws + OFF_QN); const bf16_t* KN = (const bf16_t*)(p.ws + OFF_KN);
    bf16_t* OB = (bf16_t*)(p.ws + OFF_OABC) + (size_t)GT * 1024;
    const float scale = 0.08838834764831845f;
    for (int u = bid * 8 + wid; u < GT * 8; u += nb * 8) {
        const int row = u >> 3, h = u & 7;
        { const unsigned qw = *(const unsigned*)(QN + (size_t)row * 1024 + h * 128 + 2 * lane); qs[2 * lane] = bflo(qw); qs[2 * lane + 1] = bfhi(qw); }
        asm volatile("s_waitcnt lgkmcnt(0)" ::: "memory");
        const int nkeys = gi.latent ? 384 : 256;
        const int sl = gi.latent ? (row >> 12) : (row >> 8), t = gi.latent ? (row & 4095) : (row & 255);
        const int r = t >> 6, c = t & 63, rs = min(max(r - 4, 0), 56), cs = min(max(c - 8, 0), 48);
        const int bs = 2 * (gi.grp - 1) + sl;
        float mx = -3.0e38f;
#pragma unroll 1
        for (int s = 0; s < 6; ++s) {
            const int kk = s * 64 + lane;
            if (kk < nkeys) {
                float dot = 0.f; float bias = 0.f;
                if (gi.latent && kk >= 128) { const float* kp = p.cache_k + ((((size_t)bs * DEPTH + gi.l) * 8 + h) * 256 + (kk - 128)) * 128;
#pragma unroll 4
                    for (int d = 0; d < 128; d += 4) { const f32x4 kv = *(const f32x4*)(kp + d); const f32x4 qv = *(const f32x4*)(qs + d); dot += kv[0] * qv[0] + kv[1] * qv[1] + kv[2] * qv[2] + kv[3] * qv[3]; } }
                else { int krow;
                    if (gi.latent) { const int i = kk >> 4, j = kk & 15; krow = sl * 4096 + (rs + i) * 64 + cs + j;
                        bias = p.na_rpb[(((size_t)gi.l * 8 + h) * 15 + (rs + i - r + 7)) * 31 + min(max(cs + j - c + 15, 0), 30)]; }
                    else krow = sl * 256 + kk;
                    const bf16_t* kp = KN + (size_t)krow * 1024 + h * 128;
#pragma unroll 4
                    for (int d = 0; d < 128; d += 8) { const u32x4 kw = *(const u32x4*)(kp + d); const f32x4 qa = *(const f32x4*)(qs + d), qb = *(const f32x4*)(qs + d + 4);
                        dot += bflo(kw.x) * qa[0] + bfhi(kw.x) * qa[1] + bflo(kw.y) * qa[2] + bfhi(kw.y) * qa[3] + bflo(kw.z) * qb[0] + bfhi(kw.z) * qb[1] + bflo(kw.w) * qb[2] + bfhi(kw.w) * qb[3]; } }
                const float sc = dot * scale + bias; mx = fmaxf(mx, sc); ps[kk] = sc;
            }
        }
        mx = wave_max(mx);
        float sum = 0.f;
#pragma unroll 1
        for (int s = 0; s < 6; ++s) { const int kk = s * 64 + lane; if (kk < nkeys) { const float e = __expf(ps[kk] - mx); ps[kk] = e; sum += e; } }
        sum = wave_sum(sum); const float inv = 1.0f / sum;
        asm volatile("s_waitcnt lgkmcnt(0)" ::: "memory");
        float o0 = 0.f, o1 = 0.f;
        for (int kk = 0; kk < nkeys; ++kk) {
            const float pv = ps[kk]; float v0, v1;
            if (gi.latent && kk >= 128) { const f32x2 vv = *(const f32x2*)(p.cache_v + ((((size_t)bs * DEPTH + gi.l) * 8 + h) * 256 + (kk - 128)) * 128 + 2 * lane); v0 = vv[0]; v1 = vv[1]; }
            else { const int krow = gi.latent ? sl * 4096 + (rs + (kk >> 4)) * 64 + cs + (kk & 15) : sl * 256 + kk;
                const unsigned vw = *(const unsigned*)(P + (size_t)krow * NP + C_NV + h * 128 + 2 * lane); v0 = bflo(vw); v1 = bfhi(vw); }
            o0 += pv * v0; o1 += pv * v1;
        }
        *(unsigned*)(OB + (size_t)row * 1024 + h * 128 + 2 * lane) = pk2(o0 * inv, o1 * inv);
        asm volatile("s_waitcnt lgkmcnt(0)" ::: "memory");
    }
}

DI float log_sigmoid_(float x) { return fminf(x, 0.f) - log1pf(expf(-fabsf(x))); }
DI void phase_gla_naive(const Params& p, GrpInfo gi, int bid, int nb) {
    const int tid = ltid(), e = tid & 255, dh = tid >> 8, L = gi.L;
    float* qs = (float*)smem; float* ks = qs + 16 * 128; float* as_ = ks + 16 * 128; float* vs = as_ + 16 * 128; float* op = vs + 16 * 256;
    const bf16_t* P = (const bf16_t*)(p.ws + OFF_P);
    for (int u = bid; u < gi.nseq * 8; u += nb) {
        const int sl = u >> 3, h = (u >> 1) & 3, dir = u & 1;
        float* O = (float*)(p.ws + (dir ? OFF_OB : OFF_OF));
        float S[64];
        if (gi.latent) { const int bs = 2 * (gi.grp - 1) + sl; const float* s0 = p.state_gla + (((((size_t)bs * DEPTH + gi.l) * 2 + dir) * 4 + h) * 128 + dh * 64) * 256 + e;
#pragma unroll
            for (int j = 0; j < 64; ++j) S[j] = s0[(size_t)j * 256]; }
        else {
#pragma unroll
            for (int j = 0; j < 64; ++j) S[j] = 0.f; }
        const float* wa = p.gla_wa2 + (((size_t)gi.l * 2 + dir) * 16) * 512 + h * 128;
        const float* ba = p.gla_ba2 + ((size_t)gi.l * 2 + dir) * 512 + h * 128;
        for (int bt = 0; bt < L / 16; ++bt) {
            __syncthreads();
#pragma unroll
            for (int i = 0; i < 4; ++i) {
                const int idx = tid + 512 * i, tt = idx >> 7, d = idx & 127, ts = bt * 16 + tt, t = dir ? L - 1 - ts : ts, row = sl * L + t;
                const bf16_t* pr = P + (size_t)row * NP;
                float q = bf2f(pr[C_GQ + h * 128 + d]) * 0.08838834764831845f, k = bf2f(pr[C_GK + h * 128 + d]);
                if (gi.latent) {
                    const float q2 = bf2f(pr[C_GQ + h * 128 + (d ^ 64)]) * 0.08838834764831845f, k2 = bf2f(pr[C_GK + h * 128 + (d ^ 64)]);
                    const int ii = d & 63, f = ii & 31; const float pos = (float)(ii < 32 ? (t >> 6) : (t & 63));
                    const float ang = pos * powf(10000.0f, -(float)f / 32.0f); float sn, cs; sincosf(ang, &sn, &cs);
                    if (d < 64) { q = q * cs - q2 * sn; k = k * cs - k2 * sn; } else { q = q2 * sn + q * cs; k = k2 * sn + k * cs; }
                }
                float xg = ba[d];
#pragma unroll
                for (int r = 0; r < 16; ++r) xg += bf2f(pr[C_GA + dir * 16 + r]) * wa[(size_t)r * 512 + d];
                qs[tt * 128 + d] = q; ks[tt * 128 + d] = k; as_[tt * 128 + d] = expf(log_sigmoid_(xg) * (1.0f / 16.0f));
            }
#pragma unroll
            for (int i = 0; i < 8; ++i) { const int idx = tid + 512 * i, tt = idx >> 8, ee = idx & 255, ts = bt * 16 + tt, t = dir ? L - 1 - ts : ts, row = sl * L + t;
                vs[tt * 256 + ee] = bf2f(P[(size_t)row * NP + C_GV + h * 256 + ee]); }
            __syncthreads();
            for (int tt = 0; tt < 16; ++tt) {
                const float v = vs[tt * 256 + e]; float acc = 0.f;
#pragma unroll
                for (int j4 = 0; j4 < 16; ++j4) {
                    const f32x4 a4 = *(const f32x4*)(as_ + tt * 128 + dh * 64 + j4 * 4), k4 = *(const f32x4*)(ks + tt * 128 + dh * 64 + j4 * 4), q4 = *(const f32x4*)(qs + tt * 128 + dh * 64 + j4 * 4);
#pragma unroll
                    for (int jj = 0; jj < 4; ++jj) { const int j = j4 * 4 + jj; S[j] = a4[jj] * S[j] + k4[jj] * v; acc += q4[jj] * S[j]; }
                }
                op[(tt * 2 + dh) * 256 + e] = acc;
            }
            __syncthreads();
#pragma unroll
            for (int i = 0; i < 8; ++i) { const int idx = tid + 512 * i, tt = idx >> 8, ee = idx & 255, ts = bt * 16 + tt, t = dir ? L - 1 - ts : ts, row = sl * L + t;
                O[(size_t)row * 1024 + h * 256 + ee] = op[(tt * 2) * 256 + ee] + op[(tt * 2 + 1) * 256 + ee]; }
        }
        if (!gi.latent) { float* so = p.out + OUT_ST + (((((size_t)sl * DEPTH + gi.l) * 2 + dir) * 4 + h) * 128 + dh * 64) * 256 + e;
#pragma unroll
            for (int j = 0; j < 64; ++j) so[(size_t)j * 256] = S[j]; }
    }
}
DI void phase_gla_post(const Params& p, GrpInfo gi, int bid, int nb) {
    const int tid = ltid(), lane = tid & 63, wid = tid >> 6;
    const bf16_t* P = (const bf16_t*)(p.ws + OFF_P);
    const float* Of = (const float*)(p.ws + OFF_OF); const float* Ob = (const float*)(p.ws + OFF_OB);
    bf16_t* OA = (bf16_t*)(p.ws + OFF_OABC);
    const f32x4 g = *(const f32x4*)(p.gla_norm_g + gi.l * 256 + lane * 4);
    for (int u = bid * 8 + wid; u < GT * 4; u += nb * 8) {
        const int row = u >> 2, h = u & 3; const size_t o = (size_t)row * 1024 + h * 256 + lane * 4;
        const f32x4 v = *(const f32x4*)(Of + o) + *(const f32x4*)(Ob + o);
        const float rs = rsqrtf(wave_sum(v[0] * v[0] + v[1] * v[1] + v[2] * v[2] + v[3] * v[3]) * (1.0f / 256) + EPS);
        const u32x2 gw = *(const u32x2*)(P + (size_t)row * NP + C_GG + h * 256 + lane * 4);
        const float g0 = bflo(gw.x), g1 = bfhi(gw.x), g2 = bflo(gw.y), g3 = bfhi(gw.y);
        u32x2 w; w.x = pk2(v[0] * rs * g[0] * (g0 * sigmoidf_(g0)), v[1] * rs * g[1] * (g1 * sigmoidf_(g1)));
        w.y = pk2(v[2] * rs * g[2] * (g2 * sigmoidf_(g2)), v[3] * rs * g[3] * (g3 * sigmoidf_(g3)));
        *(u32x2*)(OA + o) = w;
    }
}

DI void phase_hyena_naive(const Params& p, GrpInfo gi, int bid, int nb) {
    const int tid = ltid(), L = gi.L, TPC = L / 8, CH = 4096 / L, ci = tid / TPC, tg = tid % TPC, t0 = tg * 8;
    float* z = (float*)smem;
    float* hp = z + 4096;
    const bf16_t* P = (const bf16_t*)(p.ws + OFF_P);
    bf16_t* OC = (bf16_t*)(p.ws + OFF_OABC) + (size_t)2 * GT * 1024;
    const int nun = gi.nseq * (1024 / CH);
    for (int u = bid; u < nun; u += nb) {
        const int sl = u / (1024 / CH), c = (u % (1024 / CH)) * CH + ci;
        float x1[8], x2[8], zr[8], cv[8];
        const float* cw = p.hy_conv_w + (size_t)gi.l * 3 * 3072; const float* cb = p.hy_conv_b + (size_t)gi.l * 3072;
        __syncthreads();
#pragma unroll
        for (int i = 0; i < 8; ++i) {
            const int t = t0 + i; const size_t rb = (size_t)(sl * L + t) * NP + C_HY;
            float r[3];
#pragma unroll
            for (int part = 0; part < 3; ++part) { const int j = part * 1024 + c;
                const float um = t > 0 ? bf2f(P[rb - NP + j]) : 0.f, u0 = bf2f(P[rb + j]), up = t < L - 1 ? bf2f(P[rb + NP + j]) : 0.f;
                r[part] = cb[j] + cw[j] * um + cw[3072 + j] * u0 + cw[2 * 3072 + j] * up; }
            x1[i] = r[0]; x2[i] = r[1]; zr[i] = r[2]; z[ci * L + t] = r[2];
        }
#pragma unroll
        for (int o = 0; o < 2; ++o) {
            const float* f = filt_ptr(p.ws, gi.l, gi.latent ? 1 : 0) + ((size_t)o * 1024 + c) * L;
#pragma unroll
            for (int i = 0; i < 8; ++i) { hp[ci * 2 * L + L / 2 + t0 + i] = f[t0 + i]; const int zi = t0 + i; hp[ci * 2 * L + (zi < L / 2 ? zi : L + zi)] = 0.f; }
            __syncthreads();
#pragma unroll
            for (int i = 0; i < 8; ++i) cv[i] = 0.f;
            const float* hb = hp + ci * 2 * L; const float* zb = z + ci * L;
            f32x4 hi0 = *(const f32x4*)(hb + t0 + L), hi1 = *(const f32x4*)(hb + t0 + L + 4);
            for (int s = 0; s < L; s += 8) {
                const int idx0 = t0 + L - s;
                const f32x4 lo0 = *(const f32x4*)(hb + idx0 - 8), lo1 = *(const f32x4*)(hb + idx0 - 4);
                const f32x4 z0 = *(const f32x4*)(zb + s), z1 = *(const f32x4*)(zb + s + 4);
                const float hbuf[16] = {lo0[0], lo0[1], lo0[2], lo0[3], lo1[0], lo1[1], lo1[2], lo1[3], hi0[0], hi0[1], hi0[2], hi0[3], hi1[0], hi1[1], hi1[2], hi1[3]};
                const float zz[8] = {z0[0], z0[1], z0[2], z0[3], z1[0], z1[1], z1[2], z1[3]};
#pragma unroll
                for (int ss = 0; ss < 8; ++ss)
#pragma unroll
                    for (int i = 0; i < 8; ++i) cv[i] += zz[ss] * hbuf[8 - ss + i];
                hi0 = lo0; hi1 = lo1;
            }
            const float bo = p.hy_bias[((size_t)gi.l * 2 + o) * 1024 + c];
            __syncthreads();
            if (o == 0) {
#pragma unroll
                for (int i = 0; i < 8; ++i) { zr[i] = x1[i] * (cv[i] + bo * zr[i]); z[ci * L + t0 + i] = zr[i]; }
            } else {
#pragma unroll
                for (int i = 0; i < 8; ++i) OC[(size_t)(sl * L + t0 + i) * 1024 + c] = f2bf(x2[i] * (cv[i] + bo * zr[i]));
            }
        }
    }
}
#define LAS3 __attribute__((address_space(3)))
constexpr int LDS_MAIN = 131072, LDS_BYTES = LDS_MAIN + 256;

DI const float* x_in_ptr(const Params& p, int grp, int l) {
    if (l == 0) return grp == 0 ? p.x_prompt : p.x_sample + (size_t)(grp - 1) * GT * DM;
    return grp == 0 ? p.out + OUT_YP : p.out + OUT_YS + (size_t)(grp - 1) * GT * DM;
}
DI float* x_out_ptr(const Params& p, int grp) { return grp == 0 ? p.out + OUT_YP : p.out + OUT_YS + (size_t)(grp - 1) * GT * DM; }

template <class Epi> DI void gemm_ph(const bf16_t* A, const bf16_t* Bt, int M, int N, int K, const Epi& E) {
    pg8::Gemm g; g.A = A; g.Bt = Bt; g.M = M; g.N = N; g.K = K; g.pad = 0;
    pg8::StaticOrder S; S.init(M, N, (int)gridDim.x, (int)blockIdx.x);
    pg8::gemm_phase<Epi, pg8::StaticOrder, false>((LAS3 unsigned char*)smem, g, S, E, nullptr);
}

__global__ __launch_bounds__(512, 2) void k_mega(Params p) {
    const int bid = blockIdx.x, nb = gridDim.x;
    volatile LAS unsigned* xbw = (volatile LAS unsigned*)((LAS3 unsigned char*)smem + LDS_MAIN);
    if (threadIdx.x == 0) { xbw[0] = 0u; xbw[1] = 0u; xbw[2] = 0u; xbw[3] = 0u; }
    __syncthreads();
    XcdBarrier bar = xcd_barrier_post((unsigned*)(p.ws + OFF_BAR), xbw);
    unsigned char* ws = p.ws;
    phase_convert(p, bid, nb);
    phase_adaln(p, bid, nb);
    phase_hyena_hid(p, bid, nb);
    xcd_barrier(bar);
    phase_filters(p, bid, nb);
    xcd_barrier(bar);
    const float* mod = (const float*)(ws + OFF_MOD);
    bf16_t* H = (bf16_t*)(ws + OFF_H); bf16_t* P = (bf16_t*)(ws + OFF_P); bf16_t* OABC = (bf16_t*)(ws + OFF_OABC); bf16_t* MBF = (bf16_t*)(ws + OFF_MBF); float* M32 = (float*)(ws + OFF_M32);
    for (int l = 0; l < DEPTH; ++l) for (int grp = 0; grp < NGRP; ++grp) {
        const GrpInfo gi = grp_info(grp, l);
        const float* xin = x_in_ptr(p, grp, l); float* xout = x_out_ptr(p, grp);
        const int crA = grp == 0 ? 0 : 1 + 2 * (grp - 1), crB = grp == 0 ? 0 : crA + 1;
        const float* mA = mod + ((size_t)l * NCOND + crA) * (NMOD * DM); const float* mB = mod + ((size_t)l * NCOND + crB) * (NMOD * DM);
        phase_norm(p, xin, p.norm1_g + l * DM, l, grp, 0, DM, bid, nb);
        xcd_barrier(bar);
        gemm_ph(H, (const bf16_t*)(ws + OFF_WIN) + (size_t)l * NP * DM, GT, NP, DM, EpiStoreBf16<0>{P, NP, 0});
        xcd_barrier(bar);
        phase_na_prep(p, gi, bid, nb);
        phase_gla_naive(p, gi, bid, nb);
        phase_hyena_naive(p, gi, bid, nb);
        xcd_barrier(bar);
        phase_na_naive(p, gi, bid, nb);
        phase_gla_post(p, gi, bid, nb);
        xcd_barrier(bar);
        const bf16_t* wbr = (const bf16_t*)(ws + OFF_WBR) + (size_t)l * 3 * DM * 1024;
        gemm_ph(OABC, wbr, GT, DM, 1024, EpiGate<0>{P + C_GATE, M32, MBF, NP, 0});
        xcd_barrier(bar);
        gemm_ph(OABC + (size_t)GT * 1024, wbr + (size_t)DM * 1024, GT, DM, 1024, EpiGate<1>{P + C_GATE + DM, M32, MBF, NP, 0});
        xcd_barrier(bar);
        gemm_ph(OABC + (size_t)2 * GT * 1024, wbr + (size_t)2 * DM * 1024, GT, DM, 1024, EpiGate<2>{P + C_GATE + 2 * DM, M32, MBF, NP, 0});
        xcd_barrier(bar);
        gemm_ph(MBF, (const bf16_t*)(ws + OFF_WOUT) + (size_t)l * DM * DM, GT, DM, DM, EpiResid{xin, xout, mA + 2 * DM, mB + 2 * DM});
        xcd_barrier(bar);
        phase_norm(p, xout, p.norm2_g + l * DM, l, grp, 3 * DM, 4 * DM, bid, nb);
        xcd_barrier(bar);
        gemm_ph(H, (const bf16_t*)(ws + OFF_W1) + (size_t)l * DFF * DM, GT, DFF, DM, EpiStoreBf16<1>{P, DFF, 0});
        xcd_barrier(bar);
        gemm_ph(P, (const bf16_t*)(ws + OFF_W2) + (size_t)l * DM * DFF, GT, DM, DFF, EpiResid{xout, xout, mA + 5 * DM, mB + 5 * DM});
        xcd_barrier(bar);
    }
}

extern "C" void kernel_launch(void* const* d_in, const int* in_sizes, int n_in, void* d_out, int out_size, void* d_ws, size_t ws_size, hipStream_t stream) {
    Params p{};
    const float** f = (const float**)&p;
    for (int i = 0; i < 33; ++i) f[i] = (const float*)d_in[i];
    p.out = (float*)d_out; p.ws = (unsigned char*)d_ws;
    if (ws_size < WS_END) { fprintf(stderr, "workspace too small: %zu < %zu\n", ws_size, (size_t)WS_END); return; }
    static int grid = 0;
    if (!grid) {
        int dev = 0, cus = 0, per_cu = 0;
        (void)hipGetDevice(&dev);
        (void)hipDeviceGetAttribute(&cus, hipDeviceAttributeMultiprocessorCount, dev);
        (void)hipFuncSetAttribute((const void*)k_mega, hipFuncAttributeMaxDynamicSharedMemorySize, LDS_BYTES);
        (void)hipOccupancyMaxActiveBlocksPerMultiprocessor(&per_cu, k_mega, 512, LDS_BYTES);
        grid = cus * (per_cu < 1 ? per_cu : 1);
        if (grid <= 0) { fprintf(stderr, "occupancy query failed: cus %d per_cu %d\n", cus, per_cu); grid = 0; return; }
    }
    (void)hipMemsetAsync(p.ws + OFF_BAR, 0, XCD_BAR_WORDS * sizeof(unsigned), stream);
    hipLaunchKernelGGL(k_mega, dim3(grid), dim3(512), LDS_BYTES, stream, p);
}
```

```cpp
#include <hip/hip_runtime.h>
#include <stdint.h>
#include <stdio.h>

constexpr int DM = 2048, DFF = 8192, NMOD = 6, NCOND = 9;
constexpr int GT = 8192;
constexpr int NGRP = 5, DEPTH = 2;
constexpr int C_GQ = 0, C_GK = 512, C_GV = 1024, C_GG = 2048, C_GA = 3072, C_NQ = 3328, C_NK = 4352, C_NV = 5376, C_HY = 6400, C_GATE = 9472, NP = 15616;
constexpr int IN_TOTAL = 15392;
constexpr float EPS = 1e-6f;

typedef unsigned short bf16_t;
typedef float f32x4 __attribute__((ext_vector_type(4)));
typedef float f32x2 __attribute__((ext_vector_type(2)));
typedef unsigned u32x4 __attribute__((ext_vector_type(4)));
typedef unsigned u32x2 __attribute__((ext_vector_type(2)));
#define DI __device__ __forceinline__

DI int ltid() { int t = threadIdx.x; asm volatile("" : "+v"(t)); return t; }
DI float bf2f(bf16_t b) { return __uint_as_float(((unsigned)b) << 16); }
DI float bflo(unsigned w) { return __uint_as_float(w << 16); }
DI float bfhi(unsigned w) { return __uint_as_float(w & 0xffff0000u); }
DI bf16_t f2bf(float f) { unsigned u = __float_as_uint(f); u += 0x7FFFu + ((u >> 16) & 1u); return (bf16_t)(u >> 16); }
DI unsigned pk2(float lo, float hi) { return (unsigned)f2bf(lo) | ((unsigned)f2bf(hi) << 16); }
DI float sigmoidf_(float x) { return 1.0f / (1.0f + __expf(-x)); }
DI float wave_sum(float v, int lane) {
#pragma unroll
    for (int o = 32; o >= 1; o >>= 1) v += __int_as_float(__builtin_amdgcn_ds_bpermute((lane ^ o) << 2, __float_as_int(v))); return v; }
DI float wave_max(float v, int lane) {
#pragma unroll
    for (int o = 32; o >= 1; o >>= 1) v = fmaxf(v, __int_as_float(__builtin_amdgcn_ds_bpermute((lane ^ o) << 2, __float_as_int(v)))); return v; }

constexpr size_t al256(size_t x) { return (x + 255) & ~(size_t)255; }
constexpr size_t OFF_BAR  = 0;
constexpr size_t OFF_MOD  = 65536;
constexpr size_t OFF_HID  = OFF_MOD  + al256((size_t)DEPTH * NCOND * 12288 * 4);
constexpr size_t OFF_FILT = OFF_HID  + (size_t)DEPTH * 2 * 4096 * 64 * 4;
constexpr size_t FILT_L   = (size_t)2 * 1024 * (256 + 4096) * 4;
constexpr size_t OFF_WIN  = OFF_FILT + DEPTH * FILT_L;
constexpr size_t OFF_WBR  = OFF_WIN  + (size_t)DEPTH * NP * DM * 2;
constexpr size_t OFF_WOUT = OFF_WBR  + (size_t)DEPTH * 3 * DM * 1024 * 2;
constexpr size_t OFF_W1   = OFF_WOUT + (size_t)DEPTH * DM * DM * 2;
constexpr size_t OFF_W2   = OFF_W1   + (size_t)DEPTH * DFF * DM * 2;
constexpr size_t OFF_H    = OFF_W2   + (size_t)DEPTH * DFF * DM * 2;
constexpr size_t OFF_P    = OFF_H    + (size_t)GT * DM * 2;
constexpr size_t OFF_OF   = OFF_P    + (size_t)GT * NP * 2;
constexpr size_t OFF_OB   = OFF_OF   + (size_t)GT * 1024 * 4;
constexpr size_t OFF_OABC = OFF_OB   + (size_t)GT * 1024 * 4;
constexpr size_t OFF_M32  = OFF_OABC + (size_t)3 * GT * 1024 * 2;
constexpr size_t OFF_MBF  = OFF_M32  + (size_t)GT * DM * 4;
constexpr size_t OFF_QN   = OFF_MBF  + (size_t)GT * DM * 2;
constexpr size_t OFF_KN   = OFF_QN   + (size_t)GT * 1024 * 2;
constexpr size_t OFF_QF   = OFF_KN   + (size_t)GT * 1024 * 2;
constexpr size_t OFF_QB   = OFF_QF   + (size_t)GT * 512 * 2;
constexpr size_t OFF_KFT  = OFF_QB   + (size_t)GT * 512 * 2;
constexpr size_t OFF_KBT  = OFF_KFT  + (size_t)GT * 512 * 2;
constexpr size_t OFF_VT   = OFF_KBT  + (size_t)GT * 512 * 2;
constexpr size_t OFF_DEC  = OFF_VT   + (size_t)GT * 1024 * 2;
constexpr size_t OFF_OI   = OFF_DEC  + (size_t)2 * 128 * 512 * 4;
constexpr size_t OFF_UCT  = OFF_OI   + (size_t)GT * 1024 * 4;
constexpr size_t OFF_OCT  = OFF_UCT  + (size_t)3072 * GT * 2;
constexpr size_t WS_END   = OFF_OCT  + (size_t)1024 * GT * 2;
static_assert(WS_END < (size_t)1190000000, "workspace too large");

constexpr size_t OUT_YP = 0, OUT_YS = (size_t)32 * 256 * DM, OUT_ST = OUT_YS + (size_t)8 * 4096 * DM,
                 OUT_CK = OUT_ST + (size_t)32 * 2 * 2 * 4 * 128 * 256, OUT_CV = OUT_CK + (size_t)32 * 2 * 8 * 256 * 128;

struct Params {
    const float *x_prompt, *x_sample, *state_gla, *cache_k, *cache_v, *c, *c_ctx, *w_mod, *b_mod, *norm1_g, *norm2_g, *w_in, *gla_wa2, *gla_ba2, *gla_norm_g,
                *na_qnorm_g, *na_knorm_g, *na_rpb, *hy_conv_w, *hy_conv_b, *hy_f1_w, *hy_f1_b, *hy_f2_w, *hy_f2_b, *hy_f3_w, *hy_freq, *hy_bias,
                *w_br_a, *w_br_b, *w_br_c, *w_out, *w_mlp1, *w_mlp2;
    float* out; unsigned char* ws;
};
constexpr int NPARAM = 35;
union ParamsU { Params s; unsigned long long a[NPARAM]; };
static_assert(sizeof(Params) == NPARAM * 8, "Params must be 35 pointers");
DI unsigned char* lws(const Params& p) { unsigned char* w = p.ws; asm volatile("" : "+s"(w)); return w; }
DI float* lout(const Params& p) { float* w = p.out; asm volatile("" : "+s"(w)); return w; }
namespace pg8 {
#define PG8_LAS __attribute__((address_space(3)))
typedef unsigned short bf16_t;
typedef short bf16x8 __attribute__((ext_vector_type(8)));
typedef float f32x4 __attribute__((ext_vector_type(4)));
typedef unsigned u32x4 __attribute__((ext_vector_type(4)));
constexpr int BM = 256, BK = 64, HALF = 128, HTB = HALF * BK * 2  , STAGE_BYTES = 8 * HTB, NXCD = 8, WGM = 8;
__host__ __device__ __forceinline__ int lds_byte(int r, int c) { const int st = (r >> 4) * 2 + (c >> 5), rr = r & 15, cc = c & 31, ob = rr * 64 + cc * 2; return st * 1024 + (ob ^ (((ob >> 9) & 1) << 5)); }
__host__ __device__ __forceinline__ void stage_rc(int b, int& R, int& C) { const int st = b / 1024, sb = b % 1024, swz = sb ^ (((sb >> 9) & 1) << 5); R = (st >> 1) * 16 + swz / 64; C = (st & 1) * 32 + (swz % 64) / 2; }
__host__ __device__ __forceinline__ int perm32(int rho) { const int n = rho >> 4, i = rho & 15; return 8 * (i >> 2) + 4 * n + (i & 3); }
struct Unit { int pm, pn; };
struct Gemm { const bf16_t* A; const bf16_t* Bt; int M, N, K, pad; };
struct StaticOrder {
    int nM, nN, nwg, G, c;
    __host__ __device__ void init(int M, int N, int G_, int c_) { nM = M / BM; nN = N / BM; nwg = nM * nN; G = G_; c = c_; }
    __host__ __device__ bool next(int i, Unit& u) const {
        const long L = (long)i * G + c; if (L >= nwg) return false;
        int wgid = (int)L; { const int q = nwg / NXCD, r = nwg % NXCD, xcd = wgid % NXCD, off = wgid / NXCD; wgid = (xcd < r ? xcd * (q + 1) : r * (q + 1) + (xcd - r) * q) + off; }
        const int nig = WGM * nN, gid = wgid / nig, fm = gid * WGM, gsz = (nM - fm) < WGM ? (nM - fm) : WGM;
        u.pm = fm + ((wgid % nig) % gsz); u.pn = (wgid % nig) / gsz; return true;
    }
    __device__ __forceinline__ void a_ready(const Unit&) const {}
    __device__ __forceinline__ void done(const Unit&) const {}
};
__device__ __forceinline__ unsigned cvt_pk_bf16(float lo, float hi) { unsigned r; asm volatile("v_cvt_pk_bf16_f32 %0, %1, %2" : "=v"(r) : "v"(lo), "v"(hi)); return r; }
template <class Epi, class Sched, bool STAMP = false>
__device__ __forceinline__ void gemm_phase(PG8_LAS unsigned char* lds, const Gemm g, const Sched& S, const Epi& E, unsigned long long* stamps) {
    int tid_ = threadIdx.x; asm volatile("" : "+v"(tid_));
    const int tid = tid_, wid = __builtin_amdgcn_readfirstlane(tid >> 6), lane = tid & 63, wr = wid >> 2, wc = wid & 3, fr = lane & 15, fq = lane >> 4;
    const int K = g.K, nt = K / BK;
    int ts_lo = 0, ts_hi = 0, nts = 0; const unsigned long long rt_entry = STAMP ? (unsigned long long)wall_clock64() : 0ull;
#define PG8_STAMP() do { if (STAMP && wid == 0 && nts < 64) { const unsigned long long _c = (unsigned long long)clock64(); \
        ts_lo = (lane == nts) ? (int)(unsigned)_c : ts_lo; ts_hi = (lane == nts) ? (int)(unsigned)(_c >> 32) : ts_hi; ++nts; } } while (0)
    PG8_STAMP();
    unsigned voffA[2], voffB[2];
#pragma unroll
    for (int i = 0; i < 2; ++i) { int R, C; stage_rc(tid * 16 + i * 8192, R, C); const int Rb = Epi::PERM ? ((R & ~31) + perm32(R & 31)) : R;
        voffA[i] = (unsigned)(R * K + C) * 2u; voffB[i] = (unsigned)(Rb * K + C) * 2u; }
    const size_t kstep = (size_t)(BK * 2);
    const size_t hstep = (size_t)HALF * K * 2;
    const size_t tstep = 2 * hstep;
    const unsigned ldsw = (unsigned)wid * 1024u;
    const int aoff = lds_byte(wr * 64 + fr, fq * 8), boff = lds_byte(wc * 32 + fr, fq * 8);
#define PG8_SA(b, h) (((b) * 2 + (h)) * HTB)
#define PG8_SB(b, h) ((4 + (b) * 2 + (h)) * HTB)
#define PG8_STAGE(bufoff, gbase, voff) do { _Pragma("unroll") for (int _i = 0; _i < 2; ++_i) \
        __builtin_amdgcn_global_load_lds((const unsigned*)((const char*)(gbase) + (voff)[_i]), (PG8_LAS unsigned*)(lds + (bufoff) + ldsw + _i * 8192), 16, 0, 0); } while (0)
#define PG8_LDA(dst, b, h) do { _Pragma("unroll") for (int m = 0; m < 4; ++m) _Pragma("unroll") for (int k = 0; k < 2; ++k) dst[m][k] = *(const PG8_LAS bf16x8*)(lds + PG8_SA(b, h) + aoff + m * 2048 + k * 1024); } while (0)
#define PG8_LDB(dst, b, h) do { _Pragma("unroll") for (int n = 0; n < 2; ++n) _Pragma("unroll") for (int k = 0; k < 2; ++k) dst[n][k] = *(const PG8_LAS bf16x8*)(lds + PG8_SB(b, h) + boff + n * 2048 + k * 1024); } while (0)
#define PG8_MMA(ai, bj, At, Bt) do { __builtin_amdgcn_s_setprio(1); _Pragma("unroll") for (int m = 0; m < 4; ++m) _Pragma("unroll") for (int n = 0; n < 2; ++n) _Pragma("unroll") for (int k = 0; k < 2; ++k) \
        acc[ai][bj][m][n] = __builtin_amdgcn_mfma_f32_16x16x32_bf16(Bt[n][k], At[m][k], acc[ai][bj][m][n], 0, 0, 0); __builtin_amdgcn_s_setprio(0); } while (0)
#define PG8_WAIT_V(n) asm volatile("s_waitcnt vmcnt(" #n ")" ::: "memory")
#define PG8_WAIT_L(n) asm volatile("s_waitcnt lgkmcnt(" #n ")" ::: "memory")
#define PG8_BAR __builtin_amdgcn_s_barrier()
#define PG8_SCHED __builtin_amdgcn_sched_barrier(0)
    Unit cur, nxt; int ui = 0;
    if (!S.next(0, cur)) return;
    f32x4 acc[2][2][4][2];
#pragma unroll
    for (int a = 0; a < 2; ++a)
#pragma unroll
        for (int b = 0; b < 2; ++b)
#pragma unroll
            for (int m = 0; m < 4; ++m)
#pragma unroll
                for (int n = 0; n < 2; ++n) acc[a][b][m][n] = (f32x4){0.f, 0.f, 0.f, 0.f};
    bf16x8 At[4][2], B0[2][2], B1[2][2];
    const char* cA = (const char*)g.A + (size_t)cur.pm * tstep; const char* cB = (const char*)g.Bt + (size_t)cur.pn * tstep;
    S.a_ready(cur);
    PG8_STAGE(PG8_SB(0, 0), cB, voffB); PG8_STAGE(PG8_SA(0, 0), cA, voffA); PG8_STAGE(PG8_SB(0, 1), cB + hstep, voffB); PG8_STAGE(PG8_SA(0, 1), cA + hstep, voffA);
    if (wr == 1) PG8_BAR;
    PG8_WAIT_V(4); PG8_BAR;
    PG8_STAGE(PG8_SB(1, 0), cB + kstep, voffB); PG8_STAGE(PG8_SA(1, 0), cA + kstep, voffA); PG8_STAGE(PG8_SB(1, 1), cB + hstep + kstep, voffB);
    PG8_WAIT_V(6); PG8_BAR;
    PG8_STAMP();
    for (;;) {
        const bool has_next = S.next(ui + 1, nxt);
        const char* nA = has_next ? (const char*)g.A + (size_t)nxt.pm * tstep : cA; const char* nB = has_next ? (const char*)g.Bt + (size_t)nxt.pn * tstep : cB;
        for (int t = 0; t < nt; t += 2) {
            const bool last = (t == nt - 2);
            const char* a1 = cA + (size_t)(t + 1) * kstep;
            const char* a2 = last ? nA : cA + (size_t)(t + 2) * kstep; const char* b2 = last ? nB : cB + (size_t)(t + 2) * kstep;
            const char* a3 = a2 + kstep; const char* b3 = b2 + kstep;
            if (last && has_next) S.a_ready(nxt);
            PG8_LDB(B0, 0, 0); PG8_SCHED; PG8_LDA(At, 0, 0); PG8_STAGE(PG8_SA(1, 1), a1 + hstep, voffA);
            PG8_WAIT_L(8); PG8_BAR; PG8_WAIT_L(0); PG8_MMA(0, 0, At, B0); PG8_BAR; PG8_SCHED;
            PG8_LDB(B1, 0, 1); PG8_STAGE(PG8_SB(0, 0), b2, voffB);
            PG8_BAR; PG8_WAIT_L(0); PG8_MMA(0, 1, At, B1); PG8_BAR;
            PG8_LDA(At, 0, 1); PG8_STAGE(PG8_SA(0, 0), a2, voffA);
            PG8_BAR; PG8_WAIT_L(0); PG8_MMA(1, 0, At, B0); PG8_BAR; PG8_SCHED;
            PG8_STAGE(PG8_SB(0, 1), b2 + hstep, voffB);
            PG8_WAIT_V(6); PG8_BAR; PG8_MMA(1, 1, At, B1); PG8_BAR;
            PG8_LDB(B0, 1, 0); PG8_SCHED; PG8_LDA(At, 1, 0); PG8_STAGE(PG8_SA(0, 1), a2 + hstep, voffA);
            PG8_WAIT_L(8); PG8_BAR; PG8_WAIT_L(0); PG8_MMA(0, 0, At, B0); PG8_BAR; PG8_SCHED;
            PG8_LDB(B1, 1, 1); PG8_STAGE(PG8_SB(1, 0), b3, voffB);
            PG8_BAR; PG8_WAIT_L(0); PG8_MMA(0, 1, At, B1); PG8_BAR;
            PG8_LDA(At, 1, 1); PG8_STAGE(PG8_SA(1, 0), a3, voffA);
            PG8_BAR; PG8_WAIT_L(0); PG8_MMA(1, 0, At, B0); PG8_BAR; PG8_SCHED;
            PG8_STAGE(PG8_SB(1, 1), b3 + hstep, voffB);
            PG8_WAIT_V(6); PG8_BAR; PG8_MMA(1, 1, At, B1); PG8_BAR;
        }
        PG8_STAMP();
        if constexpr (!Epi::AFTER_DRAIN) { E(acc, cur, wr, wc, fr, fq); S.done(cur); }
        PG8_STAMP();
        if (!has_next) break;
#pragma unroll
        for (int a = 0; a < 2; ++a)
#pragma unroll
            for (int b = 0; b < 2; ++b)
#pragma unroll
                for (int m = 0; m < 4; ++m)
#pragma unroll
                    for (int n = 0; n < 2; ++n) acc[a][b][m][n] = (f32x4){0.f, 0.f, 0.f, 0.f};
        cur = nxt; cA = nA; cB = nB; ++ui;
    }
    PG8_WAIT_V(0);
    if (wr == 0) PG8_BAR;
    PG8_BAR;
    if constexpr (Epi::AFTER_DRAIN) { E.fused(acc, cur, wr, wc, fr, fq, lds, wid, lane); S.done(cur); }
    PG8_STAMP();
    if (STAMP && wid == 0) { stamps[lane] = lane < nts ? (((unsigned long long)(unsigned)ts_hi << 32) | (unsigned)ts_lo) : 0ull;
        if (lane == 62) stamps[62] = rt_entry; if (lane == 63) stamps[63] = (unsigned long long)wall_clock64(); }
#undef PG8_STAMP
#undef PG8_SA
#undef PG8_SB
#undef PG8_STAGE
#undef PG8_LDA
#undef PG8_LDB
#undef PG8_MMA
#undef PG8_WAIT_V
#undef PG8_WAIT_L
#undef PG8_BAR
#undef PG8_SCHED
}
}
#define XB_TMO      128
#define XB_XCNT(j)  (256  + 64 * (j))
#define XB_XSUB(j)  (1280 + 64 * (j))
#define XB_XGEN(j)  (2304 + 64 * (j))
#define XB_TOP      3328
#define XB_TOPGEN   3392
#define XCD_BAR_WORDS 3456
#define XB_SPIN_CAP (1u << 18)
#define LAS __attribute__((address_space(3)))

__device__ __forceinline__ unsigned xb_ld(unsigned* p)              { return __hip_atomic_load(p, __ATOMIC_RELAXED, __HIP_MEMORY_SCOPE_AGENT); }
__device__ __forceinline__ unsigned xb_add(unsigned* p, unsigned v) { return __hip_atomic_fetch_add(p, v, __ATOMIC_RELAXED, __HIP_MEMORY_SCOPE_AGENT); }
__device__ __forceinline__ unsigned xb_xcc_id() { return (unsigned)__builtin_amdgcn_s_getreg((3 << 11) | 20) & 0xFu; }
#define XB_SPIN(cond, bar) do { unsigned _sp = 0; while (cond) { __builtin_amdgcn_s_sleep(1); \
    if ((++_sp & 255u) == 0u) { if (xb_ld(&(bar)[XB_TMO])) break; if (_sp > XB_SPIN_CAP) { atomicAdd(&(bar)[XB_TMO], 1u); break; } } } } while (0)

struct XcdBarrier {
    unsigned* bar; unsigned x;
    volatile LAS unsigned* st;
};

__device__ __forceinline__ XcdBarrier xcd_barrier_post(unsigned* bar, volatile LAS unsigned* st) {
    XcdBarrier b; b.bar = bar; b.x = (unsigned)__builtin_amdgcn_readfirstlane((int)xb_xcc_id()); b.st = st;
    if (threadIdx.x == 0) (void)xb_add(&bar[XB_XCNT(b.x)], 1u);
    return b;
}
__device__ __forceinline__ void xcd_barrier_complete(unsigned* bar, unsigned x, unsigned& nloc, unsigned& nx) {
    const unsigned G = gridDim.x * gridDim.y * gridDim.z;
    unsigned sum, cnt, mine, sp = 0u;
    for (;;) {
        sum = 0u; cnt = 0u; mine = 0u;
#pragma unroll
        for (unsigned j = 0; j < 16; ++j) { const unsigned c = xb_ld(&bar[XB_XCNT(j)]); sum += c; cnt += (c > 0u) ? 1u : 0u; mine = (j == x) ? c : mine; }
        if (sum == G) break;
        __builtin_amdgcn_s_sleep(1);
        if ((++sp & 255u) == 0u) { if (xb_ld(&bar[XB_TMO])) break; if (sp > XB_SPIN_CAP) { atomicAdd(&bar[XB_TMO], 1u); break; } }
    }
    nloc = mine > 0u ? mine : 1u; nx = cnt > 0u ? cnt : 1u;
}

__device__ __forceinline__ void xcd_barrier(const XcdBarrier& b) {
    asm volatile("s_waitcnt vmcnt(0)" ::: "memory");
    __syncthreads();
    if (threadIdx.x == 0) {
        unsigned* bar = b.bar; unsigned bx = b.x; asm volatile("" : "+s"(bx));
        __builtin_amdgcn_s_waitcnt(0);
        unsigned nloc = b.st[0], nx = b.st[1];
        if (nloc == 0u) { xcd_barrier_complete(bar, bx, nloc, nx); b.st[0] = nloc; b.st[1] = nx; }
        const unsigned old = xb_add(&bar[XB_XSUB(bx)], 1u);
        const unsigned gen = old / nloc;
        if (old + 1u == (gen + 1u) * nloc) {
            __builtin_amdgcn_fence(__ATOMIC_RELEASE, "agent");
            asm volatile("s_waitcnt vmcnt(0)" ::: "memory");
            const unsigned og = xb_add(&bar[XB_TOP], 1u);
            const unsigned tg = og / nx;
            if (og + 1u == (tg + 1u) * nx) xb_add(&bar[XB_TOPGEN], 1u);
            else XB_SPIN(xb_ld(&bar[XB_TOPGEN]) == tg, bar);
            __builtin_amdgcn_fence(__ATOMIC_ACQUIRE, "agent");
            xb_add(&bar[XB_XGEN(bx)], 1u);
            asm volatile("s_waitcnt vmcnt(0)" ::: "memory");
        } else {
            XB_SPIN(xb_ld(&bar[XB_XGEN(bx)]) == gen, bar);
            __builtin_amdgcn_fence(__ATOMIC_ACQUIRE, "agent");
            asm volatile("s_waitcnt vmcnt(0)" ::: "memory");
        }
    }
    __syncthreads();
}

extern __shared__ __attribute__((aligned(16))) unsigned char smem[];

DI void convT_tile(const float* __restrict__ src, int ldsrc, bf16_t* __restrict__ dst, int K, int tile, int ntn, bool inmap) {
    float* t = (float*)smem;
    const int tid = ltid(), tk = tile / ntn, tn = tile % ntn, k0 = tk * 64, n0 = tn * 64;
    __syncthreads();
#pragma unroll
    for (int r = 0; r < 8; ++r) {
        const int i = (tid >> 6) + 8 * r, j = tid & 63, n = n0 + j;
        int sn = n; bool z = false;
        if (inmap) { if (n >= 3104 && n < C_NQ) z = true; else if (n >= C_NQ) sn = n - 224; }
        t[i * 65 + j] = z ? 0.f : src[(size_t)(k0 + i) * ldsrc + sn];
    }
    __syncthreads();
    const int j = tid >> 3, i8 = (tid & 7) * 8;
    u32x4 w;
    w.x = pk2(t[(i8 + 0) * 65 + j], t[(i8 + 1) * 65 + j]); w.y = pk2(t[(i8 + 2) * 65 + j], t[(i8 + 3) * 65 + j]);
    w.z = pk2(t[(i8 + 4) * 65 + j], t[(i8 + 5) * 65 + j]); w.w = pk2(t[(i8 + 6) * 65 + j], t[(i8 + 7) * 65 + j]);
    *(u32x4*)(dst + (size_t)(n0 + j) * K + k0 + i8) = w;
}
DI void phase_convert(const Params& p, int bid, int nb) {
    for (int l = 0; l < DEPTH; ++l) {
        { const int ntn = NP / 64, nt = (DM / 64) * ntn; bf16_t* d = (bf16_t*)(lws(p) + OFF_WIN) + (size_t)l * NP * DM;
          for (int t = bid; t < nt; t += nb) convT_tile(p.w_in + (size_t)l * DM * IN_TOTAL, IN_TOTAL, d, DM, t, ntn, true); }
        for (int br = 0; br < 3; ++br) { const float* s = (br == 0 ? p.w_br_a : br == 1 ? p.w_br_b : p.w_br_c) + (size_t)l * 1024 * DM;
          const int ntn = DM / 64, nt = (1024 / 64) * ntn; bf16_t* d = (bf16_t*)(lws(p) + OFF_WBR) + ((size_t)l * 3 + br) * DM * 1024;
          for (int t = bid; t < nt; t += nb) convT_tile(s, DM, d, 1024, t, ntn, false); }
        { const int ntn = DM / 64, nt = (DM / 64) * ntn; bf16_t* d = (bf16_t*)(lws(p) + OFF_WOUT) + (size_t)l * DM * DM;
          for (int t = bid; t < nt; t += nb) convT_tile(p.w_out + (size_t)l * DM * DM, DM, d, DM, t, ntn, false); }
        { const int ntn = DFF / 64, nt = (DM / 64) * ntn; bf16_t* d = (bf16_t*)(lws(p) + OFF_W1) + (size_t)l * DFF * DM;
          for (int t = bid; t < nt; t += nb) convT_tile(p.w_mlp1 + (size_t)l * DM * DFF, DFF, d, DM, t, ntn, false); }
        { const int ntn = DM / 64, nt = (DFF / 64) * ntn; bf16_t* d = (bf16_t*)(lws(p) + OFF_W2) + (size_t)l * DM * DFF;
          for (int t = bid; t < nt; t += nb) convT_tile(p.w_mlp2 + (size_t)l * DFF * DM, DM, d, DFF, t, ntn, false); }
    }
}

DI void phase_adaln(const Params& p, int bid, int nb) {
    float* sc = (float*)smem;
    float* red = sc + NCOND * DM;
    const int tid = ltid();
    __syncthreads();
    for (int i = tid; i < NCOND * DM; i += 512) { const int r = i / DM, k = i % DM; const float v = r == 0 ? p.c_ctx[k] : p.c[(size_t)(r - 1) * DM + k]; sc[i] = v * sigmoidf_(v); }
    __syncthreads();
    const int nun = DEPTH * (NMOD * DM / 64);
    for (int u = bid; u < nun; u += nb) {
        const int l = u / (NMOD * DM / 64), j0 = (u % (NMOD * DM / 64)) * 64, j = tid & 63, ks = tid >> 6;
        const float* w = p.w_mod + (size_t)l * DM * (NMOD * DM) + j0 + j;
        float acc[NCOND];
#pragma unroll
        for (int r = 0; r < NCOND; ++r) acc[r] = 0.f;
        for (int k = ks * 256; k < ks * 256 + 256; ++k) { const float wv = w[(size_t)k * (NMOD * DM)];
#pragma unroll
            for (int r = 0; r < NCOND; ++r) acc[r] += sc[r * DM + k] * wv; }
#pragma unroll
        for (int r = 0; r < NCOND; ++r) red[(ks * NCOND + r) * 64 + j] = acc[r];
        __syncthreads();
        for (int i = tid; i < NCOND * 64; i += 512) { const int r = i / 64, jj = i % 64; float s = p.b_mod[(size_t)l * NMOD * DM + j0 + jj];
#pragma unroll
            for (int q = 0; q < 8; ++q) s += red[(q * NCOND + r) * 64 + jj];
            ((float*)(lws(p) + OFF_MOD))[((size_t)l * NCOND + r) * (NMOD * DM) + j0 + jj] = s; }
        __syncthreads();
    }
}

DI void phase_hyena_hid(const Params& p, int bid, int nb) {
    float* zf = (float*)smem;
    float* h1 = zf + 8 * 36;
    const int tid = ltid(), tt = tid >> 6, j = tid & 63;
    const int nun = DEPTH * (256 / 8 + 4096 / 8);
    for (int u = bid; u < nun; u += nb) {
        const int l = u / 544, r = u % 544, ls = r < 32 ? 0 : 1, tb = ls ? r - 32 : r, L = ls ? 4096 : 256, t = tb * 8 + tt;
        const float tn = (float)t / (float)L;
        __syncthreads();
        if (j < 33) { float v; if (j == 0) v = tn; else { const int band = j <= 16 ? j : j - 16; const float ang = 6.283185307179586f * tn * (float)band; v = j <= 16 ? cosf(ang) : sinf(ang); } zf[tt * 36 + j] = v; }
        __syncthreads();
        const float fr = p.hy_freq[l * 64 + j];
        float a = p.hy_f1_b[l * 64 + j];
        for (int i = 0; i < 33; ++i) a += zf[tt * 36 + i] * p.hy_f1_w[((size_t)l * 33 + i) * 64 + j];
        h1[tt * 64 + j] = sinf(fr * a);
        __syncthreads();
        float b = p.hy_f2_b[l * 64 + j];
        for (int i = 0; i < 64; ++i) b += h1[tt * 64 + i] * p.hy_f2_w[((size_t)l * 64 + i) * 64 + j];
        ((float*)(lws(p) + OFF_HID))[(((size_t)l * 2 + ls) * 4096 + t) * 64 + j] = sinf(fr * b);
    }
}
DI const float* filt_ptr(const unsigned char* ws, int l, int ls) { return (const float*)(ws + OFF_FILT + (size_t)l * FILT_L) + (ls ? (size_t)2 * 1024 * 256 : 0); }
DI void phase_filters(const Params& p, int bid, int nb) {
    float* f3s = (float*)smem;
    float* red = f3s + 256;
    const int tid = ltid(), lane = tid & 63, wid = tid >> 6;
    const int nun = DEPTH * 2 * 512;
    for (int u = bid; u < nun; u += nb) {
        const int l = u / 1024, ls = (u / 512) & 1, cg = u % 512, L = ls ? 4096 : 256, col0 = cg * 4;
        __syncthreads();
        if (tid < 256) f3s[tid] = p.hy_f3_w[((size_t)l * 64 + (tid >> 2)) * 2048 + col0 + (tid & 3)];
        __syncthreads();
        const float* hid = (const float*)(lws(p) + OFF_HID) + ((size_t)l * 2 + ls) * 4096 * 64;
        float val[8][4]; float ss[4] = {0.f, 0.f, 0.f, 0.f};
        float delta[4];
#pragma unroll
        for (int cc = 0; cc < 4; ++cc) { const int c = (col0 + cc) & 1023; const float a = -3.0701134573253943f, b = -15.350567286626972f; delta[cc] = fabsf(a + (b - a) * ((float)c / 1023.0f)); }
#pragma unroll
        for (int i = 0; i < 8; ++i) {
            const int t = tid + 512 * i;
#pragma unroll
            for (int cc = 0; cc < 4; ++cc) val[i][cc] = 0.f;
            if (t < L) {
                const f32x4* hr = (const f32x4*)(hid + (size_t)t * 64);
                float a0 = 0.f, a1 = 0.f, a2 = 0.f, a3 = 0.f;
#pragma unroll
                for (int q = 0; q < 16; ++q) { const f32x4 hv = hr[q];
#pragma unroll
                    for (int e = 0; e < 4; ++e) { const f32x4 w = *(const f32x4*)(f3s + (q * 4 + e) * 4); a0 += hv[e] * w[0]; a1 += hv[e] * w[1]; a2 += hv[e] * w[2]; a3 += hv[e] * w[3]; } }
                const float dist = fabsf((float)t - (float)(L / 2)) * (2.0f / (float)L);
                val[i][0] = a0 * expf(-dist * delta[0]); val[i][1] = a1 * expf(-dist * delta[1]); val[i][2] = a2 * expf(-dist * delta[2]); val[i][3] = a3 * expf(-dist * delta[3]);
#pragma unroll
                for (int cc = 0; cc < 4; ++cc) ss[cc] += val[i][cc] * val[i][cc];
            }
        }
#pragma unroll
        for (int cc = 0; cc < 4; ++cc) { ss[cc] = wave_sum(ss[cc], lane); if (lane == 0) red[wid * 4 + cc] = ss[cc]; }
        __syncthreads();
        float sc[4];
#pragma unroll
        for (int cc = 0; cc < 4; ++cc) { float s = 0.f;
#pragma unroll
            for (int q = 0; q < 8; ++q) s += red[q * 4 + cc]; sc[cc] = rsqrtf(s + EPS); }
        float* fo = (float*)filt_ptr(lws(p), l, ls);
#pragma unroll
        for (int i = 0; i < 8; ++i) { const int t = tid + 512 * i; if (t < L) {
#pragma unroll
            for (int cc = 0; cc < 4; ++cc) { const int col = col0 + cc; fo[((size_t)(col >> 10) * 1024 + (col & 1023)) * L + t] = val[i][cc] * sc[cc]; } } }
    }
}

DI int cond_row(int grp, int row) { return grp == 0 ? 0 : 1 + 2 * (grp - 1) + (row >> 12); }
DI void phase_norm(const Params& p, const float* x, const float* g, int l, int grp, int shoff, int scoff, int bid, int nb) {
    const int tid = ltid(), lane = tid & 63, wid = tid >> 6;
    bf16_t* h = (bf16_t*)(lws(p) + OFF_H);
    for (int row = bid * 8 + wid; row < GT; row += nb * 8) {
        const float* xr = x + (size_t)row * DM;
        f32x4 v[8]; float ss = 0.f;
#pragma unroll
        for (int i = 0; i < 8; ++i) { v[i] = *(const f32x4*)(xr + i * 256 + lane * 4); ss += v[i][0] * v[i][0] + v[i][1] * v[i][1] + v[i][2] * v[i][2] + v[i][3] * v[i][3]; }
        ss = wave_sum(ss, lane);
        const float rs = rsqrtf(ss * (1.0f / DM) + EPS);
        const float* md = (const float*)(lws(p) + OFF_MOD) + ((size_t)l * NCOND + cond_row(grp, row)) * (NMOD * DM);
#pragma unroll
        for (int i = 0; i < 8; ++i) { const int c = i * 256 + lane * 4; const f32x4 gv = *(const f32x4*)(g + c), sh = *(const f32x4*)(md + shoff + c), sc = *(const f32x4*)(md + scoff + c);
            f32x4 o = v[i] * rs * gv * (sc + 1.0f) + sh; u32x2 w; w.x = pk2(o[0], o[1]); w.y = pk2(o[2], o[3]); *(u32x2*)(h + (size_t)row * DM + c) = w; }
    }
}
using pg8::Unit; using pg8::cvt_pk_bf16;
template <int ACT> struct EpiStoreBf16 {
    static constexpr bool PERM = true, AFTER_DRAIN = false;
    bf16_t* O; int ldc; int pad;
    __device__ __forceinline__ void operator()(const f32x4 (&acc)[2][2][4][2], const Unit& u, int wr, int wc, int fr, int fq) const {
        const int row0 = u.pm * 256 + wr * 64 + fr, col0 = u.pn * 256 + wc * 32 + 8 * fq;
#pragma unroll
        for (int ai = 0; ai < 2; ++ai)
#pragma unroll
            for (int m = 0; m < 4; ++m) { bf16_t* rowp = O + (size_t)(row0 + ai * 128 + m * 16) * ldc + col0;
#pragma unroll
                for (int bj = 0; bj < 2; ++bj) { f32x4 v0 = acc[ai][bj][m][0], v1 = acc[ai][bj][m][1];
                    if (ACT == 1) {
#pragma unroll
                        for (int j = 0; j < 4; ++j) { const float a = fmaxf(v0[j], 0.f), b = fmaxf(v1[j], 0.f); v0[j] = a * a; v1[j] = b * b; } }
                    u32x4 w; w.x = cvt_pk_bf16(v0[0], v0[1]); w.y = cvt_pk_bf16(v0[2], v0[3]); w.z = cvt_pk_bf16(v1[0], v1[1]); w.w = cvt_pk_bf16(v1[2], v1[3]);
                    *(u32x4*)(rowp + bj * 128) = w; } }
    }
};
template <int MODE> struct EpiGate {
    static constexpr bool PERM = true, AFTER_DRAIN = false;
    const bf16_t* gate; float* m32; bf16_t* mbf; int ldg; int pad;
    __device__ __forceinline__ void operator()(const f32x4 (&acc)[2][2][4][2], const Unit& u, int wr, int wc, int fr, int fq) const {
        const int row0 = u.pm * 256 + wr * 64 + fr, col0 = u.pn * 256 + wc * 32 + 8 * fq;
#pragma unroll
        for (int ai = 0; ai < 2; ++ai)
#pragma unroll
            for (int m = 0; m < 4; ++m) { const size_t row = (size_t)(row0 + ai * 128 + m * 16);
#pragma unroll
                for (int bj = 0; bj < 2; ++bj) { const int col = col0 + bj * 128;
                    const u32x4 gw = *(const u32x4*)(gate + row * ldg + col);
                    f32x4 s0, s1;
                    s0[0] = sigmoidf_(bflo(gw.x)); s0[1] = sigmoidf_(bfhi(gw.x)); s0[2] = sigmoidf_(bflo(gw.y)); s0[3] = sigmoidf_(bfhi(gw.y));
                    s1[0] = sigmoidf_(bflo(gw.z)); s1[1] = sigmoidf_(bfhi(gw.z)); s1[2] = sigmoidf_(bflo(gw.w)); s1[3] = sigmoidf_(bfhi(gw.w));
                    f32x4 v0 = acc[ai][bj][m][0] * s0, v1 = acc[ai][bj][m][1] * s1;
                    float* mp = m32 + row * DM + col;
                    if (MODE >= 1) { v0 += *(const f32x4*)mp; v1 += *(const f32x4*)(mp + 4); }
                    if (MODE <= 1) { *(f32x4*)mp = v0; *(f32x4*)(mp + 4) = v1; }
                    else { u32x4 w; w.x = cvt_pk_bf16(v0[0], v0[1]); w.y = cvt_pk_bf16(v0[2], v0[3]); w.z = cvt_pk_bf16(v1[0], v1[1]); w.w = cvt_pk_bf16(v1[2], v1[3]);
                           *(u32x4*)(mbf + row * DM + col) = w; } } }
    }
};
struct EpiResid {
    static constexpr bool PERM = true, AFTER_DRAIN = false;
    const float* xin; float* xout; const float* gA; const float* gB;
    __device__ __forceinline__ void operator()(const f32x4 (&acc)[2][2][4][2], const Unit& u, int wr, int wc, int fr, int fq) const {
        const int row0 = u.pm * 256 + wr * 64 + fr, col0 = u.pn * 256 + wc * 32 + 8 * fq;
        const float* gv = (u.pm * 256 < 4096) ? gA : gB;
#pragma unroll
        for (int bj = 0; bj < 2; ++bj) { const int col = col0 + bj * 128; const f32x4 g0 = *(const f32x4*)(gv + col), g1 = *(const f32x4*)(gv + col + 4);
#pragma unroll
            for (int ai = 0; ai < 2; ++ai)
#pragma unroll
                for (int m = 0; m < 4; ++m) { const size_t o = (size_t)(row0 + ai * 128 + m * 16) * DM + col;
                    const f32x4 a0 = *(const f32x4*)(xin + o), a1 = *(const f32x4*)(xin + o + 4);
                    *(f32x4*)(xout + o) = a0 + g0 * acc[ai][bj][m][0]; *(f32x4*)(xout + o + 4) = a1 + g1 * acc[ai][bj][m][1]; } }
    }
};

struct GrpInfo { int grp, l, L, nseq, latent; };
DI GrpInfo grp_info(int grp, int l) { GrpInfo g; g.grp = grp; g.l = l; g.latent = grp > 0; g.L = grp ? 4096 : 256; g.nseq = grp ? 2 : 32; return g; }

DI void phase_na_prep(const Params& p, GrpInfo gi, int bid, int nb) {
    const int tid = ltid(), lane = tid & 63, wid = tid >> 6;
    const bf16_t* P = (const bf16_t*)(lws(p) + OFF_P);
    bf16_t* QN = (bf16_t*)(lws(p) + OFF_QN); bf16_t* KN = (bf16_t*)(lws(p) + OFF_KN);
    const float gq0 = p.na_qnorm_g[gi.l * 128 + 2 * lane], gq1 = p.na_qnorm_g[gi.l * 128 + 2 * lane + 1];
    const float gk0 = p.na_knorm_g[gi.l * 128 + 2 * lane], gk1 = p.na_knorm_g[gi.l * 128 + 2 * lane + 1];
    for (int u = bid * 8 + wid; u < GT * 8; u += nb * 8) {
        const int row = u >> 3, h = u & 7;
        const unsigned qw = *(const unsigned*)(P + (size_t)row * NP + C_NQ + h * 128 + 2 * lane);
        const unsigned kw = *(const unsigned*)(P + (size_t)row * NP + C_NK + h * 128 + 2 * lane);
        const float q0 = bflo(qw), q1 = bfhi(qw), k0 = bflo(kw), k1 = bfhi(kw);
        const float qs = rsqrtf(wave_sum(q0 * q0 + q1 * q1, lane) * (1.0f / 128) + EPS), ks = rsqrtf(wave_sum(k0 * k0 + k1 * k1, lane) * (1.0f / 128) + EPS);
        const float a0 = q0 * qs * gq0, a1 = q1 * qs * gq1, b0 = k0 * ks * gk0, b1 = k1 * ks * gk1;
        *(unsigned*)(QN + (size_t)row * 1024 + h * 128 + 2 * lane) = pk2(a0, a1);
        *(unsigned*)(KN + (size_t)row * 1024 + h * 128 + 2 * lane) = pk2(b0, b1);
        if (!gi.latent) { const int b = row >> 8, t = row & 255; const size_t o = ((((size_t)b * DEPTH + gi.l) * 8 + h) * 256 + t) * 128 + 2 * lane;
            const unsigned vw = *(const unsigned*)(P + (size_t)row * NP + C_NV + h * 128 + 2 * lane);
            *(f32x2*)(lout(p) + OUT_CK + o) = (f32x2){b0, b1}; *(f32x2*)(lout(p) + OUT_CV + o) = (f32x2){bflo(vw), bfhi(vw)}; }
    }
}
DI void phase_na_naive(const Params& p, GrpInfo gi, int bid, int nb) {
    const int tid = ltid(), lane = tid & 63, wid = tid >> 6;
    float* qs = (float*)smem + wid * 512;
    float* ps = qs + 128;
    const bf16_t* P = (const bf16_t*)(lws(p) + OFF_P);
    const bf16_t* QN = (const bf16_t*)(lws(p) + OFF_QN); const bf16_t* KN = (const bf16_t*)(lws(p) + OFF_KN);
    bf16_t* OB = (bf16_t*)(lws(p) + OFF_OABC) + (size_t)GT * 1024;
    const float scale = 0.08838834764831845f;
    for (int u = bid * 8 + wid; u < GT * 8; u += nb * 8) {
        const int row = u >> 3, h = u & 7;
        { const unsigned qw = *(const unsigned*)(QN + (size_t)row * 1024 + h * 128 + 2 * lane); qs[2 * lane] = bflo(qw); qs[2 * lane + 1] = bfhi(qw); }
        asm volatile("s_waitcnt lgkmcnt(0)" ::: "memory");
        const int nkeys = gi.latent ? 384 : 256;
        const int sl = gi.latent ? (row >> 12) : (row >> 8), t = gi.latent ? (row & 4095) : (row & 255);
        const int r = t >> 6, c = t & 63, rs = min(max(r - 4, 0), 56), cs = min(max(c - 8, 0), 48);
        const int bs = 2 * (gi.grp - 1) + sl;
        float mx = -3.0e38f;
#pragma unroll 1
        for (int s = 0; s < 6; ++s) {
            const int kk = s * 64 + lane;
            if (kk < nkeys) {
                float dot = 0.f; float bias = 0.f;
                if (gi.latent && kk >= 128) { const float* kp = p.cache_k + ((((size_t)bs * DEPTH + gi.l) * 8 + h) * 256 + (kk - 128)) * 128;
#pragma unroll 4
                    for (int d = 0; d < 128; d += 4) { const f32x4 kv = *(const f32x4*)(kp + d); const f32x4 qv = *(const f32x4*)(qs + d); dot += kv[0] * qv[0] + kv[1] * qv[1] + kv[2] * qv[2] + kv[3] * qv[3]; } }
                else { int krow;
                    if (gi.latent) { const int i = kk >> 4, j = kk & 15; krow = sl * 4096 + (rs + i) * 64 + cs + j;
                        bias = p.na_rpb[(((size_t)gi.l * 8 + h) * 15 + (rs + i - r + 7)) * 31 + min(max(cs + j - c + 15, 0), 30)]; }
                    else krow = sl * 256 + kk;
                    const bf16_t* kp = KN + (size_t)krow * 1024 + h * 128;
#pragma unroll 4
                    for (int d = 0; d < 128; d += 8) { const u32x4 kw = *(const u32x4*)(kp + d); const f32x4 qa = *(const f32x4*)(qs + d), qb = *(const f32x4*)(qs + d + 4);
                        dot += bflo(kw.x) * qa[0] + bfhi(kw.x) * qa[1] + bflo(kw.y) * qa[2] + bfhi(kw.y) * qa[3] + bflo(kw.z) * qb[0] + bfhi(kw.z) * qb[1] + bflo(kw.w) * qb[2] + bfhi(kw.w) * qb[3]; } }
                const float sc = dot * scale + bias; mx = fmaxf(mx, sc); ps[kk] = sc;
            }
        }
        mx = wave_max(mx, lane);
        float sum = 0.f;
#pragma unroll 1
        for (int s = 0; s < 6; ++s) { const int kk = s * 64 + lane; if (kk < nkeys) { const float e = __expf(ps[kk] - mx); ps[kk] = e; sum += e; } }
        sum = wave_sum(sum, lane); const float inv = 1.0f / sum;
        asm volatile("s_waitcnt lgkmcnt(0)" ::: "memory");
        float o0 = 0.f, o1 = 0.f;
        for (int kk = 0; kk < nkeys; ++kk) {
            const float pv = ps[kk]; float v0, v1;
            if (gi.latent && kk >= 128) { const f32x2 vv = *(const f32x2*)(p.cache_v + ((((size_t)bs * DEPTH + gi.l) * 8 + h) * 256 + (kk - 128)) * 128 + 2 * lane); v0 = vv[0]; v1 = vv[1]; }
            else { const int krow = gi.latent ? sl * 4096 + (rs + (kk >> 4)) * 64 + cs + (kk & 15) : sl * 256 + kk;
                const unsigned vw = *(const unsigned*)(P + (size_t)krow * NP + C_NV + h * 128 + 2 * lane); v0 = bflo(vw); v1 = bfhi(vw); }
            o0 += pv * v0; o1 += pv * v1;
        }
        *(unsigned*)(OB + (size_t)row * 1024 + h * 128 + 2 * lane) = pk2(o0 * inv, o1 * inv);
        asm volatile("s_waitcnt lgkmcnt(0)" ::: "memory");
    }
}

DI float log_sigmoid_(float x) { return fminf(x, 0.f) - log1pf(expf(-fabsf(x))); }
DI void phase_gla_naive(const Params& p, GrpInfo gi, int bid, int nb) {
    const int tid = ltid(), e = tid & 255, dh = tid >> 8, L = gi.L;
    float* qs = (float*)smem; float* ks = qs + 16 * 128; float* as_ = ks + 16 * 128; float* vs = as_ + 16 * 128; float* op = vs + 16 * 256;
    const bf16_t* P = (const bf16_t*)(lws(p) + OFF_P);
    for (int u = bid; u < gi.nseq * 8; u += nb) {
        const int sl = u >> 3, h = (u >> 1) & 3, dir = u & 1;
        float* O = (float*)(lws(p) + (dir ? OFF_OB : OFF_OF));
        float S[64];
        if (gi.latent) { const int bs = 2 * (gi.grp - 1) + sl; const float* s0 = p.state_gla + (((((size_t)bs * DEPTH + gi.l) * 2 + dir) * 4 + h) * 128 + dh * 64) * 256 + e;
#pragma unroll
            for (int j = 0; j < 64; ++j) S[j] = s0[(size_t)j * 256]; }
        else {
#pragma unroll
            for (int j = 0; j < 64; ++j) S[j] = 0.f; }
        const float* wa = p.gla_wa2 + (((size_t)gi.l * 2 + dir) * 16) * 512 + h * 128;
        const float* ba = p.gla_ba2 + ((size_t)gi.l * 2 + dir) * 512 + h * 128;
        for (int bt = 0; bt < L / 16; ++bt) {
            __syncthreads();
#pragma unroll
            for (int i = 0; i < 4; ++i) {
                const int idx = tid + 512 * i, tt = idx >> 7, d = idx & 127, ts = bt * 16 + tt, t = dir ? L - 1 - ts : ts, row = sl * L + t;
                const bf16_t* pr = P + (size_t)row * NP;
                float q = bf2f(pr[C_GQ + h * 128 + d]) * 0.08838834764831845f, k = bf2f(pr[C_GK + h * 128 + d]);
                if (gi.latent) {
                    const float q2 = bf2f(pr[C_GQ + h * 128 + (d ^ 64)]) * 0.08838834764831845f, k2 = bf2f(pr[C_GK + h * 128 + (d ^ 64)]);
                    const int ii = d & 63, f = ii & 31; const float pos = (float)(ii < 32 ? (t >> 6) : (t & 63));
                    const float ang = pos * powf(10000.0f, -(float)f / 32.0f); float sn, cs; sincosf(ang, &sn, &cs);
                    if (d < 64) { q = q * cs - q2 * sn; k = k * cs - k2 * sn; } else { q = q2 * sn + q * cs; k = k2 * sn + k * cs; }
                }
                float xg = ba[d];
#pragma unroll
                for (int r = 0; r < 16; ++r) xg += bf2f(pr[C_GA + dir * 16 + r]) * wa[(size_t)r * 512 + d];
                qs[tt * 128 + d] = q; ks[tt * 128 + d] = k; as_[tt * 128 + d] = expf(log_sigmoid_(xg) * (1.0f / 16.0f));
            }
#pragma unroll
            for (int i = 0; i < 8; ++i) { const int idx = tid + 512 * i, tt = idx >> 8, ee = idx & 255, ts = bt * 16 + tt, t = dir ? L - 1 - ts : ts, row = sl * L + t;
                vs[tt * 256 + ee] = bf2f(P[(size_t)row * NP + C_GV + h * 256 + ee]); }
            __syncthreads();
            for (int tt = 0; tt < 16; ++tt) {
                const float v = vs[tt * 256 + e]; float acc = 0.f;
#pragma unroll
                for (int j4 = 0; j4 < 16; ++j4) {
                    const f32x4 a4 = *(const f32x4*)(as_ + tt * 128 + dh * 64 + j4 * 4), k4 = *(const f32x4*)(ks + tt * 128 + dh * 64 + j4 * 4), q4 = *(const f32x4*)(qs + tt * 128 + dh * 64 + j4 * 4);
#pragma unroll
                    for (int jj = 0; jj < 4; ++jj) { const int j = j4 * 4 + jj; S[j] = a4[jj] * S[j] + k4[jj] * v; acc += q4[jj] * S[j]; }
                }
                op[(tt * 2 + dh) * 256 + e] = acc;
            }
            __syncthreads();
#pragma unroll
            for (int i = 0; i < 8; ++i) { const int idx = tid + 512 * i, tt = idx >> 8, ee = idx & 255, ts = bt * 16 + tt, t = dir ? L - 1 - ts : ts, row = sl * L + t;
                O[(size_t)row * 1024 + h * 256 + ee] = op[(tt * 2) * 256 + ee] + op[(tt * 2 + 1) * 256 + ee]; }
        }
        if (!gi.latent) { float* so = lout(p) + OUT_ST + (((((size_t)sl * DEPTH + gi.l) * 2 + dir) * 4 + h) * 128 + dh * 64) * 256 + e;
#pragma unroll
            for (int j = 0; j < 64; ++j) so[(size_t)j * 256] = S[j]; }
    }
}
template <bool WITH_OI> DI void phase_gla_post(const Params& p, GrpInfo gi, int bid, int nb) {
    const int tid = ltid(), lane = tid & 63, wid = tid >> 6;
    const bf16_t* P = (const bf16_t*)(lws(p) + OFF_P);
    const float* Of = (const float*)(lws(p) + OFF_OF); const float* Ob = (const float*)(lws(p) + OFF_OB); const float* Oi = (const float*)(lws(p) + OFF_OI);
    bf16_t* OA = (bf16_t*)(lws(p) + OFF_OABC);
    const f32x4 g = *(const f32x4*)(p.gla_norm_g + gi.l * 256 + lane * 4);
    for (int u = bid * 8 + wid; u < GT * 4; u += nb * 8) {
        const int row = u >> 2, h = u & 3; const size_t o = (size_t)row * 1024 + h * 256 + lane * 4;
        f32x4 v = *(const f32x4*)(Of + o) + *(const f32x4*)(Ob + o); if (WITH_OI) v += *(const f32x4*)(Oi + o);
        const float rs = rsqrtf(wave_sum(v[0] * v[0] + v[1] * v[1] + v[2] * v[2] + v[3] * v[3], lane) * (1.0f / 256) + EPS);
        const u32x2 gw = *(const u32x2*)(P + (size_t)row * NP + C_GG + h * 256 + lane * 4);
        const float g0 = bflo(gw.x), g1 = bfhi(gw.x), g2 = bflo(gw.y), g3 = bfhi(gw.y);
        u32x2 w; w.x = pk2(v[0] * rs * g[0] * (g0 * sigmoidf_(g0)), v[1] * rs * g[1] * (g1 * sigmoidf_(g1)));
        w.y = pk2(v[2] * rs * g[2] * (g2 * sigmoidf_(g2)), v[3] * rs * g[3] * (g3 * sigmoidf_(g3)));
        *(u32x2*)(OA + o) = w;
    }
}

DI void phase_hyena_naive(const Params& p, GrpInfo gi, int bid, int nb) {
    const int tid = ltid(), L = gi.L, TPC = L / 8, CH = 4096 / L, ci = tid / TPC, tg = tid % TPC, t0 = tg * 8;
    float* z = (float*)smem;
    float* hp = z + 4096;
    const bf16_t* P = (const bf16_t*)(lws(p) + OFF_P);
    bf16_t* OC = (bf16_t*)(lws(p) + OFF_OABC) + (size_t)2 * GT * 1024;
    const int nun = gi.nseq * (1024 / CH);
    for (int u = bid; u < nun; u += nb) {
        const int sl = u / (1024 / CH), c = (u % (1024 / CH)) * CH + ci;
        float x1[8], x2[8], zr[8], cv[8];
        const float* cw = p.hy_conv_w + (size_t)gi.l * 3 * 3072; const float* cb = p.hy_conv_b + (size_t)gi.l * 3072;
        __syncthreads();
#pragma unroll
        for (int i = 0; i < 8; ++i) {
            const int t = t0 + i; const size_t rb = (size_t)(sl * L + t) * NP + C_HY;
            float r[3];
#pragma unroll
            for (int part = 0; part < 3; ++part) { const int j = part * 1024 + c;
                const float um = t > 0 ? bf2f(P[rb - NP + j]) : 0.f, u0 = bf2f(P[rb + j]), up = t < L - 1 ? bf2f(P[rb + NP + j]) : 0.f;
                r[part] = cb[j] + cw[j] * um + cw[3072 + j] * u0 + cw[2 * 3072 + j] * up; }
            x1[i] = r[0]; x2[i] = r[1]; zr[i] = r[2]; z[ci * L + t] = r[2];
        }
#pragma unroll
        for (int o = 0; o < 2; ++o) {
            const float* f = filt_ptr(lws(p), gi.l, gi.latent ? 1 : 0) + ((size_t)o * 1024 + c) * L;
#pragma unroll
            for (int i = 0; i < 8; ++i) { hp[ci * 2 * L + L / 2 + t0 + i] = f[t0 + i]; const int zi = t0 + i; hp[ci * 2 * L + (zi < L / 2 ? zi : L + zi)] = 0.f; }
            __syncthreads();
#pragma unroll
            for (int i = 0; i < 8; ++i) cv[i] = 0.f;
            const float* hb = hp + ci * 2 * L; const float* zb = z + ci * L;
            f32x4 hi0 = *(const f32x4*)(hb + t0 + L), hi1 = *(const f32x4*)(hb + t0 + L + 4);
            for (int s = 0; s < L; s += 8) {
                const int idx0 = t0 + L - s;
                const f32x4 lo0 = *(const f32x4*)(hb + idx0 - 8), lo1 = *(const f32x4*)(hb + idx0 - 4);
                const f32x4 z0 = *(const f32x4*)(zb + s), z1 = *(const f32x4*)(zb + s + 4);
                const float hbuf[16] = {lo0[0], lo0[1], lo0[2], lo0[3], lo1[0], lo1[1], lo1[2], lo1[3], hi0[0], hi0[1], hi0[2], hi0[3], hi1[0], hi1[1], hi1[2], hi1[3]};
                const float zz[8] = {z0[0], z0[1], z0[2], z0[3], z1[0], z1[1], z1[2], z1[3]};
#pragma unroll
                for (int ss = 0; ss < 8; ++ss)
#pragma unroll
                    for (int i = 0; i < 8; ++i) cv[i] += zz[ss] * hbuf[8 - ss + i];
                hi0 = lo0; hi1 = lo1;
            }
            const float bo = p.hy_bias[((size_t)gi.l * 2 + o) * 1024 + c];
            __syncthreads();
            if (o == 0) {
#pragma unroll
                for (int i = 0; i < 8; ++i) { zr[i] = x1[i] * (cv[i] + bo * zr[i]); z[ci * L + t0 + i] = zr[i]; }
            } else {
#pragma unroll
                for (int i = 0; i < 8; ++i) OC[(size_t)(sl * L + t0 + i) * 1024 + c] = f2bf(x2[i] * (cv[i] + bo * zr[i]));
            }
        }
    }
}
typedef short bf16x8 __attribute__((ext_vector_type(8)));
typedef short bf16x4 __attribute__((ext_vector_type(4)));
#define MFMA16(a, b, c) __builtin_amdgcn_mfma_f32_16x16x32_bf16((a), (b), (c), 0, 0, 0)
constexpr int QKP = 136;
constexpr int TP = 72;
DI float log_sigmoid_fast(float x) { return fminf(x, 0.f) - __logf(1.0f + __expf(-fabsf(x))); }
DI bf16x8 pack8(const f32x4& a, const f32x4& b) { u32x4 w; w.x = pk2(a[0], a[1]); w.y = pk2(a[2], a[3]); w.z = pk2(b[0], b[1]); w.w = pk2(b[2], b[3]); return __builtin_bit_cast(bf16x8, w); }

DI void gla_prep_unit(const Params& p, const GrpInfo gi, int unit, int tid) {
    const int cg = unit >> 2, h = unit & 3, row0 = cg * 64, t0 = row0 & (gi.L - 1), l = gi.l;
    const int lane = tid & 63, wid = tid >> 6, r16 = lane & 15, q4 = lane >> 4;
    float* laf = (float*)smem; float* lab = laf + 8192;
    bf16_t* QFs = (bf16_t*)(smem + 65536); bf16_t* KFs = QFs + 64 * QKP; bf16_t* QBs = KFs + 64 * QKP; bf16_t* KBs = QBs + 64 * QKP;
    bf16_t* VTs = (bf16_t*)smem; bf16_t* As = (bf16_t*)(smem + 36864);
    const bf16_t* P = (const bf16_t*)(lws(p) + OFF_P);
    __syncthreads();
    {
        const int t = tid >> 3, d0 = (tid & 7) * 16;
        const bf16_t* pr = P + (size_t)(row0 + t) * NP + C_GA;
        float ga[32];
#pragma unroll
        for (int i = 0; i < 4; ++i) { const u32x4 w = *(const u32x4*)(pr + 8 * i); ga[8 * i] = bflo(w.x); ga[8 * i + 1] = bfhi(w.x); ga[8 * i + 2] = bflo(w.y); ga[8 * i + 3] = bfhi(w.y); ga[8 * i + 4] = bflo(w.z); ga[8 * i + 5] = bfhi(w.z); ga[8 * i + 6] = bflo(w.w); ga[8 * i + 7] = bfhi(w.w); }
#pragma unroll
        for (int dir = 0; dir < 2; ++dir) {
            const float* wa = p.gla_wa2 + (((size_t)l * 2 + dir) * 16) * 512 + h * 128 + d0;
            const float* ba = p.gla_ba2 + ((size_t)l * 2 + dir) * 512 + h * 128 + d0;
            float* dst = (dir ? lab : laf) + t * 128 + d0;
#pragma unroll
            for (int j4 = 0; j4 < 4; ++j4) {
                f32x4 x = *(const f32x4*)(ba + 4 * j4);
#pragma unroll
                for (int r = 0; r < 16; ++r) x += *(const f32x4*)(wa + (size_t)r * 512 + 4 * j4) * ga[dir * 16 + r];
                f32x4 o; o[0] = log_sigmoid_fast(x[0]) * 0.0625f; o[1] = log_sigmoid_fast(x[1]) * 0.0625f; o[2] = log_sigmoid_fast(x[2]) * 0.0625f; o[3] = log_sigmoid_fast(x[3]) * 0.0625f;
                *(f32x4*)(dst + 4 * j4) = o;
            }
        }
    }
    __syncthreads();
    if (tid < 256) {
        const int d = tid & 127;
        if (tid < 128) { float a = 0.f; for (int t = 0; t < 64; ++t) { a += laf[t * 128 + d]; laf[t * 128 + d] = a; } }
        else { float a = 0.f; for (int t = 63; t >= 0; --t) { a += lab[t * 128 + d]; lab[t * 128 + d] = a; } }
    }
    __syncthreads();
    {
        const int t = tid >> 3, dlo = (tid & 7) * 8, ta = t0 + t;
        const bf16_t* pr = P + (size_t)(row0 + t) * NP + h * 128;
        const u32x4 qlw = *(const u32x4*)(pr + C_GQ + dlo), qhw = *(const u32x4*)(pr + C_GQ + 64 + dlo), klw = *(const u32x4*)(pr + C_GK + dlo), khw = *(const u32x4*)(pr + C_GK + 64 + dlo);
        float ql[8], qh[8], kl[8], kh[8];
#pragma unroll
        for (int j = 0; j < 4; ++j) { ql[2 * j] = bflo(qlw[j]); ql[2 * j + 1] = bfhi(qlw[j]); qh[2 * j] = bflo(qhw[j]); qh[2 * j + 1] = bfhi(qhw[j]); kl[2 * j] = bflo(klw[j]); kl[2 * j + 1] = bfhi(klw[j]); kh[2 * j] = bflo(khw[j]); kh[2 * j + 1] = bfhi(khw[j]); }
#pragma unroll
        for (int j = 0; j < 8; ++j) {
            ql[j] *= 0.08838834764831845f; qh[j] *= 0.08838834764831845f;
            if (gi.latent) {
                const int ii = dlo + j, f = ii & 31; const float pos = (float)(ii < 32 ? (ta >> 6) : (ta & 63));
                const float ang = pos * exp2f(-(float)f * 0.41524101186092029f); float sn, cs; sincosf(ang, &sn, &cs);
                const float a = ql[j] * cs - qh[j] * sn, b = ql[j] * sn + qh[j] * cs; ql[j] = a; qh[j] = b;
                const float c = kl[j] * cs - kh[j] * sn, e = kl[j] * sn + kh[j] * cs; kl[j] = c; kh[j] = e;
            }
        }
        float* DEC = (float*)(lws(p) + OFF_DEC);
#pragma unroll
        for (int dir = 0; dir < 2; ++dir) {
            const float* bb = dir ? lab : laf;
            bf16_t* Qs = dir ? QBs : QFs; bf16_t* Ks = dir ? KBs : KFs;
            bf16_t* Qg = (bf16_t*)(lws(p) + (dir ? OFF_QB : OFF_QF)) + (size_t)(row0 + t) * 512 + h * 128;
#pragma unroll
            for (int half = 0; half < 2; ++half) {
                const int d = dlo + 64 * half;
                const f32x4 b0 = *(const f32x4*)(bb + t * 128 + d), b1 = *(const f32x4*)(bb + t * 128 + d + 4);
                float qo[8], ko[8];
#pragma unroll
                for (int j = 0; j < 8; ++j) { const float bv = j < 4 ? b0[j] : b1[j - 4]; const float qv = half ? qh[j] : ql[j], kv = half ? kh[j] : kl[j]; qo[j] = qv * __expf(bv); ko[j] = kv * __expf(-bv); }
                u32x4 qw, kw; qw.x = pk2(qo[0], qo[1]); qw.y = pk2(qo[2], qo[3]); qw.z = pk2(qo[4], qo[5]); qw.w = pk2(qo[6], qo[7]);
                kw.x = pk2(ko[0], ko[1]); kw.y = pk2(ko[2], ko[3]); kw.z = pk2(ko[4], ko[5]); kw.w = pk2(ko[6], ko[7]);
                *(u32x4*)(Qs + t * QKP + d) = qw; *(u32x4*)(Ks + t * QKP + d) = kw; *(u32x4*)(Qg + d) = qw;
                if (t == 0) { const int te = dir ? 0 : 63; const f32x4 e0 = *(const f32x4*)(bb + te * 128 + d), e1 = *(const f32x4*)(bb + te * 128 + d + 4);
                    f32x4 x0, x1;
#pragma unroll
                    for (int j = 0; j < 4; ++j) { x0[j] = __expf(e0[j]); x1[j] = __expf(e1[j]); }
                    float* dp = DEC + ((size_t)dir * 128 + cg) * 512 + h * 128 + d; *(f32x4*)dp = x0; *(f32x4*)(dp + 4) = x1; }
            }
        }
    }
    __syncthreads();
    {
        const int s = tid >> 3, e0 = (tid & 7) * 32;
        const bf16_t* pv = P + (size_t)(row0 + s) * NP + C_GV + h * 256 + e0;
#pragma unroll
        for (int i = 0; i < 4; ++i) { const u32x4 w = *(const u32x4*)(pv + 8 * i);
#pragma unroll
            for (int j = 0; j < 4; ++j) { VTs[(e0 + 8 * i + 2 * j) * TP + s] = (bf16_t)(w[j] & 0xffffu); VTs[(e0 + 8 * i + 2 * j + 1) * TP + s] = (bf16_t)(w[j] >> 16); } }
        const int mt = wid >> 1, nt0 = 2 * (wid & 1);
        f32x4 acc[2][2];
#pragma unroll
        for (int dir = 0; dir < 2; ++dir) { const bf16_t* Qs = dir ? QBs : QFs; const bf16_t* Ks = dir ? KBs : KFs;
#pragma unroll
            for (int n = 0; n < 2; ++n) acc[dir][n] = (f32x4){0.f, 0.f, 0.f, 0.f};
#pragma unroll
            for (int ks = 0; ks < 4; ++ks) { const bf16x8 a = *(const bf16x8*)(Qs + (16 * mt + r16) * QKP + 32 * ks + 8 * q4);
#pragma unroll
                for (int n = 0; n < 2; ++n) { const bf16x8 b = *(const bf16x8*)(Ks + (16 * (nt0 + n) + r16) * QKP + 32 * ks + 8 * q4); acc[dir][n] = MFMA16(a, b, acc[dir][n]); } } }
#pragma unroll
        for (int n = 0; n < 2; ++n)
#pragma unroll
            for (int i = 0; i < 4; ++i) { const int t = 16 * mt + 4 * q4 + i, s2 = 16 * (nt0 + n) + r16;
                const float v = (s2 <= t ? acc[0][n][i] : 0.f) + (s2 >= t ? acc[1][n][i] : 0.f); As[t * TP + s2] = f2bf(v); }
        const int d = tid >> 2, sq = tid & 3;
#pragma unroll
        for (int dir = 0; dir < 2; ++dir) { const bf16_t* Ks = dir ? KBs : KFs; unsigned w[8];
#pragma unroll
            for (int j = 0; j < 8; ++j) w[j] = (unsigned)Ks[(sq * 16 + 2 * j) * QKP + d] | ((unsigned)Ks[(sq * 16 + 2 * j + 1) * QKP + d] << 16);
            bf16_t* kg = (bf16_t*)(lws(p) + (dir ? OFF_KBT : OFF_KFT)) + (((size_t)cg * 4 + h) * 128 + d) * 64 + sq * 16;
            *(u32x4*)kg = (u32x4){w[0], w[1], w[2], w[3]}; *(u32x4*)(kg + 8) = (u32x4){w[4], w[5], w[6], w[7]}; }
    }
    __syncthreads();
    {
        const int e = tid >> 1, hf = tid & 1;
        bf16_t* vg = (bf16_t*)(lws(p) + OFF_VT) + (((size_t)cg * 4 + h) * 256 + e) * 64 + hf * 32;
#pragma unroll
        for (int i = 0; i < 4; ++i) *(u32x4*)(vg + 8 * i) = *(const u32x4*)(VTs + e * TP + hf * 32 + 8 * i);
        float* OI = (float*)(lws(p) + OFF_OI);
#pragma unroll
        for (int n = 0; n < 2; ++n) { const int nt = 2 * wid + n;
            bf16x8 b[2];
#pragma unroll
            for (int ks = 0; ks < 2; ++ks) b[ks] = *(const bf16x8*)(VTs + (16 * nt + r16) * TP + 32 * ks + 8 * q4);
#pragma unroll
            for (int mt = 0; mt < 4; ++mt) { f32x4 acc = (f32x4){0.f, 0.f, 0.f, 0.f};
#pragma unroll
                for (int ks = 0; ks < 2; ++ks) { const bf16x8 a = *(const bf16x8*)(As + (16 * mt + r16) * TP + 32 * ks + 8 * q4); acc = MFMA16(a, b[ks], acc); }
#pragma unroll
                for (int i = 0; i < 4; ++i) OI[(size_t)(row0 + 16 * mt + 4 * q4 + i) * 1024 + h * 256 + 16 * nt + r16] = acc[i]; } }
    }
}
DI void phase_gla_prep(const Params& p, const GrpInfo gi, int bid, int nb) {
    const int tid = ltid();
    for (int u = bid; u < 512; u += nb) gla_prep_unit(p, gi, u, tid);
}

constexpr int SC_Q = 0, SC_K = 64 * QKP * 2, SC_V = SC_K + 128 * TP * 2, SC_D = SC_V + 128 * TP * 2, SC_BUF = SC_D + 512;
DI void gla_scan_unit(const Params& p, const GrpInfo gi, int unit, int tid) {
    const int sl = unit >> 4, h = (unit >> 2) & 3, dir = (unit >> 1) & 1, eh = unit & 1, L = gi.L, NC = L >> 6, l = gi.l;
    const int lane = tid & 63, wid = tid >> 6, r16 = lane & 15, q4 = lane >> 4;
    const int ecol = eh * 128 + 16 * wid + r16;
    f32x4 S[8];
    if (gi.latent) { const int bs = 2 * (gi.grp - 1) + sl; const float* s0 = p.state_gla + ((((size_t)bs * DEPTH + l) * 2 + dir) * 4 + h) * 128 * 256 + ecol;
#pragma unroll
        for (int T = 0; T < 8; ++T)
#pragma unroll
            for (int i = 0; i < 4; ++i) S[T][i] = s0[(size_t)(16 * T + 4 * q4 + i) * 256]; }
    else {
#pragma unroll
        for (int T = 0; T < 8; ++T) S[T] = (f32x4){0.f, 0.f, 0.f, 0.f}; }
    const bf16_t* Qg = (const bf16_t*)(lws(p) + (dir ? OFF_QB : OFF_QF)); const bf16_t* Kg = (const bf16_t*)(lws(p) + (dir ? OFF_KBT : OFF_KFT)); const bf16_t* Vg = (const bf16_t*)(lws(p) + OFF_VT);
    const float* Dg = (const float*)(lws(p) + OFF_DEC) + (size_t)dir * 128 * 512;
    float* Og = (float*)(lws(p) + (dir ? OFF_OB : OFF_OF));
    u32x4 rq[2], rk[2], rv[2]; float rd = 0.f;
    const int qt0 = tid >> 4, qd = (tid & 15) * 8;
    const int kd0 = tid >> 3, ks8 = (tid & 7) * 8;
#define GLA_LOAD(c) do { const int cg_ = sl * NC + (c); const size_t r0_ = (size_t)cg_ * 64; \
        rq[0] = *(const u32x4*)(Qg + (r0_ + qt0) * 512 + h * 128 + qd); rq[1] = *(const u32x4*)(Qg + (r0_ + qt0 + 32) * 512 + h * 128 + qd); \
        rk[0] = *(const u32x4*)(Kg + (((size_t)cg_ * 4 + h) * 128 + kd0) * 64 + ks8); rk[1] = *(const u32x4*)(Kg + (((size_t)cg_ * 4 + h) * 128 + kd0 + 64) * 64 + ks8); \
        rv[0] = *(const u32x4*)(Vg + (((size_t)cg_ * 4 + h) * 256 + eh * 128 + kd0) * 64 + ks8); rv[1] = *(const u32x4*)(Vg + (((size_t)cg_ * 4 + h) * 256 + eh * 128 + kd0 + 64) * 64 + ks8); \
        if (tid < 128) rd = Dg[(size_t)cg_ * 512 + h * 128 + tid]; } while (0)
#define GLA_STORE(bufp) do { unsigned char* b_ = (bufp); \
        *(u32x4*)(b_ + SC_Q + (qt0 * QKP + qd) * 2) = rq[0]; *(u32x4*)(b_ + SC_Q + ((qt0 + 32) * QKP + qd) * 2) = rq[1]; \
        *(u32x4*)(b_ + SC_K + (kd0 * TP + ks8) * 2) = rk[0]; *(u32x4*)(b_ + SC_K + ((kd0 + 64) * TP + ks8) * 2) = rk[1]; \
        *(u32x4*)(b_ + SC_V + (kd0 * TP + ks8) * 2) = rv[0]; *(u32x4*)(b_ + SC_V + ((kd0 + 64) * TP + ks8) * 2) = rv[1]; \
        if (tid < 128) *(float*)(b_ + SC_D + tid * 4) = rd; } while (0)
    __syncthreads();
    GLA_LOAD(dir ? NC - 1 : 0);
    GLA_STORE(smem);
    __syncthreads();
    for (int ci = 0; ci < NC; ++ci) {
        const int c = dir ? NC - 1 - ci : ci;
        if (ci + 1 < NC) GLA_LOAD(dir ? c - 1 : c + 1);
        const unsigned char* buf = smem + (ci & 1) * SC_BUF;
        const bf16_t* Qs = (const bf16_t*)(buf + SC_Q); const bf16_t* Kt = (const bf16_t*)(buf + SC_K); const bf16_t* Vt = (const bf16_t*)(buf + SC_V); const float* Dv = (const float*)(buf + SC_D);
        bf16x8 bS[4];
#pragma unroll
        for (int ks = 0; ks < 4; ++ks) bS[ks] = pack8(S[2 * ks], S[2 * ks + 1]);
        const size_t orow0 = ((size_t)(sl * NC + c) * 64);
#pragma unroll
        for (int mt = 0; mt < 4; ++mt) { f32x4 acc = (f32x4){0.f, 0.f, 0.f, 0.f};
#pragma unroll
            for (int ks = 0; ks < 4; ++ks) { const bf16_t* qp = Qs + (16 * mt + r16) * QKP + 32 * ks + 4 * q4;
                const bf16x4 a0 = *(const bf16x4*)qp, a1 = *(const bf16x4*)(qp + 16);
                const bf16x8 a = (bf16x8){a0[0], a0[1], a0[2], a0[3], a1[0], a1[1], a1[2], a1[3]};
                acc = MFMA16(a, bS[ks], acc); }
#pragma unroll
            for (int i = 0; i < 4; ++i) Og[(orow0 + 16 * mt + 4 * q4 + i) * 1024 + h * 256 + ecol] = acc[i]; }
        bf16x8 bv[2];
#pragma unroll
        for (int ks = 0; ks < 2; ++ks) bv[ks] = *(const bf16x8*)(Vt + (16 * wid + r16) * TP + 32 * ks + 8 * q4);
#pragma unroll
        for (int T = 0; T < 8; ++T) {
#pragma unroll
            for (int ks = 0; ks < 2; ++ks) { const bf16x8 a = *(const bf16x8*)(Kt + (16 * T + r16) * TP + 32 * ks + 8 * q4); S[T] = MFMA16(a, bv[ks], S[T]); }
            const f32x4 dv = *(const f32x4*)(Dv + 16 * T + 4 * q4); S[T] *= dv; }
        if (ci + 1 < NC) GLA_STORE(smem + ((ci + 1) & 1) * SC_BUF);
        __syncthreads();
    }
#undef GLA_LOAD
#undef GLA_STORE
    if (!gi.latent) { float* so = lout(p) + OUT_ST + ((((size_t)sl * DEPTH + l) * 2 + dir) * 4 + h) * 128 * 256 + ecol;
#pragma unroll
        for (int T = 0; T < 8; ++T)
#pragma unroll
            for (int i = 0; i < 4; ++i) so[(size_t)(16 * T + 4 * q4 + i) * 256] = S[T][i]; }
}
DI void phase_gla_scan(const Params& p, const GrpInfo gi, int bid, int nb) {
    const int tid = ltid();
    for (int u = bid; u < gi.nseq * 16; u += nb) gla_scan_unit(p, gi, u, tid);
}
typedef float f32x16 __attribute__((ext_vector_type(16)));
#define MFMA32(a, b, c) __builtin_amdgcn_mfma_f32_32x32x16_bf16((a), (b), (c), 0, 0, 0)

DI void phase_hy_prep(const Params& p, const GrpInfo gi, int bid, int nb) {
    const int tid = ltid(), L = gi.L;
    bf16_t* T = (bf16_t*)smem;
    const bf16_t* P = (const bf16_t*)(lws(p) + OFF_P);
    bf16_t* UcT = (bf16_t*)(lws(p) + OFF_UCT);
    const float* cw = p.hy_conv_w + (size_t)gi.l * 3 * 3072; const float* cb = p.hy_conv_b + (size_t)gi.l * 3072;
    for (int u = bid; u < 128 * 48; u += nb) {
        const int rt = u / 48, ct = u % 48, row0 = rt * 64, j0 = ct * 64;
        const int t = tid >> 3, js = tid & 7, row = row0 + t, tpos = row & (L - 1), j = j0 + js * 8;
        const bf16_t* pr = P + (size_t)row * NP + C_HY + j;
        const u32x4 z4 = (u32x4){0u, 0u, 0u, 0u};
        const u32x4 um = tpos > 0 ? *(const u32x4*)(pr - NP) : z4, u0 = *(const u32x4*)pr, up = tpos < L - 1 ? *(const u32x4*)(pr + NP) : z4;
        __syncthreads();
#pragma unroll
        for (int q = 0; q < 4; ++q) {
            const float o0 = cb[j + 2 * q] + cw[j + 2 * q] * bflo(um[q]) + cw[3072 + j + 2 * q] * bflo(u0[q]) + cw[6144 + j + 2 * q] * bflo(up[q]);
            const float o1 = cb[j + 2 * q + 1] + cw[j + 2 * q + 1] * bfhi(um[q]) + cw[3072 + j + 2 * q + 1] * bfhi(u0[q]) + cw[6144 + j + 2 * q + 1] * bfhi(up[q]);
            T[(js * 8 + 2 * q) * TP + t] = f2bf(o0); T[(js * 8 + 2 * q + 1) * TP + t] = f2bf(o1);
        }
        __syncthreads();
        const int jj = tid >> 3, ts = tid & 7;
        *(u32x4*)(UcT + (size_t)(j0 + jj) * GT + row0 + ts * 8) = *(const u32x4*)(T + jj * TP + ts * 8);
    }
}
DI void phase_hy_post(const Params& p, const GrpInfo gi, int bid, int nb) {
    const int tid = ltid();
    bf16_t* T = (bf16_t*)smem;
    const bf16_t* OcT = (const bf16_t*)(lws(p) + OFF_OCT);
    bf16_t* OC = (bf16_t*)(lws(p) + OFF_OABC) + (size_t)2 * GT * 1024;
    for (int u = bid; u < 128 * 16; u += nb) {
        const int rt = u >> 4, ct = u & 15, row0 = rt * 64, c0 = ct * 64;
        const int c = tid >> 3, ts = tid & 7;
        const u32x4 w = *(const u32x4*)(OcT + (size_t)(c0 + c) * GT + row0 + ts * 8);
        __syncthreads();
#pragma unroll
        for (int q = 0; q < 4; ++q) { T[(ts * 8 + 2 * q) * TP + c] = (bf16_t)(w[q] & 0xffffu); T[(ts * 8 + 2 * q + 1) * TP + c] = (bf16_t)(w[q] >> 16); }
        __syncthreads();
        const int t = tid >> 3, cs = tid & 7;
        *(u32x4*)(OC + (size_t)(row0 + t) * 1024 + c0 + cs * 8) = *(const u32x4*)(T + t * TP + cs * 8);
    }
}

constexpr int HY_HF = 0;
constexpr int HY_Z = 16384;
constexpr int HY_ZERO = HY_Z + 20480;
constexpr int HY_HC = HY_ZERO + 64;
DI int hy_pitch(int L) { return (L + 72) * 2; }
DI int hy_zoff(int s) { return (s >> 5) * 80 + (s & 31) * 2; }
DI void hy_build_copies(int L, int tid) {
    const float* hf = (const float*)(smem + HY_HF);
    const int nch = (L + 64) / 8, pitch = hy_pitch(L);
    for (int ch = tid; ch < 8 * nch; ch += 512) {
        const int e = ch / nch, i8 = (ch % nch) * 8;
        float v[8];
#pragma unroll
        for (int j = 0; j < 8; ++j) { const int x = i8 + j - 32 + e; v[j] = (x >= 0 && x < L) ? hf[L - 1 - x] : 0.f; }
        u32x4 w; w.x = pk2(v[0], v[1]); w.y = pk2(v[2], v[3]); w.z = pk2(v[4], v[5]); w.w = pk2(v[6], v[7]);
        *(u32x4*)(smem + HY_HC + e * pitch + i8 * 2) = w;
    }
}
DI f32x16 hy_conv(int L, int lane, int tb_row0  , int t0) {
    const int m = lane & 31, kh = lane >> 5, e = (7 - (m & 7)) & 7, pitch = hy_pitch(L);
    const int ND = L / 16 + 2;
    int delta = -(L / 2) - 16;
    int aoff = HY_HC + e * pitch + (L / 2 - 1 - delta - m + 8 * kh - e + 32) * 2;
    f32x16 acc;
#pragma unroll
    for (int i = 0; i < 16; ++i) acc[i] = 0.f;
    for (int dl = 0; dl < ND; ++dl) {
        const bf16x8 a = *(const bf16x8*)(smem + aoff);
        const int s0 = t0 - delta;
        const bool inr = (unsigned)s0 <= (unsigned)(L - 16);
        const int zo = inr ? HY_Z + hy_zoff(tb_row0 - delta) + 16 * kh : HY_ZERO;
        const bf16x8 b = *(const bf16x8*)(smem + zo);
        acc = MFMA32(a, b, acc);
        delta += 16; aoff -= 32;
    }
    return acc;
}
DI void hy_conv_unit(const Params& p, const GrpInfo gi, int c, int tid) {
    const int L = gi.L, lane = tid & 63, wid = tid >> 6, n = lane & 31, hi = lane >> 5;
    const int g = 32 * wid + n, tpl = L >> 5, b = g / tpl, t0 = (g % tpl) * 32, frow = b * L + t0;
    const bf16_t* UcT = (const bf16_t*)(lws(p) + OFF_UCT);
    bf16_t* OcT = (bf16_t*)(lws(p) + OFF_OCT);
    const float* f0 = filt_ptr(lws(p), gi.l, gi.latent ? 1 : 0) + (size_t)c * L;
    const float* f1 = f0 + (size_t)1024 * L;
    float* hf = (float*)(smem + HY_HF);
    __syncthreads();
    {
        const bf16_t* zg = UcT + (size_t)(2048 + c) * GT;
#pragma unroll
        for (int i = 0; i < 2; ++i) { const int s = (tid + 512 * i) * 8; *(u32x4*)(smem + HY_Z + hy_zoff(s)) = *(const u32x4*)(zg + s); }
        if (tid < 4) *(unsigned*)(smem + HY_ZERO + 4 * tid) = 0u;
        for (int i = tid * 4; i < L; i += 2048) *(f32x4*)(hf + i) = *(const f32x4*)(f0 + i);
    }
    __syncthreads();
    hy_build_copies(L, tid);
    __syncthreads();
    f32x16 acc = hy_conv(L, lane, frow, t0);
    const float bias0 = p.hy_bias[((size_t)gi.l * 2 + 0) * 1024 + c], bias1 = p.hy_bias[((size_t)gi.l * 2 + 1) * 1024 + c];
    u32x2 z1w[4];
#pragma unroll
    for (int gq = 0; gq < 4; ++gq) {
        const int fr = frow + 8 * gq + 4 * hi;
        const u32x2 xw = *(const u32x2*)(UcT + (size_t)c * GT + fr);
        const u32x2 zw = *(const u32x2*)(smem + HY_Z + hy_zoff(fr));
        const float o0 = bflo(xw.x) * (acc[4 * gq] + bias0 * bflo(zw.x)), o1 = bfhi(xw.x) * (acc[4 * gq + 1] + bias0 * bfhi(zw.x));
        const float o2 = bflo(xw.y) * (acc[4 * gq + 2] + bias0 * bflo(zw.y)), o3 = bfhi(xw.y) * (acc[4 * gq + 3] + bias0 * bfhi(zw.y));
        z1w[gq].x = pk2(o0, o1); z1w[gq].y = pk2(o2, o3);
    }
    __syncthreads();
#pragma unroll
    for (int gq = 0; gq < 4; ++gq) *(u32x2*)(smem + HY_Z + hy_zoff(frow + 8 * gq + 4 * hi)) = z1w[gq];
    for (int i = tid * 4; i < L; i += 2048) *(f32x4*)(hf + i) = *(const f32x4*)(f1 + i);
    __syncthreads();
    hy_build_copies(L, tid);
    __syncthreads();
    acc = hy_conv(L, lane, frow, t0);
#pragma unroll
    for (int gq = 0; gq < 4; ++gq) {
        const int fr = frow + 8 * gq + 4 * hi;
        const u32x2 xw = *(const u32x2*)(UcT + (size_t)(1024 + c) * GT + fr);
        const float o0 = bflo(xw.x) * (acc[4 * gq] + bias1 * bflo(z1w[gq].x)), o1 = bfhi(xw.x) * (acc[4 * gq + 1] + bias1 * bfhi(z1w[gq].x));
        const float o2 = bflo(xw.y) * (acc[4 * gq + 2] + bias1 * bflo(z1w[gq].y)), o3 = bfhi(xw.y) * (acc[4 * gq + 3] + bias1 * bfhi(z1w[gq].y));
        u32x2 w; w.x = pk2(o0, o1); w.y = pk2(o2, o3);
        *(u32x2*)(OcT + (size_t)c * GT + fr) = w;
    }
}
DI void phase_hy_conv(const Params& p, const GrpInfo gi, int bid, int nb) {
    const int tid = ltid();
    for (int c = bid; c < 1024; c += nb) hy_conv_unit(p, gi, c, tid);
}
#define LAS3 __attribute__((address_space(3)))
constexpr int LDS_MAIN = 139264, LDS_PARAMS = LDS_MAIN + 64, LDS_BYTES = LDS_MAIN + 512;

DI Params lp() {
    ParamsU u;
#pragma unroll
    for (int i = 0; i < NPARAM; ++i) {
        const unsigned long long v = *(const LAS3 unsigned long long*)((LAS3 unsigned char*)smem + LDS_PARAMS + 8 * i);
        const unsigned lo = (unsigned)__builtin_amdgcn_readfirstlane((int)(unsigned)v), hi = (unsigned)__builtin_amdgcn_readfirstlane((int)(unsigned)(v >> 32));
        u.a[i] = ((unsigned long long)hi << 32) | lo;
    }
    return u.s;
}
DI const float* x_in_ptr(const Params& p, int grp, int l) {
    if (l == 0) return grp == 0 ? p.x_prompt : p.x_sample + (size_t)(grp - 1) * GT * DM;
    return grp == 0 ? p.out + OUT_YP : p.out + OUT_YS + (size_t)(grp - 1) * GT * DM;
}
DI float* x_out_ptr(const Params& p, int grp) { return grp == 0 ? p.out + OUT_YP : p.out + OUT_YS + (size_t)(grp - 1) * GT * DM; }

template <class Epi> DI void gemm_ph(const bf16_t* A, const bf16_t* Bt, int M, int N, int K, const Epi& E) {
    pg8::Gemm g; g.A = A; g.Bt = Bt; g.M = M; g.N = N; g.K = K; g.pad = 0;
    pg8::StaticOrder S; S.init(M, N, (int)gridDim.x, (int)blockIdx.x);
    pg8::gemm_phase<Epi, pg8::StaticOrder, false>((LAS3 unsigned char*)smem, g, S, E, nullptr);
}
struct ModPtrs { const float* mA; const float* mB; };
DI ModPtrs mod_ptrs(const Params& q, int grp, int l) {
    const int crA = grp == 0 ? 0 : 1 + 2 * (grp - 1), crB = grp == 0 ? 0 : crA + 1;
    const float* mod = (const float*)(q.ws + OFF_MOD);
    ModPtrs m; m.mA = mod + ((size_t)l * NCOND + crA) * (NMOD * DM); m.mB = mod + ((size_t)l * NCOND + crB) * (NMOD * DM); return m;
}

__global__ __launch_bounds__(512, 2) void k_mega(Params p) {
    const int bid = blockIdx.x, nb = gridDim.x;
    volatile LAS unsigned* xbw = (volatile LAS unsigned*)((LAS3 unsigned char*)smem + LDS_MAIN);
    if (threadIdx.x == 0) {
        xbw[0] = 0u; xbw[1] = 0u; xbw[2] = 0u; xbw[3] = 0u;
        ParamsU u; u.s = p;
#pragma unroll
        for (int i = 0; i < NPARAM; ++i) *(LAS3 unsigned long long*)((LAS3 unsigned char*)smem + LDS_PARAMS + 8 * i) = u.a[i];
    }
    __syncthreads();
    XcdBarrier bar;
    { const Params q = lp(); bar = xcd_barrier_post((unsigned*)(q.ws + OFF_BAR), xbw); }
    { const Params q = lp(); phase_convert(q, bid, nb); }
    { const Params q = lp(); phase_adaln(q, bid, nb); }
    { const Params q = lp(); phase_hyena_hid(q, bid, nb); }
    xcd_barrier(bar);
    { const Params q = lp(); phase_filters(q, bid, nb); }
    xcd_barrier(bar);
    for (int l0 = 0; l0 < DEPTH; ++l0) for (int grp0 = 0; grp0 < NGRP; ++grp0) {
        int l = l0, grp = grp0; asm volatile("" : "+s"(l), "+s"(grp));
        const GrpInfo gi = grp_info(grp, l);
        { const Params q = lp(); phase_norm(q, x_in_ptr(q, grp, l), q.norm1_g + l * DM, l, grp, 0, DM, bid, nb); }
        xcd_barrier(bar);
        { const Params q = lp(); gemm_ph((const bf16_t*)(q.ws + OFF_H), (const bf16_t*)(q.ws + OFF_WIN) + (size_t)l * NP * DM, GT, NP, DM, EpiStoreBf16<0>{(bf16_t*)(q.ws + OFF_P), NP, 0}); }
        xcd_barrier(bar);
        { const Params q = lp(); phase_gla_prep(q, gi, bid, nb); }
        { const Params q = lp(); phase_na_prep(q, gi, bid, nb); }
        { const Params q = lp(); phase_hy_prep(q, gi, bid, nb); }
        xcd_barrier(bar);
        { const Params q = lp(); phase_gla_scan(q, gi, bid, nb); }
        { const Params q = lp(); phase_hy_conv(q, gi, bid, nb); }
        { const Params q = lp(); phase_na_naive(q, gi, bid, nb); }
        xcd_barrier(bar);
        { const Params q = lp(); phase_gla_post<true>(q, gi, bid, nb); }
        { const Params q = lp(); phase_hy_post(q, gi, bid, nb); }
        xcd_barrier(bar);
        { const Params q = lp(); const bf16_t* wbr = (const bf16_t*)(q.ws + OFF_WBR) + (size_t)l * 3 * DM * 1024; const bf16_t* OABC = (const bf16_t*)(q.ws + OFF_OABC);
          gemm_ph(OABC, wbr, GT, DM, 1024, EpiGate<0>{(const bf16_t*)(q.ws + OFF_P) + C_GATE, (float*)(q.ws + OFF_M32), (bf16_t*)(q.ws + OFF_MBF), NP, 0}); }
        xcd_barrier(bar);
        { const Params q = lp(); const bf16_t* wbr = (const bf16_t*)(q.ws + OFF_WBR) + (size_t)l * 3 * DM * 1024; const bf16_t* OABC = (const bf16_t*)(q.ws + OFF_OABC);
          gemm_ph(OABC + (size_t)GT * 1024, wbr + (size_t)DM * 1024, GT, DM, 1024, EpiGate<1>{(const bf16_t*)(q.ws + OFF_P) + C_GATE + DM, (float*)(q.ws + OFF_M32), (bf16_t*)(q.ws + OFF_MBF), NP, 0}); }
        xcd_barrier(bar);
        { const Params q = lp(); const bf16_t* wbr = (const bf16_t*)(q.ws + OFF_WBR) + (size_t)l * 3 * DM * 1024; const bf16_t* OABC = (const bf16_t*)(q.ws + OFF_OABC);
          gemm_ph(OABC + (size_t)2 * GT * 1024, wbr + (size_t)2 * DM * 1024, GT, DM, 1024, EpiGate<2>{(const bf16_t*)(q.ws + OFF_P) + C_GATE + 2 * DM, (float*)(q.ws + OFF_M32), (bf16_t*)(q.ws + OFF_MBF), NP, 0}); }
        xcd_barrier(bar);
        { const Params q = lp(); const ModPtrs m = mod_ptrs(q, grp, l);
          gemm_ph((const bf16_t*)(q.ws + OFF_MBF), (const bf16_t*)(q.ws + OFF_WOUT) + (size_t)l * DM * DM, GT, DM, DM, EpiResid{x_in_ptr(q, grp, l), x_out_ptr(q, grp), m.mA + 2 * DM, m.mB + 2 * DM}); }
        xcd_barrier(bar);
        { const Params q = lp(); phase_norm(q, x_out_ptr(q, grp), q.norm2_g + l * DM, l, grp, 3 * DM, 4 * DM, bid, nb); }
        xcd_barrier(bar);
        { const Params q = lp(); gemm_ph((const bf16_t*)(q.ws + OFF_H), (const bf16_t*)(q.ws + OFF_W1) + (size_t)l * DFF * DM, GT, DFF, DM, EpiStoreBf16<1>{(bf16_t*)(q.ws + OFF_P), DFF, 0}); }
        xcd_barrier(bar);
        { const Params q = lp(); const ModPtrs m = mod_ptrs(q, grp, l);
          gemm_ph((const bf16_t*)(q.ws + OFF_P), (const bf16_t*)(q.ws + OFF_W2) + (size_t)l * DM * DFF, GT, DM, DFF, EpiResid{x_out_ptr(q, grp), x_out_ptr(q, grp), m.mA + 5 * DM, m.mB + 5 * DM}); }
        xcd_barrier(bar);
    }
}

extern "C" void kernel_launch(void* const* d_in, const int* in_sizes, int n_in, void* d_out, int out_size, void* d_ws, size_t ws_size, hipStream_t stream) {
    Params p{};
    const float** f = (const float**)&p;
    for (int i = 0; i < 33; ++i) f[i] = (const float*)d_in[i];
    p.out = (float*)d_out; p.ws = (unsigned char*)d_ws;
    if (ws_size < WS_END) { fprintf(stderr, "workspace too small: %zu < %zu\n", ws_size, (size_t)WS_END); return; }
    static int grid = 0;
    if (!grid) {
        int dev = 0, cus = 0, per_cu = 0;
        (void)hipGetDevice(&dev);
        (void)hipDeviceGetAttribute(&cus, hipDeviceAttributeMultiprocessorCount, dev);
        (void)hipFuncSetAttribute((const void*)k_mega, hipFuncAttributeMaxDynamicSharedMemorySize, LDS_BYTES);
        (void)hipOccupancyMaxActiveBlocksPerMultiprocessor(&per_cu, k_mega, 512, LDS_BYTES);
        grid = cus * (per_cu < 1 ? per_cu : 1);
        if (grid <= 0) { fprintf(stderr, "occupancy query failed: cus %d per_cu %d\n", cus, per_cu); grid = 0; return; }
    }
    (void)hipMemsetAsync(p.ws + OFF_BAR, 0, XCD_BAR_WORDS * sizeof(unsigned), stream);
    hipLaunchKernelGGL(k_mega, dim3(grid), dim3(512), LDS_BYTES, stream, p);
}
```

```cpp
#include <hip/hip_runtime.h>
#include <stdint.h>
#include <stdio.h>

constexpr int DM = 2048, DFF = 8192, NMOD = 6, NCOND = 9;
constexpr int GT = 8192;
constexpr int NGRP = 5, DEPTH = 2;
constexpr int C_GQ = 0, C_GK = 512, C_GV = 1024, C_GG = 2048, C_GA = 3072, C_NQ = 3328, C_NK = 4352, C_NV = 5376, C_HY = 6400, C_GATE = 9472, NP = 15616;
constexpr int IN_TOTAL = 15392;
constexpr float EPS = 1e-6f;

typedef unsigned short bf16_t;
typedef float f32x4 __attribute__((ext_vector_type(4)));
typedef float f32x2 __attribute__((ext_vector_type(2)));
typedef unsigned u32x4 __attribute__((ext_vector_type(4)));
typedef unsigned u32x2 __attribute__((ext_vector_type(2)));
#define DI __device__ __forceinline__

DI int ltid() { int t = threadIdx.x; asm volatile("" : "+v"(t)); return t; }
DI float bf2f(bf16_t b) { return __uint_as_float(((unsigned)b) << 16); }
DI float bflo(unsigned w) { return __uint_as_float(w << 16); }
DI float bfhi(unsigned w) { return __uint_as_float(w & 0xffff0000u); }
DI bf16_t f2bf(float f) { unsigned u = __float_as_uint(f); u += 0x7FFFu + ((u >> 16) & 1u); return (bf16_t)(u >> 16); }
DI unsigned pk2(float lo, float hi) { return (unsigned)f2bf(lo) | ((unsigned)f2bf(hi) << 16); }
DI float sigmoidf_(float x) { return 1.0f / (1.0f + __expf(-x)); }
DI float wave_sum(float v, int lane) {
#pragma unroll
    for (int o = 32; o >= 1; o >>= 1) v += __int_as_float(__builtin_amdgcn_ds_bpermute((lane ^ o) << 2, __float_as_int(v))); return v; }
DI float wave_max(float v, int lane) {
#pragma unroll
    for (int o = 32; o >= 1; o >>= 1) v = fmaxf(v, __int_as_float(__builtin_amdgcn_ds_bpermute((lane ^ o) << 2, __float_as_int(v)))); return v; }

constexpr size_t al256(size_t x) { return (x + 255) & ~(size_t)255; }
constexpr size_t OFF_BAR  = 0;
constexpr size_t OFF_MOD  = 65536;
constexpr size_t OFF_HID  = OFF_MOD  + al256((size_t)DEPTH * NCOND * 12288 * 4);
constexpr size_t OFF_FILT = OFF_HID  + (size_t)DEPTH * 2 * 4096 * 64 * 4;
constexpr size_t FILT_L   = (size_t)2 * 1024 * (256 + 4096) * 4;
constexpr size_t OFF_WIN  = OFF_FILT + DEPTH * FILT_L;
constexpr size_t OFF_WBR  = OFF_WIN  + (size_t)DEPTH * NP * DM * 2;
constexpr size_t OFF_WOUT = OFF_WBR  + (size_t)DEPTH * 3 * DM * 1024 * 2;
constexpr size_t OFF_W1   = OFF_WOUT + (size_t)DEPTH * DM * DM * 2;
constexpr size_t OFF_W2   = OFF_W1   + (size_t)DEPTH * DFF * DM * 2;
constexpr size_t OFF_H    = OFF_W2   + (size_t)DEPTH * DFF * DM * 2;
constexpr size_t OFF_P    = OFF_H    + (size_t)GT * DM * 2;
constexpr size_t OFF_OF   = OFF_P    + (size_t)GT * NP * 2;
constexpr size_t OFF_OB   = OFF_OF   + (size_t)GT * 1024 * 4;
constexpr size_t OFF_OABC = OFF_OB   + (size_t)GT * 1024 * 4;
constexpr size_t OFF_M32  = OFF_OABC + (size_t)3 * GT * 1024 * 2;
constexpr size_t OFF_MBF  = OFF_M32  + (size_t)GT * DM * 4;
constexpr size_t OFF_QN   = OFF_MBF  + (size_t)GT * DM * 2;
constexpr size_t OFF_KN   = OFF_QN   + (size_t)GT * 1024 * 2;
constexpr size_t OFF_QF   = OFF_KN   + (size_t)GT * 1024 * 2;
constexpr size_t OFF_QB   = OFF_QF   + (size_t)GT * 512 * 2;
constexpr size_t OFF_KFT  = OFF_QB   + (size_t)GT * 512 * 2;
constexpr size_t OFF_KBT  = OFF_KFT  + (size_t)GT * 512 * 2;
constexpr size_t OFF_VT   = OFF_KBT  + (size_t)GT * 512 * 2;
constexpr size_t OFF_DEC  = OFF_VT   + (size_t)GT * 1024 * 2;
constexpr size_t OFF_OI   = OFF_DEC  + (size_t)2 * 128 * 512 * 4;
constexpr size_t OFF_UCT  = OFF_OI   + (size_t)GT * 1024 * 4;
constexpr size_t OFF_OCT  = OFF_UCT  + (size_t)3072 * GT * 2;
constexpr size_t OFF_VTN  = OFF_OCT  + (size_t)1024 * GT * 2;
constexpr size_t OFF_CK   = OFF_VTN  + (size_t)GT * 1024 * 2;
constexpr size_t OFF_CVT  = OFF_CK   + (size_t)8 * 2 * 8 * 256 * 128 * 2;
constexpr size_t WS_END   = OFF_CVT  + (size_t)8 * 2 * 8 * 256 * 128 * 2;
static_assert(WS_END < (size_t)1190000000, "workspace too large");

constexpr size_t OUT_YP = 0, OUT_YS = (size_t)32 * 256 * DM, OUT_ST = OUT_YS + (size_t)8 * 4096 * DM,
                 OUT_CK = OUT_ST + (size_t)32 * 2 * 2 * 4 * 128 * 256, OUT_CV = OUT_CK + (size_t)32 * 2 * 8 * 256 * 128;

struct Params {
    const float *x_prompt, *x_sample, *state_gla, *cache_k, *cache_v, *c, *c_ctx, *w_mod, *b_mod, *norm1_g, *norm2_g, *w_in, *gla_wa2, *gla_ba2, *gla_norm_g,
                *na_qnorm_g, *na_knorm_g, *na_rpb, *hy_conv_w, *hy_conv_b, *hy_f1_w, *hy_f1_b, *hy_f2_w, *hy_f2_b, *hy_f3_w, *hy_freq, *hy_bias,
                *w_br_a, *w_br_b, *w_br_c, *w_out, *w_mlp1, *w_mlp2;
    float* out; unsigned char* ws;
};
constexpr int NPARAM = 35;
union ParamsU { Params s; unsigned long long a[NPARAM]; };
static_assert(sizeof(Params) == NPARAM * 8, "Params must be 35 pointers");
DI unsigned char* lws(const Params& p) { unsigned char* w = p.ws; asm volatile("" : "+s"(w)); return w; }
DI float* lout(const Params& p) { float* w = p.out; asm volatile("" : "+s"(w)); return w; }
namespace pg8 {
#define PG8_LAS __attribute__((address_space(3)))
typedef unsigned short bf16_t;
typedef short bf16x8 __attribute__((ext_vector_type(8)));
typedef float f32x4 __attribute__((ext_vector_type(4)));
typedef unsigned u32x4 __attribute__((ext_vector_type(4)));
constexpr int BM = 256, BK = 64, HALF = 128, HTB = HALF * BK * 2  , STAGE_BYTES = 8 * HTB, NXCD = 8, WGM = 8;
__host__ __device__ __forceinline__ int lds_byte(int r, int c) { const int st = (r >> 4) * 2 + (c >> 5), rr = r & 15, cc = c & 31, ob = rr * 64 + cc * 2; return st * 1024 + (ob ^ (((ob >> 9) & 1) << 5)); }
__host__ __device__ __forceinline__ void stage_rc(int b, int& R, int& C) { const int st = b / 1024, sb = b % 1024, swz = sb ^ (((sb >> 9) & 1) << 5); R = (st >> 1) * 16 + swz / 64; C = (st & 1) * 32 + (swz % 64) / 2; }
__host__ __device__ __forceinline__ int perm32(int rho) { const int n = rho >> 4, i = rho & 15; return 8 * (i >> 2) + 4 * n + (i & 3); }
struct Unit { int pm, pn; };
struct Gemm { const bf16_t* A; const bf16_t* Bt; int M, N, K, pad; };
struct StaticOrder {
    int nM, nN, nwg, G, c;
    __host__ __device__ void init(int M, int N, int G_, int c_) { nM = M / BM; nN = N / BM; nwg = nM * nN; G = G_; c = c_; }
    __host__ __device__ bool next(int i, Unit& u) const {
        const long L = (long)i * G + c; if (L >= nwg) return false;
        int wgid = (int)L; { const int q = nwg / NXCD, r = nwg % NXCD, xcd = wgid % NXCD, off = wgid / NXCD; wgid = (xcd < r ? xcd * (q + 1) : r * (q + 1) + (xcd - r) * q) + off; }
        const int nig = WGM * nN, gid = wgid / nig, fm = gid * WGM, gsz = (nM - fm) < WGM ? (nM - fm) : WGM;
        u.pm = fm + ((wgid % nig) % gsz); u.pn = (wgid % nig) / gsz; return true;
    }
    __device__ __forceinline__ void a_ready(const Unit&) const {}
    __device__ __forceinline__ void done(const Unit&) const {}
};
__device__ __forceinline__ unsigned cvt_pk_bf16(float lo, float hi) { unsigned r; asm volatile("v_cvt_pk_bf16_f32 %0, %1, %2" : "=v"(r) : "v"(lo), "v"(hi)); return r; }
template <class Epi, class Sched, bool STAMP = false>
__device__ __forceinline__ void gemm_phase(PG8_LAS unsigned char* lds, const Gemm g, const Sched& S, const Epi& E, unsigned long long* stamps) {
    int tid_ = threadIdx.x; asm volatile("" : "+v"(tid_));
    const int tid = tid_, wid = __builtin_amdgcn_readfirstlane(tid >> 6), lane = tid & 63, wr = wid >> 2, wc = wid & 3, fr = lane & 15, fq = lane >> 4;
    const int K = g.K, nt = K / BK;
    int ts_lo = 0, ts_hi = 0, nts = 0; const unsigned long long rt_entry = STAMP ? (unsigned long long)wall_clock64() : 0ull;
#define PG8_STAMP() do { if (STAMP && wid == 0 && nts < 64) { const unsigned long long _c = (unsigned long long)clock64(); \
        ts_lo = (lane == nts) ? (int)(unsigned)_c : ts_lo; ts_hi = (lane == nts) ? (int)(unsigned)(_c >> 32) : ts_hi; ++nts; } } while (0)
    PG8_STAMP();
    unsigned voffA[2], voffB[2];
#pragma unroll
    for (int i = 0; i < 2; ++i) { int R, C; stage_rc(tid * 16 + i * 8192, R, C); const int Rb = Epi::PERM ? ((R & ~31) + perm32(R & 31)) : R;
        voffA[i] = (unsigned)(R * K + C) * 2u; voffB[i] = (unsigned)(Rb * K + C) * 2u; }
    const size_t kstep = (size_t)(BK * 2);
    const size_t hstep = (size_t)HALF * K * 2;
    const size_t tstep = 2 * hstep;
    const unsigned ldsw = (unsigned)wid * 1024u;
    const int aoff = lds_byte(wr * 64 + fr, fq * 8), boff = lds_byte(wc * 32 + fr, fq * 8);
#define PG8_SA(b, h) (((b) * 2 + (h)) * HTB)
#define PG8_SB(b, h) ((4 + (b) * 2 + (h)) * HTB)
#define PG8_STAGE(bufoff, gbase, voff) do { _Pragma("unroll") for (int _i = 0; _i < 2; ++_i) \
        __builtin_amdgcn_global_load_lds((const unsigned*)((const char*)(gbase) + (voff)[_i]), (PG8_LAS unsigned*)(lds + (bufoff) + ldsw + _i * 8192), 16, 0, 0); } while (0)
#define PG8_LDA(dst, b, h) do { _Pragma("unroll") for (int m = 0; m < 4; ++m) _Pragma("unroll") for (int k = 0; k < 2; ++k) dst[m][k] = *(const PG8_LAS bf16x8*)(lds + PG8_SA(b, h) + aoff + m * 2048 + k * 1024); } while (0)
#define PG8_LDB(dst, b, h) do { _Pragma("unroll") for (int n = 0; n < 2; ++n) _Pragma("unroll") for (int k = 0; k < 2; ++k) dst[n][k] = *(const PG8_LAS bf16x8*)(lds + PG8_SB(b, h) + boff + n * 2048 + k * 1024); } while (0)
#define PG8_MMA(ai, bj, At, Bt) do { __builtin_amdgcn_s_setprio(1); _Pragma("unroll") for (int m = 0; m < 4; ++m) _Pragma("unroll") for (int n = 0; n < 2; ++n) _Pragma("unroll") for (int k = 0; k < 2; ++k) \
        acc[ai][bj][m][n] = __builtin_amdgcn_mfma_f32_16x16x32_bf16(Bt[n][k], At[m][k], acc[ai][bj][m][n], 0, 0, 0); __builtin_amdgcn_s_setprio(0); } while (0)
#define PG8_WAIT_V(n) asm volatile("s_waitcnt vmcnt(" #n ")" ::: "memory")
#define PG8_WAIT_L(n) asm volatile("s_waitcnt lgkmcnt(" #n ")" ::: "memory")
#define PG8_BAR __builtin_amdgcn_s_barrier()
#define PG8_SCHED __builtin_amdgcn_sched_barrier(0)
    Unit cur, nxt; int ui = 0;
    if (!S.next(0, cur)) return;
    f32x4 acc[2][2][4][2];
#pragma unroll
    for (int a = 0; a < 2; ++a)
#pragma unroll
        for (int b = 0; b < 2; ++b)
#pragma unroll
            for (int m = 0; m < 4; ++m)
#pragma unroll
                for (int n = 0; n < 2; ++n) acc[a][b][m][n] = (f32x4){0.f, 0.f, 0.f, 0.f};
    bf16x8 At[4][2], B0[2][2], B1[2][2];
    const char* cA = (const char*)g.A + (size_t)cur.pm * tstep; const char* cB = (const char*)g.Bt + (size_t)cur.pn * tstep;
    S.a_ready(cur);
    PG8_STAGE(PG8_SB(0, 0), cB, voffB); PG8_STAGE(PG8_SA(0, 0), cA, voffA); PG8_STAGE(PG8_SB(0, 1), cB + hstep, voffB); PG8_STAGE(PG8_SA(0, 1), cA + hstep, voffA);
    if (wr == 1) PG8_BAR;
    PG8_WAIT_V(4); PG8_BAR;
    PG8_STAGE(PG8_SB(1, 0), cB + kstep, voffB); PG8_STAGE(PG8_SA(1, 0), cA + kstep, voffA); PG8_STAGE(PG8_SB(1, 1), cB + hstep + kstep, voffB);
    PG8_WAIT_V(6); PG8_BAR;
    PG8_STAMP();
    for (;;) {
        const bool has_next = S.next(ui + 1, nxt);
        const char* nA = has_next ? (const char*)g.A + (size_t)nxt.pm * tstep : cA; const char* nB = has_next ? (const char*)g.Bt + (size_t)nxt.pn * tstep : cB;
        for (int t = 0; t < nt; t += 2) {
            const bool last = (t == nt - 2);
            const char* a1 = cA + (size_t)(t + 1) * kstep;
            const char* a2 = last ? nA : cA + (size_t)(t + 2) * kstep; const char* b2 = last ? nB : cB + (size_t)(t + 2) * kstep;
            const char* a3 = a2 + kstep; const char* b3 = b2 + kstep;
            if (last && has_next) S.a_ready(nxt);
            PG8_LDB(B0, 0, 0); PG8_SCHED; PG8_LDA(At, 0, 0); PG8_STAGE(PG8_SA(1, 1), a1 + hstep, voffA);
            PG8_WAIT_L(8); PG8_BAR; PG8_WAIT_L(0); PG8_MMA(0, 0, At, B0); PG8_BAR; PG8_SCHED;
            PG8_LDB(B1, 0, 1); PG8_STAGE(PG8_SB(0, 0), b2, voffB);
            PG8_BAR; PG8_WAIT_L(0); PG8_MMA(0, 1, At, B1); PG8_BAR;
            PG8_LDA(At, 0, 1); PG8_STAGE(PG8_SA(0, 0), a2, voffA);
            PG8_BAR; PG8_WAIT_L(0); PG8_MMA(1, 0, At, B0); PG8_BAR; PG8_SCHED;
            PG8_STAGE(PG8_SB(0, 1), b2 + hstep, voffB);
            PG8_WAIT_V(6); PG8_BAR; PG8_MMA(1, 1, At, B1); PG8_BAR;
            PG8_LDB(B0, 1, 0); PG8_SCHED; PG8_LDA(At, 1, 0); PG8_STAGE(PG8_SA(0, 1), a2 + hstep, voffA);
            PG8_WAIT_L(8); PG8_BAR; PG8_WAIT_L(0); PG8_MMA(0, 0, At, B0); PG8_BAR; PG8_SCHED;
            PG8_LDB(B1, 1, 1); PG8_STAGE(PG8_SB(1, 0), b3, voffB);
            PG8_BAR; PG8_WAIT_L(0); PG8_MMA(0, 1, At, B1); PG8_BAR;
            PG8_LDA(At, 1, 1); PG8_STAGE(PG8_SA(1, 0), a3, voffA);
            PG8_BAR; PG8_WAIT_L(0); PG8_MMA(1, 0, At, B0); PG8_BAR; PG8_SCHED;
            PG8_STAGE(PG8_SB(1, 1), b3 + hstep, voffB);
            PG8_WAIT_V(6); PG8_BAR; PG8_MMA(1, 1, At, B1); PG8_BAR;
        }
        PG8_STAMP();
        if constexpr (!Epi::AFTER_DRAIN) { E(acc, cur, wr, wc, fr, fq); S.done(cur); }
        PG8_STAMP();
        if (!has_next) break;
#pragma unroll
        for (int a = 0; a < 2; ++a)
#pragma unroll
            for (int b = 0; b < 2; ++b)
#pragma unroll
                for (int m = 0; m < 4; ++m)
#pragma unroll
                    for (int n = 0; n < 2; ++n) acc[a][b][m][n] = (f32x4){0.f, 0.f, 0.f, 0.f};
        cur = nxt; cA = nA; cB = nB; ++ui;
    }
    PG8_WAIT_V(0);
    if (wr == 0) PG8_BAR;
    PG8_BAR;
    if constexpr (Epi::AFTER_DRAIN) { E.fused(acc, cur, wr, wc, fr, fq, lds, wid, lane); S.done(cur); }
    PG8_STAMP();
    if (STAMP && wid == 0) { stamps[lane] = lane < nts ? (((unsigned long long)(unsigned)ts_hi << 32) | (unsigned)ts_lo) : 0ull;
        if (lane == 62) stamps[62] = rt_entry; if (lane == 63) stamps[63] = (unsigned long long)wall_clock64(); }
#undef PG8_STAMP
#undef PG8_SA
#undef PG8_SB
#undef PG8_STAGE
#undef PG8_LDA
#undef PG8_LDB
#undef PG8_MMA
#undef PG8_WAIT_V
#undef PG8_WAIT_L
#undef PG8_BAR
#undef PG8_SCHED
}
}
#define XB_TMO      128
#define XB_XCNT(j)  (256  + 64 * (j))
#define XB_XSUB(j)  (1280 + 64 * (j))
#define XB_XGEN(j)  (2304 + 64 * (j))
#define XB_TOP      3328
#define XB_TOPGEN   3392
#define XCD_BAR_WORDS 3456
#define XB_SPIN_CAP (1u << 18)
#define LAS __attribute__((address_space(3)))

__device__ __forceinline__ unsigned xb_ld(unsigned* p)              { return __hip_atomic_load(p, __ATOMIC_RELAXED, __HIP_MEMORY_SCOPE_AGENT); }
__device__ __forceinline__ unsigned xb_add(unsigned* p, unsigned v) { return __hip_atomic_fetch_add(p, v, __ATOMIC_RELAXED, __HIP_MEMORY_SCOPE_AGENT); }
__device__ __forceinline__ unsigned xb_xcc_id() { return (unsigned)__builtin_amdgcn_s_getreg((3 << 11) | 20) & 0xFu; }
#define XB_SPIN(cond, bar) do { unsigned _sp = 0; while (cond) { __builtin_amdgcn_s_sleep(1); \
    if ((++_sp & 255u) == 0u) { if (xb_ld(&(bar)[XB_TMO])) break; if (_sp > XB_SPIN_CAP) { atomicAdd(&(bar)[XB_TMO], 1u); break; } } } } while (0)

struct XcdBarrier {
    unsigned* bar; unsigned x;
    volatile LAS unsigned* st;
};

__device__ __forceinline__ XcdBarrier xcd_barrier_post(unsigned* bar, volatile LAS unsigned* st) {
    XcdBarrier b; b.bar = bar; b.x = (unsigned)__builtin_amdgcn_readfirstlane((int)xb_xcc_id()); b.st = st;
    if (threadIdx.x == 0) (void)xb_add(&bar[XB_XCNT(b.x)], 1u);
    return b;
}
__device__ __forceinline__ void xcd_barrier_complete(unsigned* bar, unsigned x, unsigned& nloc, unsigned& nx) {
    const unsigned G = gridDim.x * gridDim.y * gridDim.z;
    unsigned sum, cnt, mine, sp = 0u;
    for (;;) {
        sum = 0u; cnt = 0u; mine = 0u;
#pragma unroll
        for (unsigned j = 0; j < 16; ++j) { const unsigned c = xb_ld(&bar[XB_XCNT(j)]); sum += c; cnt += (c > 0u) ? 1u : 0u; mine = (j == x) ? c : mine; }
        if (sum == G) break;
        __builtin_amdgcn_s_sleep(1);
        if ((++sp & 255u) == 0u) { if (xb_ld(&bar[XB_TMO])) break; if (sp > XB_SPIN_CAP) { atomicAdd(&bar[XB_TMO], 1u); break; } }
    }
    nloc = mine > 0u ? mine : 1u; nx = cnt > 0u ? cnt : 1u;
}

__device__ __forceinline__ void xcd_barrier(const XcdBarrier& b) {
    asm volatile("s_waitcnt vmcnt(0)" ::: "memory");
    __syncthreads();
    if (threadIdx.x == 0) {
        unsigned* bar = b.bar; unsigned bx = b.x; asm volatile("" : "+s"(bx));
        __builtin_amdgcn_s_waitcnt(0);
        unsigned nloc = b.st[0], nx = b.st[1];
        if (nloc == 0u) { xcd_barrier_complete(bar, bx, nloc, nx); b.st[0] = nloc; b.st[1] = nx; }
        const unsigned old = xb_add(&bar[XB_XSUB(bx)], 1u);
        const unsigned gen = old / nloc;
        if (old + 1u == (gen + 1u) * nloc) {
            __builtin_amdgcn_fence(__ATOMIC_RELEASE, "agent");
            asm volatile("s_waitcnt vmcnt(0)" ::: "memory");
            const unsigned og = xb_add(&bar[XB_TOP], 1u);
            const unsigned tg = og / nx;
            if (og + 1u == (tg + 1u) * nx) xb_add(&bar[XB_TOPGEN], 1u);
            else XB_SPIN(xb_ld(&bar[XB_TOPGEN]) == tg, bar);
            __builtin_amdgcn_fence(__ATOMIC_ACQUIRE, "agent");
            xb_add(&bar[XB_XGEN(bx)], 1u);
            asm volatile("s_waitcnt vmcnt(0)" ::: "memory");
        } else {
            XB_SPIN(xb_ld(&bar[XB_XGEN(bx)]) == gen, bar);
            __builtin_amdgcn_fence(__ATOMIC_ACQUIRE, "agent");
            asm volatile("s_waitcnt vmcnt(0)" ::: "memory");
        }
    }
    __syncthreads();
}

extern __shared__ __attribute__((aligned(16))) unsigned char smem[];

DI void convT_tile(const float* __restrict__ src, int ldsrc, bf16_t* __restrict__ dst, int K, int tile, int ntn, bool inmap) {
    float* t = (float*)smem;
    const int tid = ltid(), tk = tile / ntn, tn = tile % ntn, k0 = tk * 64, n0 = tn * 64;
    __syncthreads();
#pragma unroll
    for (int r = 0; r < 8; ++r) {
        const int i = (tid >> 6) + 8 * r, j = tid & 63, n = n0 + j;
        int sn = n; bool z = false;
        if (inmap) { if (n >= 3104 && n < C_NQ) z = true; else if (n >= C_NQ) sn = n - 224; }
        t[i * 65 + j] = z ? 0.f : src[(size_t)(k0 + i) * ldsrc + sn];
    }
    __syncthreads();
    const int j = tid >> 3, i8 = (tid & 7) * 8;
    u32x4 w;
    w.x = pk2(t[(i8 + 0) * 65 + j], t[(i8 + 1) * 65 + j]); w.y = pk2(t[(i8 + 2) * 65 + j], t[(i8 + 3) * 65 + j]);
    w.z = pk2(t[(i8 + 4) * 65 + j], t[(i8 + 5) * 65 + j]); w.w = pk2(t[(i8 + 6) * 65 + j], t[(i8 + 7) * 65 + j]);
    *(u32x4*)(dst + (size_t)(n0 + j) * K + k0 + i8) = w;
}
DI void phase_convert(const Params& p, int bid, int nb) {
    for (int l = 0; l < DEPTH; ++l) {
        { const int ntn = NP / 64, nt = (DM / 64) * ntn; bf16_t* d = (bf16_t*)(lws(p) + OFF_WIN) + (size_t)l * NP * DM;
          for (int t = bid; t < nt; t += nb) convT_tile(p.w_in + (size_t)l * DM * IN_TOTAL, IN_TOTAL, d, DM, t, ntn, true); }
        for (int br = 0; br < 3; ++br) { const float* s = (br == 0 ? p.w_br_a : br == 1 ? p.w_br_b : p.w_br_c) + (size_t)l * 1024 * DM;
          const int ntn = DM / 64, nt = (1024 / 64) * ntn; bf16_t* d = (bf16_t*)(lws(p) + OFF_WBR) + ((size_t)l * 3 + br) * DM * 1024;
          for (int t = bid; t < nt; t += nb) convT_tile(s, DM, d, 1024, t, ntn, false); }
        { const int ntn = DM / 64, nt = (DM / 64) * ntn; bf16_t* d = (bf16_t*)(lws(p) + OFF_WOUT) + (size_t)l * DM * DM;
          for (int t = bid; t < nt; t += nb) convT_tile(p.w_out + (size_t)l * DM * DM, DM, d, DM, t, ntn, false); }
        { const int ntn = DFF / 64, nt = (DM / 64) * ntn; bf16_t* d = (bf16_t*)(lws(p) + OFF_W1) + (size_t)l * DFF * DM;
          for (int t = bid; t < nt; t += nb) convT_tile(p.w_mlp1 + (size_t)l * DM * DFF, DFF, d, DM, t, ntn, false); }
        { const int ntn = DM / 64, nt = (DFF / 64) * ntn; bf16_t* d = (bf16_t*)(lws(p) + OFF_W2) + (size_t)l * DM * DFF;
          for (int t = bid; t < nt; t += nb) convT_tile(p.w_mlp2 + (size_t)l * DFF * DM, DM, d, DFF, t, ntn, false); }
    }
}

DI void phase_adaln(const Params& p, int bid, int nb) {
    float* sc = (float*)smem;
    float* red = sc + NCOND * DM;
    const int tid = ltid();
    __syncthreads();
    for (int i = tid; i < NCOND * DM; i += 512) { const int r = i / DM, k = i % DM; const float v = r == 0 ? p.c_ctx[k] : p.c[(size_t)(r - 1) * DM + k]; sc[i] = v * sigmoidf_(v); }
    __syncthreads();
    const int nun = DEPTH * (NMOD * DM / 64);
    for (int u = bid; u < nun; u += nb) {
        const int l = u / (NMOD * DM / 64), j0 = (u % (NMOD * DM / 64)) * 64, j = tid & 63, ks = tid >> 6;
        const float* w = p.w_mod + (size_t)l * DM * (NMOD * DM) + j0 + j;
        float acc[NCOND];
#pragma unroll
        for (int r = 0; r < NCOND; ++r) acc[r] = 0.f;
        for (int k = ks * 256; k < ks * 256 + 256; ++k) { const float wv = w[(size_t)k * (NMOD * DM)];
#pragma unroll
            for (int r = 0; r < NCOND; ++r) acc[r] += sc[r * DM + k] * wv; }
#pragma unroll
        for (int r = 0; r < NCOND; ++r) red[(ks * NCOND + r) * 64 + j] = acc[r];
        __syncthreads();
        for (int i = tid; i < NCOND * 64; i += 512) { const int r = i / 64, jj = i % 64; float s = p.b_mod[(size_t)l * NMOD * DM + j0 + jj];
#pragma unroll
            for (int q = 0; q < 8; ++q) s += red[(q * NCOND + r) * 64 + jj];
            ((float*)(lws(p) + OFF_MOD))[((size_t)l * NCOND + r) * (NMOD * DM) + j0 + jj] = s; }
        __syncthreads();
    }
}

DI void phase_hyena_hid(const Params& p, int bid, int nb) {
    float* zf = (float*)smem;
    float* h1 = zf + 8 * 36;
    const int tid = ltid(), tt = tid >> 6, j = tid & 63;
    const int nun = DEPTH * (256 / 8 + 4096 / 8);
    for (int u = bid; u < nun; u += nb) {
        const int l = u / 544, r = u % 544, ls = r < 32 ? 0 : 1, tb = ls ? r - 32 : r, L = ls ? 4096 : 256, t = tb * 8 + tt;
        const float tn = (float)t / (float)L;
        __syncthreads();
        if (j < 33) { float v; if (j == 0) v = tn; else { const int band = j <= 16 ? j : j - 16; const float ang = 6.283185307179586f * tn * (float)band; v = j <= 16 ? cosf(ang) : sinf(ang); } zf[tt * 36 + j] = v; }
        __syncthreads();
        const float fr = p.hy_freq[l * 64 + j];
        float a = p.hy_f1_b[l * 64 + j];
        for (int i = 0; i < 33; ++i) a += zf[tt * 36 + i] * p.hy_f1_w[((size_t)l * 33 + i) * 64 + j];
        h1[tt * 64 + j] = sinf(fr * a);
        __syncthreads();
        float b = p.hy_f2_b[l * 64 + j];
        for (int i = 0; i < 64; ++i) b += h1[tt * 64 + i] * p.hy_f2_w[((size_t)l * 64 + i) * 64 + j];
        ((float*)(lws(p) + OFF_HID))[(((size_t)l * 2 + ls) * 4096 + t) * 64 + j] = sinf(fr * b);
    }
}
DI const float* filt_ptr(const unsigned char* ws, int l, int ls) { return (const float*)(ws + OFF_FILT + (size_t)l * FILT_L) + (ls ? (size_t)2 * 1024 * 256 : 0); }
DI void phase_filters(const Params& p, int bid, int nb) {
    float* f3s = (float*)smem;
    float* red = f3s + 256;
    const int tid = ltid(), lane = tid & 63, wid = tid >> 6;
    const int nun = DEPTH * 2 * 512;
    for (int u = bid; u < nun; u += nb) {
        const int l = u / 1024, ls = (u / 512) & 1, cg = u % 512, L = ls ? 4096 : 256, col0 = cg * 4;
        __syncthreads();
        if (tid < 256) f3s[tid] = p.hy_f3_w[((size_t)l * 64 + (tid >> 2)) * 2048 + col0 + (tid & 3)];
        __syncthreads();
        const float* hid = (const float*)(lws(p) + OFF_HID) + ((size_t)l * 2 + ls) * 4096 * 64;
        float val[8][4]; float ss[4] = {0.f, 0.f, 0.f, 0.f};
        float delta[4];
#pragma unroll
        for (int cc = 0; cc < 4; ++cc) { const int c = (col0 + cc) & 1023; const float a = -3.0701134573253943f, b = -15.350567286626972f; delta[cc] = fabsf(a + (b - a) * ((float)c / 1023.0f)); }
#pragma unroll
        for (int i = 0; i < 8; ++i) {
            const int t = tid + 512 * i;
#pragma unroll
            for (int cc = 0; cc < 4; ++cc) val[i][cc] = 0.f;
            if (t < L) {
                const f32x4* hr = (const f32x4*)(hid + (size_t)t * 64);
                float a0 = 0.f, a1 = 0.f, a2 = 0.f, a3 = 0.f;
#pragma unroll
                for (int q = 0; q < 16; ++q) { const f32x4 hv = hr[q];
#pragma unroll
                    for (int e = 0; e < 4; ++e) { const f32x4 w = *(const f32x4*)(f3s + (q * 4 + e) * 4); a0 += hv[e] * w[0]; a1 += hv[e] * w[1]; a2 += hv[e] * w[2]; a3 += hv[e] * w[3]; } }
                const float dist = fabsf((float)t - (float)(L / 2)) * (2.0f / (float)L);
                val[i][0] = a0 * expf(-dist * delta[0]); val[i][1] = a1 * expf(-dist * delta[1]); val[i][2] = a2 * expf(-dist * delta[2]); val[i][3] = a3 * expf(-dist * delta[3]);
#pragma unroll
                for (int cc = 0; cc < 4; ++cc) ss[cc] += val[i][cc] * val[i][cc];
            }
        }
#pragma unroll
        for (int cc = 0; cc < 4; ++cc) { ss[cc] = wave_sum(ss[cc], lane); if (lane == 0) red[wid * 4 + cc] = ss[cc]; }
        __syncthreads();
        float sc[4];
#pragma unroll
        for (int cc = 0; cc < 4; ++cc) { float s = 0.f;
#pragma unroll
            for (int q = 0; q < 8; ++q) s += red[q * 4 + cc]; sc[cc] = rsqrtf(s + EPS); }
        float* fo = (float*)filt_ptr(lws(p), l, ls);
#pragma unroll
        for (int i = 0; i < 8; ++i) { const int t = tid + 512 * i; if (t < L) {
#pragma unroll
            for (int cc = 0; cc < 4; ++cc) { const int col = col0 + cc; fo[((size_t)(col >> 10) * 1024 + (col & 1023)) * L + t] = val[i][cc] * sc[cc]; } } }
    }
}

DI int cond_row(int grp, int row) { return grp == 0 ? 0 : 1 + 2 * (grp - 1) + (row >> 12); }
DI void phase_norm(const Params& p, const float* x, const float* g, int l, int grp, int shoff, int scoff, int bid, int nb) {
    const int tid = ltid(), lane = tid & 63, wid = tid >> 6;
    bf16_t* h = (bf16_t*)(lws(p) + OFF_H);
    for (int row = bid * 8 + wid; row < GT; row += nb * 8) {
        const float* xr = x + (size_t)row * DM;
        f32x4 v[8]; float ss = 0.f;
#pragma unroll
        for (int i = 0; i < 8; ++i) { v[i] = *(const f32x4*)(xr + i * 256 + lane * 4); ss += v[i][0] * v[i][0] + v[i][1] * v[i][1] + v[i][2] * v[i][2] + v[i][3] * v[i][3]; }
        ss = wave_sum(ss, lane);
        const float rs = rsqrtf(ss * (1.0f / DM) + EPS);
        const float* md = (const float*)(lws(p) + OFF_MOD) + ((size_t)l * NCOND + cond_row(grp, row)) * (NMOD * DM);
#pragma unroll
        for (int i = 0; i < 8; ++i) { const int c = i * 256 + lane * 4; const f32x4 gv = *(const f32x4*)(g + c), sh = *(const f32x4*)(md + shoff + c), sc = *(const f32x4*)(md + scoff + c);
            f32x4 o = v[i] * rs * gv * (sc + 1.0f) + sh; u32x2 w; w.x = pk2(o[0], o[1]); w.y = pk2(o[2], o[3]); *(u32x2*)(h + (size_t)row * DM + c) = w; }
    }
}
using pg8::Unit; using pg8::cvt_pk_bf16;
template <int ACT> struct EpiStoreBf16 {
    static constexpr bool PERM = true, AFTER_DRAIN = false;
    bf16_t* O; int ldc; int pad;
    __device__ __forceinline__ void operator()(const f32x4 (&acc)[2][2][4][2], const Unit& u, int wr, int wc, int fr, int fq) const {
        const int row0 = u.pm * 256 + wr * 64 + fr, col0 = u.pn * 256 + wc * 32 + 8 * fq;
#pragma unroll
        for (int ai = 0; ai < 2; ++ai)
#pragma unroll
            for (int m = 0; m < 4; ++m) { bf16_t* rowp = O + (size_t)(row0 + ai * 128 + m * 16) * ldc + col0;
#pragma unroll
                for (int bj = 0; bj < 2; ++bj) { f32x4 v0 = acc[ai][bj][m][0], v1 = acc[ai][bj][m][1];
                    if (ACT == 1) {
#pragma unroll
                        for (int j = 0; j < 4; ++j) { const float a = fmaxf(v0[j], 0.f), b = fmaxf(v1[j], 0.f); v0[j] = a * a; v1[j] = b * b; } }
                    u32x4 w; w.x = cvt_pk_bf16(v0[0], v0[1]); w.y = cvt_pk_bf16(v0[2], v0[3]); w.z = cvt_pk_bf16(v1[0], v1[1]); w.w = cvt_pk_bf16(v1[2], v1[3]);
                    *(u32x4*)(rowp + bj * 128) = w; } }
    }
};
template <int MODE> struct EpiGate {
    static constexpr bool PERM = true, AFTER_DRAIN = false;
    const bf16_t* gate; float* m32; bf16_t* mbf; int ldg; int pad;
    __device__ __forceinline__ void operator()(const f32x4 (&acc)[2][2][4][2], const Unit& u, int wr, int wc, int fr, int fq) const {
        const int row0 = u.pm * 256 + wr * 64 + fr, col0 = u.pn * 256 + wc * 32 + 8 * fq;
#pragma unroll
        for (int ai = 0; ai < 2; ++ai)
#pragma unroll
            for (int m = 0; m < 4; ++m) { const size_t row = (size_t)(row0 + ai * 128 + m * 16);
#pragma unroll
                for (int bj = 0; bj < 2; ++bj) { const int col = col0 + bj * 128;
                    const u32x4 gw = *(const u32x4*)(gate + row * ldg + col);
                    f32x4 s0, s1;
                    s0[0] = sigmoidf_(bflo(gw.x)); s0[1] = sigmoidf_(bfhi(gw.x)); s0[2] = sigmoidf_(bflo(gw.y)); s0[3] = sigmoidf_(bfhi(gw.y));
                    s1[0] = sigmoidf_(bflo(gw.z)); s1[1] = sigmoidf_(bfhi(gw.z)); s1[2] = sigmoidf_(bflo(gw.w)); s1[3] = sigmoidf_(bfhi(gw.w));
                    f32x4 v0 = acc[ai][bj][m][0] * s0, v1 = acc[ai][bj][m][1] * s1;
                    float* mp = m32 + row * DM + col;
                    if (MODE >= 1) { v0 += *(const f32x4*)mp; v1 += *(const f32x4*)(mp + 4); }
                    if (MODE <= 1) { *(f32x4*)mp = v0; *(f32x4*)(mp + 4) = v1; }
                    else { u32x4 w; w.x = cvt_pk_bf16(v0[0], v0[1]); w.y = cvt_pk_bf16(v0[2], v0[3]); w.z = cvt_pk_bf16(v1[0], v1[1]); w.w = cvt_pk_bf16(v1[2], v1[3]);
                           *(u32x4*)(mbf + row * DM + col) = w; } } }
    }
};
struct EpiResid {
    static constexpr bool PERM = true, AFTER_DRAIN = false;
    const float* xin; float* xout; const float* gA; const float* gB;
    __device__ __forceinline__ void operator()(const f32x4 (&acc)[2][2][4][2], const Unit& u, int wr, int wc, int fr, int fq) const {
        const int row0 = u.pm * 256 + wr * 64 + fr, col0 = u.pn * 256 + wc * 32 + 8 * fq;
        const float* gv = (u.pm * 256 < 4096) ? gA : gB;
#pragma unroll
        for (int bj = 0; bj < 2; ++bj) { const int col = col0 + bj * 128; const f32x4 g0 = *(const f32x4*)(gv + col), g1 = *(const f32x4*)(gv + col + 4);
#pragma unroll
            for (int ai = 0; ai < 2; ++ai)
#pragma unroll
                for (int m = 0; m < 4; ++m) { const size_t o = (size_t)(row0 + ai * 128 + m * 16) * DM + col;
                    const f32x4 a0 = *(const f32x4*)(xin + o), a1 = *(const f32x4*)(xin + o + 4);
                    *(f32x4*)(xout + o) = a0 + g0 * acc[ai][bj][m][0]; *(f32x4*)(xout + o + 4) = a1 + g1 * acc[ai][bj][m][1]; } }
    }
};

struct GrpInfo { int grp, l, L, nseq, latent; };
DI GrpInfo grp_info(int grp, int l) { GrpInfo g; g.grp = grp; g.l = l; g.latent = grp > 0; g.L = grp ? 4096 : 256; g.nseq = grp ? 2 : 32; return g; }

DI void phase_na_prep(const Params& p, GrpInfo gi, int bid, int nb) {
    const int tid = ltid(), lane = tid & 63, wid = tid >> 6;
    const bf16_t* P = (const bf16_t*)(lws(p) + OFF_P);
    bf16_t* QN = (bf16_t*)(lws(p) + OFF_QN); bf16_t* KN = (bf16_t*)(lws(p) + OFF_KN);
    const float gq0 = p.na_qnorm_g[gi.l * 128 + 2 * lane], gq1 = p.na_qnorm_g[gi.l * 128 + 2 * lane + 1];
    const float gk0 = p.na_knorm_g[gi.l * 128 + 2 * lane], gk1 = p.na_knorm_g[gi.l * 128 + 2 * lane + 1];
    for (int u = bid * 8 + wid; u < GT * 8; u += nb * 8) {
        const int row = u >> 3, h = u & 7;
        const unsigned qw = *(const unsigned*)(P + (size_t)row * NP + C_NQ + h * 128 + 2 * lane);
        const unsigned kw = *(const unsigned*)(P + (size_t)row * NP + C_NK + h * 128 + 2 * lane);
        const float q0 = bflo(qw), q1 = bfhi(qw), k0 = bflo(kw), k1 = bfhi(kw);
        const float qs = rsqrtf(wave_sum(q0 * q0 + q1 * q1, lane) * (1.0f / 128) + EPS), ks = rsqrtf(wave_sum(k0 * k0 + k1 * k1, lane) * (1.0f / 128) + EPS);
        const float a0 = q0 * qs * gq0, a1 = q1 * qs * gq1, b0 = k0 * ks * gk0, b1 = k1 * ks * gk1;
        *(unsigned*)(QN + (size_t)row * 1024 + h * 128 + 2 * lane) = pk2(a0, a1);
        *(unsigned*)(KN + (size_t)row * 1024 + h * 128 + 2 * lane) = pk2(b0, b1);
        if (!gi.latent) { const int b = row >> 8, t = row & 255; const size_t o = ((((size_t)b * DEPTH + gi.l) * 8 + h) * 256 + t) * 128 + 2 * lane;
            const unsigned vw = *(const unsigned*)(P + (size_t)row * NP + C_NV + h * 128 + 2 * lane);
            *(f32x2*)(lout(p) + OUT_CK + o) = (f32x2){b0, b1}; *(f32x2*)(lout(p) + OUT_CV + o) = (f32x2){bflo(vw), bfhi(vw)}; }
    }
}
DI void phase_na_naive(const Params& p, GrpInfo gi, int bid, int nb) {
    const int tid = ltid(), lane = tid & 63, wid = tid >> 6;
    float* qs = (float*)smem + wid * 512;
    float* ps = qs + 128;
    const bf16_t* P = (const bf16_t*)(lws(p) + OFF_P);
    const bf16_t* QN = (const bf16_t*)(lws(p) + OFF_QN); const bf16_t* KN = (const bf16_t*)(lws(p) + OFF_KN);
    bf16_t* OB = (bf16_t*)(lws(p) + OFF_OABC) + (size_t)GT * 1024;
    const float scale = 0.08838834764831845f;
    for (int u = bid * 8 + wid; u < GT * 8; u += nb * 8) {
        const int row = u >> 3, h = u & 7;
        { const unsigned qw = *(const unsigned*)(QN + (size_t)row * 1024 + h * 128 + 2 * lane); qs[2 * lane] = bflo(qw); qs[2 * lane + 1] = bfhi(qw); }
        asm volatile("s_waitcnt lgkmcnt(0)" ::: "memory");
        const int nkeys = gi.latent ? 384 : 256;
        const int sl = gi.latent ? (row >> 12) : (row >> 8), t = gi.latent ? (row & 4095) : (row & 255);
        const int r = t >> 6, c = t & 63, rs = min(max(r - 4, 0), 56), cs = min(max(c - 8, 0), 48);
        const int bs = 2 * (gi.grp - 1) + sl;
        float mx = -3.0e38f;
#pragma unroll 1
        for (int s = 0; s < 6; ++s) {
            const int kk = s * 64 + lane;
            if (kk < nkeys) {
                float dot = 0.f; float bias = 0.f;
                if (gi.latent && kk >= 128) { const float* kp = p.cache_k + ((((size_t)bs * DEPTH + gi.l) * 8 + h) * 256 + (kk - 128)) * 128;
#pragma unroll 4
                    for (int d = 0; d < 128; d += 4) { const f32x4 kv = *(const f32x4*)(kp + d); const f32x4 qv = *(const f32x4*)(qs + d); dot += kv[0] * qv[0] + kv[1] * qv[1] + kv[2] * qv[2] + kv[3] * qv[3]; } }
                else { int krow;
                    if (gi.latent) { const int i = kk >> 4, j = kk & 15; krow = sl * 4096 + (rs + i) * 64 + cs + j;
                        bias = p.na_rpb[(((size_t)gi.l * 8 + h) * 15 + (rs + i - r + 7)) * 31 + min(max(cs + j - c + 15, 0), 30)]; }
                    else krow = sl * 256 + kk;
                    const bf16_t* kp = KN + (size_t)krow * 1024 + h * 128;
#pragma unroll 4
                    for (int d = 0; d < 128; d += 8) { const u32x4 kw = *(const u32x4*)(kp + d); const f32x4 qa = *(const f32x4*)(qs + d), qb = *(const f32x4*)(qs + d + 4);
                        dot += bflo(kw.x) * qa[0] + bfhi(kw.x) * qa[1] + bflo(kw.y) * qa[2] + bfhi(kw.y) * qa[3] + bflo(kw.z) * qb[0] + bfhi(kw.z) * qb[1] + bflo(kw.w) * qb[2] + bfhi(kw.w) * qb[3]; } }
                const float sc = dot * scale + bias; mx = fmaxf(mx, sc); ps[kk] = sc;
            }
        }
        mx = wave_max(mx, lane);
        float sum = 0.f;
#pragma unroll 1
        for (int s = 0; s < 6; ++s) { const int kk = s * 64 + lane; if (kk < nkeys) { const float e = __expf(ps[kk] - mx); ps[kk] = e; sum += e; } }
        sum = wave_sum(sum, lane); const float inv = 1.0f / sum;
        asm volatile("s_waitcnt lgkmcnt(0)" ::: "memory");
        float o0 = 0.f, o1 = 0.f;
        for (int kk = 0; kk < nkeys; ++kk) {
            const float pv = ps[kk]; float v0, v1;
            if (gi.latent && kk >= 128) { const f32x2 vv = *(const f32x2*)(p.cache_v + ((((size_t)bs * DEPTH + gi.l) * 8 + h) * 256 + (kk - 128)) * 128 + 2 * lane); v0 = vv[0]; v1 = vv[1]; }
            else { const int krow = gi.latent ? sl * 4096 + (rs + (kk >> 4)) * 64 + cs + (kk & 15) : sl * 256 + kk;
                const unsigned vw = *(const unsigned*)(P + (size_t)krow * NP + C_NV + h * 128 + 2 * lane); v0 = bflo(vw); v1 = bfhi(vw); }
            o0 += pv * v0; o1 += pv * v1;
        }
        *(unsigned*)(OB + (size_t)row * 1024 + h * 128 + 2 * lane) = pk2(o0 * inv, o1 * inv);
        asm volatile("s_waitcnt lgkmcnt(0)" ::: "memory");
    }
}

DI float log_sigmoid_(float x) { return fminf(x, 0.f) - log1pf(expf(-fabsf(x))); }
DI void phase_gla_naive(const Params& p, GrpInfo gi, int bid, int nb) {
    const int tid = ltid(), e = tid & 255, dh = tid >> 8, L = gi.L;
    float* qs = (float*)smem; float* ks = qs + 16 * 128; float* as_ = ks + 16 * 128; float* vs = as_ + 16 * 128; float* op = vs + 16 * 256;
    const bf16_t* P = (const bf16_t*)(lws(p) + OFF_P);
    for (int u = bid; u < gi.nseq * 8; u += nb) {
        const int sl = u >> 3, h = (u >> 1) & 3, dir = u & 1;
        float* O = (float*)(lws(p) + (dir ? OFF_OB : OFF_OF));
        float S[64];
        if (gi.latent) { const int bs = 2 * (gi.grp - 1) + sl; const float* s0 = p.state_gla + (((((size_t)bs * DEPTH + gi.l) * 2 + dir) * 4 + h) * 128 + dh * 64) * 256 + e;
#pragma unroll
            for (int j = 0; j < 64; ++j) S[j] = s0[(size_t)j * 256]; }
        else {
#pragma unroll
            for (int j = 0; j < 64; ++j) S[j] = 0.f; }
        const float* wa = p.gla_wa2 + (((size_t)gi.l * 2 + dir) * 16) * 512 + h * 128;
        const float* ba = p.gla_ba2 + ((size_t)gi.l * 2 + dir) * 512 + h * 128;
        for (int bt = 0; bt < L / 16; ++bt) {
            __syncthreads();
#pragma unroll
            for (int i = 0; i < 4; ++i) {
                const int idx = tid + 512 * i, tt = idx >> 7, d = idx & 127, ts = bt * 16 + tt, t = dir ? L - 1 - ts : ts, row = sl * L + t;
                const bf16_t* pr = P + (size_t)row * NP;
                float q = bf2f(pr[C_GQ + h * 128 + d]) * 0.08838834764831845f, k = bf2f(pr[C_GK + h * 128 + d]);
                if (gi.latent) {
                    const float q2 = bf2f(pr[C_GQ + h * 128 + (d ^ 64)]) * 0.08838834764831845f, k2 = bf2f(pr[C_GK + h * 128 + (d ^ 64)]);
                    const int ii = d & 63, f = ii & 31; const float pos = (float)(ii < 32 ? (t >> 6) : (t & 63));
                    const float ang = pos * powf(10000.0f, -(float)f / 32.0f); float sn, cs; sincosf(ang, &sn, &cs);
                    if (d < 64) { q = q * cs - q2 * sn; k = k * cs - k2 * sn; } else { q = q2 * sn + q * cs; k = k2 * sn + k * cs; }
                }
                float xg = ba[d];
#pragma unroll
                for (int r = 0; r < 16; ++r) xg += bf2f(pr[C_GA + dir * 16 + r]) * wa[(size_t)r * 512 + d];
                qs[tt * 128 + d] = q; ks[tt * 128 + d] = k; as_[tt * 128 + d] = expf(log_sigmoid_(xg) * (1.0f / 16.0f));
            }
#pragma unroll
            for (int i = 0; i < 8; ++i) { const int idx = tid + 512 * i, tt = idx >> 8, ee = idx & 255, ts = bt * 16 + tt, t = dir ? L - 1 - ts : ts, row = sl * L + t;
                vs[tt * 256 + ee] = bf2f(P[(size_t)row * NP + C_GV + h * 256 + ee]); }
            __syncthreads();
            for (int tt = 0; tt < 16; ++tt) {
                const float v = vs[tt * 256 + e]; float acc = 0.f;
#pragma unroll
                for (int j4 = 0; j4 < 16; ++j4) {
                    const f32x4 a4 = *(const f32x4*)(as_ + tt * 128 + dh * 64 + j4 * 4), k4 = *(const f32x4*)(ks + tt * 128 + dh * 64 + j4 * 4), q4 = *(const f32x4*)(qs + tt * 128 + dh * 64 + j4 * 4);
#pragma unroll
                    for (int jj = 0; jj < 4; ++jj) { const int j = j4 * 4 + jj; S[j] = a4[jj] * S[j] + k4[jj] * v; acc += q4[jj] * S[j]; }
                }
                op[(tt * 2 + dh) * 256 + e] = acc;
            }
            __syncthreads();
#pragma unroll
            for (int i = 0; i < 8; ++i) { const int idx = tid + 512 * i, tt = idx >> 8, ee = idx & 255, ts = bt * 16 + tt, t = dir ? L - 1 - ts : ts, row = sl * L + t;
                O[(size_t)row * 1024 + h * 256 + ee] = op[(tt * 2) * 256 + ee] + op[(tt * 2 + 1) * 256 + ee]; }
        }
        if (!gi.latent) { float* so = lout(p) + OUT_ST + (((((size_t)sl * DEPTH + gi.l) * 2 + dir) * 4 + h) * 128 + dh * 64) * 256 + e;
#pragma unroll
            for (int j = 0; j < 64; ++j) so[(size_t)j * 256] = S[j]; }
    }
}
template <bool WITH_OI> DI void phase_gla_post(const Params& p, GrpInfo gi, int bid, int nb) {
    const int tid = ltid(), lane = tid & 63, wid = tid >> 6;
    const bf16_t* P = (const bf16_t*)(lws(p) + OFF_P);
    const float* Of = (const float*)(lws(p) + OFF_OF); const float* Ob = (const float*)(lws(p) + OFF_OB); const float* Oi = (const float*)(lws(p) + OFF_OI);
    bf16_t* OA = (bf16_t*)(lws(p) + OFF_OABC);
    const f32x4 g = *(const f32x4*)(p.gla_norm_g + gi.l * 256 + lane * 4);
    for (int u = bid * 8 + wid; u < GT * 4; u += nb * 8) {
        const int row = u >> 2, h = u & 3; const size_t o = (size_t)row * 1024 + h * 256 + lane * 4;
        f32x4 v = *(const f32x4*)(Of + o) + *(const f32x4*)(Ob + o); if (WITH_OI) v += *(const f32x4*)(Oi + o);
        const float rs = rsqrtf(wave_sum(v[0] * v[0] + v[1] * v[1] + v[2] * v[2] + v[3] * v[3], lane) * (1.0f / 256) + EPS);
        const u32x2 gw = *(const u32x2*)(P + (size_t)row * NP + C_GG + h * 256 + lane * 4);
        const float g0 = bflo(gw.x), g1 = bfhi(gw.x), g2 = bflo(gw.y), g3 = bfhi(gw.y);
        u32x2 w; w.x = pk2(v[0] * rs * g[0] * (g0 * sigmoidf_(g0)), v[1] * rs * g[1] * (g1 * sigmoidf_(g1)));
        w.y = pk2(v[2] * rs * g[2] * (g2 * sigmoidf_(g2)), v[3] * rs * g[3] * (g3 * sigmoidf_(g3)));
        *(u32x2*)(OA + o) = w;
    }
}

DI void phase_hyena_naive(const Params& p, GrpInfo gi, int bid, int nb) {
    const int tid = ltid(), L = gi.L, TPC = L / 8, CH = 4096 / L, ci = tid / TPC, tg = tid % TPC, t0 = tg * 8;
    float* z = (float*)smem;
    float* hp = z + 4096;
    const bf16_t* P = (const bf16_t*)(lws(p) + OFF_P);
    bf16_t* OC = (bf16_t*)(lws(p) + OFF_OABC) + (size_t)2 * GT * 1024;
    const int nun = gi.nseq * (1024 / CH);
    for (int u = bid; u < nun; u += nb) {
        const int sl = u / (1024 / CH), c = (u % (1024 / CH)) * CH + ci;
        float x1[8], x2[8], zr[8], cv[8];
        const float* cw = p.hy_conv_w + (size_t)gi.l * 3 * 3072; const float* cb = p.hy_conv_b + (size_t)gi.l * 3072;
        __syncthreads();
#pragma unroll
        for (int i = 0; i < 8; ++i) {
            const int t = t0 + i; const size_t rb = (size_t)(sl * L + t) * NP + C_HY;
            float r[3];
#pragma unroll
            for (int part = 0; part < 3; ++part) { const int j = part * 1024 + c;
                const float um = t > 0 ? bf2f(P[rb - NP + j]) : 0.f, u0 = bf2f(P[rb + j]), up = t < L - 1 ? bf2f(P[rb + NP + j]) : 0.f;
                r[part] = cb[j] + cw[j] * um + cw[3072 + j] * u0 + cw[2 * 3072 + j] * up; }
            x1[i] = r[0]; x2[i] = r[1]; zr[i] = r[2]; z[ci * L + t] = r[2];
        }
#pragma unroll
        for (int o = 0; o < 2; ++o) {
            const float* f = filt_ptr(lws(p), gi.l, gi.latent ? 1 : 0) + ((size_t)o * 1024 + c) * L;
#pragma unroll
            for (int i = 0; i < 8; ++i) { hp[ci * 2 * L + L / 2 + t0 + i] = f[t0 + i]; const int zi = t0 + i; hp[ci * 2 * L + (zi < L / 2 ? zi : L + zi)] = 0.f; }
            __syncthreads();
#pragma unroll
            for (int i = 0; i < 8; ++i) cv[i] = 0.f;
            const float* hb = hp + ci * 2 * L; const float* zb = z + ci * L;
            f32x4 hi0 = *(const f32x4*)(hb + t0 + L), hi1 = *(const f32x4*)(hb + t0 + L + 4);
            for (int s = 0; s < L; s += 8) {
                const int idx0 = t0 + L - s;
                const f32x4 lo0 = *(const f32x4*)(hb + idx0 - 8), lo1 = *(const f32x4*)(hb + idx0 - 4);
                const f32x4 z0 = *(const f32x4*)(zb + s), z1 = *(const f32x4*)(zb + s + 4);
                const float hbuf[16] = {lo0[0], lo0[1], lo0[2], lo0[3], lo1[0], lo1[1], lo1[2], lo1[3], hi0[0], hi0[1], hi0[2], hi0[3], hi1[0], hi1[1], hi1[2], hi1[3]};
                const float zz[8] = {z0[0], z0[1], z0[2], z0[3], z1[0], z1[1], z1[2], z1[3]};
#pragma unroll
                for (int ss = 0; ss < 8; ++ss)
#pragma unroll
                    for (int i = 0; i < 8; ++i) cv[i] += zz[ss] * hbuf[8 - ss + i];
                hi0 = lo0; hi1 = lo1;
            }
            const float bo = p.hy_bias[((size_t)gi.l * 2 + o) * 1024 + c];
            __syncthreads();
            if (o == 0) {
#pragma unroll
                for (int i = 0; i < 8; ++i) { zr[i] = x1[i] * (cv[i] + bo * zr[i]); z[ci * L + t0 + i] = zr[i]; }
            } else {
#pragma unroll
                for (int i = 0; i < 8; ++i) OC[(size_t)(sl * L + t0 + i) * 1024 + c] = f2bf(x2[i] * (cv[i] + bo * zr[i]));
            }
        }
    }
}
typedef short bf16x8 __attribute__((ext_vector_type(8)));
typedef short bf16x4 __attribute__((ext_vector_type(4)));
#define MFMA16(a, b, c) __builtin_amdgcn_mfma_f32_16x16x32_bf16((a), (b), (c), 0, 0, 0)
constexpr int QKP = 136;
constexpr int TP = 72;
DI float log_sigmoid_fast(float x) { return fminf(x, 0.f) - __logf(1.0f + __expf(-fabsf(x))); }
DI bf16x8 pack8(const f32x4& a, const f32x4& b) { u32x4 w; w.x = pk2(a[0], a[1]); w.y = pk2(a[2], a[3]); w.z = pk2(b[0], b[1]); w.w = pk2(b[2], b[3]); return __builtin_bit_cast(bf16x8, w); }

DI void gla_prep_unit(const Params& p, const GrpInfo gi, int unit, int tid) {
    const int cg = unit >> 2, h = unit & 3, row0 = cg * 64, t0 = row0 & (gi.L - 1), l = gi.l;
    const int lane = tid & 63, wid = tid >> 6, r16 = lane & 15, q4 = lane >> 4;
    float* laf = (float*)smem; float* lab = laf + 8192;
    bf16_t* QFs = (bf16_t*)(smem + 65536); bf16_t* KFs = QFs + 64 * QKP; bf16_t* QBs = KFs + 64 * QKP; bf16_t* KBs = QBs + 64 * QKP;
    bf16_t* VTs = (bf16_t*)smem; bf16_t* As = (bf16_t*)(smem + 36864);
    const bf16_t* P = (const bf16_t*)(lws(p) + OFF_P);
    __syncthreads();
    {
        const int t = tid >> 3, d0 = (tid & 7) * 16;
        const bf16_t* pr = P + (size_t)(row0 + t) * NP + C_GA;
        float ga[32];
#pragma unroll
        for (int i = 0; i < 4; ++i) { const u32x4 w = *(const u32x4*)(pr + 8 * i); ga[8 * i] = bflo(w.x); ga[8 * i + 1] = bfhi(w.x); ga[8 * i + 2] = bflo(w.y); ga[8 * i + 3] = bfhi(w.y); ga[8 * i + 4] = bflo(w.z); ga[8 * i + 5] = bfhi(w.z); ga[8 * i + 6] = bflo(w.w); ga[8 * i + 7] = bfhi(w.w); }
#pragma unroll
        for (int dir = 0; dir < 2; ++dir) {
            const float* wa = p.gla_wa2 + (((size_t)l * 2 + dir) * 16) * 512 + h * 128 + d0;
            const float* ba = p.gla_ba2 + ((size_t)l * 2 + dir) * 512 + h * 128 + d0;
            float* dst = (dir ? lab : laf) + t * 128 + d0;
#pragma unroll
            for (int j4 = 0; j4 < 4; ++j4) {
                f32x4 x = *(const f32x4*)(ba + 4 * j4);
#pragma unroll
                for (int r = 0; r < 16; ++r) x += *(const f32x4*)(wa + (size_t)r * 512 + 4 * j4) * ga[dir * 16 + r];
                f32x4 o; o[0] = log_sigmoid_fast(x[0]) * 0.0625f; o[1] = log_sigmoid_fast(x[1]) * 0.0625f; o[2] = log_sigmoid_fast(x[2]) * 0.0625f; o[3] = log_sigmoid_fast(x[3]) * 0.0625f;
                *(f32x4*)(dst + 4 * j4) = o;
            }
        }
    }
    __syncthreads();
    if (tid < 256) {
        const int d = tid & 127;
        if (tid < 128) { float a = 0.f; for (int t = 0; t < 64; ++t) { a += laf[t * 128 + d]; laf[t * 128 + d] = a; } }
        else { float a = 0.f; for (int t = 63; t >= 0; --t) { a += lab[t * 128 + d]; lab[t * 128 + d] = a; } }
    }
    __syncthreads();
    {
        const int t = tid >> 3, dlo = (tid & 7) * 8, ta = t0 + t;
        const bf16_t* pr = P + (size_t)(row0 + t) * NP + h * 128;
        const u32x4 qlw = *(const u32x4*)(pr + C_GQ + dlo), qhw = *(const u32x4*)(pr + C_GQ + 64 + dlo), klw = *(const u32x4*)(pr + C_GK + dlo), khw = *(const u32x4*)(pr + C_GK + 64 + dlo);
        float ql[8], qh[8], kl[8], kh[8];
#pragma unroll
        for (int j = 0; j < 4; ++j) { ql[2 * j] = bflo(qlw[j]); ql[2 * j + 1] = bfhi(qlw[j]); qh[2 * j] = bflo(qhw[j]); qh[2 * j + 1] = bfhi(qhw[j]); kl[2 * j] = bflo(klw[j]); kl[2 * j + 1] = bfhi(klw[j]); kh[2 * j] = bflo(khw[j]); kh[2 * j + 1] = bfhi(khw[j]); }
#pragma unroll
        for (int j = 0; j < 8; ++j) {
            ql[j] *= 0.08838834764831845f; qh[j] *= 0.08838834764831845f;
            if (gi.latent) {
                const int ii = dlo + j, f = ii & 31; const float pos = (float)(ii < 32 ? (ta >> 6) : (ta & 63));
                const float ang = pos * exp2f(-(float)f * 0.41524101186092029f); float sn, cs; sincosf(ang, &sn, &cs);
                const float a = ql[j] * cs - qh[j] * sn, b = ql[j] * sn + qh[j] * cs; ql[j] = a; qh[j] = b;
                const float c = kl[j] * cs - kh[j] * sn, e = kl[j] * sn + kh[j] * cs; kl[j] = c; kh[j] = e;
            }
        }
        float* DEC = (float*)(lws(p) + OFF_DEC);
#pragma unroll
        for (int dir = 0; dir < 2; ++dir) {
            const float* bb = dir ? lab : laf;
            bf16_t* Qs = dir ? QBs : QFs; bf16_t* Ks = dir ? KBs : KFs;
            bf16_t* Qg = (bf16_t*)(lws(p) + (dir ? OFF_QB : OFF_QF)) + (size_t)(row0 + t) * 512 + h * 128;
#pragma unroll
            for (int half = 0; half < 2; ++half) {
                const int d = dlo + 64 * half;
                const f32x4 b0 = *(const f32x4*)(bb + t * 128 + d), b1 = *(const f32x4*)(bb + t * 128 + d + 4);
                float qo[8], ko[8];
#pragma unroll
                for (int j = 0; j < 8; ++j) { const float bv = j < 4 ? b0[j] : b1[j - 4]; const float qv = half ? qh[j] : ql[j], kv = half ? kh[j] : kl[j]; qo[j] = qv * __expf(bv); ko[j] = kv * __expf(-bv); }
                u32x4 qw, kw; qw.x = pk2(qo[0], qo[1]); qw.y = pk2(qo[2], qo[3]); qw.z = pk2(qo[4], qo[5]); qw.w = pk2(qo[6], qo[7]);
                kw.x = pk2(ko[0], ko[1]); kw.y = pk2(ko[2], ko[3]); kw.z = pk2(ko[4], ko[5]); kw.w = pk2(ko[6], ko[7]);
                *(u32x4*)(Qs + t * QKP + d) = qw; *(u32x4*)(Ks + t * QKP + d) = kw; *(u32x4*)(Qg + d) = qw;
                if (t == 0) { const int te = dir ? 0 : 63; const f32x4 e0 = *(const f32x4*)(bb + te * 128 + d), e1 = *(const f32x4*)(bb + te * 128 + d + 4);
                    f32x4 x0, x1;
#pragma unroll
                    for (int j = 0; j < 4; ++j) { x0[j] = __expf(e0[j]); x1[j] = __expf(e1[j]); }
                    float* dp = DEC + ((size_t)dir * 128 + cg) * 512 + h * 128 + d; *(f32x4*)dp = x0; *(f32x4*)(dp + 4) = x1; }
            }
        }
    }
    __syncthreads();
    {
        const int s = tid >> 3, e0 = (tid & 7) * 32;
        const bf16_t* pv = P + (size_t)(row0 + s) * NP + C_GV + h * 256 + e0;
#pragma unroll
        for (int i = 0; i < 4; ++i) { const u32x4 w = *(const u32x4*)(pv + 8 * i);
#pragma unroll
            for (int j = 0; j < 4; ++j) { VTs[(e0 + 8 * i + 2 * j) * TP + s] = (bf16_t)(w[j] & 0xffffu); VTs[(e0 + 8 * i + 2 * j + 1) * TP + s] = (bf16_t)(w[j] >> 16); } }
        const int mt = wid >> 1, nt0 = 2 * (wid & 1);
        f32x4 acc[2][2];
#pragma unroll
        for (int dir = 0; dir < 2; ++dir) { const bf16_t* Qs = dir ? QBs : QFs; const bf16_t* Ks = dir ? KBs : KFs;
#pragma unroll
            for (int n = 0; n < 2; ++n) acc[dir][n] = (f32x4){0.f, 0.f, 0.f, 0.f};
#pragma unroll
            for (int ks = 0; ks < 4; ++ks) { const bf16x8 a = *(const bf16x8*)(Qs + (16 * mt + r16) * QKP + 32 * ks + 8 * q4);
#pragma unroll
                for (int n = 0; n < 2; ++n) { const bf16x8 b = *(const bf16x8*)(Ks + (16 * (nt0 + n) + r16) * QKP + 32 * ks + 8 * q4); acc[dir][n] = MFMA16(a, b, acc[dir][n]); } } }
#pragma unroll
        for (int n = 0; n < 2; ++n)
#pragma unroll
            for (int i = 0; i < 4; ++i) { const int t = 16 * mt + 4 * q4 + i, s2 = 16 * (nt0 + n) + r16;
                const float v = (s2 <= t ? acc[0][n][i] : 0.f) + (s2 >= t ? acc[1][n][i] : 0.f); As[t * TP + s2] = f2bf(v); }
        const int d = tid >> 2, sq = tid & 3;
#pragma unroll
        for (int dir = 0; dir < 2; ++dir) { const bf16_t* Ks = dir ? KBs : KFs; unsigned w[8];
#pragma unroll
            for (int j = 0; j < 8; ++j) w[j] = (unsigned)Ks[(sq * 16 + 2 * j) * QKP + d] | ((unsigned)Ks[(sq * 16 + 2 * j + 1) * QKP + d] << 16);
            bf16_t* kg = (bf16_t*)(lws(p) + (dir ? OFF_KBT : OFF_KFT)) + (((size_t)cg * 4 + h) * 128 + d) * 64 + sq * 16;
            *(u32x4*)kg = (u32x4){w[0], w[1], w[2], w[3]}; *(u32x4*)(kg + 8) = (u32x4){w[4], w[5], w[6], w[7]}; }
    }
    __syncthreads();
    {
        const int e = tid >> 1, hf = tid & 1;
        bf16_t* vg = (bf16_t*)(lws(p) + OFF_VT) + (((size_t)cg * 4 + h) * 256 + e) * 64 + hf * 32;
#pragma unroll
        for (int i = 0; i < 4; ++i) *(u32x4*)(vg + 8 * i) = *(const u32x4*)(VTs + e * TP + hf * 32 + 8 * i);
        float* OI = (float*)(lws(p) + OFF_OI);
#pragma unroll
        for (int n = 0; n < 2; ++n) { const int nt = 2 * wid + n;
            bf16x8 b[2];
#pragma unroll
            for (int ks = 0; ks < 2; ++ks) b[ks] = *(const bf16x8*)(VTs + (16 * nt + r16) * TP + 32 * ks + 8 * q4);
#pragma unroll
            for (int mt = 0; mt < 4; ++mt) { f32x4 acc = (f32x4){0.f, 0.f, 0.f, 0.f};
#pragma unroll
                for (int ks = 0; ks < 2; ++ks) { const bf16x8 a = *(const bf16x8*)(As + (16 * mt + r16) * TP + 32 * ks + 8 * q4); acc = MFMA16(a, b[ks], acc); }
#pragma unroll
                for (int i = 0; i < 4; ++i) OI[(size_t)(row0 + 16 * mt + 4 * q4 + i) * 1024 + h * 256 + 16 * nt + r16] = acc[i]; } }
    }
}
DI void phase_gla_prep(const Params& p, const GrpInfo gi, int bid, int nb) {
    const int tid = ltid();
    for (int u = bid; u < 512; u += nb) gla_prep_unit(p, gi, u, tid);
}

constexpr int SC_Q = 0, SC_K = 64 * QKP * 2, SC_V = SC_K + 128 * TP * 2, SC_D = SC_V + 128 * TP * 2, SC_BUF = SC_D + 512;
DI void gla_scan_unit(const Params& p, const GrpInfo gi, int unit, int tid) {
    const int sl = unit >> 4, h = (unit >> 2) & 3, dir = (unit >> 1) & 1, eh = unit & 1, L = gi.L, NC = L >> 6, l = gi.l;
    const int lane = tid & 63, wid = tid >> 6, r16 = lane & 15, q4 = lane >> 4;
    const int ecol = eh * 128 + 16 * wid + r16;
    f32x4 S[8];
    if (gi.latent) { const int bs = 2 * (gi.grp - 1) + sl; const float* s0 = p.state_gla + ((((size_t)bs * DEPTH + l) * 2 + dir) * 4 + h) * 128 * 256 + ecol;
#pragma unroll
        for (int T = 0; T < 8; ++T)
#pragma unroll
            for (int i = 0; i < 4; ++i) S[T][i] = s0[(size_t)(16 * T + 4 * q4 + i) * 256]; }
    else {
#pragma unroll
        for (int T = 0; T < 8; ++T) S[T] = (f32x4){0.f, 0.f, 0.f, 0.f}; }
    const bf16_t* Qg = (const bf16_t*)(lws(p) + (dir ? OFF_QB : OFF_QF)); const bf16_t* Kg = (const bf16_t*)(lws(p) + (dir ? OFF_KBT : OFF_KFT)); const bf16_t* Vg = (const bf16_t*)(lws(p) + OFF_VT);
    const float* Dg = (const float*)(lws(p) + OFF_DEC) + (size_t)dir * 128 * 512;
    float* Og = (float*)(lws(p) + (dir ? OFF_OB : OFF_OF));
    u32x4 rq[2], rk[2], rv[2]; float rd = 0.f;
    const int qt0 = tid >> 4, qd = (tid & 15) * 8;
    const int kd0 = tid >> 3, ks8 = (tid & 7) * 8;
#define GLA_LOAD(c) do { const int cg_ = sl * NC + (c); const size_t r0_ = (size_t)cg_ * 64; \
        rq[0] = *(const u32x4*)(Qg + (r0_ + qt0) * 512 + h * 128 + qd); rq[1] = *(const u32x4*)(Qg + (r0_ + qt0 + 32) * 512 + h * 128 + qd); \
        rk[0] = *(const u32x4*)(Kg + (((size_t)cg_ * 4 + h) * 128 + kd0) * 64 + ks8); rk[1] = *(const u32x4*)(Kg + (((size_t)cg_ * 4 + h) * 128 + kd0 + 64) * 64 + ks8); \
        rv[0] = *(const u32x4*)(Vg + (((size_t)cg_ * 4 + h) * 256 + eh * 128 + kd0) * 64 + ks8); rv[1] = *(const u32x4*)(Vg + (((size_t)cg_ * 4 + h) * 256 + eh * 128 + kd0 + 64) * 64 + ks8); \
        if (tid < 128) rd = Dg[(size_t)cg_ * 512 + h * 128 + tid]; } while (0)
#define GLA_STORE(bufp) do { unsigned char* b_ = (bufp); \
        *(u32x4*)(b_ + SC_Q + (qt0 * QKP + qd) * 2) = rq[0]; *(u32x4*)(b_ + SC_Q + ((qt0 + 32) * QKP + qd) * 2) = rq[1]; \
        *(u32x4*)(b_ + SC_K + (kd0 * TP + ks8) * 2) = rk[0]; *(u32x4*)(b_ + SC_K + ((kd0 + 64) * TP + ks8) * 2) = rk[1]; \
        *(u32x4*)(b_ + SC_V + (kd0 * TP + ks8) * 2) = rv[0]; *(u32x4*)(b_ + SC_V + ((kd0 + 64) * TP + ks8) * 2) = rv[1]; \
        if (tid < 128) *(float*)(b_ + SC_D + tid * 4) = rd; } while (0)
    __syncthreads();
    GLA_LOAD(dir ? NC - 1 : 0);
    GLA_STORE(smem);
    __syncthreads();
    for (int ci = 0; ci < NC; ++ci) {
        const int c = dir ? NC - 1 - ci : ci;
        if (ci + 1 < NC) GLA_LOAD(dir ? c - 1 : c + 1);
        const unsigned char* buf = smem + (ci & 1) * SC_BUF;
        const bf16_t* Qs = (const bf16_t*)(buf + SC_Q); const bf16_t* Kt = (const bf16_t*)(buf + SC_K); const bf16_t* Vt = (const bf16_t*)(buf + SC_V); const float* Dv = (const float*)(buf + SC_D);
        bf16x8 bS[4];
#pragma unroll
        for (int ks = 0; ks < 4; ++ks) bS[ks] = pack8(S[2 * ks], S[2 * ks + 1]);
        const size_t orow0 = ((size_t)(sl * NC + c) * 64);
#pragma unroll
        for (int mt = 0; mt < 4; ++mt) { f32x4 acc = (f32x4){0.f, 0.f, 0.f, 0.f};
#pragma unroll
            for (int ks = 0; ks < 4; ++ks) { const bf16_t* qp = Qs + (16 * mt + r16) * QKP + 32 * ks + 4 * q4;
                const bf16x4 a0 = *(const bf16x4*)qp, a1 = *(const bf16x4*)(qp + 16);
                const bf16x8 a = (bf16x8){a0[0], a0[1], a0[2], a0[3], a1[0], a1[1], a1[2], a1[3]};
                acc = MFMA16(a, bS[ks], acc); }
#pragma unroll
            for (int i = 0; i < 4; ++i) Og[(orow0 + 16 * mt + 4 * q4 + i) * 1024 + h * 256 + ecol] = acc[i]; }
        bf16x8 bv[2];
#pragma unroll
        for (int ks = 0; ks < 2; ++ks) bv[ks] = *(const bf16x8*)(Vt + (16 * wid + r16) * TP + 32 * ks + 8 * q4);
#pragma unroll
        for (int T = 0; T < 8; ++T) {
#pragma unroll
            for (int ks = 0; ks < 2; ++ks) { const bf16x8 a = *(const bf16x8*)(Kt + (16 * T + r16) * TP + 32 * ks + 8 * q4); S[T] = MFMA16(a, bv[ks], S[T]); }
            const f32x4 dv = *(const f32x4*)(Dv + 16 * T + 4 * q4); S[T] *= dv; }
        if (ci + 1 < NC) GLA_STORE(smem + ((ci + 1) & 1) * SC_BUF);
        __syncthreads();
    }
#undef GLA_LOAD
#undef GLA_STORE
    if (!gi.latent) { float* so = lout(p) + OUT_ST + ((((size_t)sl * DEPTH + l) * 2 + dir) * 4 + h) * 128 * 256 + ecol;
#pragma unroll
        for (int T = 0; T < 8; ++T)
#pragma unroll
            for (int i = 0; i < 4; ++i) so[(size_t)(16 * T + 4 * q4 + i) * 256] = S[T][i]; }
}
DI void phase_gla_scan(const Params& p, const GrpInfo gi, int bid, int nb) {
    const int tid = ltid();
    for (int u = bid; u < gi.nseq * 16; u += nb) gla_scan_unit(p, gi, u, tid);
}
typedef float f32x16 __attribute__((ext_vector_type(16)));
#define MFMA32(a, b, c) __builtin_amdgcn_mfma_f32_32x32x16_bf16((a), (b), (c), 0, 0, 0)

DI void phase_hy_prep(const Params& p, const GrpInfo gi, int bid, int nb) {
    const int tid = ltid(), L = gi.L;
    bf16_t* T = (bf16_t*)smem;
    const bf16_t* P = (const bf16_t*)(lws(p) + OFF_P);
    bf16_t* UcT = (bf16_t*)(lws(p) + OFF_UCT);
    const float* cw = p.hy_conv_w + (size_t)gi.l * 3 * 3072; const float* cb = p.hy_conv_b + (size_t)gi.l * 3072;
    for (int u = bid; u < 128 * 48; u += nb) {
        const int rt = u / 48, ct = u % 48, row0 = rt * 64, j0 = ct * 64;
        const int t = tid >> 3, js = tid & 7, row = row0 + t, tpos = row & (L - 1), j = j0 + js * 8;
        const bf16_t* pr = P + (size_t)row * NP + C_HY + j;
        const u32x4 z4 = (u32x4){0u, 0u, 0u, 0u};
        const u32x4 um = tpos > 0 ? *(const u32x4*)(pr - NP) : z4, u0 = *(const u32x4*)pr, up = tpos < L - 1 ? *(const u32x4*)(pr + NP) : z4;
        __syncthreads();
#pragma unroll
        for (int q = 0; q < 4; ++q) {
            const float o0 = cb[j + 2 * q] + cw[j + 2 * q] * bflo(um[q]) + cw[3072 + j + 2 * q] * bflo(u0[q]) + cw[6144 + j + 2 * q] * bflo(up[q]);
            const float o1 = cb[j + 2 * q + 1] + cw[j + 2 * q + 1] * bfhi(um[q]) + cw[3072 + j + 2 * q + 1] * bfhi(u0[q]) + cw[6144 + j + 2 * q + 1] * bfhi(up[q]);
            T[(js * 8 + 2 * q) * TP + t] = f2bf(o0); T[(js * 8 + 2 * q + 1) * TP + t] = f2bf(o1);
        }
        __syncthreads();
        const int jj = tid >> 3, ts = tid & 7;
        *(u32x4*)(UcT + (size_t)(j0 + jj) * GT + row0 + ts * 8) = *(const u32x4*)(T + jj * TP + ts * 8);
    }
}
DI void phase_hy_post(const Params& p, const GrpInfo gi, int bid, int nb) {
    const int tid = ltid();
    bf16_t* T = (bf16_t*)smem;
    const bf16_t* OcT = (const bf16_t*)(lws(p) + OFF_OCT);
    bf16_t* OC = (bf16_t*)(lws(p) + OFF_OABC) + (size_t)2 * GT * 1024;
    for (int u = bid; u < 128 * 16; u += nb) {
        const int rt = u >> 4, ct = u & 15, row0 = rt * 64, c0 = ct * 64;
        const int c = tid >> 3, ts = tid & 7;
        const u32x4 w = *(const u32x4*)(OcT + (size_t)(c0 + c) * GT + row0 + ts * 8);
        __syncthreads();
#pragma unroll
        for (int q = 0; q < 4; ++q) { T[(ts * 8 + 2 * q) * TP + c] = (bf16_t)(w[q] & 0xffffu); T[(ts * 8 + 2 * q + 1) * TP + c] = (bf16_t)(w[q] >> 16); }
        __syncthreads();
        const int t = tid >> 3, cs = tid & 7;
        *(u32x4*)(OC + (size_t)(row0 + t) * 1024 + c0 + cs * 8) = *(const u32x4*)(T + t * TP + cs * 8);
    }
}

constexpr int HY_HF = 0;
constexpr int HY_Z = 16384;
constexpr int HY_ZERO = HY_Z + 20480;
constexpr int HY_HC = HY_ZERO + 64;
DI int hy_pitch(int L) { return (L + 72) * 2; }
DI int hy_zoff(int s) { return (s >> 5) * 80 + (s & 31) * 2; }
DI void hy_build_copies(int L, int tid) {
    const float* hf = (const float*)(smem + HY_HF);
    const int nch = (L + 64) / 8, pitch = hy_pitch(L);
    for (int ch = tid; ch < 8 * nch; ch += 512) {
        const int e = ch / nch, i8 = (ch % nch) * 8;
        float v[8];
#pragma unroll
        for (int j = 0; j < 8; ++j) { const int x = i8 + j - 32 + e; v[j] = (x >= 0 && x < L) ? hf[L - 1 - x] : 0.f; }
        u32x4 w; w.x = pk2(v[0], v[1]); w.y = pk2(v[2], v[3]); w.z = pk2(v[4], v[5]); w.w = pk2(v[6], v[7]);
        *(u32x4*)(smem + HY_HC + e * pitch + i8 * 2) = w;
    }
}
DI f32x16 hy_conv(int L, int lane, int tb_row0  , int t0) {
    const int m = lane & 31, kh = lane >> 5, e = (7 - (m & 7)) & 7, pitch = hy_pitch(L);
    const int ND = L / 16 + 2;
    int delta = -(L / 2) - 16;
    int aoff = HY_HC + e * pitch + (L / 2 - 1 - delta - m + 8 * kh - e + 32) * 2;
    f32x16 acc;
#pragma unroll
    for (int i = 0; i < 16; ++i) acc[i] = 0.f;
    for (int dl = 0; dl < ND; ++dl) {
        const bf16x8 a = *(const bf16x8*)(smem + aoff);
        const int s0 = t0 - delta;
        const bool inr = (unsigned)s0 <= (unsigned)(L - 16);
        const int zo = inr ? HY_Z + hy_zoff(tb_row0 - delta) + 16 * kh : HY_ZERO;
        const bf16x8 b = *(const bf16x8*)(smem + zo);
        acc = MFMA32(a, b, acc);
        delta += 16; aoff -= 32;
    }
    return acc;
}
DI void hy_conv_unit(const Params& p, const GrpInfo gi, int c, int tid) {
    const int L = gi.L, lane = tid & 63, wid = tid >> 6, n = lane & 31, hi = lane >> 5;
    const int g = 32 * wid + n, tpl = L >> 5, b = g / tpl, t0 = (g % tpl) * 32, frow = b * L + t0;
    const bf16_t* UcT = (const bf16_t*)(lws(p) + OFF_UCT);
    bf16_t* OcT = (bf16_t*)(lws(p) + OFF_OCT);
    const float* f0 = filt_ptr(lws(p), gi.l, gi.latent ? 1 : 0) + (size_t)c * L;
    const float* f1 = f0 + (size_t)1024 * L;
    float* hf = (float*)(smem + HY_HF);
    __syncthreads();
    {
        const bf16_t* zg = UcT + (size_t)(2048 + c) * GT;
#pragma unroll
        for (int i = 0; i < 2; ++i) { const int s = (tid + 512 * i) * 8; *(u32x4*)(smem + HY_Z + hy_zoff(s)) = *(const u32x4*)(zg + s); }
        if (tid < 4) *(unsigned*)(smem + HY_ZERO + 4 * tid) = 0u;
        for (int i = tid * 4; i < L; i += 2048) *(f32x4*)(hf + i) = *(const f32x4*)(f0 + i);
    }
    __syncthreads();
    hy_build_copies(L, tid);
    __syncthreads();
    f32x16 acc = hy_conv(L, lane, frow, t0);
    const float bias0 = p.hy_bias[((size_t)gi.l * 2 + 0) * 1024 + c], bias1 = p.hy_bias[((size_t)gi.l * 2 + 1) * 1024 + c];
    u32x2 z1w[4];
#pragma unroll
    for (int gq = 0; gq < 4; ++gq) {
        const int fr = frow + 8 * gq + 4 * hi;
        const u32x2 xw = *(const u32x2*)(UcT + (size_t)c * GT + fr);
        const u32x2 zw = *(const u32x2*)(smem + HY_Z + hy_zoff(fr));
        const float o0 = bflo(xw.x) * (acc[4 * gq] + bias0 * bflo(zw.x)), o1 = bfhi(xw.x) * (acc[4 * gq + 1] + bias0 * bfhi(zw.x));
        const float o2 = bflo(xw.y) * (acc[4 * gq + 2] + bias0 * bflo(zw.y)), o3 = bfhi(xw.y) * (acc[4 * gq + 3] + bias0 * bfhi(zw.y));
        z1w[gq].x = pk2(o0, o1); z1w[gq].y = pk2(o2, o3);
    }
    __syncthreads();
#pragma unroll
    for (int gq = 0; gq < 4; ++gq) *(u32x2*)(smem + HY_Z + hy_zoff(frow + 8 * gq + 4 * hi)) = z1w[gq];
    for (int i = tid * 4; i < L; i += 2048) *(f32x4*)(hf + i) = *(const f32x4*)(f1 + i);
    __syncthreads();
    hy_build_copies(L, tid);
    __syncthreads();
    acc = hy_conv(L, lane, frow, t0);
#pragma unroll
    for (int gq = 0; gq < 4; ++gq) {
        const int fr = frow + 8 * gq + 4 * hi;
        const u32x2 xw = *(const u32x2*)(UcT + (size_t)(1024 + c) * GT + fr);
        const float o0 = bflo(xw.x) * (acc[4 * gq] + bias1 * bflo(z1w[gq].x)), o1 = bfhi(xw.x) * (acc[4 * gq + 1] + bias1 * bfhi(z1w[gq].x));
        const float o2 = bflo(xw.y) * (acc[4 * gq + 2] + bias1 * bflo(z1w[gq].y)), o3 = bfhi(xw.y) * (acc[4 * gq + 3] + bias1 * bfhi(z1w[gq].y));
        u32x2 w; w.x = pk2(o0, o1); w.y = pk2(o2, o3);
        *(u32x2*)(OcT + (size_t)c * GT + fr) = w;
    }
}
DI void phase_hy_conv(const Params& p, const GrpInfo gi, int bid, int nb) {
    const int tid = ltid();
    for (int c = bid; c < 1024; c += nb) hy_conv_unit(p, gi, c, tid);
}
constexpr float NA_QSCALE = 0.12751743074602468f;
constexpr float LOG2E = 1.4426950408889634f;

DI void phase_cache_cvt(const Params& p, int bid, int nb) {
    const int tid = ltid();
    bf16_t* T = (bf16_t*)smem;
    bf16_t* CK = (bf16_t*)(lws(p) + OFF_CK); bf16_t* CVT = (bf16_t*)(lws(p) + OFF_CVT);
    for (int u = bid; u < 8 * 2 * 8 * 4; u += nb) {
        const int bh = u >> 2, k0 = (u & 3) * 64;
        const int key = tid >> 3, ds = (tid & 7) * 16;
        const size_t src = ((size_t)bh * 256 + k0 + key) * 128 + ds;
        f32x4 kv[4], vv[4];
#pragma unroll
        for (int i = 0; i < 4; ++i) { kv[i] = *(const f32x4*)(p.cache_k + src + 4 * i); vv[i] = *(const f32x4*)(p.cache_v + src + 4 * i); }
        u32x4 w0, w1; w0.x = pk2(kv[0][0], kv[0][1]); w0.y = pk2(kv[0][2], kv[0][3]); w0.z = pk2(kv[1][0], kv[1][1]); w0.w = pk2(kv[1][2], kv[1][3]);
        w1.x = pk2(kv[2][0], kv[2][1]); w1.y = pk2(kv[2][2], kv[2][3]); w1.z = pk2(kv[3][0], kv[3][1]); w1.w = pk2(kv[3][2], kv[3][3]);
        *(u32x4*)(CK + src) = w0; *(u32x4*)(CK + src + 8) = w1;
        __syncthreads();
#pragma unroll
        for (int i = 0; i < 4; ++i)
#pragma unroll
            for (int j = 0; j < 4; ++j) T[(ds + 4 * i + j) * TP + key] = f2bf(vv[i][j]);
        __syncthreads();
        const int d = tid >> 2, ks = (tid & 3) * 16;
        bf16_t* dst = CVT + ((size_t)bh * 128 + d) * 256 + k0 + ks;
        *(u32x4*)dst = *(const u32x4*)(T + d * TP + ks); *(u32x4*)(dst + 8) = *(const u32x4*)(T + d * TP + ks + 8);
    }
}
DI void phase_na_prep2(const Params& p, const GrpInfo gi, int bid, int nb) {
    const int tid = ltid(), lane = tid & 63, wid = tid >> 6;
    const bf16_t* P = (const bf16_t*)(lws(p) + OFF_P);
    bf16_t* QN = (bf16_t*)(lws(p) + OFF_QN); bf16_t* KN = (bf16_t*)(lws(p) + OFF_KN); bf16_t* VTN = (bf16_t*)(lws(p) + OFF_VTN);
    const float gq0 = p.na_qnorm_g[gi.l * 128 + 2 * lane] * NA_QSCALE, gq1 = p.na_qnorm_g[gi.l * 128 + 2 * lane + 1] * NA_QSCALE;
    const float gk0 = p.na_knorm_g[gi.l * 128 + 2 * lane], gk1 = p.na_knorm_g[gi.l * 128 + 2 * lane + 1];
    for (int u = bid * 8 + wid; u < GT * 8; u += nb * 8) {
        const int row = u >> 3, h = u & 7;
        const unsigned qw = *(const unsigned*)(P + (size_t)row * NP + C_NQ + h * 128 + 2 * lane);
        const unsigned kw = *(const unsigned*)(P + (size_t)row * NP + C_NK + h * 128 + 2 * lane);
        const float q0 = bflo(qw), q1 = bfhi(qw), k0 = bflo(kw), k1 = bfhi(kw);
        const float qs = rsqrtf(wave_sum(q0 * q0 + q1 * q1, lane) * (1.0f / 128) + EPS), ks = rsqrtf(wave_sum(k0 * k0 + k1 * k1, lane) * (1.0f / 128) + EPS);
        const float b0 = k0 * ks * gk0, b1 = k1 * ks * gk1;
        *(unsigned*)(QN + (size_t)row * 1024 + h * 128 + 2 * lane) = pk2(q0 * qs * gq0, q1 * qs * gq1);
        *(unsigned*)(KN + (size_t)row * 1024 + h * 128 + 2 * lane) = pk2(b0, b1);
        if (!gi.latent) { const int b = row >> 8, t = row & 255; const size_t o = ((((size_t)b * DEPTH + gi.l) * 8 + h) * 256 + t) * 128 + 2 * lane;
            const unsigned vw = *(const unsigned*)(P + (size_t)row * NP + C_NV + h * 128 + 2 * lane);
            *(f32x2*)(lout(p) + OUT_CK + o) = (f32x2){b0, b1}; *(f32x2*)(lout(p) + OUT_CV + o) = (f32x2){bflo(vw), bfhi(vw)}; }
    }
    bf16_t* T = (bf16_t*)smem;
    const int L = gi.L;
    for (int u = bid; u < 128 * 8; u += nb) {
        const int cg = u >> 3, h = u & 7, row0 = cg * 64, seq = row0 / L, t0 = row0 & (L - 1);
        const int s = tid >> 3, ds = (tid & 7) * 16;
        const bf16_t* pv = P + (size_t)(row0 + s) * NP + C_NV + h * 128 + ds;
        const u32x4 w0 = *(const u32x4*)pv, w1 = *(const u32x4*)(pv + 8);
        __syncthreads();
#pragma unroll
        for (int j = 0; j < 4; ++j) { T[(ds + 2 * j) * TP + s] = (bf16_t)(w0[j] & 0xffffu); T[(ds + 2 * j + 1) * TP + s] = (bf16_t)(w0[j] >> 16);
                                      T[(ds + 8 + 2 * j) * TP + s] = (bf16_t)(w1[j] & 0xffffu); T[(ds + 8 + 2 * j + 1) * TP + s] = (bf16_t)(w1[j] >> 16); }
        __syncthreads();
        const int d = tid >> 2, sq = (tid & 3) * 16;
        bf16_t* dst = VTN + ((size_t)(seq * 8 + h) * 128 + d) * L + t0 + sq;
        *(u32x4*)dst = *(const u32x4*)(T + d * TP + sq); *(u32x4*)(dst + 8) = *(const u32x4*)(T + d * TP + sq + 8);
    }
}

typedef const __attribute__((address_space(1))) bf16_t* gbfp;
template <bool LOCAL> DI void na_block(const bf16_t* kb0, int kstride, int kA, const bf16_t* vb0, int vstride, int vA, const bf16x8 (&qB)[4], f32x4 (&O)[8], float& mrun, float& lrun,
                                       int lane, int r16, int q4, const float* rpb  , int rowoff0  , int wc0, int c, int cs) {
    const gbfp kb = (gbfp)kb0, vb = (gbfp)vb0;
    f32x4 st[8];
    const unsigned kvo = (unsigned)(r16 * kstride + 8 * q4), vvo = (unsigned)(r16 * vstride + 4 * q4);
    bf16x8 kbuf[2][4];
#define NA_LOADK(T_, slot) do { const gbfp kp_ = kb + (size_t)(((T_) >> 1) * kA + ((T_) & 1) * 16) * kstride; \
        _Pragma("unroll") for (int ks_ = 0; ks_ < 4; ++ks_) kbuf[slot][ks_] = *(const __attribute__((address_space(1))) bf16x8*)(kp_ + kvo + 32 * ks_); } while (0)
    NA_LOADK(0, 0);
#pragma unroll
    for (int T = 0; T < 8; ++T) {
        if (T < 7) NA_LOADK(T + 1, (T + 1) & 1);
        st[T] = (f32x4){0.f, 0.f, 0.f, 0.f};
#pragma unroll
        for (int ks = 0; ks < 4; ++ks) st[T] = MFMA16(kbuf[T & 1][ks], qB[ks], st[T]);
        __builtin_amdgcn_sched_barrier(0);
    }
#undef NA_LOADK
    float mx = -INFINITY;
#pragma unroll
    for (int T = 0; T < 8; ++T)
#pragma unroll
        for (int i = 0; i < 4; ++i) {
            if (LOCAL) { const int wr = T >> 1, gcol = wc0 + 16 * (T & 1) + 4 * q4 + i;
                const bool ok = gcol >= cs && gcol < cs + 16;
                const float bias = rpb[(rowoff0 + wr) * 31 + min(max(gcol - c + 15, 0), 30)];
                st[T][i] = ok ? st[T][i] + bias : -INFINITY; }
            mx = fmaxf(mx, st[T][i]);
        }
    mx = fmaxf(mx, __int_as_float(__builtin_amdgcn_ds_bpermute((lane ^ 16) << 2, __float_as_int(mx))));
    mx = fmaxf(mx, __int_as_float(__builtin_amdgcn_ds_bpermute((lane ^ 32) << 2, __float_as_int(mx))));
    const float mnew = fmaxf(mrun, mx), alpha = __builtin_amdgcn_exp2f(mrun - mnew);
    float ls = 0.f;
#pragma unroll
    for (int T = 0; T < 8; ++T)
#pragma unroll
        for (int i = 0; i < 4; ++i) { const float e = __builtin_amdgcn_exp2f(st[T][i] - mnew); st[T][i] = e; ls += e; }
    ls += __int_as_float(__builtin_amdgcn_ds_bpermute((lane ^ 16) << 2, __float_as_int(ls)));
    ls += __int_as_float(__builtin_amdgcn_ds_bpermute((lane ^ 32) << 2, __float_as_int(ls)));
    lrun = lrun * alpha + ls; mrun = mnew;
#pragma unroll
    for (int dT = 0; dT < 8; ++dT) O[dT] *= alpha;
    bf16x4 vbuf[2][8][2];
#define NA_LOADV(t_, slot) do { _Pragma("unroll") for (int dT_ = 0; dT_ < 8; ++dT_) { const gbfp vp_ = vb + (size_t)(16 * dT_) * vstride + (t_) * vA; \
        vbuf[slot][dT_][0] = *(const __attribute__((address_space(1))) bf16x4*)(vp_ + vvo); vbuf[slot][dT_][1] = *(const __attribute__((address_space(1))) bf16x4*)(vp_ + vvo + 16); } } while (0)
    NA_LOADV(0, 0);
#pragma unroll
    for (int t = 0; t < 4; ++t) {
        if (t < 3) NA_LOADV(t + 1, (t + 1) & 1);
        const bf16x8 bP = pack8(st[2 * t], st[2 * t + 1]);
#pragma unroll
        for (int dT = 0; dT < 8; ++dT) { const bf16x4 a0 = vbuf[t & 1][dT][0], a1 = vbuf[t & 1][dT][1];
            const bf16x8 a = (bf16x8){a0[0], a0[1], a0[2], a0[3], a1[0], a1[1], a1[2], a1[3]};
            O[dT] = MFMA16(a, bP, O[dT]); }
        __builtin_amdgcn_sched_barrier(0);
    }
#undef NA_LOADV
}
DI void phase_na_attn(const Params& p, const GrpInfo gi, int bid, int nb) {
    const int tid = ltid(), lane0 = tid & 63, wid = __builtin_amdgcn_readfirstlane(tid >> 6), l = gi.l;
    float* rp = (float*)smem;
    __syncthreads();
    for (int i = tid; i < 8 * 465; i += 512) rp[i] = p.na_rpb[(size_t)l * 8 * 465 + i] * LOG2E;
    __syncthreads();
    const bf16_t* QN = (const bf16_t*)(lws(p) + OFF_QN); const bf16_t* KN = (const bf16_t*)(lws(p) + OFF_KN); const bf16_t* VTN = (const bf16_t*)(lws(p) + OFF_VTN);
    const bf16_t* CK = (const bf16_t*)(lws(p) + OFF_CK); const bf16_t* CVT = (const bf16_t*)(lws(p) + OFF_CVT);
    bf16_t* OB = (bf16_t*)(lws(p) + OFF_OABC) + (size_t)GT * 1024;
    for (int u = bid; u < 512; u += nb) {
        int lane = lane0; asm volatile("" : "+v"(lane));
        const int r16 = lane & 15, q4 = lane >> 4;
        int qrow0, h, seq; int r = 0, c0 = 0;
        if (gi.latent) { const int sl = u >> 8, rp2 = u & 31; h = (u >> 5) & 7; seq = sl; r = 2 * rp2 + (wid >> 2); c0 = 16 * (wid & 3); qrow0 = sl * 4096 + r * 64 + c0; }
        else { const int b = u >> 4, half = u & 1; h = (u >> 1) & 7; seq = b; qrow0 = b * 256 + (half * 8 + wid) * 16; }
        bf16x8 qB[4];
#pragma unroll
        for (int ks = 0; ks < 4; ++ks) qB[ks] = *(const bf16x8*)(QN + (size_t)(qrow0 + r16) * 1024 + h * 128 + 32 * ks + 8 * q4);
        f32x4 O[8];
#pragma unroll
        for (int dT = 0; dT < 8; ++dT) O[dT] = (f32x4){0.f, 0.f, 0.f, 0.f};
        float mrun = -INFINITY, lrun = 0.f;
        if (gi.latent) {
            const int rs = min(max(r - 4, 0), 56), wc0 = min(max(c0 - 8, 0), 32), c = c0 + r16, cs = min(max(c - 8, 0), 48);
            const int bs = 2 * (gi.grp - 1) + seq;
#pragma unroll 1
            for (int hb = 0; hb < 2; ++hb)
                na_block<true>(KN + (size_t)(seq * 4096 + (rs + 4 * hb) * 64 + wc0) * 1024 + h * 128, 1024, 64, VTN + (size_t)(seq * 8 + h) * 128 * 4096 + (rs + 4 * hb) * 64 + wc0, 4096, 64,
                               qB, O, mrun, lrun, lane, r16, q4, rp + h * 465, rs + 4 * hb - r + 7, wc0, c, cs);
            const size_t cb = ((size_t)bs * DEPTH + l) * 8 + h;
#pragma unroll 1
            for (int hb = 0; hb < 2; ++hb)
                na_block<false>(CK + (cb * 256 + 128 * hb) * 128, 128, 32, CVT + cb * 128 * 256 + 128 * hb, 256, 32, qB, O, mrun, lrun, lane, r16, q4, rp, 0, 0, 0, 0);
        } else {
#pragma unroll 1
            for (int hb = 0; hb < 2; ++hb)
                na_block<false>(KN + (size_t)(seq * 256 + 128 * hb) * 1024 + h * 128, 1024, 32, VTN + (size_t)(seq * 8 + h) * 128 * 256 + 128 * hb, 256, 32, qB, O, mrun, lrun, lane, r16, q4, rp, 0, 0, 0, 0);
        }
        const float inv = 1.0f / lrun;
#pragma unroll
        for (int dT = 0; dT < 8; ++dT) { u32x2 w; w.x = pk2(O[dT][0] * inv, O[dT][1] * inv); w.y = pk2(O[dT][2] * inv, O[dT][3] * inv);
            *(u32x2*)(OB + (size_t)(qrow0 + r16) * 1024 + h * 128 + 16 * dT + 4 * q4) = w; }
    }
}
#define LAS3 __attribute__((address_space(3)))
constexpr int LDS_MAIN = 139264, LDS_PARAMS = LDS_MAIN + 64, LDS_BYTES = LDS_MAIN + 512;

DI Params lp() {
    ParamsU u;
#pragma unroll
    for (int i = 0; i < NPARAM; ++i) {
        const unsigned long long v = *(const LAS3 unsigned long long*)((LAS3 unsigned char*)smem + LDS_PARAMS + 8 * i);
        const unsigned lo = (unsigned)__builtin_amdgcn_readfirstlane((int)(unsigned)v), hi = (unsigned)__builtin_amdgcn_readfirstlane((int)(unsigned)(v >> 32));
        u.a[i] = ((unsigned long long)hi << 32) | lo;
    }
    return u.s;
}
DI const float* x_in_ptr(const Params& p, int grp, int l) {
    if (l == 0) return grp == 0 ? p.x_prompt : p.x_sample + (size_t)(grp - 1) * GT * DM;
    return grp == 0 ? p.out + OUT_YP : p.out + OUT_YS + (size_t)(grp - 1) * GT * DM;
}
DI float* x_out_ptr(const Params& p, int grp) { return grp == 0 ? p.out + OUT_YP : p.out + OUT_YS + (size_t)(grp - 1) * GT * DM; }

template <class Epi> DI void gemm_ph(const bf16_t* A, const bf16_t* Bt, int M, int N, int K, const Epi& E) {
    pg8::Gemm g; g.A = A; g.Bt = Bt; g.M = M; g.N = N; g.K = K; g.pad = 0;
    pg8::StaticOrder S; S.init(M, N, (int)gridDim.x, (int)blockIdx.x);
    pg8::gemm_phase<Epi, pg8::StaticOrder, false>((LAS3 unsigned char*)smem, g, S, E, nullptr);
}
struct ModPtrs { const float* mA; const float* mB; };
DI ModPtrs mod_ptrs(const Params& q, int grp, int l) {
    const int crA = grp == 0 ? 0 : 1 + 2 * (grp - 1), crB = grp == 0 ? 0 : crA + 1;
    const float* mod = (const float*)(q.ws + OFF_MOD);
    ModPtrs m; m.mA = mod + ((size_t)l * NCOND + crA) * (NMOD * DM); m.mB = mod + ((size_t)l * NCOND + crB) * (NMOD * DM); return m;
}

__global__ __launch_bounds__(512, 2) void k_mega(Params p) {
    const int bid = blockIdx.x, nb = gridDim.x;
    volatile LAS unsigned* xbw = (volatile LAS unsigned*)((LAS3 unsigned char*)smem + LDS_MAIN);
    if (threadIdx.x == 0) {
        xbw[0] = 0u; xbw[1] = 0u; xbw[2] = 0u; xbw[3] = 0u;
        ParamsU u; u.s = p;
#pragma unroll
        for (int i = 0; i < NPARAM; ++i) *(LAS3 unsigned long long*)((LAS3 unsigned char*)smem + LDS_PARAMS + 8 * i) = u.a[i];
    }
    __syncthreads();
    XcdBarrier bar;
    { const Params q = lp(); bar = xcd_barrier_post((unsigned*)(q.ws + OFF_BAR), xbw); }
    { const Params q = lp(); phase_convert(q, bid, nb); }
    { const Params q = lp(); phase_adaln(q, bid, nb); }
    { const Params q = lp(); phase_hyena_hid(q, bid, nb); }
    { const Params q = lp(); phase_cache_cvt(q, bid, nb); }
    xcd_barrier(bar);
    { const Params q = lp(); phase_filters(q, bid, nb); }
    xcd_barrier(bar);
    for (int l0 = 0; l0 < DEPTH; ++l0) for (int grp0 = 0; grp0 < NGRP; ++grp0) {
        int l = l0, grp = grp0; asm volatile("" : "+s"(l), "+s"(grp));
        const GrpInfo gi = grp_info(grp, l);
        { const Params q = lp(); phase_norm(q, x_in_ptr(q, grp, l), q.norm1_g + l * DM, l, grp, 0, DM, bid, nb); }
        xcd_barrier(bar);
        { const Params q = lp(); gemm_ph((const bf16_t*)(q.ws + OFF_H), (const bf16_t*)(q.ws + OFF_WIN) + (size_t)l * NP * DM, GT, NP, DM, EpiStoreBf16<0>{(bf16_t*)(q.ws + OFF_P), NP, 0}); }
        xcd_barrier(bar);
        { const Params q = lp(); phase_gla_prep(q, gi, bid, nb); }
        { const Params q = lp(); phase_na_prep2(q, gi, bid, nb); }
        { const Params q = lp(); phase_hy_prep(q, gi, bid, nb); }
        xcd_barrier(bar);
        { const Params q = lp(); phase_gla_scan(q, gi, bid, nb); }
        { const Params q = lp(); phase_hy_conv(q, gi, bid, nb); }
        { const Params q = lp(); phase_na_attn(q, gi, bid, nb); }
        xcd_barrier(bar);
        { const Params q = lp(); phase_gla_post<true>(q, gi, bid, nb); }
        { const Params q = lp(); phase_hy_post(q, gi, bid, nb); }
        xcd_barrier(bar);
        { const Params q = lp(); const bf16_t* wbr = (const bf16_t*)(q.ws + OFF_WBR) + (size_t)l * 3 * DM * 1024; const bf16_t* OABC = (const bf16_t*)(q.ws + OFF_OABC);
          gemm_ph(OABC, wbr, GT, DM, 1024, EpiGate<0>{(const bf16_t*)(q.ws + OFF_P) + C_GATE, (float*)(q.ws + OFF_M32), (bf16_t*)(q.ws + OFF_MBF), NP, 0}); }
        xcd_barrier(bar);
        { const Params q = lp(); const bf16_t* wbr = (const bf16_t*)(q.ws + OFF_WBR) + (size_t)l * 3 * DM * 1024; const bf16_t* OABC = (const bf16_t*)(q.ws + OFF_OABC);
          gemm_ph(OABC + (size_t)GT * 1024, wbr + (size_t)DM * 1024, GT, DM, 1024, EpiGate<1>{(const bf16_t*)(q.ws + OFF_P) + C_GATE + DM, (float*)(q.ws + OFF_M32), (bf16_t*)(q.ws + OFF_MBF), NP, 0}); }
        xcd_barrier(bar);
        { const Params q = lp(); const bf16_t* wbr = (const bf16_t*)(q.ws + OFF_WBR) + (size_t)l * 3 * DM * 1024; const bf16_t* OABC = (const bf16_t*)(q.ws + OFF_OABC);
          gemm_ph(OABC + (size_t)2 * GT * 1024, wbr + (size_t)2 * DM * 1024, GT, DM, 1024, EpiGate<2>{(const bf16_t*)(q.ws + OFF_P) + C_GATE + 2 * DM, (float*)(q.ws + OFF_M32), (bf16_t*)(q.ws + OFF_MBF), NP, 0}); }
        xcd_barrier(bar);
        { const Params q = lp(); const ModPtrs m = mod_ptrs(q, grp, l);
          gemm_ph((const bf16_t*)(q.ws + OFF_MBF), (const bf16_t*)(q.ws + OFF_WOUT) + (size_t)l * DM * DM, GT, DM, DM, EpiResid{x_in_ptr(q, grp, l), x_out_ptr(q, grp), m.mA + 2 * DM, m.mB + 2 * DM}); }
        xcd_barrier(bar);
        { const Params q = lp(); phase_norm(q, x_out_ptr(q, grp), q.norm2_g + l * DM, l, grp, 3 * DM, 4 * DM, bid, nb); }
        xcd_barrier(bar);
        { const Params q = lp(); gemm_ph((const bf16_t*)(q.ws + OFF_H), (const bf16_t*)(q.ws + OFF_W1) + (size_t)l * DFF * DM, GT, DFF, DM, EpiStoreBf16<1>{(bf16_t*)(q.ws + OFF_P), DFF, 0}); }
        xcd_barrier(bar);
        { const Params q = lp(); const ModPtrs m = mod_ptrs(q, grp, l);
          gemm_ph((const bf16_t*)(q.ws + OFF_P), (const bf16_t*)(q.ws + OFF_W2) + (size_t)l * DM * DFF, GT, DM, DFF, EpiResid{x_out_ptr(q, grp), x_out_ptr(q, grp), m.mA + 5 * DM, m.mB + 5 * DM}); }
        xcd_barrier(bar);
    }
}

extern "C" void kernel_launch(void* const* d_in, const int* in_sizes, int n_in, void* d_out, int out_size, void* d_ws, size_t ws_size, hipStream_t stream) {
    Params p{};
    const float** f = (const float**)&p;
    for (int i = 0; i < 33; ++i) f[i] = (const float*)d_in[i];
    p.out = (float*)d_out; p.ws = (unsigned char*)d_ws;
    if (ws_size < WS_END) { fprintf(stderr, "workspace too small: %zu < %zu\n", ws_size, (size_t)WS_END); return; }
    static int grid = 0;
    if (!grid) {
        int dev = 0, cus = 0, per_cu = 0;
        (void)hipGetDevice(&dev);
        (void)hipDeviceGetAttribute(&cus, hipDeviceAttributeMultiprocessorCount, dev);
        (void)hipFuncSetAttribute((const void*)k_mega, hipFuncAttributeMaxDynamicSharedMemorySize, LDS_BYTES);
        (void)hipOccupancyMaxActiveBlocksPerMultiprocessor(&per_cu, k_mega, 512, LDS_BYTES);
        grid = cus * (per_cu < 1 ? per_cu : 1);
        if (grid <= 0) { fprintf(stderr, "occupancy query failed: cus %d per_cu %d\n", cus, per_cu); grid = 0; return; }
    }
    (void)hipMemsetAsync(p.ws + OFF_BAR, 0, XCD_BAR_WORDS * sizeof(unsigned), stream);
    hipLaunchKernelGGL(k_mega, dim3(grid), dim3(512), LDS_BYTES, stream, p);
}
```

```cpp
#include <hip/hip_runtime.h>
#include <stdint.h>
#include <stdio.h>

constexpr int DM = 2048, DFF = 8192, NMOD = 6, NCOND = 9;
constexpr int GT = 8192;
constexpr int NGRP = 5, DEPTH = 2;
constexpr int C_GQ = 0, C_GK = 512, C_GV = 1024, C_GG = 2048, C_GA = 3072, C_NQ = 3328, C_NK = 4352, C_NV = 5376, C_HY = 6400, C_GATE = 9472, NP = 15616;
constexpr int IN_TOTAL = 15392;
constexpr float EPS = 1e-6f;

typedef unsigned short bf16_t;
typedef float f32x4 __attribute__((ext_vector_type(4)));
typedef float f32x2 __attribute__((ext_vector_type(2)));
typedef unsigned u32x4 __attribute__((ext_vector_type(4)));
typedef unsigned u32x2 __attribute__((ext_vector_type(2)));
#define DI __device__ __forceinline__

DI int ltid() { int t = threadIdx.x; asm volatile("" : "+v"(t)); return t; }
DI float bf2f(bf16_t b) { return __uint_as_float(((unsigned)b) << 16); }
DI float bflo(unsigned w) { return __uint_as_float(w << 16); }
DI float bfhi(unsigned w) { return __uint_as_float(w & 0xffff0000u); }
DI bf16_t f2bf(float f) { unsigned u = __float_as_uint(f); u += 0x7FFFu + ((u >> 16) & 1u); return (bf16_t)(u >> 16); }
DI unsigned pk2(float lo, float hi) { return (unsigned)f2bf(lo) | ((unsigned)f2bf(hi) << 16); }
DI float sigmoidf_(float x) { return 1.0f / (1.0f + __expf(-x)); }
DI float wave_sum(float v, int lane) {
#pragma unroll
    for (int o = 32; o >= 1; o >>= 1) v += __int_as_float(__builtin_amdgcn_ds_bpermute((lane ^ o) << 2, __float_as_int(v))); return v; }
DI float wave_max(float v, int lane) {
#pragma unroll
    for (int o = 32; o >= 1; o >>= 1) v = fmaxf(v, __int_as_float(__builtin_amdgcn_ds_bpermute((lane ^ o) << 2, __float_as_int(v)))); return v; }

constexpr size_t al256(size_t x) { return (x + 255) & ~(size_t)255; }
constexpr size_t OFF_BAR  = 0;
constexpr size_t OFF_MOD  = 65536;
constexpr size_t OFF_HID  = OFF_MOD  + al256((size_t)DEPTH * NCOND * 12288 * 4);
constexpr size_t OFF_FILT = OFF_HID  + (size_t)DEPTH * 2 * 4096 * 64 * 4;
constexpr size_t FILT_L   = (size_t)2 * 1024 * (256 + 4096) * 4;
constexpr size_t OFF_WIN  = OFF_FILT + DEPTH * FILT_L;
constexpr size_t OFF_WBR  = OFF_WIN  + (size_t)DEPTH * NP * DM * 2;
constexpr size_t OFF_WOUT = OFF_WBR  + (size_t)DEPTH * 3 * DM * 1024 * 2;
constexpr size_t OFF_W1   = OFF_WOUT + (size_t)DEPTH * DM * DM * 2;
constexpr size_t OFF_W2   = OFF_W1   + (size_t)DEPTH * DFF * DM * 2;
constexpr size_t OFF_H    = OFF_W2   + (size_t)DEPTH * DFF * DM * 2;
constexpr size_t OFF_P    = OFF_H    + (size_t)GT * DM * 2;
constexpr size_t OFF_OF   = OFF_P    + (size_t)GT * NP * 2;
constexpr size_t OFF_OB   = OFF_OF   + (size_t)GT * 1024 * 4;
constexpr size_t OFF_OABC = OFF_OB   + (size_t)GT * 1024 * 4;
constexpr size_t OFF_M32  = OFF_OABC + (size_t)3 * GT * 1024 * 2;
constexpr size_t OFF_MBF  = OFF_M32  + (size_t)GT * DM * 4;
constexpr size_t OFF_QN   = OFF_MBF  + (size_t)GT * DM * 2;
constexpr size_t OFF_KN   = OFF_QN   + (size_t)GT * 1024 * 2;
constexpr size_t OFF_QF   = OFF_KN   + (size_t)GT * 1024 * 2;
constexpr size_t OFF_QB   = OFF_QF   + (size_t)GT * 512 * 2;
constexpr size_t OFF_KFT  = OFF_QB   + (size_t)GT * 512 * 2;
constexpr size_t OFF_KBT  = OFF_KFT  + (size_t)GT * 512 * 2;
constexpr size_t OFF_VT   = OFF_KBT  + (size_t)GT * 512 * 2;
constexpr size_t OFF_DEC  = OFF_VT   + (size_t)GT * 1024 * 2;
constexpr size_t OFF_OI   = OFF_DEC  + (size_t)2 * 128 * 512 * 4;
constexpr size_t OFF_UCT  = OFF_OI   + (size_t)GT * 1024 * 4;
constexpr size_t OFF_OCT  = OFF_UCT  + (size_t)3072 * GT * 2;
constexpr size_t OFF_VTN  = OFF_OCT  + (size_t)1024 * GT * 2;
constexpr size_t OFF_CK   = OFF_VTN  + (size_t)GT * 1024 * 2;
constexpr size_t OFF_CVT  = OFF_CK   + (size_t)8 * 2 * 8 * 256 * 128 * 2;
constexpr size_t WS_END   = OFF_CVT  + (size_t)8 * 2 * 8 * 256 * 128 * 2;
static_assert(WS_END < (size_t)1190000000, "workspace too large");

constexpr size_t OUT_YP = 0, OUT_YS = (size_t)32 * 256 * DM, OUT_ST = OUT_YS + (size_t)8 * 4096 * DM,
                 OUT_CK = OUT_ST + (size_t)32 * 2 * 2 * 4 * 128 * 256, OUT_CV = OUT_CK + (size_t)32 * 2 * 8 * 256 * 128;

struct Params {
    const float *x_prompt, *x_sample, *state_gla, *cache_k, *cache_v, *c, *c_ctx, *w_mod, *b_mod, *norm1_g, *norm2_g, *w_in, *gla_wa2, *gla_ba2, *gla_norm_g,
                *na_qnorm_g, *na_knorm_g, *na_rpb, *hy_conv_w, *hy_conv_b, *hy_f1_w, *hy_f1_b, *hy_f2_w, *hy_f2_b, *hy_f3_w, *hy_freq, *hy_bias,
                *w_br_a, *w_br_b, *w_br_c, *w_out, *w_mlp1, *w_mlp2;
    float* out; unsigned char* ws;
};
constexpr int NPARAM = 35;
union ParamsU { Params s; unsigned long long a[NPARAM]; };
static_assert(sizeof(Params) == NPARAM * 8, "Params must be 35 pointers");
DI unsigned char* lws(const Params& p) { unsigned char* w = p.ws; asm volatile("" : "+s"(w)); return w; }
DI float* lout(const Params& p) { float* w = p.out; asm volatile("" : "+s"(w)); return w; }
namespace pg8 {
#define PG8_LAS __attribute__((address_space(3)))
typedef unsigned short bf16_t;
typedef short bf16x8 __attribute__((ext_vector_type(8)));
typedef float f32x4 __attribute__((ext_vector_type(4)));
typedef unsigned u32x4 __attribute__((ext_vector_type(4)));
constexpr int BM = 256, BK = 64, HALF = 128, HTB = HALF * BK * 2  , STAGE_BYTES = 8 * HTB, NXCD = 8, WGM = 8;
__host__ __device__ __forceinline__ int lds_byte(int r, int c) { const int st = (r >> 4) * 2 + (c >> 5), rr = r & 15, cc = c & 31, ob = rr * 64 + cc * 2; return st * 1024 + (ob ^ (((ob >> 9) & 1) << 5)); }
__host__ __device__ __forceinline__ void stage_rc(int b, int& R, int& C) { const int st = b / 1024, sb = b % 1024, swz = sb ^ (((sb >> 9) & 1) << 5); R = (st >> 1) * 16 + swz / 64; C = (st & 1) * 32 + (swz % 64) / 2; }
__host__ __device__ __forceinline__ int perm32(int rho) { const int n = rho >> 4, i = rho & 15; return 8 * (i >> 2) + 4 * n + (i & 3); }
struct Unit { int pm, pn; };
struct Gemm { const bf16_t* A; const bf16_t* Bt; int M, N, K, pad; };
struct StaticOrder {
    int nM, nN, nwg, G, c;
    __host__ __device__ void init(int M, int N, int G_, int c_) { nM = M / BM; nN = N / BM; nwg = nM * nN; G = G_; c = c_; }
    __host__ __device__ bool next(int i, Unit& u) const {
        const long L = (long)i * G + c; if (L >= nwg) return false;
        int wgid = (int)L; { const int q = nwg / NXCD, r = nwg % NXCD, xcd = wgid % NXCD, off = wgid / NXCD; wgid = (xcd < r ? xcd * (q + 1) : r * (q + 1) + (xcd - r) * q) + off; }
        const int nig = WGM * nN, gid = wgid / nig, fm = gid * WGM, gsz = (nM - fm) < WGM ? (nM - fm) : WGM;
        u.pm = fm + ((wgid % nig) % gsz); u.pn = (wgid % nig) / gsz; return true;
    }
    __device__ __forceinline__ void a_ready(const Unit&) const {}
    __device__ __forceinline__ void done(const Unit&) const {}
};
__device__ __forceinline__ unsigned cvt_pk_bf16(float lo, float hi) { unsigned r; asm volatile("v_cvt_pk_bf16_f32 %0, %1, %2" : "=v"(r) : "v"(lo), "v"(hi)); return r; }
template <class Epi, class Sched, bool STAMP = false>
__device__ __forceinline__ void gemm_phase(PG8_LAS unsigned char* lds, const Gemm g, const Sched& S, const Epi& E, unsigned long long* stamps) {
    int tid_ = threadIdx.x; asm volatile("" : "+v"(tid_));
    const int tid = tid_, wid = __builtin_amdgcn_readfirstlane(tid >> 6), lane = tid & 63, wr = wid >> 2, wc = wid & 3, fr = lane & 15, fq = lane >> 4;
    const int K = g.K, nt = K / BK;
    int ts_lo = 0, ts_hi = 0, nts = 0; const unsigned long long rt_entry = STAMP ? (unsigned long long)wall_clock64() : 0ull;
#define PG8_STAMP() do { if (STAMP && wid == 0 && nts < 64) { const unsigned long long _c = (unsigned long long)clock64(); \
        ts_lo = (lane == nts) ? (int)(unsigned)_c : ts_lo; ts_hi = (lane == nts) ? (int)(unsigned)(_c >> 32) : ts_hi; ++nts; } } while (0)
    PG8_STAMP();
    unsigned voffA[2], voffB[2];
#pragma unroll
    for (int i = 0; i < 2; ++i) { int R, C; stage_rc(tid * 16 + i * 8192, R, C); const int Rb = Epi::PERM ? ((R & ~31) + perm32(R & 31)) : R;
        voffA[i] = (unsigned)(R * K + C) * 2u; voffB[i] = (unsigned)(Rb * K + C) * 2u; }
    const size_t kstep = (size_t)(BK * 2);
    const size_t hstep = (size_t)HALF * K * 2;
    const size_t tstep = 2 * hstep;
    const unsigned ldsw = (unsigned)wid * 1024u;
    const int aoff = lds_byte(wr * 64 + fr, fq * 8), boff = lds_byte(wc * 32 + fr, fq * 8);
#define PG8_SA(b, h) (((b) * 2 + (h)) * HTB)
#define PG8_SB(b, h) ((4 + (b) * 2 + (h)) * HTB)
#define PG8_STAGE(bufoff, gbase, voff) do { _Pragma("unroll") for (int _i = 0; _i < 2; ++_i) \
        __builtin_amdgcn_global_load_lds((const unsigned*)((const char*)(gbase) + (voff)[_i]), (PG8_LAS unsigned*)(lds + (bufoff) + ldsw + _i * 8192), 16, 0, 0); } while (0)
#define PG8_LDA(dst, b, h) do { _Pragma("unroll") for (int m = 0; m < 4; ++m) _Pragma("unroll") for (int k = 0; k < 2; ++k) dst[m][k] = *(const PG8_LAS bf16x8*)(lds + PG8_SA(b, h) + aoff + m * 2048 + k * 1024); } while (0)
#define PG8_LDB(dst, b, h) do { _Pragma("unroll") for (int n = 0; n < 2; ++n) _Pragma("unroll") for (int k = 0; k < 2; ++k) dst[n][k] = *(const PG8_LAS bf16x8*)(lds + PG8_SB(b, h) + boff + n * 2048 + k * 1024); } while (0)
#define PG8_MMA(ai, bj, At, Bt) do { __builtin_amdgcn_s_setprio(1); _Pragma("unroll") for (int m = 0; m < 4; ++m) _Pragma("unroll") for (int n = 0; n < 2; ++n) _Pragma("unroll") for (int k = 0; k < 2; ++k) \
        acc[ai][bj][m][n] = __builtin_amdgcn_mfma_f32_16x16x32_bf16(Bt[n][k], At[m][k], acc[ai][bj][m][n], 0, 0, 0); __builtin_amdgcn_s_setprio(0); } while (0)
#define PG8_WAIT_V(n) asm volatile("s_waitcnt vmcnt(" #n ")" ::: "memory")
#define PG8_WAIT_L(n) asm volatile("s_waitcnt lgkmcnt(" #n ")" ::: "memory")
#define PG8_BAR __builtin_amdgcn_s_barrier()
#define PG8_SCHED __builtin_amdgcn_sched_barrier(0)
    Unit cur, nxt; int ui = 0;
    if (!S.next(0, cur)) return;
    f32x4 acc[2][2][4][2];
#pragma unroll
    for (int a = 0; a < 2; ++a)
#pragma unroll
        for (int b = 0; b < 2; ++b)
#pragma unroll
            for (int m = 0; m < 4; ++m)
#pragma unroll
                for (int n = 0; n < 2; ++n) acc[a][b][m][n] = (f32x4){0.f, 0.f, 0.f, 0.f};
    bf16x8 At[4][2], B0[2][2], B1[2][2];
    const char* cA = (const char*)g.A + (size_t)cur.pm * tstep; const char* cB = (const char*)g.Bt + (size_t)cur.pn * tstep;
    S.a_ready(cur);
    PG8_STAGE(PG8_SB(0, 0), cB, voffB); PG8_STAGE(PG8_SA(0, 0), cA, voffA); PG8_STAGE(PG8_SB(0, 1), cB + hstep, voffB); PG8_STAGE(PG8_SA(0, 1), cA + hstep, voffA);
    if (wr == 1) PG8_BAR;
    PG8_WAIT_V(4); PG8_BAR;
    PG8_STAGE(PG8_SB(1, 0), cB + kstep, voffB); PG8_STAGE(PG8_SA(1, 0), cA + kstep, voffA); PG8_STAGE(PG8_SB(1, 1), cB + hstep + kstep, voffB);
    PG8_WAIT_V(6); PG8_BAR;
    PG8_STAMP();
    for (;;) {
        const bool has_next = S.next(ui + 1, nxt);
        const char* nA = has_next ? (const char*)g.A + (size_t)nxt.pm * tstep : cA; const char* nB = has_next ? (const char*)g.Bt + (size_t)nxt.pn * tstep : cB;
        for (int t = 0; t < nt; t += 2) {
            const bool last = (t == nt - 2);
            const char* a1 = cA + (size_t)(t + 1) * kstep;
            const char* a2 = last ? nA : cA + (size_t)(t + 2) * kstep; const char* b2 = last ? nB : cB + (size_t)(t + 2) * kstep;
            const char* a3 = a2 + kstep; const char* b3 = b2 + kstep;
            if (last && has_next) S.a_ready(nxt);
            PG8_LDB(B0, 0, 0); PG8_SCHED; PG8_LDA(At, 0, 0); PG8_STAGE(PG8_SA(1, 1), a1 + hstep, voffA);
            PG8_WAIT_L(8); PG8_BAR; PG8_WAIT_L(0); PG8_MMA(0, 0, At, B0); PG8_BAR; PG8_SCHED;
            PG8_LDB(B1, 0, 1); PG8_STAGE(PG8_SB(0, 0), b2, voffB);
            PG8_BAR; PG8_WAIT_L(0); PG8_MMA(0, 1, At, B1); PG8_BAR;
            PG8_LDA(At, 0, 1); PG8_STAGE(PG8_SA(0, 0), a2, voffA);
            PG8_BAR; PG8_WAIT_L(0); PG8_MMA(1, 0, At, B0); PG8_BAR; PG8_SCHED;
            PG8_STAGE(PG8_SB(0, 1), b2 + hstep, voffB);
            PG8_WAIT_V(6); PG8_BAR; PG8_MMA(1, 1, At, B1); PG8_BAR;
            PG8_LDB(B0, 1, 0); PG8_SCHED; PG8_LDA(At, 1, 0); PG8_STAGE(PG8_SA(0, 1), a2 + hstep, voffA);
            PG8_WAIT_L(8); PG8_BAR; PG8_WAIT_L(0); PG8_MMA(0, 0, At, B0); PG8_BAR; PG8_SCHED;
            PG8_LDB(B1, 1, 1); PG8_STAGE(PG8_SB(1, 0), b3, voffB);
            PG8_BAR; PG8_WAIT_L(0); PG8_MMA(0, 1, At, B1); PG8_BAR;
            PG8_LDA(At, 1, 1); PG8_STAGE(PG8_SA(1, 0), a3, voffA);
            PG8_BAR; PG8_WAIT_L(0); PG8_MMA(1, 0, At, B0); PG8_BAR; PG8_SCHED;
            PG8_STAGE(PG8_SB(1, 1), b3 + hstep, voffB);
            PG8_WAIT_V(6); PG8_BAR; PG8_MMA(1, 1, At, B1); PG8_BAR;
        }
        PG8_STAMP();
        if constexpr (!Epi::AFTER_DRAIN) { E(acc, cur, wr, wc, fr, fq); S.done(cur); }
        PG8_STAMP();
        if (!has_next) break;
#pragma unroll
        for (int a = 0; a < 2; ++a)
#pragma unroll
            for (int b = 0; b < 2; ++b)
#pragma unroll
                for (int m = 0; m < 4; ++m)
#pragma unroll
                    for (int n = 0; n < 2; ++n) acc[a][b][m][n] = (f32x4){0.f, 0.f, 0.f, 0.f};
        cur = nxt; cA = nA; cB = nB; ++ui;
    }
    PG8_WAIT_V(0);
    if (wr == 0) PG8_BAR;
    PG8_BAR;
    if constexpr (Epi::AFTER_DRAIN) { E.fused(acc, cur, wr, wc, fr, fq, lds, wid, lane); S.done(cur); }
    PG8_STAMP();
    if (STAMP && wid == 0) { stamps[lane] = lane < nts ? (((unsigned long long)(unsigned)ts_hi << 32) | (unsigned)ts_lo) : 0ull;
        if (lane == 62) stamps[62] = rt_entry; if (lane == 63) stamps[63] = (unsigned long long)wall_clock64(); }
#undef PG8_STAMP
#undef PG8_SA
#undef PG8_SB
#undef PG8_STAGE
#undef PG8_LDA
#undef PG8_LDB
#undef PG8_MMA
#undef PG8_WAIT_V
#undef PG8_WAIT_L
#undef PG8_BAR
#undef PG8_SCHED
}
}
#define XB_TMO      128
#define XB_XCNT(j)  (256  + 64 * (j))
#define XB_XSUB(j)  (1280 + 64 * (j))
#define XB_XGEN(j)  (2304 + 64 * (j))
#define XB_TOP      3328
#define XB_TOPGEN   3392
#define XCD_BAR_WORDS 3456
#define XB_SPIN_CAP (1u << 18)
#define LAS __attribute__((address_space(3)))

__device__ __forceinline__ unsigned xb_ld(unsigned* p)              { return __hip_atomic_load(p, __ATOMIC_RELAXED, __HIP_MEMORY_SCOPE_AGENT); }
__device__ __forceinline__ unsigned xb_add(unsigned* p, unsigned v) { return __hip_atomic_fetch_add(p, v, __ATOMIC_RELAXED, __HIP_MEMORY_SCOPE_AGENT); }
__device__ __forceinline__ unsigned xb_xcc_id() { return (unsigned)__builtin_amdgcn_s_getreg((3 << 11) | 20) & 0xFu; }
#define XB_SPIN(cond, bar) do { unsigned _sp = 0; while (cond) { __builtin_amdgcn_s_sleep(1); \
    if ((++_sp & 255u) == 0u) { if (xb_ld(&(bar)[XB_TMO])) break; if (_sp > XB_SPIN_CAP) { atomicAdd(&(bar)[XB_TMO], 1u); break; } } } } while (0)

struct XcdBarrier {
    unsigned* bar; unsigned x;
    volatile LAS unsigned* st;
};

__device__ __forceinline__ XcdBarrier xcd_barrier_post(unsigned* bar, volatile LAS unsigned* st) {
    XcdBarrier b; b.bar = bar; b.x = (unsigned)__builtin_amdgcn_readfirstlane((int)xb_xcc_id()); b.st = st;
    if (threadIdx.x == 0) (void)xb_add(&bar[XB_XCNT(b.x)], 1u);
    return b;
}
__device__ __forceinline__ void xcd_barrier_complete(unsigned* bar, unsigned x, unsigned& nloc, unsigned& nx) {
    const unsigned G = gridDim.x * gridDim.y * gridDim.z;
    unsigned sum, cnt, mine, sp = 0u;
    for (;;) {
        sum = 0u; cnt = 0u; mine = 0u;
#pragma unroll
        for (unsigned j = 0; j < 16; ++j) { const unsigned c = xb_ld(&bar[XB_XCNT(j)]); sum += c; cnt += (c > 0u) ? 1u : 0u; mine = (j == x) ? c : mine; }
        if (sum == G) break;
        __builtin_amdgcn_s_sleep(1);
        if ((++sp & 255u) == 0u) { if (xb_ld(&bar[XB_TMO])) break; if (sp > XB_SPIN_CAP) { atomicAdd(&bar[XB_TMO], 1u); break; } }
    }
    nloc = mine > 0u ? mine : 1u; nx = cnt > 0u ? cnt : 1u;
}

__device__ __forceinline__ void xcd_barrier(const XcdBarrier& b) {
    asm volatile("s_waitcnt vmcnt(0)" ::: "memory");
    __syncthreads();
    if (threadIdx.x == 0) {
        unsigned* bar = b.bar; unsigned bx = b.x; asm volatile("" : "+s"(bx));
        __builtin_amdgcn_s_waitcnt(0);
        unsigned nloc = b.st[0], nx = b.st[1];
        if (nloc == 0u) { xcd_barrier_complete(bar, bx, nloc, nx); b.st[0] = nloc; b.st[1] = nx; }
        const unsigned old = xb_add(&bar[XB_XSUB(bx)], 1u);
        const unsigned gen = old / nloc;
        if (old + 1u == (gen + 1u) * nloc) {
            __builtin_amdgcn_fence(__ATOMIC_RELEASE, "agent");
            asm volatile("s_waitcnt vmcnt(0)" ::: "memory");
            const unsigned og = xb_add(&bar[XB_TOP], 1u);
            const unsigned tg = og / nx;
            if (og + 1u == (tg + 1u) * nx) xb_add(&bar[XB_TOPGEN], 1u);
            else XB_SPIN(xb_ld(&bar[XB_TOPGEN]) == tg, bar);
            __builtin_amdgcn_fence(__ATOMIC_ACQUIRE, "agent");
            xb_add(&bar[XB_XGEN(bx)], 1u);
            asm volatile("s_waitcnt vmcnt(0)" ::: "memory");
        } else {
            XB_SPIN(xb_ld(&bar[XB_XGEN(bx)]) == gen, bar);
            __builtin_amdgcn_fence(__ATOMIC_ACQUIRE, "agent");
            asm volatile("s_waitcnt vmcnt(0)" ::: "memory");
        }
    }
    __syncthreads();
}

extern __shared__ __attribute__((aligned(16))) unsigned char smem[];

DI void convT_tile(const float* __restrict__ src, int ldsrc, bf16_t* __restrict__ dst, int K, int tile, int ntn, bool inmap) {
    float* t = (float*)smem;
    const int tid = ltid(), tk = tile / ntn, tn = tile % ntn, k0 = tk * 64, n0 = tn * 64;
    __syncthreads();
#pragma unroll
    for (int r = 0; r < 8; ++r) {
        const int i = (tid >> 6) + 8 * r, j = tid & 63, n = n0 + j;
        int sn = n; bool z = false;
        if (inmap) { if (n >= 3104 && n < C_NQ) z = true; else if (n >= C_NQ) sn = n - 224; }
        t[i * 65 + j] = z ? 0.f : src[(size_t)(k0 + i) * ldsrc + sn];
    }
    __syncthreads();
    const int j = tid >> 3, i8 = (tid & 7) * 8;
    u32x4 w;
    w.x = pk2(t[(i8 + 0) * 65 + j], t[(i8 + 1) * 65 + j]); w.y = pk2(t[(i8 + 2) * 65 + j], t[(i8 + 3) * 65 + j]);
    w.z = pk2(t[(i8 + 4) * 65 + j], t[(i8 + 5) * 65 + j]); w.w = pk2(t[(i8 + 6) * 65 + j], t[(i8 + 7) * 65 + j]);
    *(u32x4*)(dst + (size_t)(n0 + j) * K + k0 + i8) = w;
}
DI void phase_convert(const Params& p, int bid, int nb) {
    for (int l = 0; l < DEPTH; ++l) {
        { const int ntn = NP / 64, nt = (DM / 64) * ntn; bf16_t* d = (bf16_t*)(lws(p) + OFF_WIN) + (size_t)l * NP * DM;
          for (int t = bid; t < nt; t += nb) convT_tile(p.w_in + (size_t)l * DM * IN_TOTAL, IN_TOTAL, d, DM, t, ntn, true); }
        for (int br = 0; br < 3; ++br) { const float* s = (br == 0 ? p.w_br_a : br == 1 ? p.w_br_b : p.w_br_c) + (size_t)l * 1024 * DM;
          const int ntn = DM / 64, nt = (1024 / 64) * ntn; bf16_t* d = (bf16_t*)(lws(p) + OFF_WBR) + ((size_t)l * 3 + br) * DM * 1024;
          for (int t = bid; t < nt; t += nb) convT_tile(s, DM, d, 1024, t, ntn, false); }
        { const int ntn = DM / 64, nt = (DM / 64) * ntn; bf16_t* d = (bf16_t*)(lws(p) + OFF_WOUT) + (size_t)l * DM * DM;
          for (int t = bid; t < nt; t += nb) convT_tile(p.w_out + (size_t)l * DM * DM, DM, d, DM, t, ntn, false); }
        { const int ntn = DFF / 64, nt = (DM / 64) * ntn; bf16_t* d = (bf16_t*)(lws(p) + OFF_W1) + (size_t)l * DFF * DM;
          for (int t = bid; t < nt; t += nb) convT_tile(p.w_mlp1 + (size_t)l * DM * DFF, DFF, d, DM, t, ntn, false); }
        { const int ntn = DM / 64, nt = (DFF / 64) * ntn; bf16_t* d = (bf16_t*)(lws(p) + OFF_W2) + (size_t)l * DM * DFF;
          for (int t = bid; t < nt; t += nb) convT_tile(p.w_mlp2 + (size_t)l * DFF * DM, DM, d, DFF, t, ntn, false); }
    }
}

DI void phase_adaln(const Params& p, int bid, int nb) {
    float* sc = (float*)smem;
    float* red = sc + NCOND * DM;
    const int tid = ltid();
    __syncthreads();
    for (int i = tid; i < NCOND * DM; i += 512) { const int r = i / DM, k = i % DM; const float v = r == 0 ? p.c_ctx[k] : p.c[(size_t)(r - 1) * DM + k]; sc[i] = v * sigmoidf_(v); }
    __syncthreads();
    const int nun = DEPTH * (NMOD * DM / 64);
    for (int u = bid; u < nun; u += nb) {
        const int l = u / (NMOD * DM / 64), j0 = (u % (NMOD * DM / 64)) * 64, j = tid & 63, ks = tid >> 6;
        const float* w = p.w_mod + (size_t)l * DM * (NMOD * DM) + j0 + j;
        float acc[NCOND];
#pragma unroll
        for (int r = 0; r < NCOND; ++r) acc[r] = 0.f;
        for (int k = ks * 256; k < ks * 256 + 256; ++k) { const float wv = w[(size_t)k * (NMOD * DM)];
#pragma unroll
            for (int r = 0; r < NCOND; ++r) acc[r] += sc[r * DM + k] * wv; }
#pragma unroll
        for (int r = 0; r < NCOND; ++r) red[(ks * NCOND + r) * 64 + j] = acc[r];
        __syncthreads();
        for (int i = tid; i < NCOND * 64; i += 512) { const int r = i / 64, jj = i % 64; float s = p.b_mod[(size_t)l * NMOD * DM + j0 + jj];
#pragma unroll
            for (int q = 0; q < 8; ++q) s += red[(q * NCOND + r) * 64 + jj];
            ((float*)(lws(p) + OFF_MOD))[((size_t)l * NCOND + r) * (NMOD * DM) + j0 + jj] = s; }
        __syncthreads();
    }
}

DI void phase_hyena_hid(const Params& p, int bid, int nb) {
    float* zf = (float*)smem;
    float* h1 = zf + 8 * 36;
    const int tid = ltid(), tt = tid >> 6, j = tid & 63;
    const int nun = DEPTH * (256 / 8 + 4096 / 8);
    for (int u = bid; u < nun; u += nb) {
        const int l = u / 544, r = u % 544, ls = r < 32 ? 0 : 1, tb = ls ? r - 32 : r, L = ls ? 4096 : 256, t = tb * 8 + tt;
        const float tn = (float)t / (float)L;
        __syncthreads();
        if (j < 33) { float v; if (j == 0) v = tn; else { const int band = j <= 16 ? j : j - 16; const float ang = 6.283185307179586f * tn * (float)band; v = j <= 16 ? cosf(ang) : sinf(ang); } zf[tt * 36 + j] = v; }
        __syncthreads();
        const float fr = p.hy_freq[l * 64 + j];
        float a = p.hy_f1_b[l * 64 + j];
        for (int i = 0; i < 33; ++i) a += zf[tt * 36 + i] * p.hy_f1_w[((size_t)l * 33 + i) * 64 + j];
        h1[tt * 64 + j] = sinf(fr * a);
        __syncthreads();
        float b = p.hy_f2_b[l * 64 + j];
        for (int i = 0; i < 64; ++i) b += h1[tt * 64 + i] * p.hy_f2_w[((size_t)l * 64 + i) * 64 + j];
        ((float*)(lws(p) + OFF_HID))[(((size_t)l * 2 + ls) * 4096 + t) * 64 + j] = sinf(fr * b);
    }
}
DI const float* filt_ptr(const unsigned char* ws, int l, int ls) { return (const float*)(ws + OFF_FILT + (size_t)l * FILT_L) + (ls ? (size_t)2 * 1024 * 256 : 0); }
DI void phase_filters(const Params& p, int bid, int nb) {
    float* f3s = (float*)smem;
    float* red = f3s + 256;
    const int tid = ltid(), lane = tid & 63, wid = tid >> 6;
    const int nun = DEPTH * 2 * 512;
    for (int u = bid; u < nun; u += nb) {
        const int l = u / 1024, ls = (u / 512) & 1, cg = u % 512, L = ls ? 4096 : 256, col0 = cg * 4;
        __syncthreads();
        if (tid < 256) f3s[tid] = p.hy_f3_w[((size_t)l * 64 + (tid >> 2)) * 2048 + col0 + (tid & 3)];
        __syncthreads();
        const float* hid = (const float*)(lws(p) + OFF_HID) + ((size_t)l * 2 + ls) * 4096 * 64;
        float val[8][4]; float ss[4] = {0.f, 0.f, 0.f, 0.f};
        float delta[4];
#pragma unroll
        for (int cc = 0; cc < 4; ++cc) { const int c = (col0 + cc) & 1023; const float a = -3.0701134573253943f, b = -15.350567286626972f; delta[cc] = fabsf(a + (b - a) * ((float)c / 1023.0f)); }
#pragma unroll
        for (int i = 0; i < 8; ++i) {
            const int t = tid + 512 * i;
#pragma unroll
            for (int cc = 0; cc < 4; ++cc) val[i][cc] = 0.f;
            if (t < L) {
                const f32x4* hr = (const f32x4*)(hid + (size_t)t * 64);
                float a0 = 0.f, a1 = 0.f, a2 = 0.f, a3 = 0.f;
#pragma unroll
                for (int q = 0; q < 16; ++q) { const f32x4 hv = hr[q];
#pragma unroll
                    for (int e = 0; e < 4; ++e) { const f32x4 w = *(const f32x4*)(f3s + (q * 4 + e) * 4); a0 += hv[e] * w[0]; a1 += hv[e] * w[1]; a2 += hv[e] * w[2]; a3 += hv[e] * w[3]; } }
                const float dist = fabsf((float)t - (float)(L / 2)) * (2.0f / (float)L);
                val[i][0] = a0 * expf(-dist * delta[0]); val[i][1] = a1 * expf(-dist * delta[1]); val[i][2] = a2 * expf(-dist * delta[2]); val[i][3] = a3 * expf(-dist * delta[3]);
#pragma unroll
                for (int cc = 0; cc < 4; ++cc) ss[cc] += val[i][cc] * val[i][cc];
            }
        }
#pragma unroll
        for (int cc = 0; cc < 4; ++cc) { ss[cc] = wave_sum(ss[cc], lane); if (lane == 0) red[wid * 4 + cc] = ss[cc]; }
        __syncthreads();
        float sc[4];
#pragma unroll
        for (int cc = 0; cc < 4; ++cc) { float s = 0.f;
#pragma unroll
            for (int q = 0; q < 8; ++q) s += red[q * 4 + cc]; sc[cc] = rsqrtf(s + EPS); }
        float* fo = (float*)filt_ptr(lws(p), l, ls);
#pragma unroll
        for (int i = 0; i < 8; ++i) { const int t = tid + 512 * i; if (t < L) {
#pragma unroll
            for (int cc = 0; cc < 4; ++cc) { const int col = col0 + cc; fo[((size_t)(col >> 10) * 1024 + (col & 1023)) * L + t] = val[i][cc] * sc[cc]; } } }
    }
}

DI int cond_row(int grp, int row) { return grp == 0 ? 0 : 1 + 2 * (grp - 1) + (row >> 12); }
DI void phase_norm(const Params& p, const float* x, const float* g, int l, int grp, int shoff, int scoff, int bid, int nb) {
    const int tid = ltid(), lane = tid & 63, wid = tid >> 6;
    bf16_t* h = (bf16_t*)(lws(p) + OFF_H);
    for (int row = bid * 8 + wid; row < GT; row += nb * 8) {
        const float* xr = x + (size_t)row * DM;
        f32x4 v[8]; float ss = 0.f;
#pragma unroll
        for (int i = 0; i < 8; ++i) { v[i] = *(const f32x4*)(xr + i * 256 + lane * 4); ss += v[i][0] * v[i][0] + v[i][1] * v[i][1] + v[i][2] * v[i][2] + v[i][3] * v[i][3]; }
        ss = wave_sum(ss, lane);
        const float rs = rsqrtf(ss * (1.0f / DM) + EPS);
        const float* md = (const float*)(lws(p) + OFF_MOD) + ((size_t)l * NCOND + cond_row(grp, row)) * (NMOD * DM);
#pragma unroll
        for (int i = 0; i < 8; ++i) { const int c = i * 256 + lane * 4; const f32x4 gv = *(const f32x4*)(g + c), sh = *(const f32x4*)(md + shoff + c), sc = *(const f32x4*)(md + scoff + c);
            f32x4 o = v[i] * rs * gv * (sc + 1.0f) + sh; u32x2 w; w.x = pk2(o[0], o[1]); w.y = pk2(o[2], o[3]); *(u32x2*)(h + (size_t)row * DM + c) = w; }
    }
}
using pg8::Unit; using pg8::cvt_pk_bf16;
template <int ACT> struct EpiStoreBf16 {
    static constexpr bool PERM = true, AFTER_DRAIN = false;
    bf16_t* O; int ldc; int pad;
    __device__ __forceinline__ void operator()(const f32x4 (&acc)[2][2][4][2], const Unit& u, int wr, int wc, int fr, int fq) const {
        const int row0 = u.pm * 256 + wr * 64 + fr, col0 = u.pn * 256 + wc * 32 + 8 * fq;
#pragma unroll
        for (int ai = 0; ai < 2; ++ai)
#pragma unroll
            for (int m = 0; m < 4; ++m) { bf16_t* rowp = O + (size_t)(row0 + ai * 128 + m * 16) * ldc + col0;
#pragma unroll
                for (int bj = 0; bj < 2; ++bj) { f32x4 v0 = acc[ai][bj][m][0], v1 = acc[ai][bj][m][1];
                    if (ACT == 1) {
#pragma unroll
                        for (int j = 0; j < 4; ++j) { const float a = fmaxf(v0[j], 0.f), b = fmaxf(v1[j], 0.f); v0[j] = a * a; v1[j] = b * b; } }
                    u32x4 w; w.x = cvt_pk_bf16(v0[0], v0[1]); w.y = cvt_pk_bf16(v0[2], v0[3]); w.z = cvt_pk_bf16(v1[0], v1[1]); w.w = cvt_pk_bf16(v1[2], v1[3]);
                    *(u32x4*)(rowp + bj * 128) = w; } }
    }
};
template <int MODE> struct EpiGate {
    static constexpr bool PERM = true, AFTER_DRAIN = false;
    const bf16_t* gate; float* m32; bf16_t* mbf; int ldg; int pad;
    __device__ __forceinline__ void operator()(const f32x4 (&acc)[2][2][4][2], const Unit& u, int wr, int wc, int fr, int fq) const {
        const int row0 = u.pm * 256 + wr * 64 + fr, col0 = u.pn * 256 + wc * 32 + 8 * fq;
#pragma unroll
        for (int ai = 0; ai < 2; ++ai)
#pragma unroll
            for (int m = 0; m < 4; ++m) { const size_t row = (size_t)(row0 + ai * 128 + m * 16);
#pragma unroll
                for (int bj = 0; bj < 2; ++bj) { const int col = col0 + bj * 128;
                    const u32x4 gw = *(const u32x4*)(gate + row * ldg + col);
                    f32x4 s0, s1;
                    s0[0] = sigmoidf_(bflo(gw.x)); s0[1] = sigmoidf_(bfhi(gw.x)); s0[2] = sigmoidf_(bflo(gw.y)); s0[3] = sigmoidf_(bfhi(gw.y));
                    s1[0] = sigmoidf_(bflo(gw.z)); s1[1] = sigmoidf_(bfhi(gw.z)); s1[2] = sigmoidf_(bflo(gw.w)); s1[3] = sigmoidf_(bfhi(gw.w));
                    f32x4 v0 = acc[ai][bj][m][0] * s0, v1 = acc[ai][bj][m][1] * s1;
                    float* mp = m32 + row * DM + col;
                    if (MODE >= 1) { v0 += *(const f32x4*)mp; v1 += *(const f32x4*)(mp + 4); }
                    if (MODE <= 1) { *(f32x4*)mp = v0; *(f32x4*)(mp + 4) = v1; }
                    else { u32x4 w; w.x = cvt_pk_bf16(v0[0], v0[1]); w.y = cvt_pk_bf16(v0[2], v0[3]); w.z = cvt_pk_bf16(v1[0], v1[1]); w.w = cvt_pk_bf16(v1[2], v1[3]);
                           *(u32x4*)(mbf + row * DM + col) = w; } } }
    }
};
struct EpiResid {
    static constexpr bool PERM = true, AFTER_DRAIN = false;
    const float* xin; float* xout; const float* gA; const float* gB;
    __device__ __forceinline__ void operator()(const f32x4 (&acc)[2][2][4][2], const Unit& u, int wr, int wc, int fr, int fq) const {
        const int row0 = u.pm * 256 + wr * 64 + fr, col0 = u.pn * 256 + wc * 32 + 8 * fq;
        const float* gv = (u.pm * 256 < 4096) ? gA : gB;
#pragma unroll
        for (int bj = 0; bj < 2; ++bj) { const int col = col0 + bj * 128; const f32x4 g0 = *(const f32x4*)(gv + col), g1 = *(const f32x4*)(gv + col + 4);
#pragma unroll
            for (int ai = 0; ai < 2; ++ai)
#pragma unroll
                for (int m = 0; m < 4; ++m) { const size_t o = (size_t)(row0 + ai * 128 + m * 16) * DM + col;
                    const f32x4 a0 = *(const f32x4*)(xin + o), a1 = *(const f32x4*)(xin + o + 4);
                    *(f32x4*)(xout + o) = a0 + g0 * acc[ai][bj][m][0]; *(f32x4*)(xout + o + 4) = a1 + g1 * acc[ai][bj][m][1]; } }
    }
};

struct GrpInfo { int grp, l, L, nseq, latent; };
DI GrpInfo grp_info(int grp, int l) { GrpInfo g; g.grp = grp; g.l = l; g.latent = grp > 0; g.L = grp ? 4096 : 256; g.nseq = grp ? 2 : 32; return g; }

DI void phase_na_prep(const Params& p, GrpInfo gi, int bid, int nb) {
    const int tid = ltid(), lane = tid & 63, wid = tid >> 6;
    const bf16_t* P = (const bf16_t*)(lws(p) + OFF_P);
    bf16_t* QN = (bf16_t*)(lws(p) + OFF_QN); bf16_t* KN = (bf16_t*)(lws(p) + OFF_KN);
    const float gq0 = p.na_qnorm_g[gi.l * 128 + 2 * lane], gq1 = p.na_qnorm_g[gi.l * 128 + 2 * lane + 1];
    const float gk0 = p.na_knorm_g[gi.l * 128 + 2 * lane], gk1 = p.na_knorm_g[gi.l * 128 + 2 * lane + 1];
    for (int u = bid * 8 + wid; u < GT * 8; u += nb * 8) {
        const int row = u >> 3, h = u & 7;
        const unsigned qw = *(const unsigned*)(P + (size_t)row * NP + C_NQ + h * 128 + 2 * lane);
        const unsigned kw = *(const unsigned*)(P + (size_t)row * NP + C_NK + h * 128 + 2 * lane);
        const float q0 = bflo(qw), q1 = bfhi(qw), k0 = bflo(kw), k1 = bfhi(kw);
        const float qs = rsqrtf(wave_sum(q0 * q0 + q1 * q1, lane) * (1.0f / 128) + EPS), ks = rsqrtf(wave_sum(k0 * k0 + k1 * k1, lane) * (1.0f / 128) + EPS);
        const float a0 = q0 * qs * gq0, a1 = q1 * qs * gq1, b0 = k0 * ks * gk0, b1 = k1 * ks * gk1;
        *(unsigned*)(QN + (size_t)row * 1024 + h * 128 + 2 * lane) = pk2(a0, a1);
        *(unsigned*)(KN + (size_t)row * 1024 + h * 128 + 2 * lane) = pk2(b0, b1);
        if (!gi.latent) { const int b = row >> 8, t = row & 255; const size_t o = ((((size_t)b * DEPTH + gi.l) * 8 + h) * 256 + t) * 128 + 2 * lane;
            const unsigned vw = *(const unsigned*)(P + (size_t)row * NP + C_NV + h * 128 + 2 * lane);
            *(f32x2*)(lout(p) + OUT_CK + o) = (f32x2){b0, b1}; *(f32x2*)(lout(p) + OUT_CV + o) = (f32x2){bflo(vw), bfhi(vw)}; }
    }
}
DI void phase_na_naive(const Params& p, GrpInfo gi, int bid, int nb) {
    const int tid = ltid(), lane = tid & 63, wid = tid >> 6;
    float* qs = (float*)smem + wid * 512;
    float* ps = qs + 128;
    const bf16_t* P = (const bf16_t*)(lws(p) + OFF_P);
    const bf16_t* QN = (const bf16_t*)(lws(p) + OFF_QN); const bf16_t* KN = (const bf16_t*)(lws(p) + OFF_KN);
    bf16_t* OB = (bf16_t*)(lws(p) + OFF_OABC) + (size_t)GT * 1024;
    const float scale = 0.08838834764831845f;
    for (int u = bid * 8 + wid; u < GT * 8; u += nb * 8) {
        const int row = u >> 3, h = u & 7;
        { const unsigned qw = *(const unsigned*)(QN + (size_t)row * 1024 + h * 128 + 2 * lane); qs[2 * lane] = bflo(qw); qs[2 * lane + 1] = bfhi(qw); }
        asm volatile("s_waitcnt lgkmcnt(0)" ::: "memory");
        const int nkeys = gi.latent ? 384 : 256;
        const int sl = gi.latent ? (row >> 12) : (row >> 8), t = gi.latent ? (row & 4095) : (row & 255);
        const int r = t >> 6, c = t & 63, rs = min(max(r - 4, 0), 56), cs = min(max(c - 8, 0), 48);
        const int bs = 2 * (gi.grp - 1) + sl;
        float mx = -3.0e38f;
#pragma unroll 1
        for (int s = 0; s < 6; ++s) {
            const int kk = s * 64 + lane;
            if (kk < nkeys) {
                float dot = 0.f; float bias = 0.f;
                if (gi.latent && kk >= 128) { const float* kp = p.cache_k + ((((size_t)bs * DEPTH + gi.l) * 8 + h) * 256 + (kk - 128)) * 128;
#pragma unroll 4
                    for (int d = 0; d < 128; d += 4) { const f32x4 kv = *(const f32x4*)(kp + d); const f32x4 qv = *(const f32x4*)(qs + d); dot += kv[0] * qv[0] + kv[1] * qv[1] + kv[2] * qv[2] + kv[3] * qv[3]; } }
                else { int krow;
                    if (gi.latent) { const int i = kk >> 4, j = kk & 15; krow = sl * 4096 + (rs + i) * 64 + cs + j;
                        bias = p.na_rpb[(((size_t)gi.l * 8 + h) * 15 + (rs + i - r + 7)) * 31 + min(max(cs + j - c + 15, 0), 30)]; }
                    else krow = sl * 256 + kk;
                    const bf16_t* kp = KN + (size_t)krow * 1024 + h * 128;
#pragma unroll 4
                    for (int d = 0; d < 128; d += 8) { const u32x4 kw = *(const u32x4*)(kp + d); const f32x4 qa = *(const f32x4*)(qs + d), qb = *(const f32x4*)(qs + d + 4);
                        dot += bflo(kw.x) * qa[0] + bfhi(kw.x) * qa[1] + bflo(kw.y) * qa[2] + bfhi(kw.y) * qa[3] + bflo(kw.z) * qb[0] + bfhi(kw.z) * qb[1] + bflo(kw.w) * qb[2] + bfhi(kw.w) * qb[3]; } }
                const float sc = dot * scale + bias; mx = fmaxf(mx, sc); ps[kk] = sc;
            }
        }
        mx = wave_max(mx, lane);
        float sum = 0.f;
#pragma unroll 1
        for (int s = 0; s < 6; ++s) { const int kk = s * 64 + lane; if (kk < nkeys) { const float e = __expf(ps[kk] - mx); ps[kk] = e; sum += e; } }
        sum = wave_sum(sum, lane); const float inv = 1.0f / sum;
        asm volatile("s_waitcnt lgkmcnt(0)" ::: "memory");
        float o0 = 0.f, o1 = 0.f;
        for (int kk = 0; kk < nkeys; ++kk) {
            const float pv = ps[kk]; float v0, v1;
            if (gi.latent && kk >= 128) { const f32x2 vv = *(const f32x2*)(p.cache_v + ((((size_t)bs * DEPTH + gi.l) * 8 + h) * 256 + (kk - 128)) * 128 + 2 * lane); v0 = vv[0]; v1 = vv[1]; }
            else { const int krow = gi.latent ? sl * 4096 + (rs + (kk >> 4)) * 64 + cs + (kk & 15) : sl * 256 + kk;
                const unsigned vw = *(const unsigned*)(P + (size_t)krow * NP + C_NV + h * 128 + 2 * lane); v0 = bflo(vw); v1 = bfhi(vw); }
            o0 += pv * v0; o1 += pv * v1;
        }
        *(unsigned*)(OB + (size_t)row * 1024 + h * 128 + 2 * lane) = pk2(o0 * inv, o1 * inv);
        asm volatile("s_waitcnt lgkmcnt(0)" ::: "memory");
    }
}

DI float log_sigmoid_(float x) { return fminf(x, 0.f) - log1pf(expf(-fabsf(x))); }
DI void phase_gla_naive(const Params& p, GrpInfo gi, int bid, int nb) {
    const int tid = ltid(), e = tid & 255, dh = tid >> 8, L = gi.L;
    float* qs = (float*)smem; float* ks = qs + 16 * 128; float* as_ = ks + 16 * 128; float* vs = as_ + 16 * 128; float* op = vs + 16 * 256;
    const bf16_t* P = (const bf16_t*)(lws(p) + OFF_P);
    for (int u = bid; u < gi.nseq * 8; u += nb) {
        const int sl = u >> 3, h = (u >> 1) & 3, dir = u & 1;
        float* O = (float*)(lws(p) + (dir ? OFF_OB : OFF_OF));
        float S[64];
        if (gi.latent) { const int bs = 2 * (gi.grp - 1) + sl; const float* s0 = p.state_gla + (((((size_t)bs * DEPTH + gi.l) * 2 + dir) * 4 + h) * 128 + dh * 64) * 256 + e;
#pragma unroll
            for (int j = 0; j < 64; ++j) S[j] = s0[(size_t)j * 256]; }
        else {
#pragma unroll
            for (int j = 0; j < 64; ++j) S[j] = 0.f; }
        const float* wa = p.gla_wa2 + (((size_t)gi.l * 2 + dir) * 16) * 512 + h * 128;
        const float* ba = p.gla_ba2 + ((size_t)gi.l * 2 + dir) * 512 + h * 128;
        for (int bt = 0; bt < L / 16; ++bt) {
            __syncthreads();
#pragma unroll
            for (int i = 0; i < 4; ++i) {
                const int idx = tid + 512 * i, tt = idx >> 7, d = idx & 127, ts = bt * 16 + tt, t = dir ? L - 1 - ts : ts, row = sl * L + t;
                const bf16_t* pr = P + (size_t)row * NP;
                float q = bf2f(pr[C_GQ + h * 128 + d]) * 0.08838834764831845f, k = bf2f(pr[C_GK + h * 128 + d]);
                if (gi.latent) {
                    const float q2 = bf2f(pr[C_GQ + h * 128 + (d ^ 64)]) * 0.08838834764831845f, k2 = bf2f(pr[C_GK + h * 128 + (d ^ 64)]);
                    const int ii = d & 63, f = ii & 31; const float pos = (float)(ii < 32 ? (t >> 6) : (t & 63));
                    const float ang = pos * powf(10000.0f, -(float)f / 32.0f); float sn, cs; sincosf(ang, &sn, &cs);
                    if (d < 64) { q = q * cs - q2 * sn; k = k * cs - k2 * sn; } else { q = q2 * sn + q * cs; k = k2 * sn + k * cs; }
                }
                float xg = ba[d];
#pragma unroll
                for (int r = 0; r < 16; ++r) xg += bf2f(pr[C_GA + dir * 16 + r]) * wa[(size_t)r * 512 + d];
                qs[tt * 128 + d] = q; ks[tt * 128 + d] = k; as_[tt * 128 + d] = expf(log_sigmoid_(xg) * (1.0f / 16.0f));
            }
#pragma unroll
            for (int i = 0; i < 8; ++i) { const int idx = tid + 512 * i, tt = idx >> 8, ee = idx & 255, ts = bt * 16 + tt, t = dir ? L - 1 - ts : ts, row = sl * L + t;
                vs[tt * 256 + ee] = bf2f(P[(size_t)row * NP + C_GV + h * 256 + ee]); }
            __syncthreads();
            for (int tt = 0; tt < 16; ++tt) {
                const float v = vs[tt * 256 + e]; float acc = 0.f;
#pragma unroll
                for (int j4 = 0; j4 < 16; ++j4) {
                    const f32x4 a4 = *(const f32x4*)(as_ + tt * 128 + dh * 64 + j4 * 4), k4 = *(const f32x4*)(ks + tt * 128 + dh * 64 + j4 * 4), q4 = *(const f32x4*)(qs + tt * 128 + dh * 64 + j4 * 4);
#pragma unroll
                    for (int jj = 0; jj < 4; ++jj) { const int j = j4 * 4 + jj; S[j] = a4[jj] * S[j] + k4[jj] * v; acc += q4[jj] * S[j]; }
                }
                op[(tt * 2 + dh) * 256 + e] = acc;
            }
            __syncthreads();
#pragma unroll
            for (int i = 0; i < 8; ++i) { const int idx = tid + 512 * i, tt = idx >> 8, ee = idx & 255, ts = bt * 16 + tt, t = dir ? L - 1 - ts : ts, row = sl * L + t;
                O[(size_t)row * 1024 + h * 256 + ee] = op[(tt * 2) * 256 + ee] + op[(tt * 2 + 1) * 256 + ee]; }
        }
        if (!gi.latent) { float* so = lout(p) + OUT_ST + (((((size_t)sl * DEPTH + gi.l) * 2 + dir) * 4 + h) * 128 + dh * 64) * 256 + e;
#pragma unroll
            for (int j = 0; j < 64; ++j) so[(size_t)j * 256] = S[j]; }
    }
}
template <bool WITH_OI> DI void phase_gla_post(const Params& p, GrpInfo gi, int bid, int nb) {
    const int tid = ltid(), lane = tid & 63, wid = tid >> 6;
    const bf16_t* P = (const bf16_t*)(lws(p) + OFF_P);
    const float* Of = (const float*)(lws(p) + OFF_OF); const float* Ob = (const float*)(lws(p) + OFF_OB); const float* Oi = (const float*)(lws(p) + OFF_OI);
    bf16_t* OA = (bf16_t*)(lws(p) + OFF_OABC);
    const f32x4 g = *(const f32x4*)(p.gla_norm_g + gi.l * 256 + lane * 4);
    for (int u = bid * 8 + wid; u < GT * 4; u += nb * 8) {
        const int row = u >> 2, h = u & 3; const size_t o = (size_t)row * 1024 + h * 256 + lane * 4;
        f32x4 v = *(const f32x4*)(Of + o) + *(const f32x4*)(Ob + o); if (WITH_OI) v += *(const f32x4*)(Oi + o);
        const float rs = rsqrtf(wave_sum(v[0] * v[0] + v[1] * v[1] + v[2] * v[2] + v[3] * v[3], lane) * (1.0f / 256) + EPS);
        const u32x2 gw = *(const u32x2*)(P + (size_t)row * NP + C_GG + h * 256 + lane * 4);
        const float g0 = bflo(gw.x), g1 = bfhi(gw.x), g2 = bflo(gw.y), g3 = bfhi(gw.y);
        u32x2 w; w.x = pk2(v[0] * rs * g[0] * (g0 * sigmoidf_(g0)), v[1] * rs * g[1] * (g1 * sigmoidf_(g1)));
        w.y = pk2(v[2] * rs * g[2] * (g2 * sigmoidf_(g2)), v[3] * rs * g[3] * (g3 * sigmoidf_(g3)));
        *(u32x2*)(OA + o) = w;
    }
}

DI void phase_hyena_naive(const Params& p, GrpInfo gi, int bid, int nb) {
    const int tid = ltid(), L = gi.L, TPC = L / 8, CH = 4096 / L, ci = tid / TPC, tg = tid % TPC, t0 = tg * 8;
    float* z = (float*)smem;
    float* hp = z + 4096;
    const bf16_t* P = (const bf16_t*)(lws(p) + OFF_P);
    bf16_t* OC = (bf16_t*)(lws(p) + OFF_OABC) + (size_t)2 * GT * 1024;
    const int nun = gi.nseq * (1024 / CH);
    for (int u = bid; u < nun; u += nb) {
        const int sl = u / (1024 / CH), c = (u % (1024 / CH)) * CH + ci;
        float x1[8], x2[8], zr[8], cv[8];
        const float* cw = p.hy_conv_w + (size_t)gi.l * 3 * 3072; const float* cb = p.hy_conv_b + (size_t)gi.l * 3072;
        __syncthreads();
#pragma unroll
        for (int i = 0; i < 8; ++i) {
            const int t = t0 + i; const size_t rb = (size_t)(sl * L + t) * NP + C_HY;
            float r[3];
#pragma unroll
            for (int part = 0; part < 3; ++part) { const int j = part * 1024 + c;
                const float um = t > 0 ? bf2f(P[rb - NP + j]) : 0.f, u0 = bf2f(P[rb + j]), up = t < L - 1 ? bf2f(P[rb + NP + j]) : 0.f;
                r[part] = cb[j] + cw[j] * um + cw[3072 + j] * u0 + cw[2 * 3072 + j] * up; }
            x1[i] = r[0]; x2[i] = r[1]; zr[i] = r[2]; z[ci * L + t] = r[2];
        }
#pragma unroll
        for (int o = 0; o < 2; ++o) {
            const float* f = filt_ptr(lws(p), gi.l, gi.latent ? 1 : 0) + ((size_t)o * 1024 + c) * L;
#pragma unroll
            for (int i = 0; i < 8; ++i) { hp[ci * 2 * L + L / 2 + t0 + i] = f[t0 + i]; const int zi = t0 + i; hp[ci * 2 * L + (zi < L / 2 ? zi : L + zi)] = 0.f; }
            __syncthreads();
#pragma unroll
            for (int i = 0; i < 8; ++i) cv[i] = 0.f;
            const float* hb = hp + ci * 2 * L; const float* zb = z + ci * L;
            f32x4 hi0 = *(const f32x4*)(hb + t0 + L), hi1 = *(const f32x4*)(hb + t0 + L + 4);
            for (int s = 0; s < L; s += 8) {
                const int idx0 = t0 + L - s;
                const f32x4 lo0 = *(const f32x4*)(hb + idx0 - 8), lo1 = *(const f32x4*)(hb + idx0 - 4);
                const f32x4 z0 = *(const f32x4*)(zb + s), z1 = *(const f32x4*)(zb + s + 4);
                const float hbuf[16] = {lo0[0], lo0[1], lo0[2], lo0[3], lo1[0], lo1[1], lo1[2], lo1[3], hi0[0], hi0[1], hi0[2], hi0[3], hi1[0], hi1[1], hi1[2], hi1[3]};
                const float zz[8] = {z0[0], z0[1], z0[2], z0[3], z1[0], z1[1], z1[2], z1[3]};
#pragma unroll
                for (int ss = 0; ss < 8; ++ss)
#pragma unroll
                    for (int i = 0; i < 8; ++i) cv[i] += zz[ss] * hbuf[8 - ss + i];
                hi0 = lo0; hi1 = lo1;
            }
            const float bo = p.hy_bias[((size_t)gi.l * 2 + o) * 1024 + c];
            __syncthreads();
            if (o == 0) {
#pragma unroll
                for (int i = 0; i < 8; ++i) { zr[i] = x1[i] * (cv[i] + bo * zr[i]); z[ci * L + t0 + i] = zr[i]; }
            } else {
#pragma unroll
                for (int i = 0; i < 8; ++i) OC[(size_t)(sl * L + t0 + i) * 1024 + c] = f2bf(x2[i] * (cv[i] + bo * zr[i]));
            }
        }
    }
}
typedef short bf16x8 __attribute__((ext_vector_type(8)));
typedef short bf16x4 __attribute__((ext_vector_type(4)));
#define MFMA16(a, b, c) __builtin_amdgcn_mfma_f32_16x16x32_bf16((a), (b), (c), 0, 0, 0)
constexpr int QKP = 136;
constexpr int TP = 72;
DI float log_sigmoid_fast(float x) { return fminf(x, 0.f) - __logf(1.0f + __expf(-fabsf(x))); }
DI bf16x8 pack8(const f32x4& a, const f32x4& b) { u32x4 w; w.x = pk2(a[0], a[1]); w.y = pk2(a[2], a[3]); w.z = pk2(b[0], b[1]); w.w = pk2(b[2], b[3]); return __builtin_bit_cast(bf16x8, w); }

DI void gla_prep_unit(const Params& p, const GrpInfo gi, int unit, int tid_in) {
    int tid = tid_in; asm volatile("" : "+v"(tid));
    const int cg = unit >> 2, h = unit & 3, row0 = cg * 64, t0 = row0 & (gi.L - 1), l = gi.l;
    const int lane = tid & 63, wid = tid >> 6, r16 = lane & 15, q4 = lane >> 4;
    float* laf = (float*)smem; float* lab = laf + 8192;
    bf16_t* QFs = (bf16_t*)(smem + 65536); bf16_t* KFs = QFs + 64 * QKP; bf16_t* QBs = KFs + 64 * QKP; bf16_t* KBs = QBs + 64 * QKP;
    bf16_t* VTs = (bf16_t*)smem; bf16_t* As = (bf16_t*)(smem + 36864);
    const bf16_t* P = (const bf16_t*)(lws(p) + OFF_P);
    __syncthreads();
    {
        const int t = tid >> 3, d0 = (tid & 7) * 16;
        const bf16_t* pr = P + (size_t)(row0 + t) * NP + C_GA;
        float ga[32];
#pragma unroll
        for (int i = 0; i < 4; ++i) { const u32x4 w = *(const u32x4*)(pr + 8 * i); ga[8 * i] = bflo(w.x); ga[8 * i + 1] = bfhi(w.x); ga[8 * i + 2] = bflo(w.y); ga[8 * i + 3] = bfhi(w.y); ga[8 * i + 4] = bflo(w.z); ga[8 * i + 5] = bfhi(w.z); ga[8 * i + 6] = bflo(w.w); ga[8 * i + 7] = bfhi(w.w); }
#pragma unroll
        for (int dir = 0; dir < 2; ++dir) {
            const float* wa = p.gla_wa2 + (((size_t)l * 2 + dir) * 16) * 512 + h * 128 + d0;
            const float* ba = p.gla_ba2 + ((size_t)l * 2 + dir) * 512 + h * 128 + d0;
            float* dst = (dir ? lab : laf) + t * 128 + d0;
#pragma unroll
            for (int j4 = 0; j4 < 4; ++j4) {
                f32x4 x = *(const f32x4*)(ba + 4 * j4);
#pragma unroll
                for (int r = 0; r < 16; ++r) x += *(const f32x4*)(wa + (size_t)r * 512 + 4 * j4) * ga[dir * 16 + r];
                f32x4 o; o[0] = log_sigmoid_fast(x[0]) * 0.0625f; o[1] = log_sigmoid_fast(x[1]) * 0.0625f; o[2] = log_sigmoid_fast(x[2]) * 0.0625f; o[3] = log_sigmoid_fast(x[3]) * 0.0625f;
                *(f32x4*)(dst + 4 * j4) = o;
            }
        }
    }
    __syncthreads();
    if (tid < 256) {
        const int d = tid & 127;
        if (tid < 128) { float a = 0.f; for (int t = 0; t < 64; ++t) { a += laf[t * 128 + d]; laf[t * 128 + d] = a; } }
        else { float a = 0.f; for (int t = 63; t >= 0; --t) { a += lab[t * 128 + d]; lab[t * 128 + d] = a; } }
    }
    __syncthreads();
    {
        const int t = tid >> 3, dlo = (tid & 7) * 8, ta = t0 + t;
        const bf16_t* pr = P + (size_t)(row0 + t) * NP + h * 128;
        const u32x4 qlw = *(const u32x4*)(pr + C_GQ + dlo), qhw = *(const u32x4*)(pr + C_GQ + 64 + dlo), klw = *(const u32x4*)(pr + C_GK + dlo), khw = *(const u32x4*)(pr + C_GK + 64 + dlo);
        float ql[8], qh[8], kl[8], kh[8];
#pragma unroll
        for (int j = 0; j < 4; ++j) { ql[2 * j] = bflo(qlw[j]); ql[2 * j + 1] = bfhi(qlw[j]); qh[2 * j] = bflo(qhw[j]); qh[2 * j + 1] = bfhi(qhw[j]); kl[2 * j] = bflo(klw[j]); kl[2 * j + 1] = bfhi(klw[j]); kh[2 * j] = bflo(khw[j]); kh[2 * j + 1] = bfhi(khw[j]); }
#pragma unroll
        for (int j = 0; j < 8; ++j) {
            ql[j] *= 0.08838834764831845f; qh[j] *= 0.08838834764831845f;
            if (gi.latent) {
                const int ii = dlo + j, f = ii & 31; const float pos = (float)(ii < 32 ? (ta >> 6) : (ta & 63));
                const float ang = pos * exp2f(-(float)f * 0.41524101186092029f); float sn, cs; sincosf(ang, &sn, &cs);
                const float a = ql[j] * cs - qh[j] * sn, b = ql[j] * sn + qh[j] * cs; ql[j] = a; qh[j] = b;
                const float c = kl[j] * cs - kh[j] * sn, e = kl[j] * sn + kh[j] * cs; kl[j] = c; kh[j] = e;
            }
        }
        float* DEC = (float*)(lws(p) + OFF_DEC);
#pragma unroll
        for (int dir = 0; dir < 2; ++dir) {
            const float* bb = dir ? lab : laf;
            bf16_t* Qs = dir ? QBs : QFs; bf16_t* Ks = dir ? KBs : KFs;
            bf16_t* Qg = (bf16_t*)(lws(p) + (dir ? OFF_QB : OFF_QF)) + (size_t)(row0 + t) * 512 + h * 128;
#pragma unroll
            for (int half = 0; half < 2; ++half) {
                const int d = dlo + 64 * half;
                const f32x4 b0 = *(const f32x4*)(bb + t * 128 + d), b1 = *(const f32x4*)(bb + t * 128 + d + 4);
                float qo[8], ko[8];
#pragma unroll
                for (int j = 0; j < 8; ++j) { const float bv = j < 4 ? b0[j] : b1[j - 4]; const float qv = half ? qh[j] : ql[j], kv = half ? kh[j] : kl[j]; qo[j] = qv * __expf(bv); ko[j] = kv * __expf(-bv); }
                u32x4 qw, kw; qw.x = pk2(qo[0], qo[1]); qw.y = pk2(qo[2], qo[3]); qw.z = pk2(qo[4], qo[5]); qw.w = pk2(qo[6], qo[7]);
                kw.x = pk2(ko[0], ko[1]); kw.y = pk2(ko[2], ko[3]); kw.z = pk2(ko[4], ko[5]); kw.w = pk2(ko[6], ko[7]);
                *(u32x4*)(Qs + t * QKP + d) = qw; *(u32x4*)(Ks + t * QKP + d) = kw; *(u32x4*)(Qg + d) = qw;
                if (t == 0) { const int te = dir ? 0 : 63; const f32x4 e0 = *(const f32x4*)(bb + te * 128 + d), e1 = *(const f32x4*)(bb + te * 128 + d + 4);
                    f32x4 x0, x1;
#pragma unroll
                    for (int j = 0; j < 4; ++j) { x0[j] = __expf(e0[j]); x1[j] = __expf(e1[j]); }
                    float* dp = DEC + ((size_t)dir * 128 + cg) * 512 + h * 128 + d; *(f32x4*)dp = x0; *(f32x4*)(dp + 4) = x1; }
            }
        }
    }
    __syncthreads();
    {
        const int s = tid >> 3, e0 = (tid & 7) * 32;
        const bf16_t* pv = P + (size_t)(row0 + s) * NP + C_GV + h * 256 + e0;
#pragma unroll
        for (int i = 0; i < 4; ++i) { const u32x4 w = *(const u32x4*)(pv + 8 * i);
#pragma unroll
            for (int j = 0; j < 4; ++j) { VTs[(e0 + 8 * i + 2 * j) * TP + s] = (bf16_t)(w[j] & 0xffffu); VTs[(e0 + 8 * i + 2 * j + 1) * TP + s] = (bf16_t)(w[j] >> 16); } }
        const int mt = wid >> 1, nt0 = 2 * (wid & 1);
        f32x4 acc[2][2];
#pragma unroll
        for (int dir = 0; dir < 2; ++dir) { const bf16_t* Qs = dir ? QBs : QFs; const bf16_t* Ks = dir ? KBs : KFs;
#pragma unroll
            for (int n = 0; n < 2; ++n) acc[dir][n] = (f32x4){0.f, 0.f, 0.f, 0.f};
#pragma unroll
            for (int ks = 0; ks < 4; ++ks) { const bf16x8 a = *(const bf16x8*)(Qs + (16 * mt + r16) * QKP + 32 * ks + 8 * q4);
#pragma unroll
                for (int n = 0; n < 2; ++n) { const bf16x8 b = *(const bf16x8*)(Ks + (16 * (nt0 + n) + r16) * QKP + 32 * ks + 8 * q4); acc[dir][n] = MFMA16(a, b, acc[dir][n]); } } }
#pragma unroll
        for (int n = 0; n < 2; ++n)
#pragma unroll
            for (int i = 0; i < 4; ++i) { const int t = 16 * mt + 4 * q4 + i, s2 = 16 * (nt0 + n) + r16;
                const float v = (s2 <= t ? acc[0][n][i] : 0.f) + (s2 >= t ? acc[1][n][i] : 0.f); As[t * TP + s2] = f2bf(v); }
        const int d = tid >> 2, sq = tid & 3;
#pragma unroll
        for (int dir = 0; dir < 2; ++dir) { const bf16_t* Ks = dir ? KBs : KFs; unsigned w[8];
#pragma unroll
            for (int j = 0; j < 8; ++j) w[j] = (unsigned)Ks[(sq * 16 + 2 * j) * QKP + d] | ((unsigned)Ks[(sq * 16 + 2 * j + 1) * QKP + d] << 16);
            bf16_t* kg = (bf16_t*)(lws(p) + (dir ? OFF_KBT : OFF_KFT)) + (((size_t)cg * 4 + h) * 128 + d) * 64 + sq * 16;
            *(u32x4*)kg = (u32x4){w[0], w[1], w[2], w[3]}; *(u32x4*)(kg + 8) = (u32x4){w[4], w[5], w[6], w[7]}; }
    }
    __syncthreads();
    {
        const int e = tid >> 1, hf = tid & 1;
        bf16_t* vg = (bf16_t*)(lws(p) + OFF_VT) + (((size_t)cg * 4 + h) * 256 + e) * 64 + hf * 32;
#pragma unroll
        for (int i = 0; i < 4; ++i) *(u32x4*)(vg + 8 * i) = *(const u32x4*)(VTs + e * TP + hf * 32 + 8 * i);
        float* OI = (float*)(lws(p) + OFF_OI);
#pragma unroll
        for (int n = 0; n < 2; ++n) { const int nt = 2 * wid + n;
            bf16x8 b[2];
#pragma unroll
            for (int ks = 0; ks < 2; ++ks) b[ks] = *(const bf16x8*)(VTs + (16 * nt + r16) * TP + 32 * ks + 8 * q4);
#pragma unroll
            for (int mt = 0; mt < 4; ++mt) { f32x4 acc = (f32x4){0.f, 0.f, 0.f, 0.f};
#pragma unroll
                for (int ks = 0; ks < 2; ++ks) { const bf16x8 a = *(const bf16x8*)(As + (16 * mt + r16) * TP + 32 * ks + 8 * q4); acc = MFMA16(a, b[ks], acc); }
#pragma unroll
                for (int i = 0; i < 4; ++i) OI[(size_t)(row0 + 16 * mt + 4 * q4 + i) * 1024 + h * 256 + 16 * nt + r16] = acc[i]; } }
    }
}
DI void phase_gla_prep(const Params& p, const GrpInfo gi, int bid, int nb) {
    const int tid = ltid();
    for (int u = bid; u < 512; u += nb) gla_prep_unit(p, gi, u, tid);
}

constexpr int SC_Q = 0, SC_K = 64 * QKP * 2, SC_V = SC_K + 128 * TP * 2, SC_D = SC_V + 128 * TP * 2, SC_BUF = SC_D + 512;
DI void gla_scan_unit(const Params& p, const GrpInfo gi, int unit, int tid_in) {
    int tid = tid_in; asm volatile("" : "+v"(tid));
    const int sl = unit >> 4, h = (unit >> 2) & 3, dir = (unit >> 1) & 1, eh = unit & 1, L = gi.L, NC = L >> 6, l = gi.l;
    const int lane = tid & 63, wid = tid >> 6, r16 = lane & 15, q4 = lane >> 4;
    const int ecol = eh * 128 + 16 * wid + r16;
    f32x4 S[8];
    if (gi.latent) { const int bs = 2 * (gi.grp - 1) + sl; const float* s0 = p.state_gla + ((((size_t)bs * DEPTH + l) * 2 + dir) * 4 + h) * 128 * 256 + ecol;
#pragma unroll
        for (int T = 0; T < 8; ++T)
#pragma unroll
            for (int i = 0; i < 4; ++i) S[T][i] = s0[(size_t)(16 * T + 4 * q4 + i) * 256]; }
    else {
#pragma unroll
        for (int T = 0; T < 8; ++T) S[T] = (f32x4){0.f, 0.f, 0.f, 0.f}; }
    const bf16_t* Qg = (const bf16_t*)(lws(p) + (dir ? OFF_QB : OFF_QF)); const bf16_t* Kg = (const bf16_t*)(lws(p) + (dir ? OFF_KBT : OFF_KFT)); const bf16_t* Vg = (const bf16_t*)(lws(p) + OFF_VT);
    const float* Dg = (const float*)(lws(p) + OFF_DEC) + (size_t)dir * 128 * 512;
    float* Og = (float*)(lws(p) + (dir ? OFF_OB : OFF_OF));
    u32x4 rq[2], rk[2], rv[2]; float rd = 0.f;
    const int qt0 = tid >> 4, qd = (tid & 15) * 8;
    const int kd0 = tid >> 3, ks8 = (tid & 7) * 8;
#define GLA_LOAD(c) do { const int cg_ = sl * NC + (c); const size_t r0_ = (size_t)cg_ * 64; \
        rq[0] = *(const u32x4*)(Qg + (r0_ + qt0) * 512 + h * 128 + qd); rq[1] = *(const u32x4*)(Qg + (r0_ + qt0 + 32) * 512 + h * 128 + qd); \
        rk[0] = *(const u32x4*)(Kg + (((size_t)cg_ * 4 + h) * 128 + kd0) * 64 + ks8); rk[1] = *(const u32x4*)(Kg + (((size_t)cg_ * 4 + h) * 128 + kd0 + 64) * 64 + ks8); \
        rv[0] = *(const u32x4*)(Vg + (((size_t)cg_ * 4 + h) * 256 + eh * 128 + kd0) * 64 + ks8); rv[1] = *(const u32x4*)(Vg + (((size_t)cg_ * 4 + h) * 256 + eh * 128 + kd0 + 64) * 64 + ks8); \
        if (tid < 128) rd = Dg[(size_t)cg_ * 512 + h * 128 + tid]; } while (0)
#define GLA_STORE(bufp) do { unsigned char* b_ = (bufp); \
        *(u32x4*)(b_ + SC_Q + (qt0 * QKP + qd) * 2) = rq[0]; *(u32x4*)(b_ + SC_Q + ((qt0 + 32) * QKP + qd) * 2) = rq[1]; \
        *(u32x4*)(b_ + SC_K + (kd0 * TP + ks8) * 2) = rk[0]; *(u32x4*)(b_ + SC_K + ((kd0 + 64) * TP + ks8) * 2) = rk[1]; \
        *(u32x4*)(b_ + SC_V + (kd0 * TP + ks8) * 2) = rv[0]; *(u32x4*)(b_ + SC_V + ((kd0 + 64) * TP + ks8) * 2) = rv[1]; \
        if (tid < 128) *(float*)(b_ + SC_D + tid * 4) = rd; } while (0)
    __syncthreads();
    GLA_LOAD(dir ? NC - 1 : 0);
    GLA_STORE(smem);
    __syncthreads();
    for (int ci = 0; ci < NC; ++ci) {
        const int c = dir ? NC - 1 - ci : ci;
        if (ci + 1 < NC) GLA_LOAD(dir ? c - 1 : c + 1);
        const unsigned char* buf = smem + (ci & 1) * SC_BUF;
        const bf16_t* Qs = (const bf16_t*)(buf + SC_Q); const bf16_t* Kt = (const bf16_t*)(buf + SC_K); const bf16_t* Vt = (const bf16_t*)(buf + SC_V); const float* Dv = (const float*)(buf + SC_D);
        bf16x8 bS[4];
#pragma unroll
        for (int ks = 0; ks < 4; ++ks) bS[ks] = pack8(S[2 * ks], S[2 * ks + 1]);
        const size_t orow0 = ((size_t)(sl * NC + c) * 64);
#pragma unroll
        for (int mt = 0; mt < 4; ++mt) { f32x4 acc = (f32x4){0.f, 0.f, 0.f, 0.f};
#pragma unroll
            for (int ks = 0; ks < 4; ++ks) { const bf16_t* qp = Qs + (16 * mt + r16) * QKP + 32 * ks + 4 * q4;
                const bf16x4 a0 = *(const bf16x4*)qp, a1 = *(const bf16x4*)(qp + 16);
                const bf16x8 a = (bf16x8){a0[0], a0[1], a0[2], a0[3], a1[0], a1[1], a1[2], a1[3]};
                acc = MFMA16(a, bS[ks], acc); }
#pragma unroll
            for (int i = 0; i < 4; ++i) Og[(orow0 + 16 * mt + 4 * q4 + i) * 1024 + h * 256 + ecol] = acc[i]; }
        bf16x8 bv[2];
#pragma unroll
        for (int ks = 0; ks < 2; ++ks) bv[ks] = *(const bf16x8*)(Vt + (16 * wid + r16) * TP + 32 * ks + 8 * q4);
#pragma unroll
        for (int T = 0; T < 8; ++T) {
#pragma unroll
            for (int ks = 0; ks < 2; ++ks) { const bf16x8 a = *(const bf16x8*)(Kt + (16 * T + r16) * TP + 32 * ks + 8 * q4); S[T] = MFMA16(a, bv[ks], S[T]); }
            const f32x4 dv = *(const f32x4*)(Dv + 16 * T + 4 * q4); S[T] *= dv; }
        if (ci + 1 < NC) GLA_STORE(smem + ((ci + 1) & 1) * SC_BUF);
        __syncthreads();
    }
#undef GLA_LOAD
#undef GLA_STORE
    if (!gi.latent) { float* so = lout(p) + OUT_ST + ((((size_t)sl * DEPTH + l) * 2 + dir) * 4 + h) * 128 * 256 + ecol;
#pragma unroll
        for (int T = 0; T < 8; ++T)
#pragma unroll
            for (int i = 0; i < 4; ++i) so[(size_t)(16 * T + 4 * q4 + i) * 256] = S[T][i]; }
}
DI void phase_gla_scan(const Params& p, const GrpInfo gi, int bid, int nb) {
    const int tid = ltid();
    for (int u = bid; u < gi.nseq * 16; u += nb) gla_scan_unit(p, gi, u, tid);
}
typedef float f32x16 __attribute__((ext_vector_type(16)));
#define MFMA32(a, b, c) __builtin_amdgcn_mfma_f32_32x32x16_bf16((a), (b), (c), 0, 0, 0)

DI void phase_hy_prep(const Params& p, const GrpInfo gi, int bid, int nb) {
    const int tid = ltid(), L = gi.L;
    bf16_t* T = (bf16_t*)smem;
    const bf16_t* P = (const bf16_t*)(lws(p) + OFF_P);
    bf16_t* UcT = (bf16_t*)(lws(p) + OFF_UCT);
    const float* cw = p.hy_conv_w + (size_t)gi.l * 3 * 3072; const float* cb = p.hy_conv_b + (size_t)gi.l * 3072;
    for (int u = bid; u < 128 * 48; u += nb) {
        const int rt = u / 48, ct = u % 48, row0 = rt * 64, j0 = ct * 64;
        const int t = tid >> 3, js = tid & 7, row = row0 + t, tpos = row & (L - 1), j = j0 + js * 8;
        const bf16_t* pr = P + (size_t)row * NP + C_HY + j;
        const u32x4 z4 = (u32x4){0u, 0u, 0u, 0u};
        const u32x4 um = tpos > 0 ? *(const u32x4*)(pr - NP) : z4, u0 = *(const u32x4*)pr, up = tpos < L - 1 ? *(const u32x4*)(pr + NP) : z4;
        __syncthreads();
#pragma unroll
        for (int q = 0; q < 4; ++q) {
            const float o0 = cb[j + 2 * q] + cw[j + 2 * q] * bflo(um[q]) + cw[3072 + j + 2 * q] * bflo(u0[q]) + cw[6144 + j + 2 * q] * bflo(up[q]);
            const float o1 = cb[j + 2 * q + 1] + cw[j + 2 * q + 1] * bfhi(um[q]) + cw[3072 + j + 2 * q + 1] * bfhi(u0[q]) + cw[6144 + j + 2 * q + 1] * bfhi(up[q]);
            T[(js * 8 + 2 * q) * TP + t] = f2bf(o0); T[(js * 8 + 2 * q + 1) * TP + t] = f2bf(o1);
        }
        __syncthreads();
        const int jj = tid >> 3, ts = tid & 7;
        *(u32x4*)(UcT + (size_t)(j0 + jj) * GT + row0 + ts * 8) = *(const u32x4*)(T + jj * TP + ts * 8);
    }
}
DI void phase_hy_post(const Params& p, const GrpInfo gi, int bid, int nb) {
    const int tid = ltid();
    bf16_t* T = (bf16_t*)smem;
    const bf16_t* OcT = (const bf16_t*)(lws(p) + OFF_OCT);
    bf16_t* OC = (bf16_t*)(lws(p) + OFF_OABC) + (size_t)2 * GT * 1024;
    for (int u = bid; u < 128 * 16; u += nb) {
        const int rt = u >> 4, ct = u & 15, row0 = rt * 64, c0 = ct * 64;
        const int c = tid >> 3, ts = tid & 7;
        const u32x4 w = *(const u32x4*)(OcT + (size_t)(c0 + c) * GT + row0 + ts * 8);
        __syncthreads();
#pragma unroll
        for (int q = 0; q < 4; ++q) { T[(ts * 8 + 2 * q) * TP + c] = (bf16_t)(w[q] & 0xffffu); T[(ts * 8 + 2 * q + 1) * TP + c] = (bf16_t)(w[q] >> 16); }
        __syncthreads();
        const int t = tid >> 3, cs = tid & 7;
        *(u32x4*)(OC + (size_t)(row0 + t) * 1024 + c0 + cs * 8) = *(const u32x4*)(T + t * TP + cs * 8);
    }
}

constexpr int HY_HF = 0;
constexpr int HY_Z = 16384;
constexpr int HY_ZERO = HY_Z + 20480;
constexpr int HY_HC = HY_ZERO + 64;
DI int hy_pitch(int L) { return (L + 72) * 2; }
DI int hy_zoff(int s) { return (s >> 5) * 80 + (s & 31) * 2; }
DI void hy_build_copies(int L, int tid) {
    const float* hf = (const float*)(smem + HY_HF);
    const int nch = (L + 64) / 8, pitch = hy_pitch(L);
    for (int ch = tid; ch < 8 * nch; ch += 512) {
        const int e = ch / nch, i8 = (ch % nch) * 8;
        float v[8];
#pragma unroll
        for (int j = 0; j < 8; ++j) { const int x = i8 + j - 32 + e; v[j] = (x >= 0 && x < L) ? hf[L - 1 - x] : 0.f; }
        u32x4 w; w.x = pk2(v[0], v[1]); w.y = pk2(v[2], v[3]); w.z = pk2(v[4], v[5]); w.w = pk2(v[6], v[7]);
        *(u32x4*)(smem + HY_HC + e * pitch + i8 * 2) = w;
    }
}
DI f32x16 hy_conv(int L, int lane, int tb_row0  , int t0) {
    const int m = lane & 31, kh = lane >> 5, e = (7 - (m & 7)) & 7, pitch = hy_pitch(L);
    const int ND = L / 16 + 2;
    int delta = -(L / 2) - 16;
    int aoff = HY_HC + e * pitch + (L / 2 - 1 - delta - m + 8 * kh - e + 32) * 2;
    f32x16 acc0, acc1;
#pragma unroll
    for (int i = 0; i < 16; ++i) { acc0[i] = 0.f; acc1[i] = 0.f; }
#define HY_LDB(dlt) ({ const int s0_ = t0 - (dlt); const bool inr_ = (unsigned)s0_ <= (unsigned)(L - 16); \
        const int zo_ = inr_ ? HY_Z + hy_zoff(tb_row0 - (dlt)) + 16 * kh : HY_ZERO; *(const bf16x8*)(smem + zo_); })
    bf16x8 a0 = *(const bf16x8*)(smem + aoff), a1 = *(const bf16x8*)(smem + aoff - 32);
    bf16x8 b0 = HY_LDB(delta), b1 = HY_LDB(delta + 16);
    for (int dl = 0; dl < ND; dl += 2) {
        delta += 32; aoff -= 64;
        const bf16x8 na0 = *(const bf16x8*)(smem + aoff), na1 = *(const bf16x8*)(smem + aoff - 32);
        const bf16x8 nb0 = HY_LDB(delta), nb1 = HY_LDB(delta + 16);
        acc0 = MFMA32(a0, b0, acc0);
        acc1 = MFMA32(a1, b1, acc1);
        a0 = na0; a1 = na1; b0 = nb0; b1 = nb1;
    }
#undef HY_LDB
    return acc0 + acc1;
}
DI void hy_conv_unit(const Params& p, const GrpInfo gi, int c, int tid_in) {
    int tid = tid_in; asm volatile("" : "+v"(tid));
    const int L = gi.L, lane = tid & 63, wid = tid >> 6, n = lane & 31, hi = lane >> 5;
    const int g = 32 * wid + n, tpl = L >> 5, b = g / tpl, t0 = (g % tpl) * 32, frow = b * L + t0;
    const bf16_t* UcT = (const bf16_t*)(lws(p) + OFF_UCT);
    bf16_t* OcT = (bf16_t*)(lws(p) + OFF_OCT);
    const float* f0 = filt_ptr(lws(p), gi.l, gi.latent ? 1 : 0) + (size_t)c * L;
    const float* f1 = f0 + (size_t)1024 * L;
    float* hf = (float*)(smem + HY_HF);
    __syncthreads();
    {
        const bf16_t* zg = UcT + (size_t)(2048 + c) * GT;
#pragma unroll
        for (int i = 0; i < 2; ++i) { const int s = (tid + 512 * i) * 8; *(u32x4*)(smem + HY_Z + hy_zoff(s)) = *(const u32x4*)(zg + s); }
        if (tid < 4) *(unsigned*)(smem + HY_ZERO + 4 * tid) = 0u;
        for (int i = tid * 4; i < L; i += 2048) *(f32x4*)(hf + i) = *(const f32x4*)(f0 + i);
    }
    __syncthreads();
    hy_build_copies(L, tid);
    __syncthreads();
    f32x16 acc = hy_conv(L, lane, frow, t0);
    const float bias0 = p.hy_bias[((size_t)gi.l * 2 + 0) * 1024 + c], bias1 = p.hy_bias[((size_t)gi.l * 2 + 1) * 1024 + c];
    u32x2 z1w[4];
#pragma unroll
    for (int gq = 0; gq < 4; ++gq) {
        const int fr = frow + 8 * gq + 4 * hi;
        const u32x2 xw = *(const u32x2*)(UcT + (size_t)c * GT + fr);
        const u32x2 zw = *(const u32x2*)(smem + HY_Z + hy_zoff(fr));
        const float o0 = bflo(xw.x) * (acc[4 * gq] + bias0 * bflo(zw.x)), o1 = bfhi(xw.x) * (acc[4 * gq + 1] + bias0 * bfhi(zw.x));
        const float o2 = bflo(xw.y) * (acc[4 * gq + 2] + bias0 * bflo(zw.y)), o3 = bfhi(xw.y) * (acc[4 * gq + 3] + bias0 * bfhi(zw.y));
        z1w[gq].x = pk2(o0, o1); z1w[gq].y = pk2(o2, o3);
    }
    __syncthreads();
#pragma unroll
    for (int gq = 0; gq < 4; ++gq) *(u32x2*)(smem + HY_Z + hy_zoff(frow + 8 * gq + 4 * hi)) = z1w[gq];
    for (int i = tid * 4; i < L; i += 2048) *(f32x4*)(hf + i) = *(const f32x4*)(f1 + i);
    __syncthreads();
    hy_build_copies(L, tid);
    __syncthreads();
    acc = hy_conv(L, lane, frow, t0);
#pragma unroll
    for (int gq = 0; gq < 4; ++gq) {
        const int fr = frow + 8 * gq + 4 * hi;
        const u32x2 xw = *(const u32x2*)(UcT + (size_t)(1024 + c) * GT + fr);
        const float o0 = bflo(xw.x) * (acc[4 * gq] + bias1 * bflo(z1w[gq].x)), o1 = bfhi(xw.x) * (acc[4 * gq + 1] + bias1 * bfhi(z1w[gq].x));
        const float o2 = bflo(xw.y) * (acc[4 * gq + 2] + bias1 * bflo(z1w[gq].y)), o3 = bfhi(xw.y) * (acc[4 * gq + 3] + bias1 * bfhi(z1w[gq].y));
        u32x2 w; w.x = pk2(o0, o1); w.y = pk2(o2, o3);
        *(u32x2*)(OcT + (size_t)c * GT + fr) = w;
    }
}
DI void phase_hy_conv(const Params& p, const GrpInfo gi, int bid, int nb) {
    const int tid = ltid();
    for (int c = bid; c < 1024; c += nb) hy_conv_unit(p, gi, c, tid);
}
constexpr float NA_QSCALE = 0.12751743074602468f;
constexpr float LOG2E = 1.4426950408889634f;

DI void phase_cache_cvt(const Params& p, int bid, int nb) {
    const int tid = ltid();
    bf16_t* T = (bf16_t*)smem;
    bf16_t* CK = (bf16_t*)(lws(p) + OFF_CK); bf16_t* CVT = (bf16_t*)(lws(p) + OFF_CVT);
    for (int u = bid; u < 8 * 2 * 8 * 4; u += nb) {
        const int bh = u >> 2, k0 = (u & 3) * 64;
        const int key = tid >> 3, ds = (tid & 7) * 16;
        const size_t src = ((size_t)bh * 256 + k0 + key) * 128 + ds;
        f32x4 kv[4], vv[4];
#pragma unroll
        for (int i = 0; i < 4; ++i) { kv[i] = *(const f32x4*)(p.cache_k + src + 4 * i); vv[i] = *(const f32x4*)(p.cache_v + src + 4 * i); }
        u32x4 w0, w1; w0.x = pk2(kv[0][0], kv[0][1]); w0.y = pk2(kv[0][2], kv[0][3]); w0.z = pk2(kv[1][0], kv[1][1]); w0.w = pk2(kv[1][2], kv[1][3]);
        w1.x = pk2(kv[2][0], kv[2][1]); w1.y = pk2(kv[2][2], kv[2][3]); w1.z = pk2(kv[3][0], kv[3][1]); w1.w = pk2(kv[3][2], kv[3][3]);
        *(u32x4*)(CK + src) = w0; *(u32x4*)(CK + src + 8) = w1;
        __syncthreads();
#pragma unroll
        for (int i = 0; i < 4; ++i)
#pragma unroll
            for (int j = 0; j < 4; ++j) T[(ds + 4 * i + j) * TP + key] = f2bf(vv[i][j]);
        __syncthreads();
        const int d = tid >> 2, ks = (tid & 3) * 16;
        bf16_t* dst = CVT + ((size_t)bh * 128 + d) * 256 + k0 + ks;
        *(u32x4*)dst = *(const u32x4*)(T + d * TP + ks); *(u32x4*)(dst + 8) = *(const u32x4*)(T + d * TP + ks + 8);
    }
}
DI void phase_na_prep2(const Params& p, const GrpInfo gi, int bid, int nb) {
    const int tid = ltid(), lane = tid & 63, wid = tid >> 6;
    const bf16_t* P = (const bf16_t*)(lws(p) + OFF_P);
    bf16_t* QN = (bf16_t*)(lws(p) + OFF_QN); bf16_t* KN = (bf16_t*)(lws(p) + OFF_KN); bf16_t* VTN = (bf16_t*)(lws(p) + OFF_VTN);
    const float gq0 = p.na_qnorm_g[gi.l * 128 + 2 * lane] * NA_QSCALE, gq1 = p.na_qnorm_g[gi.l * 128 + 2 * lane + 1] * NA_QSCALE;
    const float gk0 = p.na_knorm_g[gi.l * 128 + 2 * lane], gk1 = p.na_knorm_g[gi.l * 128 + 2 * lane + 1];
    for (int u = bid * 8 + wid; u < GT * 8; u += nb * 8) {
        const int row = u >> 3, h = u & 7;
        const unsigned qw = *(const unsigned*)(P + (size_t)row * NP + C_NQ + h * 128 + 2 * lane);
        const unsigned kw = *(const unsigned*)(P + (size_t)row * NP + C_NK + h * 128 + 2 * lane);
        const float q0 = bflo(qw), q1 = bfhi(qw), k0 = bflo(kw), k1 = bfhi(kw);
        const float qs = rsqrtf(wave_sum(q0 * q0 + q1 * q1, lane) * (1.0f / 128) + EPS), ks = rsqrtf(wave_sum(k0 * k0 + k1 * k1, lane) * (1.0f / 128) + EPS);
        const float b0 = k0 * ks * gk0, b1 = k1 * ks * gk1;
        *(unsigned*)(QN + (size_t)row * 1024 + h * 128 + 2 * lane) = pk2(q0 * qs * gq0, q1 * qs * gq1);
        *(unsigned*)(KN + (size_t)row * 1024 + h * 128 + 2 * lane) = pk2(b0, b1);
        if (!gi.latent) { const int b = row >> 8, t = row & 255; const size_t o = ((((size_t)b * DEPTH + gi.l) * 8 + h) * 256 + t) * 128 + 2 * lane;
            const unsigned vw = *(const unsigned*)(P + (size_t)row * NP + C_NV + h * 128 + 2 * lane);
            *(f32x2*)(lout(p) + OUT_CK + o) = (f32x2){b0, b1}; *(f32x2*)(lout(p) + OUT_CV + o) = (f32x2){bflo(vw), bfhi(vw)}; }
    }
    bf16_t* T = (bf16_t*)smem;
    const int L = gi.L;
    for (int u = bid; u < 128 * 8; u += nb) {
        const int cg = u >> 3, h = u & 7, row0 = cg * 64, seq = row0 / L, t0 = row0 & (L - 1);
        const int s = tid >> 3, ds = (tid & 7) * 16;
        const bf16_t* pv = P + (size_t)(row0 + s) * NP + C_NV + h * 128 + ds;
        const u32x4 w0 = *(const u32x4*)pv, w1 = *(const u32x4*)(pv + 8);
        __syncthreads();
#pragma unroll
        for (int j = 0; j < 4; ++j) { T[(ds + 2 * j) * TP + s] = (bf16_t)(w0[j] & 0xffffu); T[(ds + 2 * j + 1) * TP + s] = (bf16_t)(w0[j] >> 16);
                                      T[(ds + 8 + 2 * j) * TP + s] = (bf16_t)(w1[j] & 0xffffu); T[(ds + 8 + 2 * j + 1) * TP + s] = (bf16_t)(w1[j] >> 16); }
        __syncthreads();
        const int d = tid >> 2, sq = (tid & 3) * 16;
        bf16_t* dst = VTN + ((size_t)(seq * 8 + h) * 128 + d) * L + t0 + sq;
        *(u32x4*)dst = *(const u32x4*)(T + d * TP + sq); *(u32x4*)(dst + 8) = *(const u32x4*)(T + d * TP + sq + 8);
    }
}

typedef const __attribute__((address_space(1))) bf16_t* gbfp;
template <bool LOCAL> DI void na_block(const bf16_t* kb0, int kstride, int kA, const bf16_t* vb0, int vstride, int vA, const bf16x8 (&qB)[4], f32x4 (&O)[8], float& mrun, float& lrun,
                                       int lane, int r16, int q4, const float* rpb  , int rowoff0  , int wc0, int c, int cs) {
    const gbfp kb = (gbfp)kb0, vb = (gbfp)vb0;
    f32x4 st[8];
    const unsigned kvo = (unsigned)(r16 * kstride + 8 * q4), vvo = (unsigned)(r16 * vstride + 4 * q4);
    bf16x8 kbuf[2][4];
#define NA_LOADK(T_, slot) do { const gbfp kp_ = kb + (size_t)(((T_) >> 1) * kA + ((T_) & 1) * 16) * kstride; \
        _Pragma("unroll") for (int ks_ = 0; ks_ < 4; ++ks_) kbuf[slot][ks_] = *(const __attribute__((address_space(1))) bf16x8*)(kp_ + kvo + 32 * ks_); } while (0)
    NA_LOADK(0, 0);
#pragma unroll
    for (int T = 0; T < 8; ++T) {
        if (T < 7) NA_LOADK(T + 1, (T + 1) & 1);
        st[T] = (f32x4){0.f, 0.f, 0.f, 0.f};
#pragma unroll
        for (int ks = 0; ks < 4; ++ks) st[T] = MFMA16(kbuf[T & 1][ks], qB[ks], st[T]);
        __builtin_amdgcn_sched_barrier(0);
    }
#undef NA_LOADK
    float mx = -INFINITY;
#pragma unroll
    for (int T = 0; T < 8; ++T)
#pragma unroll
        for (int i = 0; i < 4; ++i) {
            if (LOCAL) { const int wr = T >> 1, gcol = wc0 + 16 * (T & 1) + 4 * q4 + i;
                const bool ok = gcol >= cs && gcol < cs + 16;
                const float bias = rpb[(rowoff0 + wr) * 31 + min(max(gcol - c + 15, 0), 30)];
                st[T][i] = ok ? st[T][i] + bias : -INFINITY; }
            mx = fmaxf(mx, st[T][i]);
        }
    mx = fmaxf(mx, __int_as_float(__builtin_amdgcn_ds_bpermute((lane ^ 16) << 2, __float_as_int(mx))));
    mx = fmaxf(mx, __int_as_float(__builtin_amdgcn_ds_bpermute((lane ^ 32) << 2, __float_as_int(mx))));
    const float mnew = fmaxf(mrun, mx), alpha = __builtin_amdgcn_exp2f(mrun - mnew);
    float ls = 0.f;
#pragma unroll
    for (int T = 0; T < 8; ++T)
#pragma unroll
        for (int i = 0; i < 4; ++i) { const float e = __builtin_amdgcn_exp2f(st[T][i] - mnew); st[T][i] = e; ls += e; }
    ls += __int_as_float(__builtin_amdgcn_ds_bpermute((lane ^ 16) << 2, __float_as_int(ls)));
    ls += __int_as_float(__builtin_amdgcn_ds_bpermute((lane ^ 32) << 2, __float_as_int(ls)));
    lrun = lrun * alpha + ls; mrun = mnew;
#pragma unroll
    for (int dT = 0; dT < 8; ++dT) O[dT] *= alpha;
    bf16x4 vbuf[2][8][2];
#define NA_LOADV(t_, slot) do { _Pragma("unroll") for (int dT_ = 0; dT_ < 8; ++dT_) { const gbfp vp_ = vb + (size_t)(16 * dT_) * vstride + (t_) * vA; \
        vbuf[slot][dT_][0] = *(const __attribute__((address_space(1))) bf16x4*)(vp_ + vvo); vbuf[slot][dT_][1] = *(const __attribute__((address_space(1))) bf16x4*)(vp_ + vvo + 16); } } while (0)
    NA_LOADV(0, 0);
#pragma unroll
    for (int t = 0; t < 4; ++t) {
        if (t < 3) NA_LOADV(t + 1, (t + 1) & 1);
        const bf16x8 bP = pack8(st[2 * t], st[2 * t + 1]);
#pragma unroll
        for (int dT = 0; dT < 8; ++dT) { const bf16x4 a0 = vbuf[t & 1][dT][0], a1 = vbuf[t & 1][dT][1];
            const bf16x8 a = (bf16x8){a0[0], a0[1], a0[2], a0[3], a1[0], a1[1], a1[2], a1[3]};
            O[dT] = MFMA16(a, bP, O[dT]); }
        __builtin_amdgcn_sched_barrier(0);
    }
#undef NA_LOADV
}
constexpr int LDS_RPB_OFF = 139264 + 512;
DI void na_load_rpb(const Params& p, int l, int tid) {
    float* rp = (float*)(smem + LDS_RPB_OFF);
    for (int i = tid; i < 8 * 465; i += 512) rp[i] = p.na_rpb[(size_t)l * 8 * 465 + i] * LOG2E;
}
DI void na_attn_unit(const Params& p, const GrpInfo gi, int u, int tid_in) {
    int tid = tid_in; asm volatile("" : "+v"(tid));
    const int lane0 = tid & 63, wid = __builtin_amdgcn_readfirstlane(tid >> 6), l = gi.l;
    const float* rp = (const float*)(smem + LDS_RPB_OFF);
    const bf16_t* QN = (const bf16_t*)(lws(p) + OFF_QN); const bf16_t* KN = (const bf16_t*)(lws(p) + OFF_KN); const bf16_t* VTN = (const bf16_t*)(lws(p) + OFF_VTN);
    const bf16_t* CK = (const bf16_t*)(lws(p) + OFF_CK); const bf16_t* CVT = (const bf16_t*)(lws(p) + OFF_CVT);
    bf16_t* OB = (bf16_t*)(lws(p) + OFF_OABC) + (size_t)GT * 1024;
    {
        int lane = lane0; asm volatile("" : "+v"(lane));
        const int r16 = lane & 15, q4 = lane >> 4;
        int qrow0, h, seq; int r = 0, c0 = 0;
        if (gi.latent) { const int sl = u >> 8, rp2 = u & 31; h = (u >> 5) & 7; seq = sl; r = 2 * rp2 + (wid >> 2); c0 = 16 * (wid & 3); qrow0 = sl * 4096 + r * 64 + c0; }
        else { const int b = u >> 4, half = u & 1; h = (u >> 1) & 7; seq = b; qrow0 = b * 256 + (half * 8 + wid) * 16; }
        bf16x8 qB[4];
#pragma unroll
        for (int ks = 0; ks < 4; ++ks) qB[ks] = *(const bf16x8*)(QN + (size_t)(qrow0 + r16) * 1024 + h * 128 + 32 * ks + 8 * q4);
        f32x4 O[8];
#pragma unroll
        for (int dT = 0; dT < 8; ++dT) O[dT] = (f32x4){0.f, 0.f, 0.f, 0.f};
        float mrun = -INFINITY, lrun = 0.f;
        if (gi.latent) {
            const int rs = min(max(r - 4, 0), 56), wc0 = min(max(c0 - 8, 0), 32), c = c0 + r16, cs = min(max(c - 8, 0), 48);
            const int bs = 2 * (gi.grp - 1) + seq;
#pragma unroll 1
            for (int hb = 0; hb < 2; ++hb)
                na_block<true>(KN + (size_t)(seq * 4096 + (rs + 4 * hb) * 64 + wc0) * 1024 + h * 128, 1024, 64, VTN + (size_t)(seq * 8 + h) * 128 * 4096 + (rs + 4 * hb) * 64 + wc0, 4096, 64,
                               qB, O, mrun, lrun, lane, r16, q4, rp + h * 465, rs + 4 * hb - r + 7, wc0, c, cs);
            const size_t cb = ((size_t)bs * DEPTH + l) * 8 + h;
#pragma unroll 1
            for (int hb = 0; hb < 2; ++hb)
                na_block<false>(CK + (cb * 256 + 128 * hb) * 128, 128, 32, CVT + cb * 128 * 256 + 128 * hb, 256, 32, qB, O, mrun, lrun, lane, r16, q4, rp, 0, 0, 0, 0);
        } else {
#pragma unroll 1
            for (int hb = 0; hb < 2; ++hb)
                na_block<false>(KN + (size_t)(seq * 256 + 128 * hb) * 1024 + h * 128, 1024, 32, VTN + (size_t)(seq * 8 + h) * 128 * 256 + 128 * hb, 256, 32, qB, O, mrun, lrun, lane, r16, q4, rp, 0, 0, 0, 0);
        }
        const float inv = 1.0f / lrun;
#pragma unroll
        for (int dT = 0; dT < 8; ++dT) { u32x2 w; w.x = pk2(O[dT][0] * inv, O[dT][1] * inv); w.y = pk2(O[dT][2] * inv, O[dT][3] * inv);
            *(u32x2*)(OB + (size_t)(qrow0 + r16) * 1024 + h * 128 + 16 * dT + 4 * q4) = w; }
    }
}
#define LAS3 __attribute__((address_space(3)))
#ifndef REPMASK
#define REPMASK 0
#endif
constexpr int LDS_MAIN = 139264, LDS_PARAMS = LDS_MAIN + 64, LDS_UNIT = LDS_MAIN + 32, LDS_BYTES = LDS_MAIN + 512 + 8 * 465 * 4;
static_assert(LDS_RPB_OFF == LDS_MAIN + 512 && LDS_BYTES <= 163840, "LDS map");
constexpr int CTR_WORD0 = XCD_BAR_WORDS, CTR_WORDS = 64 * 16;

DI Params lp() {
    ParamsU u;
#pragma unroll
    for (int i = 0; i < NPARAM; ++i) {
        const unsigned long long v = *(const LAS3 unsigned long long*)((LAS3 unsigned char*)smem + LDS_PARAMS + 8 * i);
        const unsigned lo = (unsigned)__builtin_amdgcn_readfirstlane((int)(unsigned)v), hi = (unsigned)__builtin_amdgcn_readfirstlane((int)(unsigned)(v >> 32));
        u.a[i] = ((unsigned long long)hi << 32) | lo;
    }
    return u.s;
}
DI const float* x_in_ptr(const Params& p, int grp, int l) {
    if (l == 0) return grp == 0 ? p.x_prompt : p.x_sample + (size_t)(grp - 1) * GT * DM;
    return grp == 0 ? p.out + OUT_YP : p.out + OUT_YS + (size_t)(grp - 1) * GT * DM;
}
DI float* x_out_ptr(const Params& p, int grp) { return grp == 0 ? p.out + OUT_YP : p.out + OUT_YS + (size_t)(grp - 1) * GT * DM; }

template <class Epi> DI void gemm_ph(const bf16_t* A, const bf16_t* Bt, int M, int N, int K, const Epi& E) {
    pg8::Gemm g; g.A = A; g.Bt = Bt; g.M = M; g.N = N; g.K = K; g.pad = 0;
    pg8::StaticOrder S; S.init(M, N, (int)gridDim.x, (int)blockIdx.x);
    pg8::gemm_phase<Epi, pg8::StaticOrder, false>((LAS3 unsigned char*)smem, g, S, E, nullptr);
}
struct ModPtrs { const float* mA; const float* mB; };
DI ModPtrs mod_ptrs(const Params& q, int grp, int l) {
    const int crA = grp == 0 ? 0 : 1 + 2 * (grp - 1), crB = grp == 0 ? 0 : crA + 1;
    const float* mod = (const float*)(q.ws + OFF_MOD);
    ModPtrs m; m.mA = mod + ((size_t)l * NCOND + crA) * (NMOD * DM); m.mB = mod + ((size_t)l * NCOND + crB) * (NMOD * DM); return m;
}

__global__ __launch_bounds__(512, 2) void k_mega(Params p) {
    const int bid = blockIdx.x, nb = gridDim.x;
    volatile LAS unsigned* xbw = (volatile LAS unsigned*)((LAS3 unsigned char*)smem + LDS_MAIN);
    if (threadIdx.x == 0) {
        xbw[0] = 0u; xbw[1] = 0u; xbw[2] = 0u; xbw[3] = 0u;
        ParamsU u; u.s = p;
#pragma unroll
        for (int i = 0; i < NPARAM; ++i) *(LAS3 unsigned long long*)((LAS3 unsigned char*)smem + LDS_PARAMS + 8 * i) = u.a[i];
    }
    __syncthreads();
    XcdBarrier bar;
    { const Params q = lp(); bar = xcd_barrier_post((unsigned*)(q.ws + OFF_BAR), xbw); }
    for (int rep_ = 0; rep_ < 1 + ((REPMASK >> 8) & 1); ++rep_) { const Params q = lp(); phase_convert(q, bid, nb); }
    { const Params q = lp(); phase_adaln(q, bid, nb); }
    { const Params q = lp(); phase_hyena_hid(q, bid, nb); }
    { const Params q = lp(); phase_cache_cvt(q, bid, nb); }
    xcd_barrier(bar);
    { const Params q = lp(); phase_filters(q, bid, nb); }
    xcd_barrier(bar);
    for (int l0 = 0; l0 < DEPTH; ++l0) for (int grp0 = 0; grp0 < NGRP; ++grp0) {
        int l = l0, grp = grp0; asm volatile("" : "+s"(l), "+s"(grp));
        const GrpInfo gi = grp_info(grp, l);
        for (int rep_ = 0; rep_ < 1 + ((REPMASK >> 0) & 1); ++rep_) { const Params q = lp(); phase_norm(q, x_in_ptr(q, grp, l), q.norm1_g + l * DM, l, grp, 0, DM, bid, nb); }
        xcd_barrier(bar);
        for (int rep_ = 0; rep_ < 1 + ((REPMASK >> 1) & 1); ++rep_) { const Params q = lp(); gemm_ph((const bf16_t*)(q.ws + OFF_H), (const bf16_t*)(q.ws + OFF_WIN) + (size_t)l * NP * DM, GT, NP, DM, EpiStoreBf16<0>{(bf16_t*)(q.ws + OFF_P), NP, 0}); }
        xcd_barrier(bar);
        for (int rep_ = 0; rep_ < 1 + ((REPMASK >> 2) & 1); ++rep_) { const Params q = lp(); phase_gla_prep(q, gi, bid, nb); }
        for (int rep_ = 0; rep_ < 1 + ((REPMASK >> 2) & 1); ++rep_) { const Params q = lp(); phase_na_prep2(q, gi, bid, nb); }
        for (int rep_ = 0; rep_ < 1 + ((REPMASK >> 2) & 1); ++rep_) { const Params q = lp(); phase_hy_prep(q, gi, bid, nb); }
        xcd_barrier(bar);
        {
            const Params q = lp(); const int tid = ltid();
            na_load_rpb(q, l, tid);
            unsigned* head = (unsigned*)(q.ws + OFF_BAR) + CTR_WORD0 + 64 * (l * NGRP + grp);
            volatile LAS3 int* su = (volatile LAS3 int*)((LAS3 unsigned char*)smem + LDS_UNIT);
            const int nscan = gi.nseq * 16, nhy = 1024, nna = 512, ntot = nscan + nhy + nna;
            for (;;) {
                __syncthreads();
                if (tid == 0) *su = (int)__hip_atomic_fetch_add(head, 1u, __ATOMIC_RELAXED, __HIP_MEMORY_SCOPE_AGENT);
                __syncthreads();
                const int u = __builtin_amdgcn_readfirstlane(*su);
                if (u >= ntot) break;
                if (u < nscan) gla_scan_unit(q, gi, u, tid);
                else if (u < nscan + nhy) hy_conv_unit(q, gi, u - nscan, tid);
                else na_attn_unit(q, gi, u - nscan - nhy, tid);
            }
        }
        xcd_barrier(bar);
        for (int rep_ = 0; rep_ < 1 + ((REPMASK >> 6) & 1); ++rep_) { const Params q = lp(); phase_gla_post<true>(q, gi, bid, nb); }
        for (int rep_ = 0; rep_ < 1 + ((REPMASK >> 6) & 1); ++rep_) { const Params q = lp(); phase_hy_post(q, gi, bid, nb); }
        xcd_barrier(bar);
        { const Params q = lp(); const bf16_t* wbr = (const bf16_t*)(q.ws + OFF_WBR) + (size_t)l * 3 * DM * 1024; const bf16_t* OABC = (const bf16_t*)(q.ws + OFF_OABC);
          gemm_ph(OABC, wbr, GT, DM, 1024, EpiGate<0>{(const bf16_t*)(q.ws + OFF_P) + C_GATE, (float*)(q.ws + OFF_M32), (bf16_t*)(q.ws + OFF_MBF), NP, 0}); }
        xcd_barrier(bar);
        { const Params q = lp(); const bf16_t* wbr = (const bf16_t*)(q.ws + OFF_WBR) + (size_t)l * 3 * DM * 1024; const bf16_t* OABC = (const bf16_t*)(q.ws + OFF_OABC);
          gemm_ph(OABC + (size_t)GT * 1024, wbr + (size_t)DM * 1024, GT, DM, 1024, EpiGate<1>{(const bf16_t*)(q.ws + OFF_P) + C_GATE + DM, (float*)(q.ws + OFF_M32), (bf16_t*)(q.ws + OFF_MBF), NP, 0}); }
        xcd_barrier(bar);
        { const Params q = lp(); const bf16_t* wbr = (const bf16_t*)(q.ws + OFF_WBR) + (size_t)l * 3 * DM * 1024; const bf16_t* OABC = (const bf16_t*)(q.ws + OFF_OABC);
          gemm_ph(OABC + (size_t)2 * GT * 1024, wbr + (size_t)2 * DM * 1024, GT, DM, 1024, EpiGate<2>{(const bf16_t*)(q.ws + OFF_P) + C_GATE + 2 * DM, (float*)(q.ws + OFF_M32), (bf16_t*)(q.ws + OFF_MBF), NP, 0}); }
        xcd_barrier(bar);
        { const Params q = lp(); const ModPtrs m = mod_ptrs(q, grp, l);
          gemm_ph((const bf16_t*)(q.ws + OFF_MBF), (const bf16_t*)(q.ws + OFF_WOUT) + (size_t)l * DM * DM, GT, DM, DM, EpiResid{x_in_ptr(q, grp, l), x_out_ptr(q, grp), m.mA + 2 * DM, m.mB + 2 * DM}); }
        xcd_barrier(bar);
        { const Params q = lp(); phase_norm(q, x_out_ptr(q, grp), q.norm2_g + l * DM, l, grp, 3 * DM, 4 * DM, bid, nb); }
        xcd_barrier(bar);
        for (int rep_ = 0; rep_ < 1 + ((REPMASK >> 7) & 1); ++rep_) { const Params q = lp(); gemm_ph((const bf16_t*)(q.ws + OFF_H), (const bf16_t*)(q.ws + OFF_W1) + (size_t)l * DFF * DM, GT, DFF, DM, EpiStoreBf16<1>{(bf16_t*)(q.ws + OFF_P), DFF, 0}); }
        xcd_barrier(bar);
        { const Params q = lp(); const ModPtrs m = mod_ptrs(q, grp, l);
          gemm_ph((const bf16_t*)(q.ws + OFF_P), (const bf16_t*)(q.ws + OFF_W2) + (size_t)l * DM * DFF, GT, DM, DFF, EpiResid{x_out_ptr(q, grp), x_out_ptr(q, grp), m.mA + 5 * DM, m.mB + 5 * DM}); }
        xcd_barrier(bar);
    }
}

extern "C" void kernel_launch(void* const* d_in, const int* in_sizes, int n_in, void* d_out, int out_size, void* d_ws, size_t ws_size, hipStream_t stream) {
    Params p{};
    const float** f = (const float**)&p;
    for (int i = 0; i < 33; ++i) f[i] = (const float*)d_in[i];
    p.out = (float*)d_out; p.ws = (unsigned char*)d_ws;
    if (ws_size < WS_END) { fprintf(stderr, "workspace too small: %zu < %zu\n", ws_size, (size_t)WS_END); return; }
    static int grid = 0;
    if (!grid) {
        int dev = 0, cus = 0, per_cu = 0;
        (void)hipGetDevice(&dev);
        (void)hipDeviceGetAttribute(&cus, hipDeviceAttributeMultiprocessorCount, dev);
        (void)hipFuncSetAttribute((const void*)k_mega, hipFuncAttributeMaxDynamicSharedMemorySize, LDS_BYTES);
        (void)hipOccupancyMaxActiveBlocksPerMultiprocessor(&per_cu, k_mega, 512, LDS_BYTES);
        grid = cus * (per_cu < 1 ? per_cu : 1);
        if (grid <= 0) { fprintf(stderr, "occupancy query failed: cus %d per_cu %d\n", cus, per_cu); grid = 0; return; }
    }
    (void)hipMemsetAsync(p.ws + OFF_BAR, 0, (XCD_BAR_WORDS + CTR_WORDS) * sizeof(unsigned), stream);
    hipLaunchKernelGGL(k_mega, dim3(grid), dim3(512), LDS_BYTES, stream, p);
}
```

```cpp
#include <hip/hip_runtime.h>
#include <stdint.h>
#include <stdio.h>

constexpr int DM = 2048, DFF = 8192, NMOD = 6, NCOND = 9;
constexpr int GT = 8192;
constexpr int NGRP = 5, DEPTH = 2;
constexpr int C_GQ = 0, C_GK = 512, C_GV = 1024, C_GG = 2048, C_GA = 3072, C_NQ = 3328, C_NK = 4352, C_NV = 5376, C_HY = 6400, C_GATE = 9472, NP = 15616;
constexpr int IN_TOTAL = 15392;
constexpr float EPS = 1e-6f;

typedef unsigned short bf16_t;
typedef float f32x4 __attribute__((ext_vector_type(4)));
typedef float f32x2 __attribute__((ext_vector_type(2)));
typedef unsigned u32x4 __attribute__((ext_vector_type(4)));
typedef unsigned u32x2 __attribute__((ext_vector_type(2)));
#define DI __device__ __forceinline__

DI int ltid() { int t = threadIdx.x; asm volatile("" : "+v"(t)); return t; }
DI float bf2f(bf16_t b) { return __uint_as_float(((unsigned)b) << 16); }
DI float bflo(unsigned w) { return __uint_as_float(w << 16); }
DI float bfhi(unsigned w) { return __uint_as_float(w & 0xffff0000u); }
DI bf16_t f2bf(float f) { unsigned u = __float_as_uint(f); u += 0x7FFFu + ((u >> 16) & 1u); return (bf16_t)(u >> 16); }
DI unsigned pk2(float lo, float hi) { return (unsigned)f2bf(lo) | ((unsigned)f2bf(hi) << 16); }
DI float sigmoidf_(float x) { return 1.0f / (1.0f + __expf(-x)); }
DI float wave_sum(float v, int lane) {
#pragma unroll
    for (int o = 32; o >= 1; o >>= 1) v += __int_as_float(__builtin_amdgcn_ds_bpermute((lane ^ o) << 2, __float_as_int(v))); return v; }
DI float wave_max(float v, int lane) {
#pragma unroll
    for (int o = 32; o >= 1; o >>= 1) v = fmaxf(v, __int_as_float(__builtin_amdgcn_ds_bpermute((lane ^ o) << 2, __float_as_int(v)))); return v; }

constexpr size_t al256(size_t x) { return (x + 255) & ~(size_t)255; }
constexpr size_t OFF_BAR  = 0;
constexpr size_t OFF_MOD  = 65536;
constexpr size_t OFF_HID  = OFF_MOD  + al256((size_t)DEPTH * NCOND * 12288 * 4);
constexpr size_t OFF_FILT = OFF_HID  + (size_t)DEPTH * 2 * 4096 * 64 * 4;
constexpr size_t FILT_L   = (size_t)2 * 1024 * (256 + 4096) * 4;
constexpr size_t OFF_WIN  = OFF_FILT + DEPTH * FILT_L;
constexpr size_t OFF_WBR  = OFF_WIN  + (size_t)DEPTH * NP * DM * 2;
constexpr size_t OFF_WOUT = OFF_WBR  + (size_t)DEPTH * 3 * DM * 1024 * 2;
constexpr size_t OFF_W1   = OFF_WOUT + (size_t)DEPTH * DM * DM * 2;
constexpr size_t OFF_W2   = OFF_W1   + (size_t)DEPTH * DFF * DM * 2;
constexpr size_t OFF_H    = OFF_W2   + (size_t)DEPTH * DFF * DM * 2;
constexpr size_t OFF_P    = OFF_H    + (size_t)GT * DM * 2;
constexpr size_t OFF_OF   = OFF_P    + (size_t)GT * NP * 2;
constexpr size_t OFF_OB   = OFF_OF   + (size_t)GT * 1024 * 4;
constexpr size_t OFF_OABC = OFF_OB   + (size_t)GT * 1024 * 4;
constexpr size_t OFF_M32  = OFF_OABC + (size_t)3 * GT * 1024 * 2;
constexpr size_t OFF_MBF  = OFF_M32  + (size_t)GT * DM * 4;
constexpr size_t OFF_QN   = OFF_MBF  + (size_t)GT * DM * 2;
constexpr size_t OFF_KN   = OFF_QN   + (size_t)GT * 1024 * 2;
constexpr size_t OFF_QF   = OFF_KN   + (size_t)GT * 1024 * 2;
constexpr size_t OFF_QB   = OFF_QF   + (size_t)GT * 512 * 2;
constexpr size_t OFF_KFT  = OFF_QB   + (size_t)GT * 512 * 2;
constexpr size_t OFF_KBT  = OFF_KFT  + (size_t)GT * 512 * 2;
constexpr size_t OFF_VT   = OFF_KBT  + (size_t)GT * 512 * 2;
constexpr size_t OFF_DEC  = OFF_VT   + (size_t)GT * 1024 * 2;
constexpr size_t OFF_OI   = OFF_DEC  + (size_t)2 * 128 * 512 * 4;
constexpr size_t OFF_UCT  = OFF_OI   + (size_t)GT * 1024 * 4;
constexpr size_t OFF_OCT  = OFF_UCT  + (size_t)3072 * GT * 2;
constexpr size_t OFF_VTN  = OFF_OCT  + (size_t)1024 * GT * 2;
constexpr size_t OFF_CK   = OFF_VTN  + (size_t)GT * 1024 * 2;
constexpr size_t OFF_CVT  = OFF_CK   + (size_t)8 * 2 * 8 * 256 * 128 * 2;
constexpr size_t WS_END   = OFF_CVT  + (size_t)8 * 2 * 8 * 256 * 128 * 2;
static_assert(WS_END < (size_t)1190000000, "workspace too large");

constexpr size_t OUT_YP = 0, OUT_YS = (size_t)32 * 256 * DM, OUT_ST = OUT_YS + (size_t)8 * 4096 * DM,
                 OUT_CK = OUT_ST + (size_t)32 * 2 * 2 * 4 * 128 * 256, OUT_CV = OUT_CK + (size_t)32 * 2 * 8 * 256 * 128;

struct Params {
    const float *x_prompt, *x_sample, *state_gla, *cache_k, *cache_v, *c, *c_ctx, *w_mod, *b_mod, *norm1_g, *norm2_g, *w_in, *gla_wa2, *gla_ba2, *gla_norm_g,
                *na_qnorm_g, *na_knorm_g, *na_rpb, *hy_conv_w, *hy_conv_b, *hy_f1_w, *hy_f1_b, *hy_f2_w, *hy_f2_b, *hy_f3_w, *hy_freq, *hy_bias,
                *w_br_a, *w_br_b, *w_br_c, *w_out, *w_mlp1, *w_mlp2;
    float* out; unsigned char* ws;
};
constexpr int NPARAM = 35;
union ParamsU { Params s; unsigned long long a[NPARAM]; };
static_assert(sizeof(Params) == NPARAM * 8, "Params must be 35 pointers");
DI unsigned char* lws(const Params& p) { unsigned char* w = p.ws; asm volatile("" : "+s"(w)); return w; }
DI float* lout(const Params& p) { float* w = p.out; asm volatile("" : "+s"(w)); return w; }
namespace pg8 {
#define PG8_LAS __attribute__((address_space(3)))
typedef unsigned short bf16_t;
typedef short bf16x8 __attribute__((ext_vector_type(8)));
typedef float f32x4 __attribute__((ext_vector_type(4)));
typedef unsigned u32x4 __attribute__((ext_vector_type(4)));
constexpr int BM = 256, BK = 64, HALF = 128, HTB = HALF * BK * 2  , STAGE_BYTES = 8 * HTB, NXCD = 8, WGM = 8;
__host__ __device__ __forceinline__ int lds_byte(int r, int c) { const int st = (r >> 4) * 2 + (c >> 5), rr = r & 15, cc = c & 31, ob = rr * 64 + cc * 2; return st * 1024 + (ob ^ (((ob >> 9) & 1) << 5)); }
__host__ __device__ __forceinline__ void stage_rc(int b, int& R, int& C) { const int st = b / 1024, sb = b % 1024, swz = sb ^ (((sb >> 9) & 1) << 5); R = (st >> 1) * 16 + swz / 64; C = (st & 1) * 32 + (swz % 64) / 2; }
__host__ __device__ __forceinline__ int perm32(int rho) { const int n = rho >> 4, i = rho & 15; return 8 * (i >> 2) + 4 * n + (i & 3); }
struct Unit { int pm, pn; };
struct Gemm { const bf16_t* A; const bf16_t* Bt; int M, N, K, pad; };
struct StaticOrder {
    int nM, nN, nwg, G, c;
    __host__ __device__ void init(int M, int N, int G_, int c_) { nM = M / BM; nN = N / BM; nwg = nM * nN; G = G_; c = c_; }
    __host__ __device__ bool next(int i, Unit& u) const {
        const long L = (long)i * G + c; if (L >= nwg) return false;
        int wgid = (int)L; { const int q = nwg / NXCD, r = nwg % NXCD, xcd = wgid % NXCD, off = wgid / NXCD; wgid = (xcd < r ? xcd * (q + 1) : r * (q + 1) + (xcd - r) * q) + off; }
        const int nig = WGM * nN, gid = wgid / nig, fm = gid * WGM, gsz = (nM - fm) < WGM ? (nM - fm) : WGM;
        u.pm = fm + ((wgid % nig) % gsz); u.pn = (wgid % nig) / gsz; return true;
    }
    __device__ __forceinline__ void a_ready(const Unit&) const {}
    __device__ __forceinline__ void done(const Unit&) const {}
};
__device__ __forceinline__ unsigned cvt_pk_bf16(float lo, float hi) { unsigned r; asm volatile("v_cvt_pk_bf16_f32 %0, %1, %2" : "=v"(r) : "v"(lo), "v"(hi)); return r; }
template <class Epi, class Sched, bool STAMP = false>
__device__ __forceinline__ void gemm_phase(PG8_LAS unsigned char* lds, const Gemm g, const Sched& S, const Epi& E, unsigned long long* stamps) {
    int tid_ = threadIdx.x; asm volatile("" : "+v"(tid_));
    const int tid = tid_, wid = __builtin_amdgcn_readfirstlane(tid >> 6), lane = tid & 63, wr = wid >> 2, wc = wid & 3, fr = lane & 15, fq = lane >> 4;
    const int K = g.K, nt = K / BK;
    int ts_lo = 0, ts_hi = 0, nts = 0; const unsigned long long rt_entry = STAMP ? (unsigned long long)wall_clock64() : 0ull;
#define PG8_STAMP() do { if (STAMP && wid == 0 && nts < 64) { const unsigned long long _c = (unsigned long long)clock64(); \
        ts_lo = (lane == nts) ? (int)(unsigned)_c : ts_lo; ts_hi = (lane == nts) ? (int)(unsigned)(_c >> 32) : ts_hi; ++nts; } } while (0)
    PG8_STAMP();
    unsigned voffA[2], voffB[2];
#pragma unroll
    for (int i = 0; i < 2; ++i) { int R, C; stage_rc(tid * 16 + i * 8192, R, C); const int Rb = Epi::PERM ? ((R & ~31) + perm32(R & 31)) : R;
        voffA[i] = (unsigned)(R * K + C) * 2u; voffB[i] = (unsigned)(Rb * K + C) * 2u; }
    const size_t kstep = (size_t)(BK * 2);
    const size_t hstep = (size_t)HALF * K * 2;
    const size_t tstep = 2 * hstep;
    const unsigned ldsw = (unsigned)wid * 1024u;
    const int aoff = lds_byte(wr * 64 + fr, fq * 8), boff = lds_byte(wc * 32 + fr, fq * 8);
#define PG8_SA(b, h) (((b) * 2 + (h)) * HTB)
#define PG8_SB(b, h) ((4 + (b) * 2 + (h)) * HTB)
#define PG8_STAGE(bufoff, gbase, voff) do { _Pragma("unroll") for (int _i = 0; _i < 2; ++_i) \
        __builtin_amdgcn_global_load_lds((const unsigned*)((const char*)(gbase) + (voff)[_i]), (PG8_LAS unsigned*)(lds + (bufoff) + ldsw + _i * 8192), 16, 0, 0); } while (0)
#define PG8_LDA(dst, b, h) do { _Pragma("unroll") for (int m = 0; m < 4; ++m) _Pragma("unroll") for (int k = 0; k < 2; ++k) dst[m][k] = *(const PG8_LAS bf16x8*)(lds + PG8_SA(b, h) + aoff + m * 2048 + k * 1024); } while (0)
#define PG8_LDB(dst, b, h) do { _Pragma("unroll") for (int n = 0; n < 2; ++n) _Pragma("unroll") for (int k = 0; k < 2; ++k) dst[n][k] = *(const PG8_LAS bf16x8*)(lds + PG8_SB(b, h) + boff + n * 2048 + k * 1024); } while (0)
#define PG8_MMA(ai, bj, At, Bt) do { __builtin_amdgcn_s_setprio(1); _Pragma("unroll") for (int m = 0; m < 4; ++m) _Pragma("unroll") for (int n = 0; n < 2; ++n) _Pragma("unroll") for (int k = 0; k < 2; ++k) \
        acc[ai][bj][m][n] = __builtin_amdgcn_mfma_f32_16x16x32_bf16(Bt[n][k], At[m][k], acc[ai][bj][m][n], 0, 0, 0); __builtin_amdgcn_s_setprio(0); } while (0)
#define PG8_WAIT_V(n) asm volatile("s_waitcnt vmcnt(" #n ")" ::: "memory")
#define PG8_WAIT_L(n) asm volatile("s_waitcnt lgkmcnt(" #n ")" ::: "memory")
#define PG8_BAR __builtin_amdgcn_s_barrier()
#define PG8_SCHED __builtin_amdgcn_sched_barrier(0)
    Unit cur, nxt; int ui = 0;
    if (!S.next(0, cur)) return;
    f32x4 acc[2][2][4][2];
#pragma unroll
    for (int a = 0; a < 2; ++a)
#pragma unroll
        for (int b = 0; b < 2; ++b)
#pragma unroll
            for (int m = 0; m < 4; ++m)
#pragma unroll
                for (int n = 0; n < 2; ++n) acc[a][b][m][n] = (f32x4){0.f, 0.f, 0.f, 0.f};
    bf16x8 At[4][2], B0[2][2], B1[2][2];
    const char* cA = (const char*)g.A + (size_t)cur.pm * tstep; const char* cB = (const char*)g.Bt + (size_t)cur.pn * tstep;
    S.a_ready(cur);
    PG8_STAGE(PG8_SB(0, 0), cB, voffB); PG8_STAGE(PG8_SA(0, 0), cA, voffA); PG8_STAGE(PG8_SB(0, 1), cB + hstep, voffB); PG8_STAGE(PG8_SA(0, 1), cA + hstep, voffA);
    if (wr == 1) PG8_BAR;
    PG8_WAIT_V(4); PG8_BAR;
    PG8_STAGE(PG8_SB(1, 0), cB + kstep, voffB); PG8_STAGE(PG8_SA(1, 0), cA + kstep, voffA); PG8_STAGE(PG8_SB(1, 1), cB + hstep + kstep, voffB);
    PG8_WAIT_V(6); PG8_BAR;
    PG8_STAMP();
    for (;;) {
        const bool has_next = S.next(ui + 1, nxt);
        const char* nA = has_next ? (const char*)g.A + (size_t)nxt.pm * tstep : cA; const char* nB = has_next ? (const char*)g.Bt + (size_t)nxt.pn * tstep : cB;
        for (int t = 0; t < nt; t += 2) {
            if constexpr (Epi::KHOOK) { if (t == E.kh0 || t == E.kh1) E.khook(acc, cur, t, wr, wc, fr, fq); }
            const bool last = (t == nt - 2);
            const char* a1 = cA + (size_t)(t + 1) * kstep;
            const char* a2 = last ? nA : cA + (size_t)(t + 2) * kstep; const char* b2 = last ? nB : cB + (size_t)(t + 2) * kstep;
            const char* a3 = a2 + kstep; const char* b3 = b2 + kstep;
            if (last && has_next) S.a_ready(nxt);
            PG8_LDB(B0, 0, 0); PG8_SCHED; PG8_LDA(At, 0, 0); PG8_STAGE(PG8_SA(1, 1), a1 + hstep, voffA);
            PG8_WAIT_L(8); PG8_BAR; PG8_WAIT_L(0); PG8_MMA(0, 0, At, B0); PG8_BAR; PG8_SCHED;
            PG8_LDB(B1, 0, 1); PG8_STAGE(PG8_SB(0, 0), b2, voffB);
            PG8_BAR; PG8_WAIT_L(0); PG8_MMA(0, 1, At, B1); PG8_BAR;
            PG8_LDA(At, 0, 1); PG8_STAGE(PG8_SA(0, 0), a2, voffA);
            PG8_BAR; PG8_WAIT_L(0); PG8_MMA(1, 0, At, B0); PG8_BAR; PG8_SCHED;
            PG8_STAGE(PG8_SB(0, 1), b2 + hstep, voffB);
            PG8_WAIT_V(6); PG8_BAR; PG8_MMA(1, 1, At, B1); PG8_BAR;
            PG8_LDB(B0, 1, 0); PG8_SCHED; PG8_LDA(At, 1, 0); PG8_STAGE(PG8_SA(0, 1), a2 + hstep, voffA);
            PG8_WAIT_L(8); PG8_BAR; PG8_WAIT_L(0); PG8_MMA(0, 0, At, B0); PG8_BAR; PG8_SCHED;
            PG8_LDB(B1, 1, 1); PG8_STAGE(PG8_SB(1, 0), b3, voffB);
            PG8_BAR; PG8_WAIT_L(0); PG8_MMA(0, 1, At, B1); PG8_BAR;
            PG8_LDA(At, 1, 1); PG8_STAGE(PG8_SA(1, 0), a3, voffA);
            PG8_BAR; PG8_WAIT_L(0); PG8_MMA(1, 0, At, B0); PG8_BAR; PG8_SCHED;
            PG8_STAGE(PG8_SB(1, 1), b3 + hstep, voffB);
            PG8_WAIT_V(6); PG8_BAR; PG8_MMA(1, 1, At, B1); PG8_BAR;
        }
        PG8_STAMP();
        if constexpr (!Epi::AFTER_DRAIN) { E(acc, cur, wr, wc, fr, fq); S.done(cur); }
        PG8_STAMP();
        if (!has_next) break;
#pragma unroll
        for (int a = 0; a < 2; ++a)
#pragma unroll
            for (int b = 0; b < 2; ++b)
#pragma unroll
                for (int m = 0; m < 4; ++m)
#pragma unroll
                    for (int n = 0; n < 2; ++n) acc[a][b][m][n] = (f32x4){0.f, 0.f, 0.f, 0.f};
        cur = nxt; cA = nA; cB = nB; ++ui;
    }
    PG8_WAIT_V(0);
    if (wr == 0) PG8_BAR;
    PG8_BAR;
    if constexpr (Epi::AFTER_DRAIN) { E.fused(acc, cur, wr, wc, fr, fq, lds, wid, lane); S.done(cur); }
    PG8_STAMP();
    if (STAMP && wid == 0) { stamps[lane] = lane < nts ? (((unsigned long long)(unsigned)ts_hi << 32) | (unsigned)ts_lo) : 0ull;
        if (lane == 62) stamps[62] = rt_entry; if (lane == 63) stamps[63] = (unsigned long long)wall_clock64(); }
#undef PG8_STAMP
#undef PG8_SA
#undef PG8_SB
#undef PG8_STAGE
#undef PG8_LDA
#undef PG8_LDB
#undef PG8_MMA
#undef PG8_WAIT_V
#undef PG8_WAIT_L
#undef PG8_BAR
#undef PG8_SCHED
}
}
#define XB_TMO      128
#define XB_XCNT(j)  (256  + 64 * (j))
#define XB_XSUB(j)  (1280 + 64 * (j))
#define XB_XGEN(j)  (2304 + 64 * (j))
#define XB_TOP      3328
#define XB_TOPGEN   3392
#define XCD_BAR_WORDS 3456
#define XB_SPIN_CAP (1u << 18)
#define LAS __attribute__((address_space(3)))

__device__ __forceinline__ unsigned xb_ld(unsigned* p)              { return __hip_atomic_load(p, __ATOMIC_RELAXED, __HIP_MEMORY_SCOPE_AGENT); }
__device__ __forceinline__ unsigned xb_add(unsigned* p, unsigned v) { return __hip_atomic_fetch_add(p, v, __ATOMIC_RELAXED, __HIP_MEMORY_SCOPE_AGENT); }
__device__ __forceinline__ unsigned xb_xcc_id() { return (unsigned)__builtin_amdgcn_s_getreg((3 << 11) | 20) & 0xFu; }
#define XB_SPIN(cond, bar) do { unsigned _sp = 0; while (cond) { __builtin_amdgcn_s_sleep(1); \
    if ((++_sp & 255u) == 0u) { if (xb_ld(&(bar)[XB_TMO])) break; if (_sp > XB_SPIN_CAP) { atomicAdd(&(bar)[XB_TMO], 1u); break; } } } } while (0)

struct XcdBarrier {
    unsigned* bar; unsigned x;
    volatile LAS unsigned* st;
};

__device__ __forceinline__ XcdBarrier xcd_barrier_post(unsigned* bar, volatile LAS unsigned* st) {
    XcdBarrier b; b.bar = bar; b.x = (unsigned)__builtin_amdgcn_readfirstlane((int)xb_xcc_id()); b.st = st;
    if (threadIdx.x == 0) (void)xb_add(&bar[XB_XCNT(b.x)], 1u);
    return b;
}
__device__ __forceinline__ void xcd_barrier_complete(unsigned* bar, unsigned x, unsigned& nloc, unsigned& nx) {
    const unsigned G = gridDim.x * gridDim.y * gridDim.z;
    unsigned sum, cnt, mine, sp = 0u;
    for (;;) {
        sum = 0u; cnt = 0u; mine = 0u;
#pragma unroll
        for (unsigned j = 0; j < 16; ++j) { const unsigned c = xb_ld(&bar[XB_XCNT(j)]); sum += c; cnt += (c > 0u) ? 1u : 0u; mine = (j == x) ? c : mine; }
        if (sum == G) break;
        __builtin_amdgcn_s_sleep(1);
        if ((++sp & 255u) == 0u) { if (xb_ld(&bar[XB_TMO])) break; if (sp > XB_SPIN_CAP) { atomicAdd(&bar[XB_TMO], 1u); break; } }
    }
    nloc = mine > 0u ? mine : 1u; nx = cnt > 0u ? cnt : 1u;
}

__device__ __forceinline__ void xcd_barrier(const XcdBarrier& b) {
    asm volatile("s_waitcnt vmcnt(0)" ::: "memory");
    __syncthreads();
    if (threadIdx.x == 0) {
        unsigned* bar = b.bar; unsigned bx = b.x; asm volatile("" : "+s"(bx));
        __builtin_amdgcn_s_waitcnt(0);
        unsigned nloc = b.st[0], nx = b.st[1];
        if (nloc == 0u) { xcd_barrier_complete(bar, bx, nloc, nx); b.st[0] = nloc; b.st[1] = nx; }
        const unsigned old = xb_add(&bar[XB_XSUB(bx)], 1u);
        const unsigned gen = old / nloc;
        if (old + 1u == (gen + 1u) * nloc) {
            __builtin_amdgcn_fence(__ATOMIC_RELEASE, "agent");
            asm volatile("s_waitcnt vmcnt(0)" ::: "memory");
            const unsigned og = xb_add(&bar[XB_TOP], 1u);
            const unsigned tg = og / nx;
            if (og + 1u == (tg + 1u) * nx) xb_add(&bar[XB_TOPGEN], 1u);
            else XB_SPIN(xb_ld(&bar[XB_TOPGEN]) == tg, bar);
            __builtin_amdgcn_fence(__ATOMIC_ACQUIRE, "agent");
            xb_add(&bar[XB_XGEN(bx)], 1u);
            asm volatile("s_waitcnt vmcnt(0)" ::: "memory");
        } else {
            XB_SPIN(xb_ld(&bar[XB_XGEN(bx)]) == gen, bar);
            __builtin_amdgcn_fence(__ATOMIC_ACQUIRE, "agent");
            asm volatile("s_waitcnt vmcnt(0)" ::: "memory");
        }
    }
    __syncthreads();
}

extern __shared__ __attribute__((aligned(16))) unsigned char smem[];

DI void convT_tile(const float* __restrict__ src, int ldsrc, bf16_t* __restrict__ dst, int K  , int tile, int ntn, bool inmap) {
    float* t = (float*)smem;
    const int tid = ltid(), tk = tile / ntn, tn = tile % ntn, k0 = tk * 64, n0 = tn * 64;
    __syncthreads();
#pragma unroll
    for (int r = 0; r < 8; ++r) {
        const int i = (tid >> 6) + 8 * r, j = tid & 63, n = n0 + j;
        int sn = n; bool z = false;
        if (inmap) { if (n >= 3104 && n < C_NQ) z = true; else if (n >= C_NQ) sn = n - 224; }
        t[i * 65 + j] = z ? 0.f : src[(size_t)(k0 + i) * ldsrc + sn];
    }
    __syncthreads();
    const int j = tid >> 3, i8 = (tid & 7) * 8;
    u32x4 w;
    w.x = pk2(t[(i8 + 0) * 65 + j], t[(i8 + 1) * 65 + j]); w.y = pk2(t[(i8 + 2) * 65 + j], t[(i8 + 3) * 65 + j]);
    w.z = pk2(t[(i8 + 4) * 65 + j], t[(i8 + 5) * 65 + j]); w.w = pk2(t[(i8 + 6) * 65 + j], t[(i8 + 7) * 65 + j]);
    *(u32x4*)(dst + (size_t)(n0 + j) * K + k0 + i8) = w;
}
DI void phase_convert(const Params& p, int bid, int nb) {
    for (int l = 0; l < DEPTH; ++l) {
        { const int ntn = NP / 64, nt = (DM / 64) * ntn; bf16_t* d = (bf16_t*)(lws(p) + OFF_WIN) + (size_t)l * NP * DM;
          for (int t = bid; t < nt; t += nb) convT_tile(p.w_in + (size_t)l * DM * IN_TOTAL, IN_TOTAL, d, DM, t, ntn, true); }
        for (int br = 0; br < 3; ++br) { const float* s = (br == 0 ? p.w_br_a : br == 1 ? p.w_br_b : p.w_br_c) + (size_t)l * 1024 * DM;
          const int ntn = DM / 64, nt = (1024 / 64) * ntn; bf16_t* d = (bf16_t*)(lws(p) + OFF_WBR) + (size_t)l * DM * 3072 + br * 1024;
          for (int t = bid; t < nt; t += nb) convT_tile(s, DM, d, 3072, t, ntn, false); }
        { const int ntn = DM / 64, nt = (DM / 64) * ntn; bf16_t* d = (bf16_t*)(lws(p) + OFF_WOUT) + (size_t)l * DM * DM;
          for (int t = bid; t < nt; t += nb) convT_tile(p.w_out + (size_t)l * DM * DM, DM, d, DM, t, ntn, false); }
        { const int ntn = DFF / 64, nt = (DM / 64) * ntn; bf16_t* d = (bf16_t*)(lws(p) + OFF_W1) + (size_t)l * DFF * DM;
          for (int t = bid; t < nt; t += nb) convT_tile(p.w_mlp1 + (size_t)l * DM * DFF, DFF, d, DM, t, ntn, false); }
        { const int ntn = DM / 64, nt = (DFF / 64) * ntn; bf16_t* d = (bf16_t*)(lws(p) + OFF_W2) + (size_t)l * DM * DFF;
          for (int t = bid; t < nt; t += nb) convT_tile(p.w_mlp2 + (size_t)l * DFF * DM, DM, d, DFF, t, ntn, false); }
    }
}

DI void phase_adaln(const Params& p, int bid, int nb) {
    float* sc = (float*)smem;
    float* red = sc + NCOND * DM;
    const int tid = ltid();
    __syncthreads();
    for (int i = tid; i < NCOND * DM; i += 512) { const int r = i / DM, k = i % DM; const float v = r == 0 ? p.c_ctx[k] : p.c[(size_t)(r - 1) * DM + k]; sc[i] = v * sigmoidf_(v); }
    __syncthreads();
    const int nun = DEPTH * (NMOD * DM / 64);
    for (int u = bid; u < nun; u += nb) {
        const int l = u / (NMOD * DM / 64), j0 = (u % (NMOD * DM / 64)) * 64, j = tid & 63, ks = tid >> 6;
        const float* w = p.w_mod + (size_t)l * DM * (NMOD * DM) + j0 + j;
        float acc[NCOND];
#pragma unroll
        for (int r = 0; r < NCOND; ++r) acc[r] = 0.f;
        for (int k = ks * 256; k < ks * 256 + 256; ++k) { const float wv = w[(size_t)k * (NMOD * DM)];
#pragma unroll
            for (int r = 0; r < NCOND; ++r) acc[r] += sc[r * DM + k] * wv; }
#pragma unroll
        for (int r = 0; r < NCOND; ++r) red[(ks * NCOND + r) * 64 + j] = acc[r];
        __syncthreads();
        for (int i = tid; i < NCOND * 64; i += 512) { const int r = i / 64, jj = i % 64; float s = p.b_mod[(size_t)l * NMOD * DM + j0 + jj];
#pragma unroll
            for (int q = 0; q < 8; ++q) s += red[(q * NCOND + r) * 64 + jj];
            ((float*)(lws(p) + OFF_MOD))[((size_t)l * NCOND + r) * (NMOD * DM) + j0 + jj] = s; }
        __syncthreads();
    }
}

DI void phase_hyena_hid(const Params& p, int bid, int nb) {
    float* zf = (float*)smem;
    float* h1 = zf + 8 * 36;
    const int tid = ltid(), tt = tid >> 6, j = tid & 63;
    const int nun = DEPTH * (256 / 8 + 4096 / 8);
    for (int u = bid; u < nun; u += nb) {
        const int l = u / 544, r = u % 544, ls = r < 32 ? 0 : 1, tb = ls ? r - 32 : r, L = ls ? 4096 : 256, t = tb * 8 + tt;
        const float tn = (float)t / (float)L;
        __syncthreads();
        if (j < 33) { float v; if (j == 0) v = tn; else { const int band = j <= 16 ? j : j - 16; const float ang = 6.283185307179586f * tn * (float)band; v = j <= 16 ? cosf(ang) : sinf(ang); } zf[tt * 36 + j] = v; }
        __syncthreads();
        const float fr = p.hy_freq[l * 64 + j];
        float a = p.hy_f1_b[l * 64 + j];
        for (int i = 0; i < 33; ++i) a += zf[tt * 36 + i] * p.hy_f1_w[((size_t)l * 33 + i) * 64 + j];
        h1[tt * 64 + j] = sinf(fr * a);
        __syncthreads();
        float b = p.hy_f2_b[l * 64 + j];
        for (int i = 0; i < 64; ++i) b += h1[tt * 64 + i] * p.hy_f2_w[((size_t)l * 64 + i) * 64 + j];
        ((float*)(lws(p) + OFF_HID))[(((size_t)l * 2 + ls) * 4096 + t) * 64 + j] = sinf(fr * b);
    }
}
DI const float* filt_ptr(const unsigned char* ws, int l, int ls) { return (const float*)(ws + OFF_FILT + (size_t)l * FILT_L) + (ls ? (size_t)2 * 1024 * 256 : 0); }
DI void phase_filters(const Params& p, int bid, int nb) {
    float* f3s = (float*)smem;
    float* red = f3s + 256;
    const int tid = ltid(), lane = tid & 63, wid = tid >> 6;
    const int nun = DEPTH * 2 * 512;
    for (int u = bid; u < nun; u += nb) {
        const int l = u / 1024, ls = (u / 512) & 1, cg = u % 512, L = ls ? 4096 : 256, col0 = cg * 4;
        __syncthreads();
        if (tid < 256) f3s[tid] = p.hy_f3_w[((size_t)l * 64 + (tid >> 2)) * 2048 + col0 + (tid & 3)];
        __syncthreads();
        const float* hid = (const float*)(lws(p) + OFF_HID) + ((size_t)l * 2 + ls) * 4096 * 64;
        float val[8][4]; float ss[4] = {0.f, 0.f, 0.f, 0.f};
        float delta[4];
#pragma unroll
        for (int cc = 0; cc < 4; ++cc) { const int c = (col0 + cc) & 1023; const float a = -3.0701134573253943f, b = -15.350567286626972f; delta[cc] = fabsf(a + (b - a) * ((float)c / 1023.0f)); }
#pragma unroll
        for (int i = 0; i < 8; ++i) {
            const int t = tid + 512 * i;
#pragma unroll
            for (int cc = 0; cc < 4; ++cc) val[i][cc] = 0.f;
            if (t < L) {
                const f32x4* hr = (const f32x4*)(hid + (size_t)t * 64);
                float a0 = 0.f, a1 = 0.f, a2 = 0.f, a3 = 0.f;
#pragma unroll
                for (int q = 0; q < 16; ++q) { const f32x4 hv = hr[q];
#pragma unroll
                    for (int e = 0; e < 4; ++e) { const f32x4 w = *(const f32x4*)(f3s + (q * 4 + e) * 4); a0 += hv[e] * w[0]; a1 += hv[e] * w[1]; a2 += hv[e] * w[2]; a3 += hv[e] * w[3]; } }
                const float dist = fabsf((float)t - (float)(L / 2)) * (2.0f / (float)L);
                val[i][0] = a0 * expf(-dist * delta[0]); val[i][1] = a1 * expf(-dist * delta[1]); val[i][2] = a2 * expf(-dist * delta[2]); val[i][3] = a3 * expf(-dist * delta[3]);
#pragma unroll
                for (int cc = 0; cc < 4; ++cc) ss[cc] += val[i][cc] * val[i][cc];
            }
        }
#pragma unroll
        for (int cc = 0; cc < 4; ++cc) { ss[cc] = wave_sum(ss[cc], lane); if (lane == 0) red[wid * 4 + cc] = ss[cc]; }
        __syncthreads();
        float sc[4];
#pragma unroll
        for (int cc = 0; cc < 4; ++cc) { float s = 0.f;
#pragma unroll
            for (int q = 0; q < 8; ++q) s += red[q * 4 + cc]; sc[cc] = rsqrtf(s + EPS); }
        float* fo = (float*)filt_ptr(lws(p), l, ls);
#pragma unroll
        for (int i = 0; i < 8; ++i) { const int t = tid + 512 * i; if (t < L) {
#pragma unroll
            for (int cc = 0; cc < 4; ++cc) { const int col = col0 + cc; fo[((size_t)(col >> 10) * 1024 + (col & 1023)) * L + t] = val[i][cc] * sc[cc]; } } }
    }
}

DI int cond_row(int grp, int row) { return grp == 0 ? 0 : 1 + 2 * (grp - 1) + (row >> 12); }
DI void phase_norm(const Params& p, const float* x, const float* g, int l, int grp, int shoff, int scoff, int bid, int nb) {
    const int tid = ltid(), lane = tid & 63, wid = tid >> 6;
    bf16_t* h = (bf16_t*)(lws(p) + OFF_H);
    for (int row = bid * 8 + wid; row < GT; row += nb * 8) {
        const float* xr = x + (size_t)row * DM;
        f32x4 v[8]; float ss = 0.f;
#pragma unroll
        for (int i = 0; i < 8; ++i) { v[i] = *(const f32x4*)(xr + i * 256 + lane * 4); ss += v[i][0] * v[i][0] + v[i][1] * v[i][1] + v[i][2] * v[i][2] + v[i][3] * v[i][3]; }
        ss = wave_sum(ss, lane);
        const float rs = rsqrtf(ss * (1.0f / DM) + EPS);
        const float* md = (const float*)(lws(p) + OFF_MOD) + ((size_t)l * NCOND + cond_row(grp, row)) * (NMOD * DM);
#pragma unroll
        for (int i = 0; i < 8; ++i) { const int c = i * 256 + lane * 4; const f32x4 gv = *(const f32x4*)(g + c), sh = *(const f32x4*)(md + shoff + c), sc = *(const f32x4*)(md + scoff + c);
            f32x4 o = v[i] * rs * gv * (sc + 1.0f) + sh; u32x2 w; w.x = pk2(o[0], o[1]); w.y = pk2(o[2], o[3]); *(u32x2*)(h + (size_t)row * DM + c) = w; }
    }
}
using pg8::Unit; using pg8::cvt_pk_bf16;
template <int ACT> struct EpiStoreBf16 {
    static constexpr bool PERM = true, AFTER_DRAIN = false, KHOOK = false;
    bf16_t* O; int ldc; int pad;
    __device__ __forceinline__ void operator()(const f32x4 (&acc)[2][2][4][2], const Unit& u, int wr, int wc, int fr, int fq) const {
        const int row0 = u.pm * 256 + wr * 64 + fr, col0 = u.pn * 256 + wc * 32 + 8 * fq;
#pragma unroll
        for (int ai = 0; ai < 2; ++ai)
#pragma unroll
            for (int m = 0; m < 4; ++m) { bf16_t* rowp = O + (size_t)(row0 + ai * 128 + m * 16) * ldc + col0;
#pragma unroll
                for (int bj = 0; bj < 2; ++bj) { f32x4 v0 = acc[ai][bj][m][0], v1 = acc[ai][bj][m][1];
                    if (ACT == 1) {
#pragma unroll
                        for (int j = 0; j < 4; ++j) { const float a = fmaxf(v0[j], 0.f), b = fmaxf(v1[j], 0.f); v0[j] = a * a; v1[j] = b * b; } }
                    u32x4 w; w.x = cvt_pk_bf16(v0[0], v0[1]); w.y = cvt_pk_bf16(v0[2], v0[3]); w.z = cvt_pk_bf16(v1[0], v1[1]); w.w = cvt_pk_bf16(v1[2], v1[3]);
                    *(u32x4*)(rowp + bj * 128) = w; } }
    }
};
struct EpiGate3 {
    static constexpr bool PERM = true, AFTER_DRAIN = false, KHOOK = true;
    static constexpr int kh0 = 16, kh1 = 32;
    const bf16_t* gate; bf16_t* mbf; int ldg; int pad;
    __device__ __forceinline__ void khook(f32x4 (&acc)[2][2][4][2], const Unit& u, int t, int wr, int wc, int fr, int fq) const {
        typedef const __attribute__((address_space(1))) unsigned char* gptr;
        typedef const __attribute__((address_space(1))) u32x4* gvec;
        const gptr gb = (gptr)gate;
        int fr_ = fr, fq_ = fq; asm volatile("" : "+v"(fr_), "+v"(fq_));
        const int bn = (t == kh0) ? 0 : DM;
        const unsigned off0 = (unsigned)(((u.pm * 256 + wr * 64 + fr_) * NP + bn + u.pn * 256 + wc * 32 + 8 * fq_) * 2);
#pragma unroll
        for (int ai = 0; ai < 2; ++ai)
#pragma unroll
            for (int m = 0; m < 4; ++m) {
#pragma unroll
                for (int bj = 0; bj < 2; ++bj) { const unsigned off = off0 + (unsigned)((ai * 128 + m * 16) * NP * 2 + bj * 256);
                    const u32x4 nw = *(gvec)(gb + off), dw = *(gvec)(gb + off + DM * 2);
                    float r[8];
#pragma unroll
                    for (int j = 0; j < 4; ++j) { r[2 * j] = (1.0f + __expf(-bflo(dw[j]))) / (1.0f + __expf(-bflo(nw[j]))); r[2 * j + 1] = (1.0f + __expf(-bfhi(dw[j]))) / (1.0f + __expf(-bfhi(nw[j]))); }
                    acc[ai][bj][m][0] *= (f32x4){r[0], r[1], r[2], r[3]}; acc[ai][bj][m][1] *= (f32x4){r[4], r[5], r[6], r[7]}; }
                asm volatile("" ::: "memory"); }
    }
    __device__ __forceinline__ void operator()(const f32x4 (&acc)[2][2][4][2], const Unit& u, int wr, int wc, int fr, int fq) const {
        const int row0 = u.pm * 256 + wr * 64 + fr, col0 = u.pn * 256 + wc * 32 + 8 * fq;
#pragma unroll
        for (int ai = 0; ai < 2; ++ai)
#pragma unroll
            for (int m = 0; m < 4; ++m) { const size_t row = (size_t)(row0 + ai * 128 + m * 16);
#pragma unroll
                for (int bj = 0; bj < 2; ++bj) { const int col = col0 + bj * 128;
                    const u32x4 gw = *(const u32x4*)(gate + row * ldg + 2 * DM + col);
                    f32x4 s0, s1;
                    s0[0] = sigmoidf_(bflo(gw.x)); s0[1] = sigmoidf_(bfhi(gw.x)); s0[2] = sigmoidf_(bflo(gw.y)); s0[3] = sigmoidf_(bfhi(gw.y));
                    s1[0] = sigmoidf_(bflo(gw.z)); s1[1] = sigmoidf_(bfhi(gw.z)); s1[2] = sigmoidf_(bflo(gw.w)); s1[3] = sigmoidf_(bfhi(gw.w));
                    const f32x4 v0 = acc[ai][bj][m][0] * s0, v1 = acc[ai][bj][m][1] * s1;
                    u32x4 w; w.x = cvt_pk_bf16(v0[0], v0[1]); w.y = cvt_pk_bf16(v0[2], v0[3]); w.z = cvt_pk_bf16(v1[0], v1[1]); w.w = cvt_pk_bf16(v1[2], v1[3]);
                    *(u32x4*)(mbf + row * DM + col) = w; } }
    }
};
struct EpiResid {
    static constexpr bool PERM = true, AFTER_DRAIN = false, KHOOK = false;
    const float* xin; float* xout; const float* gA; const float* gB;
    __device__ __forceinline__ void operator()(const f32x4 (&acc)[2][2][4][2], const Unit& u, int wr, int wc, int fr, int fq) const {
        const int row0 = u.pm * 256 + wr * 64 + fr, col0 = u.pn * 256 + wc * 32 + 8 * fq;
        const float* gv = (u.pm * 256 < 4096) ? gA : gB;
#pragma unroll
        for (int bj = 0; bj < 2; ++bj) { const int col = col0 + bj * 128; const f32x4 g0 = *(const f32x4*)(gv + col), g1 = *(const f32x4*)(gv + col + 4);
#pragma unroll
            for (int ai = 0; ai < 2; ++ai)
#pragma unroll
                for (int m = 0; m < 4; ++m) { const size_t o = (size_t)(row0 + ai * 128 + m * 16) * DM + col;
                    const f32x4 a0 = *(const f32x4*)(xin + o), a1 = *(const f32x4*)(xin + o + 4);
                    *(f32x4*)(xout + o) = a0 + g0 * acc[ai][bj][m][0]; *(f32x4*)(xout + o + 4) = a1 + g1 * acc[ai][bj][m][1]; } }
    }
};

struct GrpInfo { int grp, l, L, nseq, latent; };
DI GrpInfo grp_info(int grp, int l) { GrpInfo g; g.grp = grp; g.l = l; g.latent = grp > 0; g.L = grp ? 4096 : 256; g.nseq = grp ? 2 : 32; return g; }

template <bool WITH_OI> DI void phase_gla_post(const Params& p, GrpInfo gi, int bid, int nb) {
    const int tid = ltid(), lane = tid & 63, wid = tid >> 6;
    const bf16_t* P = (const bf16_t*)(lws(p) + OFF_P);
    const float* Of = (const float*)(lws(p) + OFF_OF); const float* Ob = (const float*)(lws(p) + OFF_OB); const float* Oi = (const float*)(lws(p) + OFF_OI);
    bf16_t* OA = (bf16_t*)(lws(p) + OFF_OABC);
    const f32x4 g = *(const f32x4*)(p.gla_norm_g + gi.l * 256 + lane * 4);
    for (int u = bid * 8 + wid; u < GT * 4; u += nb * 8) {
        const int row = u >> 2, h = u & 3; const size_t o = (size_t)row * 1024 + h * 256 + lane * 4, oa = (size_t)row * 3072 + h * 256 + lane * 4;
        f32x4 v = *(const f32x4*)(Of + o) + *(const f32x4*)(Ob + o); if (WITH_OI) v += *(const f32x4*)(Oi + o);
        const float rs = rsqrtf(wave_sum(v[0] * v[0] + v[1] * v[1] + v[2] * v[2] + v[3] * v[3], lane) * (1.0f / 256) + EPS);
        const u32x2 gw = *(const u32x2*)(P + (size_t)row * NP + C_GG + h * 256 + lane * 4);
        const float g0 = bflo(gw.x), g1 = bfhi(gw.x), g2 = bflo(gw.y), g3 = bfhi(gw.y);
        u32x2 w; w.x = pk2(v[0] * rs * g[0] * (g0 * sigmoidf_(g0)), v[1] * rs * g[1] * (g1 * sigmoidf_(g1)));
        w.y = pk2(v[2] * rs * g[2] * (g2 * sigmoidf_(g2)), v[3] * rs * g[3] * (g3 * sigmoidf_(g3)));
        *(u32x2*)(OA + oa) = w;
    }
}

typedef short bf16x8 __attribute__((ext_vector_type(8)));
typedef short bf16x4 __attribute__((ext_vector_type(4)));
#define MFMA16(a, b, c) __builtin_amdgcn_mfma_f32_16x16x32_bf16((a), (b), (c), 0, 0, 0)
constexpr int QKP = 136;
constexpr int TP = 80;
DI float log_sigmoid_fast(float x) { return fminf(x, 0.f) - __logf(1.0f + __expf(-fabsf(x))); }
DI bf16x8 pack8(const f32x4& a, const f32x4& b) { u32x4 w; w.x = pk2(a[0], a[1]); w.y = pk2(a[2], a[3]); w.z = pk2(b[0], b[1]); w.w = pk2(b[2], b[3]); return __builtin_bit_cast(bf16x8, w); }

DI void gla_prep_unit(const Params& p, const GrpInfo gi, int unit, int tid_in) {
    int tid = tid_in; asm volatile("" : "+v"(tid));
    const int cg = unit >> 2, h = unit & 3, row0 = cg * 64, t0 = row0 & (gi.L - 1), l = gi.l;
    const int lane = tid & 63, wid = tid >> 6, r16 = lane & 15, q4 = lane >> 4;
    float* laf = (float*)smem; float* lab = laf + 8192;
    bf16_t* QFs = (bf16_t*)(smem + 65536); bf16_t* KFs = QFs + 64 * QKP; bf16_t* QBs = KFs + 64 * QKP; bf16_t* KBs = QBs + 64 * QKP;
    bf16_t* VTs = (bf16_t*)smem; bf16_t* As = (bf16_t*)(smem + 40960);
    const bf16_t* P = (const bf16_t*)(lws(p) + OFF_P);
    __syncthreads();
    {
        const int t = tid >> 3, d0 = (tid & 7) * 16;
        const bf16_t* pr = P + (size_t)(row0 + t) * NP + C_GA;
        float ga[32];
#pragma unroll
        for (int i = 0; i < 4; ++i) { const u32x4 w = *(const u32x4*)(pr + 8 * i); ga[8 * i] = bflo(w.x); ga[8 * i + 1] = bfhi(w.x); ga[8 * i + 2] = bflo(w.y); ga[8 * i + 3] = bfhi(w.y); ga[8 * i + 4] = bflo(w.z); ga[8 * i + 5] = bfhi(w.z); ga[8 * i + 6] = bflo(w.w); ga[8 * i + 7] = bfhi(w.w); }
#pragma unroll
        for (int dir = 0; dir < 2; ++dir) {
            const float* wa = p.gla_wa2 + (((size_t)l * 2 + dir) * 16) * 512 + h * 128 + d0;
            const float* ba = p.gla_ba2 + ((size_t)l * 2 + dir) * 512 + h * 128 + d0;
            float* dst = (dir ? lab : laf) + t * 128 + d0;
#pragma unroll
            for (int j4 = 0; j4 < 4; ++j4) {
                f32x4 x = *(const f32x4*)(ba + 4 * j4);
#pragma unroll
                for (int r = 0; r < 16; ++r) x += *(const f32x4*)(wa + (size_t)r * 512 + 4 * j4) * ga[dir * 16 + r];
                f32x4 o; o[0] = log_sigmoid_fast(x[0]) * 0.0625f; o[1] = log_sigmoid_fast(x[1]) * 0.0625f; o[2] = log_sigmoid_fast(x[2]) * 0.0625f; o[3] = log_sigmoid_fast(x[3]) * 0.0625f;
                *(f32x4*)(dst + 4 * j4) = o;
            }
        }
    }
    __syncthreads();
    if (tid < 256) {
        const int d = tid & 127;
        if (tid < 128) { float a = 0.f; for (int t = 0; t < 64; ++t) { a += laf[t * 128 + d]; laf[t * 128 + d] = a; } }
        else { float a = 0.f; for (int t = 63; t >= 0; --t) { a += lab[t * 128 + d]; lab[t * 128 + d] = a; } }
    }
    __syncthreads();
    {
        const int t = tid >> 3, dlo = (tid & 7) * 8, ta = t0 + t;
        const bf16_t* pr = P + (size_t)(row0 + t) * NP + h * 128;
        const u32x4 qlw = *(const u32x4*)(pr + C_GQ + dlo), qhw = *(const u32x4*)(pr + C_GQ + 64 + dlo), klw = *(const u32x4*)(pr + C_GK + dlo), khw = *(const u32x4*)(pr + C_GK + 64 + dlo);
        float ql[8], qh[8], kl[8], kh[8];
#pragma unroll
        for (int j = 0; j < 4; ++j) { ql[2 * j] = bflo(qlw[j]); ql[2 * j + 1] = bfhi(qlw[j]); qh[2 * j] = bflo(qhw[j]); qh[2 * j + 1] = bfhi(qhw[j]); kl[2 * j] = bflo(klw[j]); kl[2 * j + 1] = bfhi(klw[j]); kh[2 * j] = bflo(khw[j]); kh[2 * j + 1] = bfhi(khw[j]); }
#pragma unroll
        for (int j = 0; j < 8; ++j) {
            ql[j] *= 0.08838834764831845f; qh[j] *= 0.08838834764831845f;
            if (gi.latent) {
                const int ii = dlo + j, f = ii & 31; const float pos = (float)(ii < 32 ? (ta >> 6) : (ta & 63));
                const float ang = pos * exp2f(-(float)f * 0.41524101186092029f); float sn, cs; sincosf(ang, &sn, &cs);
                const float a = ql[j] * cs - qh[j] * sn, b = ql[j] * sn + qh[j] * cs; ql[j] = a; qh[j] = b;
                const float c = kl[j] * cs - kh[j] * sn, e = kl[j] * sn + kh[j] * cs; kl[j] = c; kh[j] = e;
            }
        }
        float* DEC = (float*)(lws(p) + OFF_DEC);
#pragma unroll
        for (int dir = 0; dir < 2; ++dir) {
            const float* bb = dir ? lab : laf;
            bf16_t* Qs = dir ? QBs : QFs; bf16_t* Ks = dir ? KBs : KFs;
            bf16_t* Qg = (bf16_t*)(lws(p) + (dir ? OFF_QB : OFF_QF)) + (size_t)(row0 + t) * 512 + h * 128;
#pragma unroll
            for (int half = 0; half < 2; ++half) {
                const int d = dlo + 64 * half;
                const f32x4 b0 = *(const f32x4*)(bb + t * 128 + d), b1 = *(const f32x4*)(bb + t * 128 + d + 4);
                float qo[8], ko[8];
#pragma unroll
                for (int j = 0; j < 8; ++j) { const float bv = j < 4 ? b0[j] : b1[j - 4]; const float qv = half ? qh[j] : ql[j], kv = half ? kh[j] : kl[j]; qo[j] = qv * __expf(bv); ko[j] = kv * __expf(-bv); }
                u32x4 qw, kw; qw.x = pk2(qo[0], qo[1]); qw.y = pk2(qo[2], qo[3]); qw.z = pk2(qo[4], qo[5]); qw.w = pk2(qo[6], qo[7]);
                kw.x = pk2(ko[0], ko[1]); kw.y = pk2(ko[2], ko[3]); kw.z = pk2(ko[4], ko[5]); kw.w = pk2(ko[6], ko[7]);
                *(u32x4*)(Qs + t * QKP + d) = qw; *(u32x4*)(Ks + t * QKP + d) = kw; *(u32x4*)(Qg + d) = qw;
                if (t == 0) { const int te = dir ? 0 : 63; const f32x4 e0 = *(const f32x4*)(bb + te * 128 + d), e1 = *(const f32x4*)(bb + te * 128 + d + 4);
                    f32x4 x0, x1;
#pragma unroll
                    for (int j = 0; j < 4; ++j) { x0[j] = __expf(e0[j]); x1[j] = __expf(e1[j]); }
                    float* dp = DEC + ((size_t)dir * 128 + cg) * 512 + h * 128 + d; *(f32x4*)dp = x0; *(f32x4*)(dp + 4) = x1; }
            }
        }
    }
    __syncthreads();
    {
        const int s = tid >> 3, e0 = (tid & 7) * 32;
        const bf16_t* pv = P + (size_t)(row0 + s) * NP + C_GV + h * 256 + e0;
#pragma unroll
        for (int i = 0; i < 4; ++i) { const u32x4 w = *(const u32x4*)(pv + 8 * i);
#pragma unroll
            for (int j = 0; j < 4; ++j) { VTs[(e0 + 8 * i + 2 * j) * TP + s] = (bf16_t)(w[j] & 0xffffu); VTs[(e0 + 8 * i + 2 * j + 1) * TP + s] = (bf16_t)(w[j] >> 16); } }
        const int mt = wid >> 1, nt0 = 2 * (wid & 1);
        f32x4 acc[2][2];
#pragma unroll
        for (int dir = 0; dir < 2; ++dir) { const bf16_t* Qs = dir ? QBs : QFs; const bf16_t* Ks = dir ? KBs : KFs;
#pragma unroll
            for (int n = 0; n < 2; ++n) acc[dir][n] = (f32x4){0.f, 0.f, 0.f, 0.f};
#pragma unroll
            for (int ks = 0; ks < 4; ++ks) { const bf16x8 a = *(const bf16x8*)(Qs + (16 * mt + r16) * QKP + 32 * ks + 8 * q4);
#pragma unroll
                for (int n = 0; n < 2; ++n) { const bf16x8 b = *(const bf16x8*)(Ks + (16 * (nt0 + n) + r16) * QKP + 32 * ks + 8 * q4); acc[dir][n] = MFMA16(a, b, acc[dir][n]); } } }
#pragma unroll
        for (int n = 0; n < 2; ++n)
#pragma unroll
            for (int i = 0; i < 4; ++i) { const int t = 16 * mt + 4 * q4 + i, s2 = 16 * (nt0 + n) + r16;
                const float v = (s2 <= t ? acc[0][n][i] : 0.f) + (s2 >= t ? acc[1][n][i] : 0.f); As[t * TP + s2] = f2bf(v); }
        const int d = tid >> 2, sq = tid & 3;
#pragma unroll
        for (int dir = 0; dir < 2; ++dir) { const bf16_t* Ks = dir ? KBs : KFs; unsigned w[8];
#pragma unroll
            for (int j = 0; j < 8; ++j) w[j] = (unsigned)Ks[(sq * 16 + 2 * j) * QKP + d] | ((unsigned)Ks[(sq * 16 + 2 * j + 1) * QKP + d] << 16);
            bf16_t* kg = (bf16_t*)(lws(p) + (dir ? OFF_KBT : OFF_KFT)) + (((size_t)cg * 4 + h) * 128 + d) * 64 + sq * 16;
            *(u32x4*)kg = (u32x4){w[0], w[1], w[2], w[3]}; *(u32x4*)(kg + 8) = (u32x4){w[4], w[5], w[6], w[7]}; }
    }
    __syncthreads();
    {
        const int e = tid >> 1, hf = tid & 1;
        bf16_t* vg = (bf16_t*)(lws(p) + OFF_VT) + (((size_t)cg * 4 + h) * 256 + e) * 64 + hf * 32;
#pragma unroll
        for (int i = 0; i < 4; ++i) *(u32x4*)(vg + 8 * i) = *(const u32x4*)(VTs + e * TP + hf * 32 + 8 * i);
        float* OI = (float*)(lws(p) + OFF_OI);
#pragma unroll
        for (int n = 0; n < 2; ++n) { const int nt = 2 * wid + n;
            bf16x8 b[2];
#pragma unroll
            for (int ks = 0; ks < 2; ++ks) b[ks] = *(const bf16x8*)(VTs + (16 * nt + r16) * TP + 32 * ks + 8 * q4);
#pragma unroll
            for (int mt = 0; mt < 4; ++mt) { f32x4 acc = (f32x4){0.f, 0.f, 0.f, 0.f};
#pragma unroll
                for (int ks = 0; ks < 2; ++ks) { const bf16x8 a = *(const bf16x8*)(As + (16 * mt + r16) * TP + 32 * ks + 8 * q4); acc = MFMA16(a, b[ks], acc); }
#pragma unroll
                for (int i = 0; i < 4; ++i) OI[(size_t)(row0 + 16 * mt + 4 * q4 + i) * 1024 + h * 256 + 16 * nt + r16] = acc[i]; } }
    }
}
DI void phase_gla_prep(const Params& p, const GrpInfo gi, int bid, int nb) {
    const int tid = ltid();
    for (int u = bid; u < 512; u += nb) gla_prep_unit(p, gi, u, tid);
}

constexpr int SC_Q = 0, SC_K = 64 * QKP * 2, SC_V = SC_K + 128 * TP * 2, SC_D = SC_V + 128 * TP * 2, SC_BUF = SC_D + 512;
DI void gla_scan_unit(const Params& p, const GrpInfo gi, int unit, int tid_in) {
    int tid = tid_in; asm volatile("" : "+v"(tid));
    const int sl = unit >> 4, h = (unit >> 2) & 3, dir = (unit >> 1) & 1, eh = unit & 1, L = gi.L, NC = L >> 6, l = gi.l;
    const int lane = tid & 63, wid = tid >> 6, r16 = lane & 15, q4 = lane >> 4;
    const int ecol = eh * 128 + 16 * wid + r16;
    f32x4 S[8];
    if (gi.latent) { const int bs = 2 * (gi.grp - 1) + sl; const float* s0 = p.state_gla + ((((size_t)bs * DEPTH + l) * 2 + dir) * 4 + h) * 128 * 256 + ecol;
#pragma unroll
        for (int T = 0; T < 8; ++T)
#pragma unroll
            for (int i = 0; i < 4; ++i) S[T][i] = s0[(size_t)(16 * T + 4 * q4 + i) * 256]; }
    else {
#pragma unroll
        for (int T = 0; T < 8; ++T) S[T] = (f32x4){0.f, 0.f, 0.f, 0.f}; }
    const bf16_t* Qg = (const bf16_t*)(lws(p) + (dir ? OFF_QB : OFF_QF)); const bf16_t* Kg = (const bf16_t*)(lws(p) + (dir ? OFF_KBT : OFF_KFT)); const bf16_t* Vg = (const bf16_t*)(lws(p) + OFF_VT);
    const float* Dg = (const float*)(lws(p) + OFF_DEC) + (size_t)dir * 128 * 512;
    float* Og = (float*)(lws(p) + (dir ? OFF_OB : OFF_OF));
    u32x4 rq[2], rk[2], rv[2]; float rd = 0.f;
    const int qt0 = tid >> 4, qd = (tid & 15) * 8;
    const int kd0 = tid >> 3, ks8 = (tid & 7) * 8;
#define GLA_LOAD(c) do { const int cg_ = sl * NC + (c); const size_t r0_ = (size_t)cg_ * 64; \
        rq[0] = *(const u32x4*)(Qg + (r0_ + qt0) * 512 + h * 128 + qd); rq[1] = *(const u32x4*)(Qg + (r0_ + qt0 + 32) * 512 + h * 128 + qd); \
        rk[0] = *(const u32x4*)(Kg + (((size_t)cg_ * 4 + h) * 128 + kd0) * 64 + ks8); rk[1] = *(const u32x4*)(Kg + (((size_t)cg_ * 4 + h) * 128 + kd0 + 64) * 64 + ks8); \
        rv[0] = *(const u32x4*)(Vg + (((size_t)cg_ * 4 + h) * 256 + eh * 128 + kd0) * 64 + ks8); rv[1] = *(const u32x4*)(Vg + (((size_t)cg_ * 4 + h) * 256 + eh * 128 + kd0 + 64) * 64 + ks8); \
        if (tid < 128) rd = Dg[(size_t)cg_ * 512 + h * 128 + tid]; } while (0)
#define GLA_STORE(bufp) do { unsigned char* b_ = (bufp); \
        *(u32x4*)(b_ + SC_Q + (qt0 * QKP + qd) * 2) = rq[0]; *(u32x4*)(b_ + SC_Q + ((qt0 + 32) * QKP + qd) * 2) = rq[1]; \
        *(u32x4*)(b_ + SC_K + (kd0 * TP + ks8) * 2) = rk[0]; *(u32x4*)(b_ + SC_K + ((kd0 + 64) * TP + ks8) * 2) = rk[1]; \
        *(u32x4*)(b_ + SC_V + (kd0 * TP + ks8) * 2) = rv[0]; *(u32x4*)(b_ + SC_V + ((kd0 + 64) * TP + ks8) * 2) = rv[1]; \
        if (tid < 128) *(float*)(b_ + SC_D + tid * 4) = rd; } while (0)
    __syncthreads();
    GLA_LOAD(dir ? NC - 1 : 0);
    GLA_STORE(smem);
    __syncthreads();
    for (int ci = 0; ci < NC; ++ci) {
        const int c = dir ? NC - 1 - ci : ci;
        if (ci + 1 < NC) GLA_LOAD(dir ? c - 1 : c + 1);
        const unsigned char* buf = smem + (ci & 1) * SC_BUF;
        const bf16_t* Qs = (const bf16_t*)(buf + SC_Q); const bf16_t* Kt = (const bf16_t*)(buf + SC_K); const bf16_t* Vt = (const bf16_t*)(buf + SC_V); const float* Dv = (const float*)(buf + SC_D);
        bf16x8 bS[4];
#pragma unroll
        for (int ks = 0; ks < 4; ++ks) bS[ks] = pack8(S[2 * ks], S[2 * ks + 1]);
        const size_t orow0 = ((size_t)(sl * NC + c) * 64);
#pragma unroll
        for (int mt = 0; mt < 4; ++mt) { f32x4 acc = (f32x4){0.f, 0.f, 0.f, 0.f};
#pragma unroll
            for (int ks = 0; ks < 4; ++ks) { const bf16_t* qp = Qs + (16 * mt + r16) * QKP + 32 * ks + 4 * q4;
                const bf16x4 a0 = *(const bf16x4*)qp, a1 = *(const bf16x4*)(qp + 16);
                const bf16x8 a = (bf16x8){a0[0], a0[1], a0[2], a0[3], a1[0], a1[1], a1[2], a1[3]};
                acc = MFMA16(a, bS[ks], acc); }
#pragma unroll
            for (int i = 0; i < 4; ++i) Og[(orow0 + 16 * mt + 4 * q4 + i) * 1024 + h * 256 + ecol] = acc[i]; }
        bf16x8 bv[2];
#pragma unroll
        for (int ks = 0; ks < 2; ++ks) bv[ks] = *(const bf16x8*)(Vt + (16 * wid + r16) * TP + 32 * ks + 8 * q4);
#pragma unroll
        for (int T = 0; T < 8; ++T) {
#pragma unroll
            for (int ks = 0; ks < 2; ++ks) { const bf16x8 a = *(const bf16x8*)(Kt + (16 * T + r16) * TP + 32 * ks + 8 * q4); S[T] = MFMA16(a, bv[ks], S[T]); }
            const f32x4 dv = *(const f32x4*)(Dv + 16 * T + 4 * q4); S[T] *= dv; }
        if (ci + 1 < NC) GLA_STORE(smem + ((ci + 1) & 1) * SC_BUF);
        __syncthreads();
    }
#undef GLA_LOAD
#undef GLA_STORE
    if (!gi.latent) { float* so = lout(p) + OUT_ST + ((((size_t)sl * DEPTH + l) * 2 + dir) * 4 + h) * 128 * 256 + ecol;
#pragma unroll
        for (int T = 0; T < 8; ++T)
#pragma unroll
            for (int i = 0; i < 4; ++i) so[(size_t)(16 * T + 4 * q4 + i) * 256] = S[T][i]; }
}
DI void phase_gla_scan(const Params& p, const GrpInfo gi, int bid, int nb) {
    const int tid = ltid();
    for (int u = bid; u < gi.nseq * 16; u += nb) gla_scan_unit(p, gi, u, tid);
}
typedef float f32x16 __attribute__((ext_vector_type(16)));
#define MFMA32(a, b, c) __builtin_amdgcn_mfma_f32_32x32x16_bf16((a), (b), (c), 0, 0, 0)

DI void phase_hy_prep(const Params& p, const GrpInfo gi, int bid, int nb) {
    const int tid = ltid(), L = gi.L;
    bf16_t* T = (bf16_t*)smem;
    const bf16_t* P = (const bf16_t*)(lws(p) + OFF_P);
    bf16_t* UcT = (bf16_t*)(lws(p) + OFF_UCT);
    const float* cw = p.hy_conv_w + (size_t)gi.l * 3 * 3072; const float* cb = p.hy_conv_b + (size_t)gi.l * 3072;
    for (int u = bid; u < 128 * 48; u += nb) {
        const int rt = u / 48, ct = u % 48, row0 = rt * 64, j0 = ct * 64;
        const int t = tid >> 3, js = tid & 7, row = row0 + t, tpos = row & (L - 1), j = j0 + js * 8;
        const bf16_t* pr = P + (size_t)row * NP + C_HY + j;
        const u32x4 z4 = (u32x4){0u, 0u, 0u, 0u};
        const u32x4 um = tpos > 0 ? *(const u32x4*)(pr - NP) : z4, u0 = *(const u32x4*)pr, up = tpos < L - 1 ? *(const u32x4*)(pr + NP) : z4;
        __syncthreads();
#pragma unroll
        for (int q = 0; q < 4; ++q) {
            const float o0 = cb[j + 2 * q] + cw[j + 2 * q] * bflo(um[q]) + cw[3072 + j + 2 * q] * bflo(u0[q]) + cw[6144 + j + 2 * q] * bflo(up[q]);
            const float o1 = cb[j + 2 * q + 1] + cw[j + 2 * q + 1] * bfhi(um[q]) + cw[3072 + j + 2 * q + 1] * bfhi(u0[q]) + cw[6144 + j + 2 * q + 1] * bfhi(up[q]);
            T[(js * 8 + 2 * q) * TP + t] = f2bf(o0); T[(js * 8 + 2 * q + 1) * TP + t] = f2bf(o1);
        }
        __syncthreads();
        const int jj = tid >> 3, ts = tid & 7;
        *(u32x4*)(UcT + (size_t)(j0 + jj) * GT + row0 + ts * 8) = *(const u32x4*)(T + jj * TP + ts * 8);
    }
}
DI void phase_hy_post(const Params& p, const GrpInfo gi, int bid, int nb) {
    const int tid = ltid();
    bf16_t* T = (bf16_t*)smem;
    const bf16_t* OcT = (const bf16_t*)(lws(p) + OFF_OCT);
    bf16_t* OC = (bf16_t*)(lws(p) + OFF_OABC) + 2048;
    for (int u = bid; u < 128 * 16; u += nb) {
        const int rt = u >> 4, ct = u & 15, row0 = rt * 64, c0 = ct * 64;
        const int c = tid >> 3, ts = tid & 7;
        const u32x4 w = *(const u32x4*)(OcT + (size_t)(c0 + c) * GT + row0 + ts * 8);
        __syncthreads();
#pragma unroll
        for (int q = 0; q < 4; ++q) { T[(ts * 8 + 2 * q) * TP + c] = (bf16_t)(w[q] & 0xffffu); T[(ts * 8 + 2 * q + 1) * TP + c] = (bf16_t)(w[q] >> 16); }
        __syncthreads();
        const int t = tid >> 3, cs = tid & 7;
        *(u32x4*)(OC + (size_t)(row0 + t) * 3072 + c0 + cs * 8) = *(const u32x4*)(T + t * TP + cs * 8);
    }
}

constexpr int HY_HF = 0;
constexpr int HY_Z = 16384;
constexpr int HY_ZERO = HY_Z + 20480;
constexpr int HY_HC = HY_ZERO + 64;
DI int hy_pitch(int L) { return (L + 96) * 2; }
DI int hy_zoff(int s) { return (s >> 5) * 80 + (s & 31) * 2; }
DI void hy_build_copies(int L, int tid) {
    const float* hf = (const float*)(smem + HY_HF);
    const int nch = (L + 64) / 8, pitch = hy_pitch(L);
    for (int ch = tid; ch < 8 * nch; ch += 512) {
        const int e = ch / nch, i8 = (ch % nch) * 8;
        float v[8];
#pragma unroll
        for (int j = 0; j < 8; ++j) { const int x = i8 + j - 32 + e; v[j] = (x >= 0 && x < L) ? hf[L - 1 - x] : 0.f; }
        u32x4 w; w.x = pk2(v[0], v[1]); w.y = pk2(v[2], v[3]); w.z = pk2(v[4], v[5]); w.w = pk2(v[6], v[7]);
        *(u32x4*)(smem + HY_HC + e * pitch + i8 * 2) = w;
    }
}
DI f32x16 hy_conv(int L, int lane, int tb_row0  , int t0) {
    const int m = lane & 31, kh = lane >> 5, e = (7 - (m & 7)) & 7, pitch = hy_pitch(L);
    const int ND = L / 16 + 2;
    int delta = -(L / 2) - 16;
    int aoff = HY_HC + e * pitch + (L / 2 - 1 - delta - m + 8 * kh - e + 32) * 2;
    f32x16 acc0, acc1;
#pragma unroll
    for (int i = 0; i < 16; ++i) { acc0[i] = 0.f; acc1[i] = 0.f; }
#define HY_LDB(dlt) ({ const int s0_ = t0 - (dlt); const bool inr_ = (unsigned)s0_ <= (unsigned)(L - 16); \
        const int zo_ = inr_ ? HY_Z + hy_zoff(tb_row0 - (dlt)) + 16 * kh : HY_ZERO; *(const bf16x8*)(smem + zo_); })
    bf16x8 a0 = *(const bf16x8*)(smem + aoff), a1 = *(const bf16x8*)(smem + aoff - 32);
    bf16x8 b0 = HY_LDB(delta), b1 = HY_LDB(delta + 16);
    for (int dl = 0; dl < ND; dl += 2) {
        delta += 32; aoff -= 64;
        const bf16x8 na0 = *(const bf16x8*)(smem + aoff), na1 = *(const bf16x8*)(smem + aoff - 32);
        const bf16x8 nb0 = HY_LDB(delta), nb1 = HY_LDB(delta + 16);
        acc0 = MFMA32(a0, b0, acc0);
        acc1 = MFMA32(a1, b1, acc1);
        a0 = na0; a1 = na1; b0 = nb0; b1 = nb1;
    }
#undef HY_LDB
    return acc0 + acc1;
}
DI void hy_conv_unit(const Params& p, const GrpInfo gi, int c, int tid_in) {
    int tid = tid_in; asm volatile("" : "+v"(tid));
    const int L = gi.L, lane = tid & 63, wid = tid >> 6, n = lane & 31, hi = lane >> 5;
    const int g = 32 * wid + n, tpl = L >> 5, b = g / tpl, t0 = (g % tpl) * 32, frow = b * L + t0;
    const bf16_t* UcT = (const bf16_t*)(lws(p) + OFF_UCT);
    bf16_t* OcT = (bf16_t*)(lws(p) + OFF_OCT);
    const float* f0 = filt_ptr(lws(p), gi.l, gi.latent ? 1 : 0) + (size_t)c * L;
    const float* f1 = f0 + (size_t)1024 * L;
    float* hf = (float*)(smem + HY_HF);
    __syncthreads();
    {
        const bf16_t* zg = UcT + (size_t)(2048 + c) * GT;
#pragma unroll
        for (int i = 0; i < 2; ++i) { const int s = (tid + 512 * i) * 8; *(u32x4*)(smem + HY_Z + hy_zoff(s)) = *(const u32x4*)(zg + s); }
        if (tid < 4) *(unsigned*)(smem + HY_ZERO + 4 * tid) = 0u;
        for (int i = tid * 4; i < L; i += 2048) *(f32x4*)(hf + i) = *(const f32x4*)(f0 + i);
    }
    __syncthreads();
    hy_build_copies(L, tid);
    __syncthreads();
    f32x16 acc = hy_conv(L, lane, frow, t0);
    const float bias0 = p.hy_bias[((size_t)gi.l * 2 + 0) * 1024 + c], bias1 = p.hy_bias[((size_t)gi.l * 2 + 1) * 1024 + c];
    u32x2 z1w[4];
#pragma unroll
    for (int gq = 0; gq < 4; ++gq) {
        const int fr = frow + 8 * gq + 4 * hi;
        const u32x2 xw = *(const u32x2*)(UcT + (size_t)c * GT + fr);
        const u32x2 zw = *(const u32x2*)(smem + HY_Z + hy_zoff(fr));
        const float o0 = bflo(xw.x) * (acc[4 * gq] + bias0 * bflo(zw.x)), o1 = bfhi(xw.x) * (acc[4 * gq + 1] + bias0 * bfhi(zw.x));
        const float o2 = bflo(xw.y) * (acc[4 * gq + 2] + bias0 * bflo(zw.y)), o3 = bfhi(xw.y) * (acc[4 * gq + 3] + bias0 * bfhi(zw.y));
        z1w[gq].x = pk2(o0, o1); z1w[gq].y = pk2(o2, o3);
    }
    __syncthreads();
#pragma unroll
    for (int gq = 0; gq < 4; ++gq) *(u32x2*)(smem + HY_Z + hy_zoff(frow + 8 * gq + 4 * hi)) = z1w[gq];
    for (int i = tid * 4; i < L; i += 2048) *(f32x4*)(hf + i) = *(const f32x4*)(f1 + i);
    __syncthreads();
    hy_build_copies(L, tid);
    __syncthreads();
    acc = hy_conv(L, lane, frow, t0);
#pragma unroll
    for (int gq = 0; gq < 4; ++gq) {
        const int fr = frow + 8 * gq + 4 * hi;
        const u32x2 xw = *(const u32x2*)(UcT + (size_t)(1024 + c) * GT + fr);
        const float o0 = bflo(xw.x) * (acc[4 * gq] + bias1 * bflo(z1w[gq].x)), o1 = bfhi(xw.x) * (acc[4 * gq + 1] + bias1 * bfhi(z1w[gq].x));
        const float o2 = bflo(xw.y) * (acc[4 * gq + 2] + bias1 * bflo(z1w[gq].y)), o3 = bfhi(xw.y) * (acc[4 * gq + 3] + bias1 * bfhi(z1w[gq].y));
        u32x2 w; w.x = pk2(o0, o1); w.y = pk2(o2, o3);
        *(u32x2*)(OcT + (size_t)c * GT + fr) = w;
    }
}
DI void phase_hy_conv(const Params& p, const GrpInfo gi, int bid, int nb) {
    const int tid = ltid();
    for (int c = bid; c < 1024; c += nb) hy_conv_unit(p, gi, c, tid);
}
constexpr float NA_QSCALE = 0.12751743074602468f;
constexpr float LOG2E = 1.4426950408889634f;

DI void phase_cache_cvt(const Params& p, int bid, int nb) {
    const int tid = ltid();
    bf16_t* T = (bf16_t*)smem;
    bf16_t* CK = (bf16_t*)(lws(p) + OFF_CK); bf16_t* CVT = (bf16_t*)(lws(p) + OFF_CVT);
    for (int u = bid; u < 8 * 2 * 8 * 4; u += nb) {
        const int bh = u >> 2, k0 = (u & 3) * 64;
        const int key = tid >> 3, ds = (tid & 7) * 16;
        const size_t src = ((size_t)bh * 256 + k0 + key) * 128 + ds;
        f32x4 kv[4], vv[4];
#pragma unroll
        for (int i = 0; i < 4; ++i) { kv[i] = *(const f32x4*)(p.cache_k + src + 4 * i); vv[i] = *(const f32x4*)(p.cache_v + src + 4 * i); }
        u32x4 w0, w1; w0.x = pk2(kv[0][0], kv[0][1]); w0.y = pk2(kv[0][2], kv[0][3]); w0.z = pk2(kv[1][0], kv[1][1]); w0.w = pk2(kv[1][2], kv[1][3]);
        w1.x = pk2(kv[2][0], kv[2][1]); w1.y = pk2(kv[2][2], kv[2][3]); w1.z = pk2(kv[3][0], kv[3][1]); w1.w = pk2(kv[3][2], kv[3][3]);
        *(u32x4*)(CK + src) = w0; *(u32x4*)(CK + src + 8) = w1;
        __syncthreads();
#pragma unroll
        for (int i = 0; i < 4; ++i)
#pragma unroll
            for (int j = 0; j < 4; ++j) T[(ds + 4 * i + j) * TP + key] = f2bf(vv[i][j]);
        __syncthreads();
        const int d = tid >> 2, ks = (tid & 3) * 16;
        bf16_t* dst = CVT + ((size_t)bh * 128 + d) * 256 + k0 + ks;
        *(u32x4*)dst = *(const u32x4*)(T + d * TP + ks); *(u32x4*)(dst + 8) = *(const u32x4*)(T + d * TP + ks + 8);
    }
}
DI void phase_na_prep2(const Params& p, const GrpInfo gi, int bid, int nb) {
    const int tid = ltid(), lane = tid & 63, wid = tid >> 6;
    const bf16_t* P = (const bf16_t*)(lws(p) + OFF_P);
    bf16_t* QN = (bf16_t*)(lws(p) + OFF_QN); bf16_t* KN = (bf16_t*)(lws(p) + OFF_KN); bf16_t* VTN = (bf16_t*)(lws(p) + OFF_VTN);
    const float gq0 = p.na_qnorm_g[gi.l * 128 + 2 * lane] * NA_QSCALE, gq1 = p.na_qnorm_g[gi.l * 128 + 2 * lane + 1] * NA_QSCALE;
    const float gk0 = p.na_knorm_g[gi.l * 128 + 2 * lane], gk1 = p.na_knorm_g[gi.l * 128 + 2 * lane + 1];
    for (int u = bid * 8 + wid; u < GT * 8; u += nb * 8) {
        const int row = u >> 3, h = u & 7;
        const unsigned qw = *(const unsigned*)(P + (size_t)row * NP + C_NQ + h * 128 + 2 * lane);
        const unsigned kw = *(const unsigned*)(P + (size_t)row * NP + C_NK + h * 128 + 2 * lane);
        const float q0 = bflo(qw), q1 = bfhi(qw), k0 = bflo(kw), k1 = bfhi(kw);
        const float qs = rsqrtf(wave_sum(q0 * q0 + q1 * q1, lane) * (1.0f / 128) + EPS), ks = rsqrtf(wave_sum(k0 * k0 + k1 * k1, lane) * (1.0f / 128) + EPS);
        const float b0 = k0 * ks * gk0, b1 = k1 * ks * gk1;
        *(unsigned*)(QN + (size_t)row * 1024 + h * 128 + 2 * lane) = pk2(q0 * qs * gq0, q1 * qs * gq1);
        *(unsigned*)(KN + (size_t)row * 1024 + h * 128 + 2 * lane) = pk2(b0, b1);
        if (!gi.latent) { const int b = row >> 8, t = row & 255; const size_t o = ((((size_t)b * DEPTH + gi.l) * 8 + h) * 256 + t) * 128 + 2 * lane;
            const unsigned vw = *(const unsigned*)(P + (size_t)row * NP + C_NV + h * 128 + 2 * lane);
            *(f32x2*)(lout(p) + OUT_CK + o) = (f32x2){b0, b1}; *(f32x2*)(lout(p) + OUT_CV + o) = (f32x2){bflo(vw), bfhi(vw)}; }
    }
    bf16_t* T = (bf16_t*)smem;
    const int L = gi.L;
    for (int u = bid; u < 128 * 8; u += nb) {
        const int cg = u >> 3, h = u & 7, row0 = cg * 64, seq = row0 / L, t0 = row0 & (L - 1);
        const int s = tid >> 3, ds = (tid & 7) * 16;
        const bf16_t* pv = P + (size_t)(row0 + s) * NP + C_NV + h * 128 + ds;
        const u32x4 w0 = *(const u32x4*)pv, w1 = *(const u32x4*)(pv + 8);
        __syncthreads();
#pragma unroll
        for (int j = 0; j < 4; ++j) { T[(ds + 2 * j) * TP + s] = (bf16_t)(w0[j] & 0xffffu); T[(ds + 2 * j + 1) * TP + s] = (bf16_t)(w0[j] >> 16);
                                      T[(ds + 8 + 2 * j) * TP + s] = (bf16_t)(w1[j] & 0xffffu); T[(ds + 8 + 2 * j + 1) * TP + s] = (bf16_t)(w1[j] >> 16); }
        __syncthreads();
        const int d = tid >> 2, sq = (tid & 3) * 16;
        bf16_t* dst = VTN + ((size_t)(seq * 8 + h) * 128 + d) * L + t0 + sq;
        *(u32x4*)dst = *(const u32x4*)(T + d * TP + sq); *(u32x4*)(dst + 8) = *(const u32x4*)(T + d * TP + sq + 8);
    }
}

typedef const __attribute__((address_space(1))) bf16_t* gbfp;
template <bool LOCAL> DI void na_block(const bf16_t* kb0, int kstride, int kA, const bf16_t* vb0, int vstride, int vA, const bf16x8 (&qB)[4], f32x4 (&O)[8], float& mrun, float& lrun,
                                       int lane, int r16, int q4, const float* rpb  , int rowoff0  , int wc0, int c, int cs) {
    const gbfp kb = (gbfp)kb0, vb = (gbfp)vb0;
    f32x4 st[8];
    const unsigned kvo = (unsigned)(r16 * kstride + 8 * q4), vvo = (unsigned)(r16 * vstride + 4 * q4);
    bf16x8 kbuf[2][4];
#define NA_LOADK(T_, slot) do { const gbfp kp_ = kb + (size_t)(((T_) >> 1) * kA + ((T_) & 1) * 16) * kstride; \
        _Pragma("unroll") for (int ks_ = 0; ks_ < 4; ++ks_) kbuf[slot][ks_] = *(const __attribute__((address_space(1))) bf16x8*)(kp_ + kvo + 32 * ks_); } while (0)
    NA_LOADK(0, 0);
#pragma unroll
    for (int T = 0; T < 8; ++T) {
        if (T < 7) NA_LOADK(T + 1, (T + 1) & 1);
        st[T] = (f32x4){0.f, 0.f, 0.f, 0.f};
#pragma unroll
        for (int ks = 0; ks < 4; ++ks) st[T] = MFMA16(kbuf[T & 1][ks], qB[ks], st[T]);
        __builtin_amdgcn_sched_barrier(0);
    }
#undef NA_LOADK
    float mx = -INFINITY;
#pragma unroll
    for (int T = 0; T < 8; ++T)
#pragma unroll
        for (int i = 0; i < 4; ++i) {
            if (LOCAL) { const int wr = T >> 1, gcol = wc0 + 16 * (T & 1) + 4 * q4 + i;
                const bool ok = gcol >= cs && gcol < cs + 16;
                const float bias = rpb[(rowoff0 + wr) * 31 + min(max(gcol - c + 15, 0), 30)];
                st[T][i] = ok ? st[T][i] + bias : -INFINITY; }
            mx = fmaxf(mx, st[T][i]);
        }
    mx = fmaxf(mx, __int_as_float(__builtin_amdgcn_ds_bpermute((lane ^ 16) << 2, __float_as_int(mx))));
    mx = fmaxf(mx, __int_as_float(__builtin_amdgcn_ds_bpermute((lane ^ 32) << 2, __float_as_int(mx))));
    const float mnew = fmaxf(mrun, mx), alpha = __builtin_amdgcn_exp2f(mrun - mnew);
    float ls = 0.f;
#pragma unroll
    for (int T = 0; T < 8; ++T)
#pragma unroll
        for (int i = 0; i < 4; ++i) { const float e = __builtin_amdgcn_exp2f(st[T][i] - mnew); st[T][i] = e; ls += e; }
    ls += __int_as_float(__builtin_amdgcn_ds_bpermute((lane ^ 16) << 2, __float_as_int(ls)));
    ls += __int_as_float(__builtin_amdgcn_ds_bpermute((lane ^ 32) << 2, __float_as_int(ls)));
    lrun = lrun * alpha + ls; mrun = mnew;
#pragma unroll
    for (int dT = 0; dT < 8; ++dT) O[dT] *= alpha;
    bf16x4 vbuf[2][8][2];
#define NA_LOADV(t_, slot) do { _Pragma("unroll") for (int dT_ = 0; dT_ < 8; ++dT_) { const gbfp vp_ = vb + (size_t)(16 * dT_) * vstride + (t_) * vA; \
        vbuf[slot][dT_][0] = *(const __attribute__((address_space(1))) bf16x4*)(vp_ + vvo); vbuf[slot][dT_][1] = *(const __attribute__((address_space(1))) bf16x4*)(vp_ + vvo + 16); } } while (0)
    NA_LOADV(0, 0);
#pragma unroll
    for (int t = 0; t < 4; ++t) {
        if (t < 3) NA_LOADV(t + 1, (t + 1) & 1);
        const bf16x8 bP = pack8(st[2 * t], st[2 * t + 1]);
#pragma unroll
        for (int dT = 0; dT < 8; ++dT) { const bf16x4 a0 = vbuf[t & 1][dT][0], a1 = vbuf[t & 1][dT][1];
            const bf16x8 a = (bf16x8){a0[0], a0[1], a0[2], a0[3], a1[0], a1[1], a1[2], a1[3]};
            O[dT] = MFMA16(a, bP, O[dT]); }
        __builtin_amdgcn_sched_barrier(0);
    }
#undef NA_LOADV
}
constexpr int LDS_RPB_OFF = 139264 + 512;
DI void na_load_rpb(const Params& p, int l, int tid) {
    float* rp = (float*)(smem + LDS_RPB_OFF);
    for (int i = tid; i < 8 * 465; i += 512) rp[i] = p.na_rpb[(size_t)l * 8 * 465 + i] * LOG2E;
}
DI void na_attn_unit(const Params& p, const GrpInfo gi, int u, int tid_in) {
    int tid = tid_in; asm volatile("" : "+v"(tid));
    const int lane0 = tid & 63, wid = __builtin_amdgcn_readfirstlane(tid >> 6), l = gi.l;
    const float* rp = (const float*)(smem + LDS_RPB_OFF);
    const bf16_t* QN = (const bf16_t*)(lws(p) + OFF_QN); const bf16_t* KN = (const bf16_t*)(lws(p) + OFF_KN); const bf16_t* VTN = (const bf16_t*)(lws(p) + OFF_VTN);
    const bf16_t* CK = (const bf16_t*)(lws(p) + OFF_CK); const bf16_t* CVT = (const bf16_t*)(lws(p) + OFF_CVT);
    bf16_t* OB = (bf16_t*)(lws(p) + OFF_OABC) + 1024;
    {
        int lane = lane0; asm volatile("" : "+v"(lane));
        const int r16 = lane & 15, q4 = lane >> 4;
        int qrow0, h, seq; int r = 0, c0 = 0;
        if (gi.latent) { const int sl = u >> 8, rp2 = u & 31; h = (u >> 5) & 7; seq = sl; r = 2 * rp2 + (wid >> 2); c0 = 16 * (wid & 3); qrow0 = sl * 4096 + r * 64 + c0; }
        else { const int b = u >> 4, half = u & 1; h = (u >> 1) & 7; seq = b; qrow0 = b * 256 + (half * 8 + wid) * 16; }
        bf16x8 qB[4];
#pragma unroll
        for (int ks = 0; ks < 4; ++ks) qB[ks] = *(const bf16x8*)(QN + (size_t)(qrow0 + r16) * 1024 + h * 128 + 32 * ks + 8 * q4);
        f32x4 O[8];
#pragma unroll
        for (int dT = 0; dT < 8; ++dT) O[dT] = (f32x4){0.f, 0.f, 0.f, 0.f};
        float mrun = -INFINITY, lrun = 0.f;
        if (gi.latent) {
            const int rs = min(max(r - 4, 0), 56), wc0 = min(max(c0 - 8, 0), 32), c = c0 + r16, cs = min(max(c - 8, 0), 48);
            const int bs = 2 * (gi.grp - 1) + seq;
#pragma unroll 1
            for (int hb = 0; hb < 2; ++hb)
                na_block<true>(KN + (size_t)(seq * 4096 + (rs + 4 * hb) * 64 + wc0) * 1024 + h * 128, 1024, 64, VTN + (size_t)(seq * 8 + h) * 128 * 4096 + (rs + 4 * hb) * 64 + wc0, 4096, 64,
                               qB, O, mrun, lrun, lane, r16, q4, rp + h * 465, rs + 4 * hb - r + 7, wc0, c, cs);
            const size_t cb = ((size_t)bs * DEPTH + l) * 8 + h;
#pragma unroll 1
            for (int hb = 0; hb < 2; ++hb)
                na_block<false>(CK + (cb * 256 + 128 * hb) * 128, 128, 32, CVT + cb * 128 * 256 + 128 * hb, 256, 32, qB, O, mrun, lrun, lane, r16, q4, rp, 0, 0, 0, 0);
        } else {
#pragma unroll 1
            for (int hb = 0; hb < 2; ++hb)
                na_block<false>(KN + (size_t)(seq * 256 + 128 * hb) * 1024 + h * 128, 1024, 32, VTN + (size_t)(seq * 8 + h) * 128 * 256 + 128 * hb, 256, 32, qB, O, mrun, lrun, lane, r16, q4, rp, 0, 0, 0, 0);
        }
        const float inv = 1.0f / lrun;
#pragma unroll
        for (int dT = 0; dT < 8; ++dT) { u32x2 w; w.x = pk2(O[dT][0] * inv, O[dT][1] * inv); w.y = pk2(O[dT][2] * inv, O[dT][3] * inv);
            *(u32x2*)(OB + (size_t)(qrow0 + r16) * 3072 + h * 128 + 16 * dT + 4 * q4) = w; }
    }
}
#define LAS3 __attribute__((address_space(3)))
#ifndef REPMASK
#define REPMASK 0
#endif
constexpr int LDS_MAIN = 139264, LDS_PARAMS = LDS_MAIN + 64, LDS_UNIT = LDS_MAIN + 32, LDS_BYTES = LDS_MAIN + 512 + 8 * 465 * 4;
static_assert(LDS_RPB_OFF == LDS_MAIN + 512 && LDS_BYTES <= 163840, "LDS map");
constexpr int CTR_WORD0 = XCD_BAR_WORDS, CTR_WORDS = 64 * 16;

DI Params lp() {
    ParamsU u;
#pragma unroll
    for (int i = 0; i < NPARAM; ++i) {
        const unsigned long long v = *(const LAS3 unsigned long long*)((LAS3 unsigned char*)smem + LDS_PARAMS + 8 * i);
        const unsigned lo = (unsigned)__builtin_amdgcn_readfirstlane((int)(unsigned)v), hi = (unsigned)__builtin_amdgcn_readfirstlane((int)(unsigned)(v >> 32));
        u.a[i] = ((unsigned long long)hi << 32) | lo;
    }
    return u.s;
}
DI const float* x_in_ptr(const Params& p, int grp, int l) {
    if (l == 0) return grp == 0 ? p.x_prompt : p.x_sample + (size_t)(grp - 1) * GT * DM;
    return grp == 0 ? p.out + OUT_YP : p.out + OUT_YS + (size_t)(grp - 1) * GT * DM;
}
DI float* x_out_ptr(const Params& p, int grp) { return grp == 0 ? p.out + OUT_YP : p.out + OUT_YS + (size_t)(grp - 1) * GT * DM; }

template <class Epi> DI void gemm_ph(const bf16_t* A, const bf16_t* Bt, int M, int N, int K, const Epi& E) {
    pg8::Gemm g; g.A = A; g.Bt = Bt; g.M = M; g.N = N; g.K = K; g.pad = 0;
    pg8::StaticOrder S; S.init(M, N, (int)gridDim.x, (int)blockIdx.x);
    pg8::gemm_phase<Epi, pg8::StaticOrder, false>((LAS3 unsigned char*)smem, g, S, E, nullptr);
}
struct ModPtrs { const float* mA; const float* mB; };
DI ModPtrs mod_ptrs(const Params& q, int grp, int l) {
    const int crA = grp == 0 ? 0 : 1 + 2 * (grp - 1), crB = grp == 0 ? 0 : crA + 1;
    const float* mod = (const float*)(q.ws + OFF_MOD);
    ModPtrs m; m.mA = mod + ((size_t)l * NCOND + crA) * (NMOD * DM); m.mB = mod + ((size_t)l * NCOND + crB) * (NMOD * DM); return m;
}

__global__ __launch_bounds__(512, 2) void k_mega(Params p) {
    const int bid = blockIdx.x, nb = gridDim.x;
    volatile LAS unsigned* xbw = (volatile LAS unsigned*)((LAS3 unsigned char*)smem + LDS_MAIN);
    if (threadIdx.x == 0) {
        xbw[0] = 0u; xbw[1] = 0u; xbw[2] = 0u; xbw[3] = 0u;
        ParamsU u; u.s = p;
#pragma unroll
        for (int i = 0; i < NPARAM; ++i) *(LAS3 unsigned long long*)((LAS3 unsigned char*)smem + LDS_PARAMS + 8 * i) = u.a[i];
    }
    __syncthreads();
    XcdBarrier bar;
    { const Params q = lp(); bar = xcd_barrier_post((unsigned*)(q.ws + OFF_BAR), xbw); }
    for (int rep_ = 0; rep_ < 1 + ((REPMASK >> 8) & 1); ++rep_) { const Params q = lp(); phase_convert(q, bid, nb); }
    { const Params q = lp(); phase_adaln(q, bid, nb); }
    { const Params q = lp(); phase_hyena_hid(q, bid, nb); }
    { const Params q = lp(); phase_cache_cvt(q, bid, nb); }
    xcd_barrier(bar);
    { const Params q = lp(); phase_filters(q, bid, nb); }
    xcd_barrier(bar);
    for (int l0 = 0; l0 < DEPTH; ++l0) for (int grp0 = 0; grp0 < NGRP; ++grp0) {
        int l = l0, grp = grp0; asm volatile("" : "+s"(l), "+s"(grp));
        const GrpInfo gi = grp_info(grp, l);
        for (int rep_ = 0; rep_ < 1 + ((REPMASK >> 0) & 1); ++rep_) { const Params q = lp(); phase_norm(q, x_in_ptr(q, grp, l), q.norm1_g + l * DM, l, grp, 0, DM, bid, nb); }
        xcd_barrier(bar);
        if ((REPMASK >> 9) & 1) { xcd_barrier(bar); xcd_barrier(bar); xcd_barrier(bar); xcd_barrier(bar); }
        for (int rep_ = 0; rep_ < 1 + ((REPMASK >> 1) & 1); ++rep_) { const Params q = lp(); gemm_ph((const bf16_t*)(q.ws + OFF_H), (const bf16_t*)(q.ws + OFF_WIN) + (size_t)l * NP * DM, GT, NP, DM, EpiStoreBf16<0>{(bf16_t*)(q.ws + OFF_P), NP, 0}); }
        xcd_barrier(bar);
        for (int rep_ = 0; rep_ < 1 + ((REPMASK >> 2) & 1); ++rep_) { const Params q = lp(); phase_gla_prep(q, gi, bid, nb); }
        for (int rep_ = 0; rep_ < 1 + ((REPMASK >> 2) & 1); ++rep_) { const Params q = lp(); phase_na_prep2(q, gi, bid, nb); }
        for (int rep_ = 0; rep_ < 1 + ((REPMASK >> 2) & 1); ++rep_) { const Params q = lp(); phase_hy_prep(q, gi, bid, nb); }
        xcd_barrier(bar);
        for (int rep_ = 0; rep_ < 1 + ((REPMASK >> 3) & 1); ++rep_) {
            const Params q = lp(); const int tid = ltid();
            na_load_rpb(q, l, tid);
            unsigned* head = (unsigned*)(q.ws + OFF_BAR) + CTR_WORD0 + 64 * (l * NGRP + grp) + 16 * rep_;
            volatile LAS3 int* su = (volatile LAS3 int*)((LAS3 unsigned char*)smem + LDS_UNIT);
            const int nscan = gi.nseq * 16, nhy = 1024, nna = 512, ntot = nscan + nhy + nna;
            for (;;) {
                __syncthreads();
                if (tid == 0) *su = (int)__hip_atomic_fetch_add(head, 1u, __ATOMIC_RELAXED, __HIP_MEMORY_SCOPE_AGENT);
                __syncthreads();
                const int u = __builtin_amdgcn_readfirstlane(*su);
                if (u >= ntot) break;
                if (u < nscan) { for (int r2 = 0; r2 < 1 + ((REPMASK >> 10) & 1); ++r2) gla_scan_unit(q, gi, u, tid); }
                else if (u < nscan + nhy) { for (int r2 = 0; r2 < 1 + ((REPMASK >> 4) & 1); ++r2) hy_conv_unit(q, gi, u - nscan, tid); }
                else { for (int r2 = 0; r2 < 1 + ((REPMASK >> 5) & 1); ++r2) na_attn_unit(q, gi, u - nscan - nhy, tid); }
            }
        }
        xcd_barrier(bar);
        for (int rep_ = 0; rep_ < 1 + ((REPMASK >> 6) & 1); ++rep_) { const Params q = lp(); phase_gla_post<true>(q, gi, bid, nb); }
        for (int rep_ = 0; rep_ < 1 + ((REPMASK >> 6) & 1); ++rep_) { const Params q = lp(); phase_hy_post(q, gi, bid, nb); }
        xcd_barrier(bar);
        { const Params q = lp();
          gemm_ph((const bf16_t*)(q.ws + OFF_OABC), (const bf16_t*)(q.ws + OFF_WBR) + (size_t)l * DM * 3072, GT, DM, 3072, EpiGate3{(const bf16_t*)(q.ws + OFF_P) + C_GATE, (bf16_t*)(q.ws + OFF_MBF), NP, 0}); }
        xcd_barrier(bar);
        { const Params q = lp(); const ModPtrs m = mod_ptrs(q, grp, l);
          gemm_ph((const bf16_t*)(q.ws + OFF_MBF), (const bf16_t*)(q.ws + OFF_WOUT) + (size_t)l * DM * DM, GT, DM, DM, EpiResid{x_in_ptr(q, grp, l), x_out_ptr(q, grp), m.mA + 2 * DM, m.mB + 2 * DM}); }
        xcd_barrier(bar);
        { const Params q = lp(); phase_norm(q, x_out_ptr(q, grp), q.norm2_g + l * DM, l, grp, 3 * DM, 4 * DM, bid, nb); }
        xcd_barrier(bar);
        for (int rep_ = 0; rep_ < 1 + ((REPMASK >> 7) & 1); ++rep_) { const Params q = lp(); gemm_ph((const bf16_t*)(q.ws + OFF_H), (const bf16_t*)(q.ws + OFF_W1) + (size_t)l * DFF * DM, GT, DFF, DM, EpiStoreBf16<1>{(bf16_t*)(q.ws + OFF_P), DFF, 0}); }
        xcd_barrier(bar);
        { const Params q = lp(); const ModPtrs m = mod_ptrs(q, grp, l);
          gemm_ph((const bf16_t*)(q.ws + OFF_P), (const bf16_t*)(q.ws + OFF_W2) + (size_t)l * DM * DFF, GT, DM, DFF, EpiResid{x_out_ptr(q, grp), x_out_ptr(q, grp), m.mA + 5 * DM, m.mB + 5 * DM}); }
        xcd_barrier(bar);
    }
}

extern "C" void kernel_launch(void* const* d_in, const int* in_sizes, int n_in, void* d_out, int out_size, void* d_ws, size_t ws_size, hipStream_t stream) {
    Params p{};
    const float** f = (const float**)&p;
    for (int i = 0; i < 33; ++i) f[i] = (const float*)d_in[i];
    p.out = (float*)d_out; p.ws = (unsigned char*)d_ws;
    if (ws_size < WS_END) { fprintf(stderr, "workspace too small: %zu < %zu\n", ws_size, (size_t)WS_END); return; }
    static int grid = 0;
    if (!grid) {
        int dev = 0, cus = 0, per_cu = 0;
        (void)hipGetDevice(&dev);
        (void)hipDeviceGetAttribute(&cus, hipDeviceAttributeMultiprocessorCount, dev);
        (void)hipFuncSetAttribute((const void*)k_mega, hipFuncAttributeMaxDynamicSharedMemorySize, LDS_BYTES);
        (void)hipOccupancyMaxActiveBlocksPerMultiprocessor(&per_cu, k_mega, 512, LDS_BYTES);
        grid = cus * (per_cu < 1 ? per_cu : 1);
        if (grid <= 0) { fprintf(stderr, "occupancy query failed: cus %d per_cu %d\n", cus, per_cu); grid = 0; return; }
    }
    (void)hipMemsetAsync(p.ws + OFF_BAR, 0, (XCD_BAR_WORDS + CTR_WORDS) * sizeof(unsigned), stream);
    hipLaunchKernelGGL(k_mega, dim3(grid), dim3(512), LDS_BYTES, stream, p);
}
```

```cpp
#include <hip/hip_runtime.h>
#include <stdint.h>
#include <stdio.h>

constexpr int DM = 2048, DFF = 8192, NMOD = 6, NCOND = 9;
constexpr int GT = 8192;
constexpr int NGRP = 5, DEPTH = 2;
constexpr int C_GQ = 0, C_GK = 512, C_GV = 1024, C_GG = 2048, C_GA = 3072, C_NQ = 3328, C_NK = 4352, C_NV = 5376, C_HY = 6400, C_GATE = 9472, NP = 15616;
constexpr int IN_TOTAL = 15392;
constexpr float EPS = 1e-6f;

typedef unsigned short bf16_t;
typedef float f32x4 __attribute__((ext_vector_type(4)));
typedef float f32x2 __attribute__((ext_vector_type(2)));
typedef unsigned u32x4 __attribute__((ext_vector_type(4)));
typedef unsigned u32x2 __attribute__((ext_vector_type(2)));
#define DI __device__ __forceinline__

DI int ltid() { int t = threadIdx.x; asm volatile("" : "+v"(t)); return t; }
DI float bf2f(bf16_t b) { return __uint_as_float(((unsigned)b) << 16); }
DI float bflo(unsigned w) { return __uint_as_float(w << 16); }
DI float bfhi(unsigned w) { return __uint_as_float(w & 0xffff0000u); }
DI bf16_t f2bf(float f) { unsigned u = __float_as_uint(f); u += 0x7FFFu + ((u >> 16) & 1u); return (bf16_t)(u >> 16); }
DI unsigned pk2(float lo, float hi) { return (unsigned)f2bf(lo) | ((unsigned)f2bf(hi) << 16); }
DI float sigmoidf_(float x) { return 1.0f / (1.0f + __expf(-x)); }
DI float wave_sum(float v, int lane) {
#pragma unroll
    for (int o = 32; o >= 1; o >>= 1) v += __int_as_float(__builtin_amdgcn_ds_bpermute((lane ^ o) << 2, __float_as_int(v))); return v; }
DI float wave_max(float v, int lane) {
#pragma unroll
    for (int o = 32; o >= 1; o >>= 1) v = fmaxf(v, __int_as_float(__builtin_amdgcn_ds_bpermute((lane ^ o) << 2, __float_as_int(v)))); return v; }

constexpr size_t al256(size_t x) { return (x + 255) & ~(size_t)255; }
constexpr size_t OFF_BAR  = 0;
constexpr size_t OFF_MOD  = 65536;
constexpr size_t OFF_HID  = OFF_MOD  + al256((size_t)DEPTH * NCOND * 12288 * 4);
constexpr size_t OFF_FILT = OFF_HID  + (size_t)DEPTH * 2 * 4096 * 64 * 4;
constexpr size_t FILT_L   = (size_t)2 * 1024 * (256 + 4096) * 4;
constexpr size_t OFF_WIN  = OFF_FILT + DEPTH * FILT_L;
constexpr size_t OFF_WBR  = OFF_WIN  + (size_t)DEPTH * NP * DM * 2;
constexpr size_t OFF_WOUT = OFF_WBR  + (size_t)DEPTH * 3 * DM * 1024 * 2;
constexpr size_t OFF_W1   = OFF_WOUT + (size_t)DEPTH * DM * DM * 2;
constexpr size_t OFF_W2   = OFF_W1   + (size_t)DEPTH * DFF * DM * 2;
constexpr size_t OFF_H    = OFF_W2   + (size_t)DEPTH * DFF * DM * 2;
constexpr size_t OFF_P    = OFF_H    + (size_t)GT * DM * 2;
constexpr size_t OFF_OF   = OFF_P    + (size_t)GT * NP * 2;
constexpr size_t OFF_OB   = OFF_OF   + (size_t)GT * 1024 * 4;
constexpr size_t OFF_OABC = OFF_OB   + (size_t)GT * 1024 * 4;
constexpr size_t OFF_M32  = OFF_OABC + (size_t)3 * GT * 1024 * 2;
constexpr size_t OFF_MBF  = OFF_M32  + (size_t)GT * DM * 4;
constexpr size_t OFF_QN   = OFF_MBF  + (size_t)GT * DM * 2;
constexpr size_t OFF_KN   = OFF_QN   + (size_t)GT * 1024 * 2;
constexpr size_t OFF_QF   = OFF_KN   + (size_t)GT * 1024 * 2;
constexpr size_t OFF_QB   = OFF_QF   + (size_t)GT * 512 * 2;
constexpr size_t OFF_KFT  = OFF_QB   + (size_t)GT * 512 * 2;
constexpr size_t OFF_KBT  = OFF_KFT  + (size_t)GT * 512 * 2;
constexpr size_t OFF_VT   = OFF_KBT  + (size_t)GT * 512 * 2;
constexpr size_t OFF_DEC  = OFF_VT   + (size_t)GT * 1024 * 2;
constexpr size_t OFF_OI   = OFF_DEC  + (size_t)2 * 128 * 512 * 4;
constexpr size_t OFF_UCT  = OFF_OI   + (size_t)GT * 1024 * 4;
constexpr size_t OFF_OCT  = OFF_UCT  + (size_t)3072 * GT * 2;
constexpr size_t OFF_VTN  = OFF_OCT  + (size_t)1024 * GT * 2;
constexpr size_t OFF_CK   = OFF_VTN  + (size_t)GT * 1024 * 2;
constexpr size_t OFF_CVT  = OFF_CK   + (size_t)8 * 2 * 8 * 256 * 128 * 2;
constexpr size_t WS_END   = OFF_CVT  + (size_t)8 * 2 * 8 * 256 * 128 * 2;
static_assert(WS_END < (size_t)1190000000, "workspace too large");

constexpr size_t OUT_YP = 0, OUT_YS = (size_t)32 * 256 * DM, OUT_ST = OUT_YS + (size_t)8 * 4096 * DM,
                 OUT_CK = OUT_ST + (size_t)32 * 2 * 2 * 4 * 128 * 256, OUT_CV = OUT_CK + (size_t)32 * 2 * 8 * 256 * 128;

struct Params {
    const float *x_prompt, *x_sample, *state_gla, *cache_k, *cache_v, *c, *c_ctx, *w_mod, *b_mod, *norm1_g, *norm2_g, *w_in, *gla_wa2, *gla_ba2, *gla_norm_g,
                *na_qnorm_g, *na_knorm_g, *na_rpb, *hy_conv_w, *hy_conv_b, *hy_f1_w, *hy_f1_b, *hy_f2_w, *hy_f2_b, *hy_f3_w, *hy_freq, *hy_bias,
                *w_br_a, *w_br_b, *w_br_c, *w_out, *w_mlp1, *w_mlp2;
    float* out; unsigned char* ws;
};
constexpr int NPARAM = 35;
union ParamsU { Params s; unsigned long long a[NPARAM]; };
static_assert(sizeof(Params) == NPARAM * 8, "Params must be 35 pointers");
DI unsigned char* lws(const Params& p) { unsigned char* w = p.ws; asm volatile("" : "+s"(w)); return w; }
DI float* lout(const Params& p) { float* w = p.out; asm volatile("" : "+s"(w)); return w; }
namespace pg8 {
#define PG8_LAS __attribute__((address_space(3)))
typedef unsigned short bf16_t;
typedef short bf16x8 __attribute__((ext_vector_type(8)));
typedef float f32x4 __attribute__((ext_vector_type(4)));
typedef unsigned u32x4 __attribute__((ext_vector_type(4)));
constexpr int BM = 256, BK = 64, HALF = 128, HTB = HALF * BK * 2  , STAGE_BYTES = 8 * HTB, NXCD = 8, WGM = 8;
__host__ __device__ __forceinline__ int lds_byte(int r, int c) { const int st = (r >> 4) * 2 + (c >> 5), rr = r & 15, cc = c & 31, ob = rr * 64 + cc * 2; return st * 1024 + (ob ^ (((ob >> 9) & 1) << 5)); }
__host__ __device__ __forceinline__ void stage_rc(int b, int& R, int& C) { const int st = b / 1024, sb = b % 1024, swz = sb ^ (((sb >> 9) & 1) << 5); R = (st >> 1) * 16 + swz / 64; C = (st & 1) * 32 + (swz % 64) / 2; }
__host__ __device__ __forceinline__ int perm32(int rho) { const int n = rho >> 4, i = rho & 15; return 8 * (i >> 2) + 4 * n + (i & 3); }
struct Unit { int pm, pn; };
struct Gemm { const bf16_t* A; const bf16_t* Bt; int M, N, K, pad; };
struct StaticOrder {
    int nM, nN, nwg, G, c;
    __host__ __device__ void init(int M, int N, int G_, int c_) { nM = M / BM; nN = N / BM; nwg = nM * nN; G = G_; c = c_; }
    __host__ __device__ bool next(int i, Unit& u) const {
        const long L = (long)i * G + c; if (L >= nwg) return false;
        int wgid = (int)L; { const int q = nwg / NXCD, r = nwg % NXCD, xcd = wgid % NXCD, off = wgid / NXCD; wgid = (xcd < r ? xcd * (q + 1) : r * (q + 1) + (xcd - r) * q) + off; }
        const int nig = WGM * nN, gid = wgid / nig, fm = gid * WGM, gsz = (nM - fm) < WGM ? (nM - fm) : WGM;
        u.pm = fm + ((wgid % nig) % gsz); u.pn = (wgid % nig) / gsz; return true;
    }
    __device__ __forceinline__ void a_ready(const Unit&) const {}
    __device__ __forceinline__ void done(const Unit&) const {}
};
__device__ __forceinline__ unsigned cvt_pk_bf16(float lo, float hi) { unsigned r; asm volatile("v_cvt_pk_bf16_f32 %0, %1, %2" : "=v"(r) : "v"(lo), "v"(hi)); return r; }
template <class Epi, class Sched, bool STAMP = false>
__device__ __forceinline__ void gemm_phase(PG8_LAS unsigned char* lds, const Gemm g, const Sched& S, const Epi& E, unsigned long long* stamps) {
    int tid_ = threadIdx.x; asm volatile("" : "+v"(tid_));
    const int tid = tid_, wid = __builtin_amdgcn_readfirstlane(tid >> 6), lane = tid & 63, wr = wid >> 2, wc = wid & 3, fr = lane & 15, fq = lane >> 4;
    const int K = g.K, nt = K / BK;
    int ts_lo = 0, ts_hi = 0, nts = 0; const unsigned long long rt_entry = STAMP ? (unsigned long long)wall_clock64() : 0ull;
#define PG8_STAMP() do { if (STAMP && wid == 0 && nts < 64) { const unsigned long long _c = (unsigned long long)clock64(); \
        ts_lo = (lane == nts) ? (int)(unsigned)_c : ts_lo; ts_hi = (lane == nts) ? (int)(unsigned)(_c >> 32) : ts_hi; ++nts; } } while (0)
    PG8_STAMP();
    unsigned voffA[2], voffB[2];
#pragma unroll
    for (int i = 0; i < 2; ++i) { int R, C; stage_rc(tid * 16 + i * 8192, R, C); const int Rb = Epi::PERM ? ((R & ~31) + perm32(R & 31)) : R;
        voffA[i] = (unsigned)(R * K + C) * 2u; voffB[i] = (unsigned)(Rb * K + C) * 2u; }
    const size_t kstep = (size_t)(BK * 2);
    const size_t hstep = (size_t)HALF * K * 2;
    const size_t tstep = 2 * hstep;
    const unsigned ldsw = (unsigned)wid * 1024u;
    const int aoff = lds_byte(wr * 64 + fr, fq * 8), boff = lds_byte(wc * 32 + fr, fq * 8);
#define PG8_SA(b, h) (((b) * 2 + (h)) * HTB)
#define PG8_SB(b, h) ((4 + (b) * 2 + (h)) * HTB)
#define PG8_STAGE(bufoff, gbase, voff) do { _Pragma("unroll") for (int _i = 0; _i < 2; ++_i) \
        __builtin_amdgcn_global_load_lds((const unsigned*)((const char*)(gbase) + (voff)[_i]), (PG8_LAS unsigned*)(lds + (bufoff) + ldsw + _i * 8192), 16, 0, 0); } while (0)
#define PG8_LDA(dst, b, h) do { _Pragma("unroll") for (int m = 0; m < 4; ++m) _Pragma("unroll") for (int k = 0; k < 2; ++k) dst[m][k] = *(const PG8_LAS bf16x8*)(lds + PG8_SA(b, h) + aoff + m * 2048 + k * 1024); } while (0)
#define PG8_LDB(dst, b, h) do { _Pragma("unroll") for (int n = 0; n < 2; ++n) _Pragma("unroll") for (int k = 0; k < 2; ++k) dst[n][k] = *(const PG8_LAS bf16x8*)(lds + PG8_SB(b, h) + boff + n * 2048 + k * 1024); } while (0)
#define PG8_MMA(ai, bj, At, Bt) do { __builtin_amdgcn_s_setprio(1); _Pragma("unroll") for (int m = 0; m < 4; ++m) _Pragma("unroll") for (int n = 0; n < 2; ++n) _Pragma("unroll") for (int k = 0; k < 2; ++k) \
        acc[ai][bj][m][n] = __builtin_amdgcn_mfma_f32_16x16x32_bf16(Bt[n][k], At[m][k], acc[ai][bj][m][n], 0, 0, 0); __builtin_amdgcn_s_setprio(0); } while (0)
#define PG8_WAIT_V(n) asm volatile("s_waitcnt vmcnt(" #n ")" ::: "memory")
#define PG8_WAIT_L(n) asm volatile("s_waitcnt lgkmcnt(" #n ")" ::: "memory")
#define PG8_BAR __builtin_amdgcn_s_barrier()
#define PG8_SCHED __builtin_amdgcn_sched_barrier(0)
    Unit cur, nxt; int ui = 0;
    if (!S.next(0, cur)) return;
    f32x4 acc[2][2][4][2];
#pragma unroll
    for (int a = 0; a < 2; ++a)
#pragma unroll
        for (int b = 0; b < 2; ++b)
#pragma unroll
            for (int m = 0; m < 4; ++m)
#pragma unroll
                for (int n = 0; n < 2; ++n) acc[a][b][m][n] = (f32x4){0.f, 0.f, 0.f, 0.f};
    bf16x8 At[4][2], B0[2][2], B1[2][2];
    const char* cA = (const char*)g.A + (size_t)cur.pm * tstep; const char* cB = (const char*)g.Bt + (size_t)cur.pn * tstep;
    S.a_ready(cur);
    PG8_STAGE(PG8_SB(0, 0), cB, voffB); PG8_STAGE(PG8_SA(0, 0), cA, voffA); PG8_STAGE(PG8_SB(0, 1), cB + hstep, voffB); PG8_STAGE(PG8_SA(0, 1), cA + hstep, voffA);
    if (wr == 1) PG8_BAR;
    PG8_WAIT_V(4); PG8_BAR;
    PG8_STAGE(PG8_SB(1, 0), cB + kstep, voffB); PG8_STAGE(PG8_SA(1, 0), cA + kstep, voffA); PG8_STAGE(PG8_SB(1, 1), cB + hstep + kstep, voffB);
    PG8_WAIT_V(6); PG8_BAR;
    PG8_STAMP();
    for (;;) {
        const bool has_next = S.next(ui + 1, nxt);
        const char* nA = has_next ? (const char*)g.A + (size_t)nxt.pm * tstep : cA; const char* nB = has_next ? (const char*)g.Bt + (size_t)nxt.pn * tstep : cB;
        for (int t = 0; t < nt; t += 2) {
            if constexpr (Epi::KHOOK) { if (t == E.kh0 || t == E.kh1) E.khook(acc, cur, t, wr, wc, fr, fq); }
            const bool last = (t == nt - 2);
            const char* a1 = cA + (size_t)(t + 1) * kstep;
            const char* a2 = last ? nA : cA + (size_t)(t + 2) * kstep; const char* b2 = last ? nB : cB + (size_t)(t + 2) * kstep;
            const char* a3 = a2 + kstep; const char* b3 = b2 + kstep;
            if (last && has_next) S.a_ready(nxt);
            PG8_LDB(B0, 0, 0); PG8_SCHED; PG8_LDA(At, 0, 0); PG8_STAGE(PG8_SA(1, 1), a1 + hstep, voffA);
            PG8_WAIT_L(8); PG8_BAR; PG8_WAIT_L(0); PG8_MMA(0, 0, At, B0); PG8_BAR; PG8_SCHED;
            PG8_LDB(B1, 0, 1); PG8_STAGE(PG8_SB(0, 0), b2, voffB);
            PG8_BAR; PG8_WAIT_L(0); PG8_MMA(0, 1, At, B1); PG8_BAR;
            PG8_LDA(At, 0, 1); PG8_STAGE(PG8_SA(0, 0), a2, voffA);
            PG8_BAR; PG8_WAIT_L(0); PG8_MMA(1, 0, At, B0); PG8_BAR; PG8_SCHED;
            PG8_STAGE(PG8_SB(0, 1), b2 + hstep, voffB);
            PG8_WAIT_V(6); PG8_BAR; PG8_MMA(1, 1, At, B1); PG8_BAR;
            PG8_LDB(B0, 1, 0); PG8_SCHED; PG8_LDA(At, 1, 0); PG8_STAGE(PG8_SA(0, 1), a2 + hstep, voffA);
            PG8_WAIT_L(8); PG8_BAR; PG8_WAIT_L(0); PG8_MMA(0, 0, At, B0); PG8_BAR; PG8_SCHED;
            PG8_LDB(B1, 1, 1); PG8_STAGE(PG8_SB(1, 0), b3, voffB);
            PG8_BAR; PG8_WAIT_L(0); PG8_MMA(0, 1, At, B1); PG8_BAR;
            PG8_LDA(At, 1, 1); PG8_STAGE(PG8_SA(1, 0), a3, voffA);
            PG8_BAR; PG8_WAIT_L(0); PG8_MMA(1, 0, At, B0); PG8_BAR; PG8_SCHED;
            PG8_STAGE(PG8_SB(1, 1), b3 + hstep, voffB);
            PG8_WAIT_V(6); PG8_BAR; PG8_MMA(1, 1, At, B1); PG8_BAR;
        }
        PG8_STAMP();
        if constexpr (!Epi::AFTER_DRAIN) { E(acc, cur, wr, wc, fr, fq); S.done(cur); }
        PG8_STAMP();
        if (!has_next) break;
#pragma unroll
        for (int a = 0; a < 2; ++a)
#pragma unroll
            for (int b = 0; b < 2; ++b)
#pragma unroll
                for (int m = 0; m < 4; ++m)
#pragma unroll
                    for (int n = 0; n < 2; ++n) acc[a][b][m][n] = (f32x4){0.f, 0.f, 0.f, 0.f};
        cur = nxt; cA = nA; cB = nB; ++ui;
    }
    PG8_WAIT_V(0);
    if (wr == 0) PG8_BAR;
    PG8_BAR;
    if constexpr (Epi::AFTER_DRAIN) { E.fused(acc, cur, wr, wc, fr, fq, lds, wid, lane); S.done(cur); }
    PG8_STAMP();
    if (STAMP && wid == 0) { stamps[lane] = lane < nts ? (((unsigned long long)(unsigned)ts_hi << 32) | (unsigned)ts_lo) : 0ull;
        if (lane == 62) stamps[62] = rt_entry; if (lane == 63) stamps[63] = (unsigned long long)wall_clock64(); }
#undef PG8_STAMP
#undef PG8_SA
#undef PG8_SB
#undef PG8_STAGE
#undef PG8_LDA
#undef PG8_LDB
#undef PG8_MMA
#undef PG8_WAIT_V
#undef PG8_WAIT_L
#undef PG8_BAR
#undef PG8_SCHED
}
}
#define XB_TMO      128
#define XB_XCNT(j)  (256  + 64 * (j))
#define XB_XSUB(j)  (1280 + 64 * (j))
#define XB_XGEN(j)  (2304 + 64 * (j))
#define XB_TOP      3328
#define XB_TOPGEN   3392
#define XCD_BAR_WORDS 3456
#define XB_SPIN_CAP (1u << 18)
#define LAS __attribute__((address_space(3)))

__device__ __forceinline__ unsigned xb_ld(unsigned* p)              { return __hip_atomic_load(p, __ATOMIC_RELAXED, __HIP_MEMORY_SCOPE_AGENT); }
__device__ __forceinline__ unsigned xb_add(unsigned* p, unsigned v) { return __hip_atomic_fetch_add(p, v, __ATOMIC_RELAXED, __HIP_MEMORY_SCOPE_AGENT); }
__device__ __forceinline__ unsigned xb_xcc_id() { return (unsigned)__builtin_amdgcn_s_getreg((3 << 11) | 20) & 0xFu; }
#define XB_SPIN(cond, bar) do { unsigned _sp = 0; while (cond) { __builtin_amdgcn_s_sleep(1); \
    if ((++_sp & 255u) == 0u) { if (xb_ld(&(bar)[XB_TMO])) break; if (_sp > XB_SPIN_CAP) { atomicAdd(&(bar)[XB_TMO], 1u); break; } } } } while (0)

struct XcdBarrier {
    unsigned* bar; unsigned x;
    volatile LAS unsigned* st;
};

__device__ __forceinline__ XcdBarrier xcd_barrier_post(unsigned* bar, volatile LAS unsigned* st) {
    XcdBarrier b; b.bar = bar; b.x = (unsigned)__builtin_amdgcn_readfirstlane((int)xb_xcc_id()); b.st = st;
    if (threadIdx.x == 0) (void)xb_add(&bar[XB_XCNT(b.x)], 1u);
    return b;
}
__device__ __forceinline__ void xcd_barrier_complete(unsigned* bar, unsigned x, unsigned& nloc, unsigned& nx) {
    const unsigned G = gridDim.x * gridDim.y * gridDim.z;
    unsigned sum, cnt, mine, sp = 0u;
    for (;;) {
        sum = 0u; cnt = 0u; mine = 0u;
#pragma unroll
        for (unsigned j = 0; j < 16; ++j) { const unsigned c = xb_ld(&bar[XB_XCNT(j)]); sum += c; cnt += (c > 0u) ? 1u : 0u; mine = (j == x) ? c : mine; }
        if (sum == G) break;
        __builtin_amdgcn_s_sleep(1);
        if ((++sp & 255u) == 0u) { if (xb_ld(&bar[XB_TMO])) break; if (sp > XB_SPIN_CAP) { atomicAdd(&bar[XB_TMO], 1u); break; } }
    }
    nloc = mine > 0u ? mine : 1u; nx = cnt > 0u ? cnt : 1u;
}

__device__ __forceinline__ void xcd_barrier(const XcdBarrier& b) {
    asm volatile("s_waitcnt vmcnt(0)" ::: "memory");
    __syncthreads();
    if (threadIdx.x == 0) {
        unsigned* bar = b.bar; unsigned bx = b.x; asm volatile("" : "+s"(bx));
        __builtin_amdgcn_s_waitcnt(0);
        unsigned nloc = b.st[0], nx = b.st[1];
        if (nloc == 0u) { xcd_barrier_complete(bar, bx, nloc, nx); b.st[0] = nloc; b.st[1] = nx; }
        const unsigned old = xb_add(&bar[XB_XSUB(bx)], 1u);
        const unsigned gen = old / nloc;
        if (old + 1u == (gen + 1u) * nloc) {
            __builtin_amdgcn_fence(__ATOMIC_RELEASE, "agent");
            asm volatile("s_waitcnt vmcnt(0)" ::: "memory");
            const unsigned og = xb_add(&bar[XB_TOP], 1u);
            const unsigned tg = og / nx;
            if (og + 1u == (tg + 1u) * nx) xb_add(&bar[XB_TOPGEN], 1u);
            else XB_SPIN(xb_ld(&bar[XB_TOPGEN]) == tg, bar);
            __builtin_amdgcn_fence(__ATOMIC_ACQUIRE, "agent");
            xb_add(&bar[XB_XGEN(bx)], 1u);
            asm volatile("s_waitcnt vmcnt(0)" ::: "memory");
        } else {
            XB_SPIN(xb_ld(&bar[XB_XGEN(bx)]) == gen, bar);
            __builtin_amdgcn_fence(__ATOMIC_ACQUIRE, "agent");
            asm volatile("s_waitcnt vmcnt(0)" ::: "memory");
        }
    }
    __syncthreads();
}

extern __shared__ __attribute__((aligned(16))) unsigned char smem[];

DI void convT_tile(const float* __restrict__ src, int ldsrc, bf16_t* __restrict__ dst, int K  , int tile, int ntn, bool inmap) {
    float* t = (float*)smem;
    const int tid = ltid(), tk = tile / ntn, tn = tile % ntn, k0 = tk * 64, n0 = tn * 64;
    __syncthreads();
#pragma unroll
    for (int r = 0; r < 8; ++r) {
        const int i = (tid >> 6) + 8 * r, j = tid & 63, n = n0 + j;
        int sn = n; bool z = false;
        if (inmap) { if (n >= 3104 && n < C_NQ) z = true; else if (n >= C_NQ) sn = n - 224; }
        t[i * 65 + j] = z ? 0.f : src[(size_t)(k0 + i) * ldsrc + sn];
    }
    __syncthreads();
    const int j = tid >> 3, i8 = (tid & 7) * 8;
    u32x4 w;
    w.x = pk2(t[(i8 + 0) * 65 + j], t[(i8 + 1) * 65 + j]); w.y = pk2(t[(i8 + 2) * 65 + j], t[(i8 + 3) * 65 + j]);
    w.z = pk2(t[(i8 + 4) * 65 + j], t[(i8 + 5) * 65 + j]); w.w = pk2(t[(i8 + 6) * 65 + j], t[(i8 + 7) * 65 + j]);
    *(u32x4*)(dst + (size_t)(n0 + j) * K + k0 + i8) = w;
}
DI void phase_convert(const Params& p, int bid, int nb) {
    for (int l = 0; l < DEPTH; ++l) {
        { const int ntn = NP / 64, nt = (DM / 64) * ntn; bf16_t* d = (bf16_t*)(lws(p) + OFF_WIN) + (size_t)l * NP * DM;
          for (int t = bid; t < nt; t += nb) convT_tile(p.w_in + (size_t)l * DM * IN_TOTAL, IN_TOTAL, d, DM, t, ntn, true); }
        for (int br = 0; br < 3; ++br) { const float* s = (br == 0 ? p.w_br_a : br == 1 ? p.w_br_b : p.w_br_c) + (size_t)l * 1024 * DM;
          const int ntn = DM / 64, nt = (1024 / 64) * ntn; bf16_t* d = (bf16_t*)(lws(p) + OFF_WBR) + (size_t)l * DM * 3072 + br * 1024;
          for (int t = bid; t < nt; t += nb) convT_tile(s, DM, d, 3072, t, ntn, false); }
        { const int ntn = DM / 64, nt = (DM / 64) * ntn; bf16_t* d = (bf16_t*)(lws(p) + OFF_WOUT) + (size_t)l * DM * DM;
          for (int t = bid; t < nt; t += nb) convT_tile(p.w_out + (size_t)l * DM * DM, DM, d, DM, t, ntn, false); }
        { const int ntn = DFF / 64, nt = (DM / 64) * ntn; bf16_t* d = (bf16_t*)(lws(p) + OFF_W1) + (size_t)l * DFF * DM;
          for (int t = bid; t < nt; t += nb) convT_tile(p.w_mlp1 + (size_t)l * DM * DFF, DFF, d, DM, t, ntn, false); }
        { const int ntn = DM / 64, nt = (DFF / 64) * ntn; bf16_t* d = (bf16_t*)(lws(p) + OFF_W2) + (size_t)l * DM * DFF;
          for (int t = bid; t < nt; t += nb) convT_tile(p.w_mlp2 + (size_t)l * DFF * DM, DM, d, DFF, t, ntn, false); }
    }
}

DI void phase_adaln(const Params& p, int bid, int nb) {
    float* sc = (float*)smem;
    float* red = sc + NCOND * DM;
    const int tid = ltid();
    __syncthreads();
    for (int i = tid; i < NCOND * DM; i += 512) { const int r = i / DM, k = i % DM; const float v = r == 0 ? p.c_ctx[k] : p.c[(size_t)(r - 1) * DM + k]; sc[i] = v * sigmoidf_(v); }
    __syncthreads();
    const int nun = DEPTH * (NMOD * DM / 64);
    for (int u = bid; u < nun; u += nb) {
        const int l = u / (NMOD * DM / 64), j0 = (u % (NMOD * DM / 64)) * 64, j = tid & 63, ks = tid >> 6;
        const float* w = p.w_mod + (size_t)l * DM * (NMOD * DM) + j0 + j;
        float acc[NCOND];
#pragma unroll
        for (int r = 0; r < NCOND; ++r) acc[r] = 0.f;
        for (int k = ks * 256; k < ks * 256 + 256; ++k) { const float wv = w[(size_t)k * (NMOD * DM)];
#pragma unroll
            for (int r = 0; r < NCOND; ++r) acc[r] += sc[r * DM + k] * wv; }
#pragma unroll
        for (int r = 0; r < NCOND; ++r) red[(ks * NCOND + r) * 64 + j] = acc[r];
        __syncthreads();
        for (int i = tid; i < NCOND * 64; i += 512) { const int r = i / 64, jj = i % 64; float s = p.b_mod[(size_t)l * NMOD * DM + j0 + jj];
#pragma unroll
            for (int q = 0; q < 8; ++q) s += red[(q * NCOND + r) * 64 + jj];
            ((float*)(lws(p) + OFF_MOD))[((size_t)l * NCOND + r) * (NMOD * DM) + j0 + jj] = s; }
        __syncthreads();
    }
}

DI void phase_hyena_hid(const Params& p, int bid, int nb) {
    float* zf = (float*)smem;
    float* h1 = zf + 8 * 36;
    const int tid = ltid(), tt = tid >> 6, j = tid & 63;
    const int nun = DEPTH * (256 / 8 + 4096 / 8);
    for (int u = bid; u < nun; u += nb) {
        const int l = u / 544, r = u % 544, ls = r < 32 ? 0 : 1, tb = ls ? r - 32 : r, L = ls ? 4096 : 256, t = tb * 8 + tt;
        const float tn = (float)t / (float)L;
        __syncthreads();
        if (j < 33) { float v; if (j == 0) v = tn; else { const int band = j <= 16 ? j : j - 16; const float ang = 6.283185307179586f * tn * (float)band; v = j <= 16 ? cosf(ang) : sinf(ang); } zf[tt * 36 + j] = v; }
        __syncthreads();
        const float fr = p.hy_freq[l * 64 + j];
        float a = p.hy_f1_b[l * 64 + j];
        for (int i = 0; i < 33; ++i) a += zf[tt * 36 + i] * p.hy_f1_w[((size_t)l * 33 + i) * 64 + j];
        h1[tt * 64 + j] = sinf(fr * a);
        __syncthreads();
        float b = p.hy_f2_b[l * 64 + j];
        for (int i = 0; i < 64; ++i) b += h1[tt * 64 + i] * p.hy_f2_w[((size_t)l * 64 + i) * 64 + j];
        ((float*)(lws(p) + OFF_HID))[(((size_t)l * 2 + ls) * 4096 + t) * 64 + j] = sinf(fr * b);
    }
}
DI const float* filt_ptr(const unsigned char* ws, int l, int ls) { return (const float*)(ws + OFF_FILT + (size_t)l * FILT_L) + (ls ? (size_t)2 * 1024 * 256 : 0); }
DI void phase_filters(const Params& p, int bid, int nb) {
    float* f3s = (float*)smem;
    float* red = f3s + 256;
    const int tid = ltid(), lane = tid & 63, wid = tid >> 6;
    const int nun = DEPTH * 2 * 512;
    for (int u = bid; u < nun; u += nb) {
        const int l = u / 1024, ls = (u / 512) & 1, cg = u % 512, L = ls ? 4096 : 256, col0 = cg * 4;
        __syncthreads();
        if (tid < 256) f3s[tid] = p.hy_f3_w[((size_t)l * 64 + (tid >> 2)) * 2048 + col0 + (tid & 3)];
        __syncthreads();
        const float* hid = (const float*)(lws(p) + OFF_HID) + ((size_t)l * 2 + ls) * 4096 * 64;
        float val[8][4]; float ss[4] = {0.f, 0.f, 0.f, 0.f};
        float delta[4];
#pragma unroll
        for (int cc = 0; cc < 4; ++cc) { const int c = (col0 + cc) & 1023; const float a = -3.0701134573253943f, b = -15.350567286626972f; delta[cc] = fabsf(a + (b - a) * ((float)c / 1023.0f)); }
#pragma unroll
        for (int i = 0; i < 8; ++i) {
            const int t = tid + 512 * i;
#pragma unroll
            for (int cc = 0; cc < 4; ++cc) val[i][cc] = 0.f;
            if (t < L) {
                const f32x4* hr = (const f32x4*)(hid + (size_t)t * 64);
                float a0 = 0.f, a1 = 0.f, a2 = 0.f, a3 = 0.f;
#pragma unroll
                for (int q = 0; q < 16; ++q) { const f32x4 hv = hr[q];
#pragma unroll
                    for (int e = 0; e < 4; ++e) { const f32x4 w = *(const f32x4*)(f3s + (q * 4 + e) * 4); a0 += hv[e] * w[0]; a1 += hv[e] * w[1]; a2 += hv[e] * w[2]; a3 += hv[e] * w[3]; } }
                const float dist = fabsf((float)t - (float)(L / 2)) * (2.0f / (float)L);
                val[i][0] = a0 * expf(-dist * delta[0]); val[i][1] = a1 * expf(-dist * delta[1]); val[i][2] = a2 * expf(-dist * delta[2]); val[i][3] = a3 * expf(-dist * delta[3]);
#pragma unroll
                for (int cc = 0; cc < 4; ++cc) ss[cc] += val[i][cc] * val[i][cc];
            }
        }
#pragma unroll
        for (int cc = 0; cc < 4; ++cc) { ss[cc] = wave_sum(ss[cc], lane); if (lane == 0) red[wid * 4 + cc] = ss[cc]; }
        __syncthreads();
        float sc[4];
#pragma unroll
        for (int cc = 0; cc < 4; ++cc) { float s = 0.f;
#pragma unroll
            for (int q = 0; q < 8; ++q) s += red[q * 4 + cc]; sc[cc] = rsqrtf(s + EPS); }
        float* fo = (float*)filt_ptr(lws(p), l, ls);
#pragma unroll
        for (int i = 0; i < 8; ++i) { const int t = tid + 512 * i; if (t < L) {
#pragma unroll
            for (int cc = 0; cc < 4; ++cc) { const int col = col0 + cc; fo[((size_t)(col >> 10) * 1024 + (col & 1023)) * L + t] = val[i][cc] * sc[cc]; } } }
    }
}

DI int cond_row(int grp, int row) { return grp == 0 ? 0 : 1 + 2 * (grp - 1) + (row >> 12); }
DI void phase_norm(const Params& p, const float* x, const float* g, int l, int grp, int shoff, int scoff, int bid, int nb) {
    const int tid = ltid(), lane = tid & 63, wid = tid >> 6;
    bf16_t* h = (bf16_t*)(lws(p) + OFF_H);
    for (int row = bid * 8 + wid; row < GT; row += nb * 8) {
        const float* xr = x + (size_t)row * DM;
        f32x4 v[8]; float ss = 0.f;
#pragma unroll
        for (int i = 0; i < 8; ++i) { v[i] = *(const f32x4*)(xr + i * 256 + lane * 4); ss += v[i][0] * v[i][0] + v[i][1] * v[i][1] + v[i][2] * v[i][2] + v[i][3] * v[i][3]; }
        ss = wave_sum(ss, lane);
        const float rs = rsqrtf(ss * (1.0f / DM) + EPS);
        const float* md = (const float*)(lws(p) + OFF_MOD) + ((size_t)l * NCOND + cond_row(grp, row)) * (NMOD * DM);
#pragma unroll
        for (int i = 0; i < 8; ++i) { const int c = i * 256 + lane * 4; const f32x4 gv = *(const f32x4*)(g + c), sh = *(const f32x4*)(md + shoff + c), sc = *(const f32x4*)(md + scoff + c);
            f32x4 o = v[i] * rs * gv * (sc + 1.0f) + sh; u32x2 w; w.x = pk2(o[0], o[1]); w.y = pk2(o[2], o[3]); *(u32x2*)(h + (size_t)row * DM + c) = w; }
    }
}
using pg8::Unit; using pg8::cvt_pk_bf16;
template <int ACT> struct EpiStoreBf16 {
    static constexpr bool PERM = true, AFTER_DRAIN = false, KHOOK = false;
    bf16_t* O; int ldc; int pad;
    __device__ __forceinline__ void operator()(const f32x4 (&acc)[2][2][4][2], const Unit& u, int wr, int wc, int fr, int fq) const {
        const int row0 = u.pm * 256 + wr * 64 + fr, col0 = u.pn * 256 + wc * 32 + 8 * fq;
#pragma unroll
        for (int ai = 0; ai < 2; ++ai)
#pragma unroll
            for (int m = 0; m < 4; ++m) { bf16_t* rowp = O + (size_t)(row0 + ai * 128 + m * 16) * ldc + col0;
#pragma unroll
                for (int bj = 0; bj < 2; ++bj) { f32x4 v0 = acc[ai][bj][m][0], v1 = acc[ai][bj][m][1];
                    if (ACT == 1) {
#pragma unroll
                        for (int j = 0; j < 4; ++j) { const float a = fmaxf(v0[j], 0.f), b = fmaxf(v1[j], 0.f); v0[j] = a * a; v1[j] = b * b; } }
                    u32x4 w; w.x = cvt_pk_bf16(v0[0], v0[1]); w.y = cvt_pk_bf16(v0[2], v0[3]); w.z = cvt_pk_bf16(v1[0], v1[1]); w.w = cvt_pk_bf16(v1[2], v1[3]);
                    *(u32x4*)(rowp + bj * 128) = w; } }
    }
};
struct EpiGate3 {
    static constexpr bool PERM = true, AFTER_DRAIN = false, KHOOK = true;
    static constexpr int kh0 = 16, kh1 = 32;
    const bf16_t* gate; bf16_t* mbf; int ldg; int pad;
    __device__ __forceinline__ void khook(f32x4 (&acc)[2][2][4][2], const Unit& u, int t, int wr, int wc, int fr, int fq) const {
        typedef const __attribute__((address_space(1))) unsigned char* gptr;
        typedef const __attribute__((address_space(1))) u32x4* gvec;
        const gptr gb = (gptr)gate;
        int fr_ = fr, fq_ = fq; asm volatile("" : "+v"(fr_), "+v"(fq_));
        const int bn = (t == kh0) ? 0 : DM;
        const unsigned off0 = (unsigned)(((u.pm * 256 + wr * 64 + fr_) * NP + bn + u.pn * 256 + wc * 32 + 8 * fq_) * 2);
#pragma unroll
        for (int ai = 0; ai < 2; ++ai)
#pragma unroll
            for (int m = 0; m < 4; ++m) {
#pragma unroll
                for (int bj = 0; bj < 2; ++bj) { const unsigned off = off0 + (unsigned)((ai * 128 + m * 16) * NP * 2 + bj * 256);
                    const u32x4 nw = *(gvec)(gb + off), dw = *(gvec)(gb + off + DM * 2);
                    float r[8];
#pragma unroll
                    for (int j = 0; j < 4; ++j) { r[2 * j] = (1.0f + __expf(-bflo(dw[j]))) / (1.0f + __expf(-bflo(nw[j]))); r[2 * j + 1] = (1.0f + __expf(-bfhi(dw[j]))) / (1.0f + __expf(-bfhi(nw[j]))); }
                    acc[ai][bj][m][0] *= (f32x4){r[0], r[1], r[2], r[3]}; acc[ai][bj][m][1] *= (f32x4){r[4], r[5], r[6], r[7]}; }
                asm volatile("" ::: "memory"); }
    }
    __device__ __forceinline__ void operator()(const f32x4 (&acc)[2][2][4][2], const Unit& u, int wr, int wc, int fr, int fq) const {
        const int row0 = u.pm * 256 + wr * 64 + fr, col0 = u.pn * 256 + wc * 32 + 8 * fq;
#pragma unroll
        for (int ai = 0; ai < 2; ++ai)
#pragma unroll
            for (int m = 0; m < 4; ++m) { const size_t row = (size_t)(row0 + ai * 128 + m * 16);
#pragma unroll
                for (int bj = 0; bj < 2; ++bj) { const int col = col0 + bj * 128;
                    const u32x4 gw = *(const u32x4*)(gate + row * ldg + 2 * DM + col);
                    f32x4 s0, s1;
                    s0[0] = sigmoidf_(bflo(gw.x)); s0[1] = sigmoidf_(bfhi(gw.x)); s0[2] = sigmoidf_(bflo(gw.y)); s0[3] = sigmoidf_(bfhi(gw.y));
                    s1[0] = sigmoidf_(bflo(gw.z)); s1[1] = sigmoidf_(bfhi(gw.z)); s1[2] = sigmoidf_(bflo(gw.w)); s1[3] = sigmoidf_(bfhi(gw.w));
                    const f32x4 v0 = acc[ai][bj][m][0] * s0, v1 = acc[ai][bj][m][1] * s1;
                    u32x4 w; w.x = cvt_pk_bf16(v0[0], v0[1]); w.y = cvt_pk_bf16(v0[2], v0[3]); w.z = cvt_pk_bf16(v1[0], v1[1]); w.w = cvt_pk_bf16(v1[2], v1[3]);
                    *(u32x4*)(mbf + row * DM + col) = w; } }
    }
};
struct EpiResid {
    static constexpr bool PERM = true, AFTER_DRAIN = false, KHOOK = false;
    const float* xin; float* xout; const float* gA; const float* gB;
    __device__ __forceinline__ void operator()(const f32x4 (&acc)[2][2][4][2], const Unit& u, int wr, int wc, int fr, int fq) const {
        const int row0 = u.pm * 256 + wr * 64 + fr, col0 = u.pn * 256 + wc * 32 + 8 * fq;
        const float* gv = (u.pm * 256 < 4096) ? gA : gB;
#pragma unroll
        for (int bj = 0; bj < 2; ++bj) { const int col = col0 + bj * 128; const f32x4 g0 = *(const f32x4*)(gv + col), g1 = *(const f32x4*)(gv + col + 4);
#pragma unroll
            for (int ai = 0; ai < 2; ++ai)
#pragma unroll
                for (int m = 0; m < 4; ++m) { const size_t o = (size_t)(row0 + ai * 128 + m * 16) * DM + col;
                    const f32x4 a0 = *(const f32x4*)(xin + o), a1 = *(const f32x4*)(xin + o + 4);
                    *(f32x4*)(xout + o) = a0 + g0 * acc[ai][bj][m][0]; *(f32x4*)(xout + o + 4) = a1 + g1 * acc[ai][bj][m][1]; } }
    }
};

struct GrpInfo { int grp, l, L, nseq, latent; };
DI GrpInfo grp_info(int grp, int l) { GrpInfo g; g.grp = grp; g.l = l; g.latent = grp > 0; g.L = grp ? 4096 : 256; g.nseq = grp ? 2 : 32; return g; }

template <bool WITH_OI> DI void phase_gla_post(const Params& p, GrpInfo gi, int bid, int nb) {
    const int tid = ltid(), lane = tid & 63, wid = tid >> 6;
    const bf16_t* P = (const bf16_t*)(lws(p) + OFF_P);
    const float* Of = (const float*)(lws(p) + OFF_OF); const float* Ob = (const float*)(lws(p) + OFF_OB); const float* Oi = (const float*)(lws(p) + OFF_OI);
    bf16_t* OA = (bf16_t*)(lws(p) + OFF_OABC);
    const f32x4 g = *(const f32x4*)(p.gla_norm_g + gi.l * 256 + lane * 4);
    for (int u = bid * 8 + wid; u < GT * 4; u += nb * 8) {
        const int row = u >> 2, h = u & 3; const size_t o = (size_t)row * 1024 + h * 256 + lane * 4, oa = (size_t)row * 3072 + h * 256 + lane * 4;
        f32x4 v = *(const f32x4*)(Of + o) + *(const f32x4*)(Ob + o); if (WITH_OI) v += *(const f32x4*)(Oi + o);
        const float rs = rsqrtf(wave_sum(v[0] * v[0] + v[1] * v[1] + v[2] * v[2] + v[3] * v[3], lane) * (1.0f / 256) + EPS);
        const u32x2 gw = *(const u32x2*)(P + (size_t)row * NP + C_GG + h * 256 + lane * 4);
        const float g0 = bflo(gw.x), g1 = bfhi(gw.x), g2 = bflo(gw.y), g3 = bfhi(gw.y);
        u32x2 w; w.x = pk2(v[0] * rs * g[0] * (g0 * sigmoidf_(g0)), v[1] * rs * g[1] * (g1 * sigmoidf_(g1)));
        w.y = pk2(v[2] * rs * g[2] * (g2 * sigmoidf_(g2)), v[3] * rs * g[3] * (g3 * sigmoidf_(g3)));
        *(u32x2*)(OA + oa) = w;
    }
}

typedef short bf16x8 __attribute__((ext_vector_type(8)));
typedef short bf16x4 __attribute__((ext_vector_type(4)));
#define MFMA16(a, b, c) __builtin_amdgcn_mfma_f32_16x16x32_bf16((a), (b), (c), 0, 0, 0)
constexpr int QKP = 136;
constexpr int TP = 80;
DI float log_sigmoid_fast(float x) { return fminf(x, 0.f) - __logf(1.0f + __expf(-fabsf(x))); }
DI bf16x8 pack8(const f32x4& a, const f32x4& b) { u32x4 w; w.x = pk2(a[0], a[1]); w.y = pk2(a[2], a[3]); w.z = pk2(b[0], b[1]); w.w = pk2(b[2], b[3]); return __builtin_bit_cast(bf16x8, w); }

DI void gla_prep_unit(const Params& p, const GrpInfo gi, int unit, int tid_in) {
    int tid = tid_in; asm volatile("" : "+v"(tid));
    const int cg = unit >> 2, h = unit & 3, row0 = cg * 64, t0 = row0 & (gi.L - 1), l = gi.l;
    const int lane = tid & 63, wid = tid >> 6, r16 = lane & 15, q4 = lane >> 4;
    float* laf = (float*)smem; float* lab = laf + 8192;
    bf16_t* QFs = (bf16_t*)(smem + 65536); bf16_t* KFs = QFs + 64 * QKP; bf16_t* QBs = KFs + 64 * QKP; bf16_t* KBs = QBs + 64 * QKP;
    bf16_t* VTs = (bf16_t*)smem; bf16_t* As = (bf16_t*)(smem + 40960);
    const bf16_t* P = (const bf16_t*)(lws(p) + OFF_P);
    __syncthreads();
    {
        const int t = tid >> 3, d0 = (tid & 7) * 16;
        const bf16_t* pr = P + (size_t)(row0 + t) * NP + C_GA;
        float ga[32];
#pragma unroll
        for (int i = 0; i < 4; ++i) { const u32x4 w = *(const u32x4*)(pr + 8 * i); ga[8 * i] = bflo(w.x); ga[8 * i + 1] = bfhi(w.x); ga[8 * i + 2] = bflo(w.y); ga[8 * i + 3] = bfhi(w.y); ga[8 * i + 4] = bflo(w.z); ga[8 * i + 5] = bfhi(w.z); ga[8 * i + 6] = bflo(w.w); ga[8 * i + 7] = bfhi(w.w); }
#pragma unroll
        for (int dir = 0; dir < 2; ++dir) {
            const float* wa = p.gla_wa2 + (((size_t)l * 2 + dir) * 16) * 512 + h * 128 + d0;
            const float* ba = p.gla_ba2 + ((size_t)l * 2 + dir) * 512 + h * 128 + d0;
            float* dst = (dir ? lab : laf) + t * 128 + d0;
#pragma unroll
            for (int j4 = 0; j4 < 4; ++j4) {
                f32x4 x = *(const f32x4*)(ba + 4 * j4);
#pragma unroll
                for (int r = 0; r < 16; ++r) x += *(const f32x4*)(wa + (size_t)r * 512 + 4 * j4) * ga[dir * 16 + r];
                f32x4 o; o[0] = log_sigmoid_fast(x[0]) * 0.0625f; o[1] = log_sigmoid_fast(x[1]) * 0.0625f; o[2] = log_sigmoid_fast(x[2]) * 0.0625f; o[3] = log_sigmoid_fast(x[3]) * 0.0625f;
                *(f32x4*)(dst + 4 * j4) = o;
            }
        }
    }
    __syncthreads();
    if (tid < 256) {
        const int d = tid & 127;
        if (tid < 128) { float a = 0.f; for (int t = 0; t < 64; ++t) { a += laf[t * 128 + d]; laf[t * 128 + d] = a; } }
        else { float a = 0.f; for (int t = 63; t >= 0; --t) { a += lab[t * 128 + d]; lab[t * 128 + d] = a; } }
    }
    __syncthreads();
    {
        const int t = tid >> 3, dlo = (tid & 7) * 8, ta = t0 + t;
        const bf16_t* pr = P + (size_t)(row0 + t) * NP + h * 128;
        const u32x4 qlw = *(const u32x4*)(pr + C_GQ + dlo), qhw = *(const u32x4*)(pr + C_GQ + 64 + dlo), klw = *(const u32x4*)(pr + C_GK + dlo), khw = *(const u32x4*)(pr + C_GK + 64 + dlo);
        float ql[8], qh[8], kl[8], kh[8];
#pragma unroll
        for (int j = 0; j < 4; ++j) { ql[2 * j] = bflo(qlw[j]); ql[2 * j + 1] = bfhi(qlw[j]); qh[2 * j] = bflo(qhw[j]); qh[2 * j + 1] = bfhi(qhw[j]); kl[2 * j] = bflo(klw[j]); kl[2 * j + 1] = bfhi(klw[j]); kh[2 * j] = bflo(khw[j]); kh[2 * j + 1] = bfhi(khw[j]); }
#pragma unroll
        for (int j = 0; j < 8; ++j) {
            ql[j] *= 0.08838834764831845f; qh[j] *= 0.08838834764831845f;
            if (gi.latent) {
                const int ii = dlo + j, f = ii & 31; const float pos = (float)(ii < 32 ? (ta >> 6) : (ta & 63));
                const float ang = pos * exp2f(-(float)f * 0.41524101186092029f); float sn, cs; sincosf(ang, &sn, &cs);
                const float a = ql[j] * cs - qh[j] * sn, b = ql[j] * sn + qh[j] * cs; ql[j] = a; qh[j] = b;
                const float c = kl[j] * cs - kh[j] * sn, e = kl[j] * sn + kh[j] * cs; kl[j] = c; kh[j] = e;
            }
        }
        float* DEC = (float*)(lws(p) + OFF_DEC);
#pragma unroll
        for (int dir = 0; dir < 2; ++dir) {
            const float* bb = dir ? lab : laf;
            bf16_t* Qs = dir ? QBs : QFs; bf16_t* Ks = dir ? KBs : KFs;
            bf16_t* Qg = (bf16_t*)(lws(p) + (dir ? OFF_QB : OFF_QF)) + (size_t)(row0 + t) * 512 + h * 128;
#pragma unroll
            for (int half = 0; half < 2; ++half) {
                const int d = dlo + 64 * half;
                const f32x4 b0 = *(const f32x4*)(bb + t * 128 + d), b1 = *(const f32x4*)(bb + t * 128 + d + 4);
                float qo[8], ko[8];
#pragma unroll
                for (int j = 0; j < 8; ++j) { const float bv = j < 4 ? b0[j] : b1[j - 4]; const float qv = half ? qh[j] : ql[j], kv = half ? kh[j] : kl[j]; qo[j] = qv * __expf(bv); ko[j] = kv * __expf(-bv); }
                u32x4 qw, kw; qw.x = pk2(qo[0], qo[1]); qw.y = pk2(qo[2], qo[3]); qw.z = pk2(qo[4], qo[5]); qw.w = pk2(qo[6], qo[7]);
                kw.x = pk2(ko[0], ko[1]); kw.y = pk2(ko[2], ko[3]); kw.z = pk2(ko[4], ko[5]); kw.w = pk2(ko[6], ko[7]);
                *(u32x4*)(Qs + t * QKP + d) = qw; *(u32x4*)(Ks + t * QKP + d) = kw; *(u32x4*)(Qg + d) = qw;
                if (t == 0) { const int te = dir ? 0 : 63; const f32x4 e0 = *(const f32x4*)(bb + te * 128 + d), e1 = *(const f32x4*)(bb + te * 128 + d + 4);
                    f32x4 x0, x1;
#pragma unroll
                    for (int j = 0; j < 4; ++j) { x0[j] = __expf(e0[j]); x1[j] = __expf(e1[j]); }
                    float* dp = DEC + ((size_t)dir * 128 + cg) * 512 + h * 128 + d; *(f32x4*)dp = x0; *(f32x4*)(dp + 4) = x1; }
            }
        }
    }
    __syncthreads();
    {
        const int s = tid >> 3, e0 = (tid & 7) * 32;
        const bf16_t* pv = P + (size_t)(row0 + s) * NP + C_GV + h * 256 + e0;
#pragma unroll
        for (int i = 0; i < 4; ++i) { const u32x4 w = *(const u32x4*)(pv + 8 * i);
#pragma unroll
            for (int j = 0; j < 4; ++j) { VTs[(e0 + 8 * i + 2 * j) * TP + s] = (bf16_t)(w[j] & 0xffffu); VTs[(e0 + 8 * i + 2 * j + 1) * TP + s] = (bf16_t)(w[j] >> 16); } }
        const int mt = wid >> 1, nt0 = 2 * (wid & 1);
        f32x4 acc[2][2];
#pragma unroll
        for (int dir = 0; dir < 2; ++dir) { const bf16_t* Qs = dir ? QBs : QFs; const bf16_t* Ks = dir ? KBs : KFs;
#pragma unroll
            for (int n = 0; n < 2; ++n) acc[dir][n] = (f32x4){0.f, 0.f, 0.f, 0.f};
#pragma unroll
            for (int ks = 0; ks < 4; ++ks) { const bf16x8 a = *(const bf16x8*)(Qs + (16 * mt + r16) * QKP + 32 * ks + 8 * q4);
#pragma unroll
                for (int n = 0; n < 2; ++n) { const bf16x8 b = *(const bf16x8*)(Ks + (16 * (nt0 + n) + r16) * QKP + 32 * ks + 8 * q4); acc[dir][n] = MFMA16(a, b, acc[dir][n]); } } }
#pragma unroll
        for (int n = 0; n < 2; ++n)
#pragma unroll
            for (int i = 0; i < 4; ++i) { const int t = 16 * mt + 4 * q4 + i, s2 = 16 * (nt0 + n) + r16;
                const float v = (s2 <= t ? acc[0][n][i] : 0.f) + (s2 >= t ? acc[1][n][i] : 0.f); As[t * TP + s2] = f2bf(v); }
        const int d = tid >> 2, sq = tid & 3;
#pragma unroll
        for (int dir = 0; dir < 2; ++dir) { const bf16_t* Ks = dir ? KBs : KFs; unsigned w[8];
#pragma unroll
            for (int j = 0; j < 8; ++j) w[j] = (unsigned)Ks[(sq * 16 + 2 * j) * QKP + d] | ((unsigned)Ks[(sq * 16 + 2 * j + 1) * QKP + d] << 16);
            bf16_t* kg = (bf16_t*)(lws(p) + (dir ? OFF_KBT : OFF_KFT)) + (((size_t)cg * 4 + h) * 128 + d) * 64 + sq * 16;
            *(u32x4*)kg = (u32x4){w[0], w[1], w[2], w[3]}; *(u32x4*)(kg + 8) = (u32x4){w[4], w[5], w[6], w[7]}; }
    }
    __syncthreads();
    {
        const int e = tid >> 1, hf = tid & 1;
        bf16_t* vg = (bf16_t*)(lws(p) + OFF_VT) + (((size_t)cg * 4 + h) * 256 + e) * 64 + hf * 32;
#pragma unroll
        for (int i = 0; i < 4; ++i) *(u32x4*)(vg + 8 * i) = *(const u32x4*)(VTs + e * TP + hf * 32 + 8 * i);
        float* OI = (float*)(lws(p) + OFF_OI);
#pragma unroll
        for (int n = 0; n < 2; ++n) { const int nt = 2 * wid + n;
            bf16x8 b[2];
#pragma unroll
            for (int ks = 0; ks < 2; ++ks) b[ks] = *(const bf16x8*)(VTs + (16 * nt + r16) * TP + 32 * ks + 8 * q4);
#pragma unroll
            for (int mt = 0; mt < 4; ++mt) { f32x4 acc = (f32x4){0.f, 0.f, 0.f, 0.f};
#pragma unroll
                for (int ks = 0; ks < 2; ++ks) { const bf16x8 a = *(const bf16x8*)(As + (16 * mt + r16) * TP + 32 * ks + 8 * q4); acc = MFMA16(a, b[ks], acc); }
#pragma unroll
                for (int i = 0; i < 4; ++i) OI[(size_t)(row0 + 16 * mt + 4 * q4 + i) * 1024 + h * 256 + 16 * nt + r16] = acc[i]; } }
    }
}
DI void phase_gla_prep(const Params& p, const GrpInfo gi, int bid, int nb) {
    const int tid = ltid();
    for (int u = bid; u < 512; u += nb) gla_prep_unit(p, gi, u, tid);
}

constexpr int SC_Q = 0, SC_K = 64 * QKP * 2, SC_V = SC_K + 128 * TP * 2, SC_D = SC_V + 128 * TP * 2, SC_BUF = SC_D + 512;
DI void gla_scan_unit(const Params& p, const GrpInfo gi, int unit, int tid_in) {
    int tid = tid_in; asm volatile("" : "+v"(tid));
    const int sl = unit >> 4, h = (unit >> 2) & 3, dir = (unit >> 1) & 1, eh = unit & 1, L = gi.L, NC = L >> 6, l = gi.l;
    const int lane = tid & 63, wid = tid >> 6, r16 = lane & 15, q4 = lane >> 4;
    const int ecol = eh * 128 + 16 * wid + r16;
    f32x4 S[8];
    if (gi.latent) { const int bs = 2 * (gi.grp - 1) + sl; const float* s0 = p.state_gla + ((((size_t)bs * DEPTH + l) * 2 + dir) * 4 + h) * 128 * 256 + ecol;
#pragma unroll
        for (int T = 0; T < 8; ++T)
#pragma unroll
            for (int i = 0; i < 4; ++i) S[T][i] = s0[(size_t)(16 * T + 4 * q4 + i) * 256]; }
    else {
#pragma unroll
        for (int T = 0; T < 8; ++T) S[T] = (f32x4){0.f, 0.f, 0.f, 0.f}; }
    const bf16_t* Qg = (const bf16_t*)(lws(p) + (dir ? OFF_QB : OFF_QF)); const bf16_t* Kg = (const bf16_t*)(lws(p) + (dir ? OFF_KBT : OFF_KFT)); const bf16_t* Vg = (const bf16_t*)(lws(p) + OFF_VT);
    const float* Dg = (const float*)(lws(p) + OFF_DEC) + (size_t)dir * 128 * 512;
    float* Og = (float*)(lws(p) + (dir ? OFF_OB : OFF_OF));
    u32x4 rq[2], rk[2], rv[2]; float rd = 0.f;
    const int qt0 = tid >> 4, qd = (tid & 15) * 8;
    const int kd0 = tid >> 3, ks8 = (tid & 7) * 8;
#define GLA_LOAD(c) do { const int cg_ = sl * NC + (c); const size_t r0_ = (size_t)cg_ * 64; \
        rq[0] = *(const u32x4*)(Qg + (r0_ + qt0) * 512 + h * 128 + qd); rq[1] = *(const u32x4*)(Qg + (r0_ + qt0 + 32) * 512 + h * 128 + qd); \
        rk[0] = *(const u32x4*)(Kg + (((size_t)cg_ * 4 + h) * 128 + kd0) * 64 + ks8); rk[1] = *(const u32x4*)(Kg + (((size_t)cg_ * 4 + h) * 128 + kd0 + 64) * 64 + ks8); \
        rv[0] = *(const u32x4*)(Vg + (((size_t)cg_ * 4 + h) * 256 + eh * 128 + kd0) * 64 + ks8); rv[1] = *(const u32x4*)(Vg + (((size_t)cg_ * 4 + h) * 256 + eh * 128 + kd0 + 64) * 64 + ks8); \
        if (tid < 128) rd = Dg[(size_t)cg_ * 512 + h * 128 + tid]; } while (0)
#define GLA_STORE(bufp) do { unsigned char* b_ = (bufp); \
        *(u32x4*)(b_ + SC_Q + (qt0 * QKP + qd) * 2) = rq[0]; *(u32x4*)(b_ + SC_Q + ((qt0 + 32) * QKP + qd) * 2) = rq[1]; \
        *(u32x4*)(b_ + SC_K + (kd0 * TP + ks8) * 2) = rk[0]; *(u32x4*)(b_ + SC_K + ((kd0 + 64) * TP + ks8) * 2) = rk[1]; \
        *(u32x4*)(b_ + SC_V + (kd0 * TP + ks8) * 2) = rv[0]; *(u32x4*)(b_ + SC_V + ((kd0 + 64) * TP + ks8) * 2) = rv[1]; \
        if (tid < 128) *(float*)(b_ + SC_D + tid * 4) = rd; } while (0)
    __syncthreads();
    GLA_LOAD(dir ? NC - 1 : 0);
    GLA_STORE(smem);
    __syncthreads();
    for (int ci = 0; ci < NC; ++ci) {
        const int c = dir ? NC - 1 - ci : ci;
        if (ci + 1 < NC) GLA_LOAD(dir ? c - 1 : c + 1);
        const unsigned char* buf = smem + (ci & 1) * SC_BUF;
        const bf16_t* Qs = (const bf16_t*)(buf + SC_Q); const bf16_t* Kt = (const bf16_t*)(buf + SC_K); const bf16_t* Vt = (const bf16_t*)(buf + SC_V); const float* Dv = (const float*)(buf + SC_D);
        bf16x8 bS[4];
#pragma unroll
        for (int ks = 0; ks < 4; ++ks) bS[ks] = pack8(S[2 * ks], S[2 * ks + 1]);
        const size_t orow0 = ((size_t)(sl * NC + c) * 64);
#pragma unroll
        for (int mt = 0; mt < 4; ++mt) { f32x4 acc = (f32x4){0.f, 0.f, 0.f, 0.f};
#pragma unroll
            for (int ks = 0; ks < 4; ++ks) { const bf16_t* qp = Qs + (16 * mt + r16) * QKP + 32 * ks + 4 * q4;
                const bf16x4 a0 = *(const bf16x4*)qp, a1 = *(const bf16x4*)(qp + 16);
                const bf16x8 a = (bf16x8){a0[0], a0[1], a0[2], a0[3], a1[0], a1[1], a1[2], a1[3]};
                acc = MFMA16(a, bS[ks], acc); }
#pragma unroll
            for (int i = 0; i < 4; ++i) Og[(orow0 + 16 * mt + 4 * q4 + i) * 1024 + h * 256 + ecol] = acc[i]; }
        bf16x8 bv[2];
#pragma unroll
        for (int ks = 0; ks < 2; ++ks) bv[ks] = *(const bf16x8*)(Vt + (16 * wid + r16) * TP + 32 * ks + 8 * q4);
#pragma unroll
        for (int T = 0; T < 8; ++T) {
#pragma unroll
            for (int ks = 0; ks < 2; ++ks) { const bf16x8 a = *(const bf16x8*)(Kt + (16 * T + r16) * TP + 32 * ks + 8 * q4); S[T] = MFMA16(a, bv[ks], S[T]); }
            const f32x4 dv = *(const f32x4*)(Dv + 16 * T + 4 * q4); S[T] *= dv; }
        if (ci + 1 < NC) GLA_STORE(smem + ((ci + 1) & 1) * SC_BUF);
        __syncthreads();
    }
#undef GLA_LOAD
#undef GLA_STORE
    if (!gi.latent) { float* so = lout(p) + OUT_ST + ((((size_t)sl * DEPTH + l) * 2 + dir) * 4 + h) * 128 * 256 + ecol;
#pragma unroll
        for (int T = 0; T < 8; ++T)
#pragma unroll
            for (int i = 0; i < 4; ++i) so[(size_t)(16 * T + 4 * q4 + i) * 256] = S[T][i]; }
}
DI void phase_gla_scan(const Params& p, const GrpInfo gi, int bid, int nb) {
    const int tid = ltid();
    for (int u = bid; u < gi.nseq * 16; u += nb) gla_scan_unit(p, gi, u, tid);
}
typedef float f32x16 __attribute__((ext_vector_type(16)));
#define MFMA32(a, b, c) __builtin_amdgcn_mfma_f32_32x32x16_bf16((a), (b), (c), 0, 0, 0)

DI void phase_hy_prep(const Params& p, const GrpInfo gi, int bid, int nb) {
    const int tid = ltid(), L = gi.L;
    bf16_t* T = (bf16_t*)smem;
    const bf16_t* P = (const bf16_t*)(lws(p) + OFF_P);
    bf16_t* UcT = (bf16_t*)(lws(p) + OFF_UCT);
    const float* cw = p.hy_conv_w + (size_t)gi.l * 3 * 3072; const float* cb = p.hy_conv_b + (size_t)gi.l * 3072;
    for (int u = bid; u < 128 * 48; u += nb) {
        const int rt = u / 48, ct = u % 48, row0 = rt * 64, j0 = ct * 64;
        const int t = tid >> 3, js = tid & 7, row = row0 + t, tpos = row & (L - 1), j = j0 + js * 8;
        const bf16_t* pr = P + (size_t)row * NP + C_HY + j;
        const u32x4 z4 = (u32x4){0u, 0u, 0u, 0u};
        const u32x4 um = tpos > 0 ? *(const u32x4*)(pr - NP) : z4, u0 = *(const u32x4*)pr, up = tpos < L - 1 ? *(const u32x4*)(pr + NP) : z4;
        __syncthreads();
#pragma unroll
        for (int q = 0; q < 4; ++q) {
            const float o0 = cb[j + 2 * q] + cw[j + 2 * q] * bflo(um[q]) + cw[3072 + j + 2 * q] * bflo(u0[q]) + cw[6144 + j + 2 * q] * bflo(up[q]);
            const float o1 = cb[j + 2 * q + 1] + cw[j + 2 * q + 1] * bfhi(um[q]) + cw[3072 + j + 2 * q + 1] * bfhi(u0[q]) + cw[6144 + j + 2 * q + 1] * bfhi(up[q]);
            T[(js * 8 + 2 * q) * TP + t] = f2bf(o0); T[(js * 8 + 2 * q + 1) * TP + t] = f2bf(o1);
        }
        __syncthreads();
        const int jj = tid >> 3, ts = tid & 7;
        *(u32x4*)(UcT + (size_t)(j0 + jj) * GT + row0 + ts * 8) = *(const u32x4*)(T + jj * TP + ts * 8);
    }
}
DI void phase_hy_post(const Params& p, const GrpInfo gi, int bid, int nb) {
    const int tid = ltid();
    bf16_t* T = (bf16_t*)smem;
    const bf16_t* OcT = (const bf16_t*)(lws(p) + OFF_OCT);
    bf16_t* OC = (bf16_t*)(lws(p) + OFF_OABC) + 2048;
    for (int u = bid; u < 128 * 16; u += nb) {
        const int rt = u >> 4, ct = u & 15, row0 = rt * 64, c0 = ct * 64;
        const int c = tid >> 3, ts = tid & 7;
        const u32x4 w = *(const u32x4*)(OcT + (size_t)(c0 + c) * GT + row0 + ts * 8);
        __syncthreads();
#pragma unroll
        for (int q = 0; q < 4; ++q) { T[(ts * 8 + 2 * q) * TP + c] = (bf16_t)(w[q] & 0xffffu); T[(ts * 8 + 2 * q + 1) * TP + c] = (bf16_t)(w[q] >> 16); }
        __syncthreads();
        const int t = tid >> 3, cs = tid & 7;
        *(u32x4*)(OC + (size_t)(row0 + t) * 3072 + c0 + cs * 8) = *(const u32x4*)(T + t * TP + cs * 8);
    }
}

constexpr int HY_HF = 0;
constexpr int HY_Z = 16384;
constexpr int HY_ZERO = HY_Z + 20480;
constexpr int HY_HC = HY_ZERO + 64;
DI int hy_pitch(int L) { return (L + 224) * 2; }
DI int hy_zoff(int s) { return (s >> 5) * 80 + (s & 31) * 2; }
DI void hy_build_copies(int L, int tid) {
    const float* hf = (const float*)(smem + HY_HF);
    const int nch = (L + 224) / 8, pitch = hy_pitch(L);
    for (int ch = tid; ch < 8 * nch; ch += 512) {
        const int e = ch / nch, i8 = (ch - e * nch) * 8;
        float v[8];
#pragma unroll
        for (int j = 0; j < 8; ++j) { const int x = i8 + j - 88 + e; v[j] = (x >= 0 && x < L) ? hf[L - 1 - x] : 0.f; }
        u32x4 w; w.x = pk2(v[0], v[1]); w.y = pk2(v[2], v[3]); w.z = pk2(v[4], v[5]); w.w = pk2(v[6], v[7]);
        *(u32x4*)(smem + HY_HC + e * pitch + i8 * 2) = w;
    }
}
DI f32x16 hy_conv(int L, int lane, int tb_row0  , int t0) {
    const int m = lane & 31, kh = lane >> 5, e = (7 - (m & 7)) & 7, pitch = hy_pitch(L);
    const int NTRIP = (L / 16 + 2 + 6) / 8;
    int delta = -(L / 2) - 16 - 48;
    int aoff = HY_HC + e * pitch + (L / 2 - 1 - delta - m + 8 * kh - e + 88) * 2;
    f32x16 acc[4];
#pragma unroll
    for (int c = 0; c < 4; ++c)
#pragma unroll
        for (int i = 0; i < 16; ++i) acc[c][i] = 0.f;
#define HY_LDB(dlt) ({ const int s0_ = t0 - (dlt); const bool inr_ = (unsigned)s0_ <= (unsigned)(L - 16); \
        const int zo_ = inr_ ? HY_Z + hy_zoff(tb_row0 - (dlt)) + 16 * kh : HY_ZERO; *(const bf16x8*)(smem + zo_); })
    bf16x8 a0[4], b0[4], a1[4], b1[4];
#pragma unroll
    for (int j = 0; j < 4; ++j) { a0[j] = *(const bf16x8*)(smem + aoff - 32 * j); b0[j] = HY_LDB(delta + 16 * j); a1[j] = *(const bf16x8*)(smem + aoff - 32 * (j + 4)); b1[j] = HY_LDB(delta + 16 * (j + 4)); }
    for (int trip = 0; trip < NTRIP; ++trip) {
        delta += 128; aoff -= 256;
#pragma unroll
        for (int j = 0; j < 4; ++j) acc[j] = MFMA32(a0[j], b0[j], acc[j]);
#pragma unroll
        for (int j = 0; j < 4; ++j) { a0[j] = *(const bf16x8*)(smem + aoff - 32 * j); b0[j] = HY_LDB(delta + 16 * j); }
#pragma unroll
        for (int j = 0; j < 4; ++j) acc[j] = MFMA32(a1[j], b1[j], acc[j]);
#pragma unroll
        for (int j = 0; j < 4; ++j) { a1[j] = *(const bf16x8*)(smem + aoff - 32 * (j + 4)); b1[j] = HY_LDB(delta + 16 * (j + 4)); }
    }
#undef HY_LDB
    return (acc[0] + acc[1]) + (acc[2] + acc[3]);
}
DI void hy_conv_unit(const Params& p, const GrpInfo gi, int c, int tid_in) {
    int tid = tid_in; asm volatile("" : "+v"(tid));
    const int L = gi.L, lane = tid & 63, wid = tid >> 6, n = lane & 31, hi = lane >> 5;
    const int g = 32 * wid + n, tpl = L >> 5, b = g / tpl, t0 = (g % tpl) * 32, frow = b * L + t0;
    const bf16_t* UcT = (const bf16_t*)(lws(p) + OFF_UCT);
    bf16_t* OcT = (bf16_t*)(lws(p) + OFF_OCT);
    const float* f0 = filt_ptr(lws(p), gi.l, gi.latent ? 1 : 0) + (size_t)c * L;
    const float* f1 = f0 + (size_t)1024 * L;
    float* hf = (float*)(smem + HY_HF);
    __syncthreads();
    {
        const bf16_t* zg = UcT + (size_t)(2048 + c) * GT;
#pragma unroll
        for (int i = 0; i < 2; ++i) { const int s = (tid + 512 * i) * 8; *(u32x4*)(smem + HY_Z + hy_zoff(s)) = *(const u32x4*)(zg + s); }
        if (tid < 4) *(unsigned*)(smem + HY_ZERO + 4 * tid) = 0u;
        for (int i = tid * 4; i < L; i += 2048) *(f32x4*)(hf + i) = *(const f32x4*)(f0 + i);
    }
    __syncthreads();
    hy_build_copies(L, tid);
    __syncthreads();
    f32x16 acc = hy_conv(L, lane, frow, t0);
    const float bias0 = p.hy_bias[((size_t)gi.l * 2 + 0) * 1024 + c], bias1 = p.hy_bias[((size_t)gi.l * 2 + 1) * 1024 + c];
    u32x2 z1w[4];
#pragma unroll
    for (int gq = 0; gq < 4; ++gq) {
        const int fr = frow + 8 * gq + 4 * hi;
        const u32x2 xw = *(const u32x2*)(UcT + (size_t)c * GT + fr);
        const u32x2 zw = *(const u32x2*)(smem + HY_Z + hy_zoff(fr));
        const float o0 = bflo(xw.x) * (acc[4 * gq] + bias0 * bflo(zw.x)), o1 = bfhi(xw.x) * (acc[4 * gq + 1] + bias0 * bfhi(zw.x));
        const float o2 = bflo(xw.y) * (acc[4 * gq + 2] + bias0 * bflo(zw.y)), o3 = bfhi(xw.y) * (acc[4 * gq + 3] + bias0 * bfhi(zw.y));
        z1w[gq].x = pk2(o0, o1); z1w[gq].y = pk2(o2, o3);
    }
    __syncthreads();
#pragma unroll
    for (int gq = 0; gq < 4; ++gq) *(u32x2*)(smem + HY_Z + hy_zoff(frow + 8 * gq + 4 * hi)) = z1w[gq];
    for (int i = tid * 4; i < L; i += 2048) *(f32x4*)(hf + i) = *(const f32x4*)(f1 + i);
    __syncthreads();
    hy_build_copies(L, tid);
    __syncthreads();
    acc = hy_conv(L, lane, frow, t0);
#pragma unroll
    for (int gq = 0; gq < 4; ++gq) {
        const int fr = frow + 8 * gq + 4 * hi;
        const u32x2 xw = *(const u32x2*)(UcT + (size_t)(1024 + c) * GT + fr);
        const float o0 = bflo(xw.x) * (acc[4 * gq] + bias1 * bflo(z1w[gq].x)), o1 = bfhi(xw.x) * (acc[4 * gq + 1] + bias1 * bfhi(z1w[gq].x));
        const float o2 = bflo(xw.y) * (acc[4 * gq + 2] + bias1 * bflo(z1w[gq].y)), o3 = bfhi(xw.y) * (acc[4 * gq + 3] + bias1 * bfhi(z1w[gq].y));
        u32x2 w; w.x = pk2(o0, o1); w.y = pk2(o2, o3);
        *(u32x2*)(OcT + (size_t)c * GT + fr) = w;
    }
}
DI void phase_hy_conv(const Params& p, const GrpInfo gi, int bid, int nb) {
    const int tid = ltid();
    for (int c = bid; c < 1024; c += nb) hy_conv_unit(p, gi, c, tid);
}
constexpr float NA_QSCALE = 0.12751743074602468f;
constexpr float LOG2E = 1.4426950408889634f;

DI void phase_cache_cvt(const Params& p, int bid, int nb) {
    const int tid = ltid();
    bf16_t* T = (bf16_t*)smem;
    bf16_t* CK = (bf16_t*)(lws(p) + OFF_CK); bf16_t* CVT = (bf16_t*)(lws(p) + OFF_CVT);
    for (int u = bid; u < 8 * 2 * 8 * 4; u += nb) {
        const int bh = u >> 2, k0 = (u & 3) * 64;
        const int key = tid >> 3, ds = (tid & 7) * 16;
        const size_t src = ((size_t)bh * 256 + k0 + key) * 128 + ds;
        f32x4 kv[4], vv[4];
#pragma unroll
        for (int i = 0; i < 4; ++i) { kv[i] = *(const f32x4*)(p.cache_k + src + 4 * i); vv[i] = *(const f32x4*)(p.cache_v + src + 4 * i); }
        u32x4 w0, w1; w0.x = pk2(kv[0][0], kv[0][1]); w0.y = pk2(kv[0][2], kv[0][3]); w0.z = pk2(kv[1][0], kv[1][1]); w0.w = pk2(kv[1][2], kv[1][3]);
        w1.x = pk2(kv[2][0], kv[2][1]); w1.y = pk2(kv[2][2], kv[2][3]); w1.z = pk2(kv[3][0], kv[3][1]); w1.w = pk2(kv[3][2], kv[3][3]);
        *(u32x4*)(CK + src) = w0; *(u32x4*)(CK + src + 8) = w1;
        __syncthreads();
#pragma unroll
        for (int i = 0; i < 4; ++i)
#pragma unroll
            for (int j = 0; j < 4; ++j) T[(ds + 4 * i + j) * TP + key] = f2bf(vv[i][j]);
        __syncthreads();
        const int d = tid >> 2, ks = (tid & 3) * 16;
        bf16_t* dst = CVT + ((size_t)bh * 128 + d) * 256 + k0 + ks;
        *(u32x4*)dst = *(const u32x4*)(T + d * TP + ks); *(u32x4*)(dst + 8) = *(const u32x4*)(T + d * TP + ks + 8);
    }
}
DI void phase_na_prep2(const Params& p, const GrpInfo gi, int bid, int nb) {
    const int tid = ltid(), lane = tid & 63, wid = tid >> 6;
    const bf16_t* P = (const bf16_t*)(lws(p) + OFF_P);
    bf16_t* QN = (bf16_t*)(lws(p) + OFF_QN); bf16_t* KN = (bf16_t*)(lws(p) + OFF_KN); bf16_t* VTN = (bf16_t*)(lws(p) + OFF_VTN);
    const float gq0 = p.na_qnorm_g[gi.l * 128 + 2 * lane] * NA_QSCALE, gq1 = p.na_qnorm_g[gi.l * 128 + 2 * lane + 1] * NA_QSCALE;
    const float gk0 = p.na_knorm_g[gi.l * 128 + 2 * lane], gk1 = p.na_knorm_g[gi.l * 128 + 2 * lane + 1];
    for (int u = bid * 8 + wid; u < GT * 8; u += nb * 8) {
        const int row = u >> 3, h = u & 7;
        const unsigned qw = *(const unsigned*)(P + (size_t)row * NP + C_NQ + h * 128 + 2 * lane);
        const unsigned kw = *(const unsigned*)(P + (size_t)row * NP + C_NK + h * 128 + 2 * lane);
        const float q0 = bflo(qw), q1 = bfhi(qw), k0 = bflo(kw), k1 = bfhi(kw);
        const float qs = rsqrtf(wave_sum(q0 * q0 + q1 * q1, lane) * (1.0f / 128) + EPS), ks = rsqrtf(wave_sum(k0 * k0 + k1 * k1, lane) * (1.0f / 128) + EPS);
        const float b0 = k0 * ks * gk0, b1 = k1 * ks * gk1;
        *(unsigned*)(QN + (size_t)row * 1024 + h * 128 + 2 * lane) = pk2(q0 * qs * gq0, q1 * qs * gq1);
        *(unsigned*)(KN + (size_t)row * 1024 + h * 128 + 2 * lane) = pk2(b0, b1);
        if (!gi.latent) { const int b = row >> 8, t = row & 255; const size_t o = ((((size_t)b * DEPTH + gi.l) * 8 + h) * 256 + t) * 128 + 2 * lane;
            const unsigned vw = *(const unsigned*)(P + (size_t)row * NP + C_NV + h * 128 + 2 * lane);
            *(f32x2*)(lout(p) + OUT_CK + o) = (f32x2){b0, b1}; *(f32x2*)(lout(p) + OUT_CV + o) = (f32x2){bflo(vw), bfhi(vw)}; }
    }
    bf16_t* T = (bf16_t*)smem;
    const int L = gi.L;
    for (int u = bid; u < 128 * 8; u += nb) {
        const int cg = u >> 3, h = u & 7, row0 = cg * 64, seq = row0 / L, t0 = row0 & (L - 1);
        const int s = tid >> 3, ds = (tid & 7) * 16;
        const bf16_t* pv = P + (size_t)(row0 + s) * NP + C_NV + h * 128 + ds;
        const u32x4 w0 = *(const u32x4*)pv, w1 = *(const u32x4*)(pv + 8);
        __syncthreads();
#pragma unroll
        for (int j = 0; j < 4; ++j) { T[(ds + 2 * j) * TP + s] = (bf16_t)(w0[j] & 0xffffu); T[(ds + 2 * j + 1) * TP + s] = (bf16_t)(w0[j] >> 16);
                                      T[(ds + 8 + 2 * j) * TP + s] = (bf16_t)(w1[j] & 0xffffu); T[(ds + 8 + 2 * j + 1) * TP + s] = (bf16_t)(w1[j] >> 16); }
        __syncthreads();
        const int d = tid >> 2, sq = (tid & 3) * 16;
        bf16_t* dst = VTN + ((size_t)(seq * 8 + h) * 128 + d) * L + t0 + sq;
        *(u32x4*)dst = *(const u32x4*)(T + d * TP + sq); *(u32x4*)(dst + 8) = *(const u32x4*)(T + d * TP + sq + 8);
    }
}

typedef const __attribute__((address_space(1))) bf16_t* gbfp;
template <bool LOCAL> DI void na_block(const bf16_t* kb0, int kstride, int kA, const bf16_t* vb0, int vstride, int vA, const bf16x8 (&qB)[4], f32x4 (&O)[8], float& mrun, float& lrun,
                                       int lane, int r16, int q4, const float* rpb  , int rowoff0  , int wc0, int c, int cs) {
    const gbfp kb = (gbfp)kb0, vb = (gbfp)vb0;
    f32x4 st[8];
    const unsigned kvo = (unsigned)(r16 * kstride + 8 * q4), vvo = (unsigned)(r16 * vstride + 4 * q4);
    bf16x8 kbuf[2][4];
#define NA_LOADK(T_, slot) do { const gbfp kp_ = kb + (size_t)(((T_) >> 1) * kA + ((T_) & 1) * 16) * kstride; \
        _Pragma("unroll") for (int ks_ = 0; ks_ < 4; ++ks_) kbuf[slot][ks_] = *(const __attribute__((address_space(1))) bf16x8*)(kp_ + kvo + 32 * ks_); } while (0)
    NA_LOADK(0, 0);
#pragma unroll
    for (int T = 0; T < 8; ++T) {
        if (T < 7) NA_LOADK(T + 1, (T + 1) & 1);
        st[T] = (f32x4){0.f, 0.f, 0.f, 0.f};
#pragma unroll
        for (int ks = 0; ks < 4; ++ks) st[T] = MFMA16(kbuf[T & 1][ks], qB[ks], st[T]);
        __builtin_amdgcn_sched_barrier(0);
    }
#undef NA_LOADK
    float mx = -INFINITY;
#pragma unroll
    for (int T = 0; T < 8; ++T)
#pragma unroll
        for (int i = 0; i < 4; ++i) {
            if (LOCAL) { const int wr = T >> 1, gcol = wc0 + 16 * (T & 1) + 4 * q4 + i;
                const bool ok = gcol >= cs && gcol < cs + 16;
                const float bias = rpb[(rowoff0 + wr) * 31 + min(max(gcol - c + 15, 0), 30)];
                st[T][i] = ok ? st[T][i] + bias : -INFINITY; }
            mx = fmaxf(mx, st[T][i]);
        }
    mx = fmaxf(mx, __int_as_float(__builtin_amdgcn_ds_bpermute((lane ^ 16) << 2, __float_as_int(mx))));
    mx = fmaxf(mx, __int_as_float(__builtin_amdgcn_ds_bpermute((lane ^ 32) << 2, __float_as_int(mx))));
    const float mnew = fmaxf(mrun, mx), alpha = __builtin_amdgcn_exp2f(mrun - mnew);
    float ls = 0.f;
#pragma unroll
    for (int T = 0; T < 8; ++T)
#pragma unroll
        for (int i = 0; i < 4; ++i) { const float e = __builtin_amdgcn_exp2f(st[T][i] - mnew); st[T][i] = e; ls += e; }
    ls += __int_as_float(__builtin_amdgcn_ds_bpermute((lane ^ 16) << 2, __float_as_int(ls)));
    ls += __int_as_float(__builtin_amdgcn_ds_bpermute((lane ^ 32) << 2, __float_as_int(ls)));
    lrun = lrun * alpha + ls; mrun = mnew;
#pragma unroll
    for (int dT = 0; dT < 8; ++dT) O[dT] *= alpha;
    bf16x4 vbuf[2][8][2];
#define NA_LOADV(t_, slot) do { _Pragma("unroll") for (int dT_ = 0; dT_ < 8; ++dT_) { const gbfp vp_ = vb + (size_t)(16 * dT_) * vstride + (t_) * vA; \
        vbuf[slot][dT_][0] = *(const __attribute__((address_space(1))) bf16x4*)(vp_ + vvo); vbuf[slot][dT_][1] = *(const __attribute__((address_space(1))) bf16x4*)(vp_ + vvo + 16); } } while (0)
    NA_LOADV(0, 0);
#pragma unroll
    for (int t = 0; t < 4; ++t) {
        if (t < 3) NA_LOADV(t + 1, (t + 1) & 1);
        const bf16x8 bP = pack8(st[2 * t], st[2 * t + 1]);
#pragma unroll
        for (int dT = 0; dT < 8; ++dT) { const bf16x4 a0 = vbuf[t & 1][dT][0], a1 = vbuf[t & 1][dT][1];
            const bf16x8 a = (bf16x8){a0[0], a0[1], a0[2], a0[3], a1[0], a1[1], a1[2], a1[3]};
            O[dT] = MFMA16(a, bP, O[dT]); }
        __builtin_amdgcn_sched_barrier(0);
    }
#undef NA_LOADV
}
constexpr int LDS_RPB_OFF = 139264 + 512;
DI void na_load_rpb(const Params& p, int l, int tid) {
    float* rp = (float*)(smem + LDS_RPB_OFF);
    for (int i = tid; i < 8 * 465; i += 512) rp[i] = p.na_rpb[(size_t)l * 8 * 465 + i] * LOG2E;
}
constexpr int NA_KP = 144, NA_VP = 72;
constexpr int NA_KS = 0, NA_VS = 64 * NA_KP * 2, NA_BUF = NA_VS + 128 * NA_VP * 2;
template <int NT, bool LOCAL> DI void na_chunk(const unsigned char* buf, int koff, const bf16x8 (&qB)[4], f32x4 (&O)[8], float& mrun, float& lrun, int lane, int r16, int q4,
                                               const float* rpb, int rowoff, int wc0, int c, int cs) {
    const bf16_t* Ks = (const bf16_t*)(buf + NA_KS); const bf16_t* Vs = (const bf16_t*)(buf + NA_VS);
    f32x4 st[NT];
#pragma unroll
    for (int T = 0; T < NT; ++T) { st[T] = (f32x4){0.f, 0.f, 0.f, 0.f};
#pragma unroll
        for (int ks = 0; ks < 4; ++ks) { const bf16x8 a = *(const bf16x8*)(Ks + (koff + 16 * T + r16) * NA_KP + 32 * ks + 8 * q4); st[T] = MFMA16(a, qB[ks], st[T]); } }
    float mx = -INFINITY;
#pragma unroll
    for (int T = 0; T < NT; ++T)
#pragma unroll
        for (int i = 0; i < 4; ++i) {
            if (LOCAL) { const int gcol = wc0 + 16 * T + 4 * q4 + i; const bool ok = gcol >= cs && gcol < cs + 16;
                const float bias = rpb[rowoff * 31 + min(max(gcol - c + 15, 0), 30)];
                st[T][i] = ok ? st[T][i] + bias : -INFINITY; }
            mx = fmaxf(mx, st[T][i]);
        }
    mx = fmaxf(mx, __int_as_float(__builtin_amdgcn_ds_bpermute((lane ^ 16) << 2, __float_as_int(mx))));
    mx = fmaxf(mx, __int_as_float(__builtin_amdgcn_ds_bpermute((lane ^ 32) << 2, __float_as_int(mx))));
    const float mnew = fmaxf(mrun, mx);
    const float alpha = (mnew == -INFINITY) ? 1.0f : __builtin_amdgcn_exp2f(mrun - mnew);
    const float msafe = (mnew == -INFINITY) ? 0.0f : mnew;
    float ls = 0.f;
#pragma unroll
    for (int T = 0; T < NT; ++T)
#pragma unroll
        for (int i = 0; i < 4; ++i) { const float e = __builtin_amdgcn_exp2f(st[T][i] - msafe); st[T][i] = e; ls += e; }
    ls += __int_as_float(__builtin_amdgcn_ds_bpermute((lane ^ 16) << 2, __float_as_int(ls)));
    ls += __int_as_float(__builtin_amdgcn_ds_bpermute((lane ^ 32) << 2, __float_as_int(ls)));
    lrun = lrun * alpha + ls; mrun = mnew;
#pragma unroll
    for (int dT = 0; dT < 8; ++dT) O[dT] *= alpha;
#pragma unroll
    for (int t = 0; t < NT / 2; ++t) {
        const bf16x8 bP = pack8(st[2 * t], st[2 * t + 1]);
#pragma unroll
        for (int dT = 0; dT < 8; ++dT) { const bf16_t* vp = Vs + (16 * dT + r16) * NA_VP + koff + 32 * t + 4 * q4;
            const bf16x4 a0 = *(const bf16x4*)vp, a1 = *(const bf16x4*)(vp + 16);
            const bf16x8 a = (bf16x8){a0[0], a0[1], a0[2], a0[3], a1[0], a1[1], a1[2], a1[3]};
            O[dT] = MFMA16(a, bP, O[dT]); }
    }
}
DI void na_attn_unit(const Params& p, const GrpInfo gi, int u, int tid_in) {
    int tid = tid_in; asm volatile("" : "+v"(tid));
    const int lane = tid & 63, wid = __builtin_amdgcn_readfirstlane(tid >> 6), l = gi.l, r16 = lane & 15, q4 = lane >> 4;
    const float* rp = (const float*)(smem + LDS_RPB_OFF);
    const bf16_t* QN = (const bf16_t*)(lws(p) + OFF_QN); const bf16_t* KN = (const bf16_t*)(lws(p) + OFF_KN); const bf16_t* VTN = (const bf16_t*)(lws(p) + OFF_VTN);
    bf16_t* OB = (bf16_t*)(lws(p) + OFF_OABC) + 1024;
    int qrow0, h, seq, r = 0, c0 = 0, r0 = 0;
    if (gi.latent) { const int sl = u >> 8, rp2 = u & 31; h = (u >> 5) & 7; seq = sl; r0 = 2 * rp2; r = r0 + (wid >> 2); c0 = 16 * (wid & 3); qrow0 = sl * 4096 + r * 64 + c0; }
    else { const int b = u >> 4, half = u & 1; h = (u >> 1) & 7; seq = b; qrow0 = b * 256 + (half * 8 + wid) * 16; }
    const int g0 = min(max(r0 - 4, 0), 56), g1 = min(max(r0 + 1 - 4, 0), 56) + 8, nch = gi.latent ? 4 + (g1 - g0) : 4;
    const bf16_t* ck; const bf16_t* cv; int ckst, cvst;
    if (gi.latent) { const size_t cb = ((size_t)(2 * (gi.grp - 1) + seq) * DEPTH + l) * 8 + h; ck = (const bf16_t*)(lws(p) + OFF_CK) + cb * 256 * 128; ckst = 128; cv = (const bf16_t*)(lws(p) + OFF_CVT) + cb * 128 * 256; cvst = 256; }
    else { ck = KN + (size_t)(seq * 256) * 1024 + h * 128; ckst = 1024; cv = VTN + (size_t)(seq * 8 + h) * 128 * 256; cvst = 256; }
    const bf16_t* lk = KN + (size_t)(seq * 4096) * 1024 + h * 128;
    const bf16_t* lv = VTN + (size_t)(seq * 8 + h) * 128 * 4096;
    const int kkey = tid >> 4, kds = (tid & 15) * 8, vd = tid >> 3, vks = (tid & 7) * 8;
    u32x4 pk[2][2], pv[2][2];
#define NA_LOAD(c_, s_) do { const int cc_ = (c_); const bf16_t* kb_; const bf16_t* vb_; int kst_, vst_; \
        if (cc_ < 4) { kb_ = ck + (size_t)(64 * cc_) * ckst; kst_ = ckst; vb_ = cv + 64 * cc_; vst_ = cvst; } else { const int g_ = g0 + cc_ - 4; kb_ = lk + (size_t)(64 * g_) * 1024; kst_ = 1024; vb_ = lv + 64 * g_; vst_ = 4096; } \
        pk[s_][0] = *(const u32x4*)(kb_ + (size_t)kkey * kst_ + kds); pk[s_][1] = *(const u32x4*)(kb_ + (size_t)(kkey + 32) * kst_ + kds); \
        pv[s_][0] = *(const u32x4*)(vb_ + (size_t)vd * vst_ + vks); pv[s_][1] = *(const u32x4*)(vb_ + (size_t)(vd + 64) * vst_ + vks); } while (0)
#define NA_STORE(bufp, s_) do { unsigned char* b_ = (bufp); \
        *(u32x4*)(b_ + NA_KS + (kkey * NA_KP + kds) * 2) = pk[s_][0]; *(u32x4*)(b_ + NA_KS + ((kkey + 32) * NA_KP + kds) * 2) = pk[s_][1]; \
        *(u32x4*)(b_ + NA_VS + (vd * NA_VP + vks) * 2) = pv[s_][0]; *(u32x4*)(b_ + NA_VS + ((vd + 64) * NA_VP + vks) * 2) = pv[s_][1]; } while (0)
    bf16x8 qB[4];
#pragma unroll
    for (int ks = 0; ks < 4; ++ks) qB[ks] = *(const bf16x8*)(QN + (size_t)(qrow0 + r16) * 1024 + h * 128 + 32 * ks + 8 * q4);
    f32x4 O[8];
#pragma unroll
    for (int dT = 0; dT < 8; ++dT) O[dT] = (f32x4){0.f, 0.f, 0.f, 0.f};
    float mrun = -INFINITY, lrun = 0.f;
    const int rs = min(max(r - 4, 0), 56), wc0 = min(max(c0 - 8, 0), 32), c = c0 + r16, cs = min(max(c - 8, 0), 48);
    __syncthreads();
    NA_LOAD(0, 0); NA_STORE(smem, 0);
    NA_LOAD(1, 1);
    __syncthreads();
    for (int ci = 0; ci < nch; ci += 2) {
        if (ci + 2 < nch) NA_LOAD(ci + 2, 0);
        if (ci < 4) na_chunk<4, false>(smem, 0, qB, O, mrun, lrun, lane, r16, q4, rp, 0, 0, 0, 0);
        else { const int g = g0 + ci - 4, wr = g - rs; if (wr >= 0 && wr < 8) na_chunk<2, true>(smem, wc0, qB, O, mrun, lrun, lane, r16, q4, rp + h * 465, g - r + 7, wc0, c, cs); }
        if (ci + 1 < nch) NA_STORE(smem + NA_BUF, 1);
        __syncthreads();
        if (ci + 1 < nch) {
            if (ci + 3 < nch) NA_LOAD(ci + 3, 1);
            if (ci + 1 < 4) na_chunk<4, false>(smem + NA_BUF, 0, qB, O, mrun, lrun, lane, r16, q4, rp, 0, 0, 0, 0);
            else { const int g = g0 + ci + 1 - 4, wr = g - rs; if (wr >= 0 && wr < 8) na_chunk<2, true>(smem + NA_BUF, wc0, qB, O, mrun, lrun, lane, r16, q4, rp + h * 465, g - r + 7, wc0, c, cs); }
            if (ci + 2 < nch) NA_STORE(smem, 0);
        }
        __syncthreads();
    }
#undef NA_LOAD
#undef NA_STORE
    const float inv = 1.0f / lrun;
#pragma unroll
    for (int dT = 0; dT < 8; ++dT) { u32x2 w; w.x = pk2(O[dT][0] * inv, O[dT][1] * inv); w.y = pk2(O[dT][2] * inv, O[dT][3] * inv);
        *(u32x2*)(OB + (size_t)(qrow0 + r16) * 3072 + h * 128 + 16 * dT + 4 * q4) = w; }
}
#define LAS3 __attribute__((address_space(3)))
#ifndef REPMASK
#define REPMASK 0
#endif
constexpr int LDS_MAIN = 139264, LDS_PARAMS = LDS_MAIN + 64, LDS_UNIT = LDS_MAIN + 32, LDS_BYTES = LDS_MAIN + 512 + 8 * 465 * 4;
static_assert(LDS_RPB_OFF == LDS_MAIN + 512 && LDS_BYTES <= 163840, "LDS map");
constexpr int CTR_WORD0 = XCD_BAR_WORDS, CTR_WORDS = 64 * 16;

DI Params lp() {
    ParamsU u;
#pragma unroll
    for (int i = 0; i < NPARAM; ++i) {
        const unsigned long long v = *(const LAS3 unsigned long long*)((LAS3 unsigned char*)smem + LDS_PARAMS + 8 * i);
        const unsigned lo = (unsigned)__builtin_amdgcn_readfirstlane((int)(unsigned)v), hi = (unsigned)__builtin_amdgcn_readfirstlane((int)(unsigned)(v >> 32));
        u.a[i] = ((unsigned long long)hi << 32) | lo;
    }
    return u.s;
}
DI const float* x_in_ptr(const Params& p, int grp, int l) {
    if (l == 0) return grp == 0 ? p.x_prompt : p.x_sample + (size_t)(grp - 1) * GT * DM;
    return grp == 0 ? p.out + OUT_YP : p.out + OUT_YS + (size_t)(grp - 1) * GT * DM;
}
DI float* x_out_ptr(const Params& p, int grp) { return grp == 0 ? p.out + OUT_YP : p.out + OUT_YS + (size_t)(grp - 1) * GT * DM; }

template <class Epi> DI void gemm_ph(const bf16_t* A, const bf16_t* Bt, int M, int N, int K, const Epi& E) {
    pg8::Gemm g; g.A = A; g.Bt = Bt; g.M = M; g.N = N; g.K = K; g.pad = 0;
    pg8::StaticOrder S; S.init(M, N, (int)gridDim.x, (int)blockIdx.x);
    pg8::gemm_phase<Epi, pg8::StaticOrder, false>((LAS3 unsigned char*)smem, g, S, E, nullptr);
}
struct ModPtrs { const float* mA; const float* mB; };
DI ModPtrs mod_ptrs(const Params& q, int grp, int l) {
    const int crA = grp == 0 ? 0 : 1 + 2 * (grp - 1), crB = grp == 0 ? 0 : crA + 1;
    const float* mod = (const float*)(q.ws + OFF_MOD);
    ModPtrs m; m.mA = mod + ((size_t)l * NCOND + crA) * (NMOD * DM); m.mB = mod + ((size_t)l * NCOND + crB) * (NMOD * DM); return m;
}

__global__ __launch_bounds__(512, 2) void k_mega(Params p) {
    const int bid = blockIdx.x, nb = gridDim.x;
    volatile LAS unsigned* xbw = (volatile LAS unsigned*)((LAS3 unsigned char*)smem + LDS_MAIN);
    if (threadIdx.x == 0) {
        xbw[0] = 0u; xbw[1] = 0u; xbw[2] = 0u; xbw[3] = 0u;
        ParamsU u; u.s = p;
#pragma unroll
        for (int i = 0; i < NPARAM; ++i) *(LAS3 unsigned long long*)((LAS3 unsigned char*)smem + LDS_PARAMS + 8 * i) = u.a[i];
    }
    __syncthreads();
    XcdBarrier bar;
    { const Params q = lp(); bar = xcd_barrier_post((unsigned*)(q.ws + OFF_BAR), xbw); }
    for (int rep_ = 0; rep_ < 1 + ((REPMASK >> 8) & 1); ++rep_) { const Params q = lp(); phase_convert(q, bid, nb); }
    { const Params q = lp(); phase_adaln(q, bid, nb); }
    { const Params q = lp(); phase_hyena_hid(q, bid, nb); }
    { const Params q = lp(); phase_cache_cvt(q, bid, nb); }
    xcd_barrier(bar);
    { const Params q = lp(); phase_filters(q, bid, nb); }
    xcd_barrier(bar);
    for (int l0 = 0; l0 < DEPTH; ++l0) for (int grp0 = 0; grp0 < NGRP; ++grp0) {
        int l = l0, grp = grp0; asm volatile("" : "+s"(l), "+s"(grp));
        const GrpInfo gi = grp_info(grp, l);
        for (int rep_ = 0; rep_ < 1 + ((REPMASK >> 0) & 1); ++rep_) { const Params q = lp(); phase_norm(q, x_in_ptr(q, grp, l), q.norm1_g + l * DM, l, grp, 0, DM, bid, nb); }
        xcd_barrier(bar);
        if ((REPMASK >> 9) & 1) { xcd_barrier(bar); xcd_barrier(bar); xcd_barrier(bar); xcd_barrier(bar); }
        for (int rep_ = 0; rep_ < 1 + ((REPMASK >> 1) & 1); ++rep_) { const Params q = lp(); gemm_ph((const bf16_t*)(q.ws + OFF_H), (const bf16_t*)(q.ws + OFF_WIN) + (size_t)l * NP * DM, GT, NP, DM, EpiStoreBf16<0>{(bf16_t*)(q.ws + OFF_P), NP, 0}); }
        xcd_barrier(bar);
        for (int rep_ = 0; rep_ < 1 + ((REPMASK >> 2) & 1); ++rep_) { const Params q = lp(); phase_gla_prep(q, gi, bid, nb); }
        for (int rep_ = 0; rep_ < 1 + ((REPMASK >> 2) & 1); ++rep_) { const Params q = lp(); phase_na_prep2(q, gi, bid, nb); }
        for (int rep_ = 0; rep_ < 1 + ((REPMASK >> 2) & 1); ++rep_) { const Params q = lp(); phase_hy_prep(q, gi, bid, nb); }
        xcd_barrier(bar);
        for (int rep_ = 0; rep_ < 1 + ((REPMASK >> 3) & 1); ++rep_) {
            const Params q = lp(); const int tid = ltid();
            na_load_rpb(q, l, tid);
            unsigned* head = (unsigned*)(q.ws + OFF_BAR) + CTR_WORD0 + 64 * (l * NGRP + grp) + 16 * rep_;
            volatile LAS3 int* su = (volatile LAS3 int*)((LAS3 unsigned char*)smem + LDS_UNIT);
            const int nscan = gi.nseq * 16, nhy = 1024, nna = 512, ntot = nscan + nhy + nna;
            for (;;) {
                __syncthreads();
                if (tid == 0) *su = (int)__hip_atomic_fetch_add(head, 1u, __ATOMIC_RELAXED, __HIP_MEMORY_SCOPE_AGENT);
                __syncthreads();
                const int u = __builtin_amdgcn_readfirstlane(*su);
                if (u >= ntot) break;
                if (u < nscan) { for (int r2 = 0; r2 < 1 + ((REPMASK >> 10) & 1); ++r2) gla_scan_unit(q, gi, u, tid); }
                else if (u < nscan + nhy) { for (int r2 = 0; r2 < 1 + ((REPMASK >> 4) & 1); ++r2) hy_conv_unit(q, gi, u - nscan, tid); }
                else { for (int r2 = 0; r2 < 1 + ((REPMASK >> 5) & 1); ++r2) na_attn_unit(q, gi, u - nscan - nhy, tid); }
            }
        }
        xcd_barrier(bar);
        for (int rep_ = 0; rep_ < 1 + ((REPMASK >> 6) & 1); ++rep_) { const Params q = lp(); phase_gla_post<true>(q, gi, bid, nb); }
        for (int rep_ = 0; rep_ < 1 + ((REPMASK >> 6) & 1); ++rep_) { const Params q = lp(); phase_hy_post(q, gi, bid, nb); }
        xcd_barrier(bar);
        { const Params q = lp();
          gemm_ph((const bf16_t*)(q.ws + OFF_OABC), (const bf16_t*)(q.ws + OFF_WBR) + (size_t)l * DM * 3072, GT, DM, 3072, EpiGate3{(const bf16_t*)(q.ws + OFF_P) + C_GATE, (bf16_t*)(q.ws + OFF_MBF), NP, 0}); }
        xcd_barrier(bar);
        { const Params q = lp(); const ModPtrs m = mod_ptrs(q, grp, l);
          gemm_ph((const bf16_t*)(q.ws + OFF_MBF), (const bf16_t*)(q.ws + OFF_WOUT) + (size_t)l * DM * DM, GT, DM, DM, EpiResid{x_in_ptr(q, grp, l), x_out_ptr(q, grp), m.mA + 2 * DM, m.mB + 2 * DM}); }
        xcd_barrier(bar);
        { const Params q = lp(); phase_norm(q, x_out_ptr(q, grp), q.norm2_g + l * DM, l, grp, 3 * DM, 4 * DM, bid, nb); }
        xcd_barrier(bar);
        for (int rep_ = 0; rep_ < 1 + ((REPMASK >> 7) & 1); ++rep_) { const Params q = lp(); gemm_ph((const bf16_t*)(q.ws + OFF_H), (const bf16_t*)(q.ws + OFF_W1) + (size_t)l * DFF * DM, GT, DFF, DM, EpiStoreBf16<1>{(bf16_t*)(q.ws + OFF_P), DFF, 0}); }
        xcd_barrier(bar);
        { const Params q = lp(); const ModPtrs m = mod_ptrs(q, grp, l);
          gemm_ph((const bf16_t*)(q.ws + OFF_P), (const bf16_t*)(q.ws + OFF_W2) + (size_t)l * DM * DFF, GT, DM, DFF, EpiResid{x_out_ptr(q, grp), x_out_ptr(q, grp), m.mA + 5 * DM, m.mB + 5 * DM}); }
        xcd_barrier(bar);
    }
}

extern "C" void kernel_launch(void* const* d_in, const int* in_sizes, int n_in, void* d_out, int out_size, void* d_ws, size_t ws_size, hipStream_t stream) {
    Params p{};
    const float** f = (const float**)&p;
    for (int i = 0; i < 33; ++i) f[i] = (const float*)d_in[i];
    p.out = (float*)d_out; p.ws = (unsigned char*)d_ws;
    if (ws_size < WS_END) { fprintf(stderr, "workspace too small: %zu < %zu\n", ws_size, (size_t)WS_END); return; }
    static int grid = 0;
    if (!grid) {
        int dev = 0, cus = 0, per_cu = 0;
        (void)hipGetDevice(&dev);
        (void)hipDeviceGetAttribute(&cus, hipDeviceAttributeMultiprocessorCount, dev);
        (void)hipFuncSetAttribute((const void*)k_mega, hipFuncAttributeMaxDynamicSharedMemorySize, LDS_BYTES);
        (void)hipOccupancyMaxActiveBlocksPerMultiprocessor(&per_cu, k_mega, 512, LDS_BYTES);
        grid = cus * (per_cu < 1 ? per_cu : 1);
        if (grid <= 0) { fprintf(stderr, "occupancy query failed: cus %d per_cu %d\n", cus, per_cu); grid = 0; return; }
    }
    (void)hipMemsetAsync(p.ws + OFF_BAR, 0, (XCD_BAR_WORDS + CTR_WORDS) * sizeof(unsigned), stream);
    hipLaunchKernelGGL(k_mega, dim3(grid), dim3(512), LDS_BYTES, stream, p);
}
```

```cpp
#include <hip/hip_runtime.h>
#include <stdint.h>
#include <stdio.h>

constexpr int DM = 2048, DFF = 8192, NMOD = 6, NCOND = 9;
constexpr int GT = 8192;
constexpr int NGRP = 5, DEPTH = 2;
constexpr int C_GQ = 0, C_GK = 512, C_GV = 1024, C_GG = 2048, C_GA = 3072, C_NQ = 3328, C_NK = 4352, C_NV = 5376, C_HY = 6400, C_GATE = 9472, NP = 15616;
constexpr int IN_TOTAL = 15392;
constexpr float EPS = 1e-6f;

typedef unsigned short bf16_t;
typedef float f32x4 __attribute__((ext_vector_type(4)));
typedef float f32x2 __attribute__((ext_vector_type(2)));
typedef unsigned u32x4 __attribute__((ext_vector_type(4)));
typedef unsigned u32x2 __attribute__((ext_vector_type(2)));
#define DI __device__ __forceinline__

DI int ltid() { int t = threadIdx.x; asm volatile("" : "+v"(t)); return t; }
DI float bf2f(bf16_t b) { return __uint_as_float(((unsigned)b) << 16); }
DI float bflo(unsigned w) { return __uint_as_float(w << 16); }
DI float bfhi(unsigned w) { return __uint_as_float(w & 0xffff0000u); }
DI bf16_t f2bf(float f) { unsigned u = __float_as_uint(f); u += 0x7FFFu + ((u >> 16) & 1u); return (bf16_t)(u >> 16); }
DI unsigned pk2(float lo, float hi) { return (unsigned)f2bf(lo) | ((unsigned)f2bf(hi) << 16); }
DI float sigmoidf_(float x) { return 1.0f / (1.0f + __expf(-x)); }
DI float wave_sum(float v, int lane) {
#pragma unroll
    for (int o = 32; o >= 1; o >>= 1) v += __int_as_float(__builtin_amdgcn_ds_bpermute((lane ^ o) << 2, __float_as_int(v))); return v; }
DI float wave_max(float v, int lane) {
#pragma unroll
    for (int o = 32; o >= 1; o >>= 1) v = fmaxf(v, __int_as_float(__builtin_amdgcn_ds_bpermute((lane ^ o) << 2, __float_as_int(v)))); return v; }

constexpr size_t al256(size_t x) { return (x + 255) & ~(size_t)255; }
constexpr size_t OFF_BAR  = 0;
constexpr size_t OFF_MOD  = 65536;
constexpr size_t OFF_HID  = OFF_MOD  + al256((size_t)DEPTH * NCOND * 12288 * 4);
constexpr size_t OFF_FILT = OFF_HID  + (size_t)DEPTH * 2 * 4096 * 64 * 4;
constexpr size_t FILT_L   = (size_t)2 * 1024 * ((256 + 232) + (4096 + 232)) * 2;
constexpr size_t OFF_WIN  = OFF_FILT + DEPTH * FILT_L;
constexpr size_t OFF_WBR  = OFF_WIN  + (size_t)DEPTH * NP * DM * 2;
constexpr size_t OFF_WOUT = OFF_WBR  + (size_t)DEPTH * 3 * DM * 1024 * 2;
constexpr size_t OFF_W1   = OFF_WOUT + (size_t)DEPTH * DM * DM * 2;
constexpr size_t OFF_W2   = OFF_W1   + (size_t)DEPTH * DFF * DM * 2;
constexpr size_t OFF_H    = OFF_W2   + (size_t)DEPTH * DFF * DM * 2;
constexpr size_t OFF_P    = OFF_H    + (size_t)GT * DM * 2;
constexpr size_t OFF_OF   = OFF_P    + (size_t)GT * NP * 2;
constexpr size_t OFF_OB   = OFF_OF   + (size_t)GT * 1024 * 4;
constexpr size_t OFF_OABC = OFF_OB   + (size_t)GT * 1024 * 4;
constexpr size_t OFF_M32  = OFF_OABC + (size_t)3 * GT * 1024 * 2;
constexpr size_t OFF_MBF  = OFF_M32  + (size_t)GT * DM * 4;
constexpr size_t OFF_QN   = OFF_MBF  + (size_t)GT * DM * 2;
constexpr size_t OFF_KN   = OFF_QN   + (size_t)GT * 1024 * 2;
constexpr size_t OFF_QF   = OFF_KN   + (size_t)GT * 1024 * 2;
constexpr size_t OFF_QB   = OFF_QF   + (size_t)GT * 512 * 2;
constexpr size_t OFF_KFT  = OFF_QB   + (size_t)GT * 512 * 2;
constexpr size_t OFF_KBT  = OFF_KFT  + (size_t)GT * 512 * 2;
constexpr size_t OFF_VT   = OFF_KBT  + (size_t)GT * 512 * 2;
constexpr size_t OFF_DEC  = OFF_VT   + (size_t)GT * 1024 * 2;
constexpr size_t OFF_OI   = OFF_DEC  + (size_t)2 * 128 * 512 * 4;
constexpr size_t OFF_UCT  = OFF_OI   + (size_t)GT * 1024 * 4;
constexpr size_t OFF_OCT  = OFF_UCT  + (size_t)3072 * GT * 2;
constexpr size_t OFF_VTN  = OFF_OCT  + (size_t)1024 * GT * 2;
constexpr size_t OFF_CK   = OFF_VTN  + (size_t)GT * 1024 * 2;
constexpr size_t OFF_CVT  = OFF_CK   + (size_t)8 * 2 * 8 * 256 * 128 * 2;
constexpr size_t WS_END   = OFF_CVT  + (size_t)8 * 2 * 8 * 256 * 128 * 2;
static_assert(WS_END < (size_t)1190000000, "workspace too large");

constexpr size_t OUT_YP = 0, OUT_YS = (size_t)32 * 256 * DM, OUT_ST = OUT_YS + (size_t)8 * 4096 * DM,
                 OUT_CK = OUT_ST + (size_t)32 * 2 * 2 * 4 * 128 * 256, OUT_CV = OUT_CK + (size_t)32 * 2 * 8 * 256 * 128;

struct Params {
    const float *x_prompt, *x_sample, *state_gla, *cache_k, *cache_v, *c, *c_ctx, *w_mod, *b_mod, *norm1_g, *norm2_g, *w_in, *gla_wa2, *gla_ba2, *gla_norm_g,
                *na_qnorm_g, *na_knorm_g, *na_rpb, *hy_conv_w, *hy_conv_b, *hy_f1_w, *hy_f1_b, *hy_f2_w, *hy_f2_b, *hy_f3_w, *hy_freq, *hy_bias,
                *w_br_a, *w_br_b, *w_br_c, *w_out, *w_mlp1, *w_mlp2;
    float* out; unsigned char* ws;
};
constexpr int NPARAM = 35;
union ParamsU { Params s; unsigned long long a[NPARAM]; };
static_assert(sizeof(Params) == NPARAM * 8, "Params must be 35 pointers");
DI unsigned char* lws(const Params& p) { unsigned char* w = p.ws; asm volatile("" : "+s"(w)); return w; }
DI float* lout(const Params& p) { float* w = p.out; asm volatile("" : "+s"(w)); return w; }
namespace pg8 {
#define PG8_LAS __attribute__((address_space(3)))
typedef unsigned short bf16_t;
typedef short bf16x8 __attribute__((ext_vector_type(8)));
typedef float f32x4 __attribute__((ext_vector_type(4)));
typedef unsigned u32x4 __attribute__((ext_vector_type(4)));
constexpr int BM = 256, BK = 64, HALF = 128, HTB = HALF * BK * 2  , STAGE_BYTES = 8 * HTB, NXCD = 8, WGM = 8;
__host__ __device__ __forceinline__ int lds_byte(int r, int c) { const int st = (r >> 4) * 2 + (c >> 5), rr = r & 15, cc = c & 31, ob = rr * 64 + cc * 2; return st * 1024 + (ob ^ (((ob >> 9) & 1) << 5)); }
__host__ __device__ __forceinline__ void stage_rc(int b, int& R, int& C) { const int st = b / 1024, sb = b % 1024, swz = sb ^ (((sb >> 9) & 1) << 5); R = (st >> 1) * 16 + swz / 64; C = (st & 1) * 32 + (swz % 64) / 2; }
__host__ __device__ __forceinline__ int perm32(int rho) { const int n = rho >> 4, i = rho & 15; return 8 * (i >> 2) + 4 * n + (i & 3); }
struct Unit { int pm, pn; };
struct Gemm { const bf16_t* A; const bf16_t* Bt; int M, N, K, pad; };
struct StaticOrder {
    int nM, nN, nwg, G, c;
    __host__ __device__ void init(int M, int N, int G_, int c_) { nM = M / BM; nN = N / BM; nwg = nM * nN; G = G_; c = c_; }
    __host__ __device__ bool next(int i, Unit& u) const {
        const long L = (long)i * G + c; if (L >= nwg) return false;
        int wgid = (int)L; { const int q = nwg / NXCD, r = nwg % NXCD, xcd = wgid % NXCD, off = wgid / NXCD; wgid = (xcd < r ? xcd * (q + 1) : r * (q + 1) + (xcd - r) * q) + off; }
        const int nig = WGM * nN, gid = wgid / nig, fm = gid * WGM, gsz = (nM - fm) < WGM ? (nM - fm) : WGM;
        u.pm = fm + ((wgid % nig) % gsz); u.pn = (wgid % nig) / gsz; return true;
    }
    __device__ __forceinline__ void a_ready(const Unit&) const {}
    __device__ __forceinline__ void done(const Unit&) const {}
};
__device__ __forceinline__ unsigned cvt_pk_bf16(float lo, float hi) { unsigned r; asm volatile("v_cvt_pk_bf16_f32 %0, %1, %2" : "=v"(r) : "v"(lo), "v"(hi)); return r; }
template <class Epi, class Sched, bool STAMP = false>
__device__ __forceinline__ void gemm_phase(PG8_LAS unsigned char* lds, const Gemm g, const Sched& S, const Epi& E, unsigned long long* stamps) {
    int tid_ = threadIdx.x; asm volatile("" : "+v"(tid_));
    const int tid = tid_, wid = __builtin_amdgcn_readfirstlane(tid >> 6), lane = tid & 63, wr = wid >> 2, wc = wid & 3, fr = lane & 15, fq = lane >> 4;
    const int K = g.K, nt = K / BK;
    int ts_lo = 0, ts_hi = 0, nts = 0; const unsigned long long rt_entry = STAMP ? (unsigned long long)wall_clock64() : 0ull;
#define PG8_STAMP() do { if (STAMP && wid == 0 && nts < 64) { const unsigned long long _c = (unsigned long long)clock64(); \
        ts_lo = (lane == nts) ? (int)(unsigned)_c : ts_lo; ts_hi = (lane == nts) ? (int)(unsigned)(_c >> 32) : ts_hi; ++nts; } } while (0)
    PG8_STAMP();
    unsigned voffA[2], voffB[2];
#pragma unroll
    for (int i = 0; i < 2; ++i) { int R, C; stage_rc(tid * 16 + i * 8192, R, C); const int Rb = Epi::PERM ? ((R & ~31) + perm32(R & 31)) : R;
        voffA[i] = (unsigned)(R * K + C) * 2u; voffB[i] = (unsigned)(Rb * K + C) * 2u; }
    const size_t kstep = (size_t)(BK * 2);
    const size_t hstep = (size_t)HALF * K * 2;
    const size_t tstep = 2 * hstep;
    const unsigned ldsw = (unsigned)wid * 1024u;
    const int aoff = lds_byte(wr * 64 + fr, fq * 8), boff = lds_byte(wc * 32 + fr, fq * 8);
#define PG8_SA(b, h) (((b) * 2 + (h)) * HTB)
#define PG8_SB(b, h) ((4 + (b) * 2 + (h)) * HTB)
#define PG8_STAGE(bufoff, gbase, voff) do { _Pragma("unroll") for (int _i = 0; _i < 2; ++_i) \
        __builtin_amdgcn_global_load_lds((const unsigned*)((const char*)(gbase) + (voff)[_i]), (PG8_LAS unsigned*)(lds + (bufoff) + ldsw + _i * 8192), 16, 0, 0); } while (0)
#define PG8_LDA(dst, b, h) do { _Pragma("unroll") for (int m = 0; m < 4; ++m) _Pragma("unroll") for (int k = 0; k < 2; ++k) dst[m][k] = *(const PG8_LAS bf16x8*)(lds + PG8_SA(b, h) + aoff + m * 2048 + k * 1024); } while (0)
#define PG8_LDB(dst, b, h) do { _Pragma("unroll") for (int n = 0; n < 2; ++n) _Pragma("unroll") for (int k = 0; k < 2; ++k) dst[n][k] = *(const PG8_LAS bf16x8*)(lds + PG8_SB(b, h) + boff + n * 2048 + k * 1024); } while (0)
#define PG8_MMA(ai, bj, At, Bt) do { __builtin_amdgcn_s_setprio(1); _Pragma("unroll") for (int m = 0; m < 4; ++m) _Pragma("unroll") for (int n = 0; n < 2; ++n) _Pragma("unroll") for (int k = 0; k < 2; ++k) \
        acc[ai][bj][m][n] = __builtin_amdgcn_mfma_f32_16x16x32_bf16(Bt[n][k], At[m][k], acc[ai][bj][m][n], 0, 0, 0); __builtin_amdgcn_s_setprio(0); } while (0)
#define PG8_WAIT_V(n) asm volatile("s_waitcnt vmcnt(" #n ")" ::: "memory")
#define PG8_WAIT_L(n) asm volatile("s_waitcnt lgkmcnt(" #n ")" ::: "memory")
#define PG8_BAR __builtin_amdgcn_s_barrier()
#define PG8_SCHED __builtin_amdgcn_sched_barrier(0)
    Unit cur, nxt; int ui = 0;
    if (!S.next(0, cur)) return;
    f32x4 acc[2][2][4][2];
#pragma unroll
    for (int a = 0; a < 2; ++a)
#pragma unroll
        for (int b = 0; b < 2; ++b)
#pragma unroll
            for (int m = 0; m < 4; ++m)
#pragma unroll
                for (int n = 0; n < 2; ++n) acc[a][b][m][n] = (f32x4){0.f, 0.f, 0.f, 0.f};
    bf16x8 At[4][2], B0[2][2], B1[2][2];
    const char* cA = (const char*)g.A + (size_t)cur.pm * tstep; const char* cB = (const char*)g.Bt + (size_t)cur.pn * tstep;
    S.a_ready(cur);
    PG8_STAGE(PG8_SB(0, 0), cB, voffB); PG8_STAGE(PG8_SA(0, 0), cA, voffA); PG8_STAGE(PG8_SB(0, 1), cB + hstep, voffB); PG8_STAGE(PG8_SA(0, 1), cA + hstep, voffA);
    if (wr == 1) PG8_BAR;
    PG8_WAIT_V(4); PG8_BAR;
    PG8_STAGE(PG8_SB(1, 0), cB + kstep, voffB); PG8_STAGE(PG8_SA(1, 0), cA + kstep, voffA); PG8_STAGE(PG8_SB(1, 1), cB + hstep + kstep, voffB);
    PG8_WAIT_V(6); PG8_BAR;
    PG8_STAMP();
    for (;;) {
        const bool has_next = S.next(ui + 1, nxt);
        const char* nA = has_next ? (const char*)g.A + (size_t)nxt.pm * tstep : cA; const char* nB = has_next ? (const char*)g.Bt + (size_t)nxt.pn * tstep : cB;
        for (int t = 0; t < nt; t += 2) {
            if constexpr (Epi::KHOOK) { if (t == E.kh0 || t == E.kh1) E.khook(acc, cur, t, wr, wc, fr, fq); }
            const bool last = (t == nt - 2);
            const char* a1 = cA + (size_t)(t + 1) * kstep;
            const char* a2 = last ? nA : cA + (size_t)(t + 2) * kstep; const char* b2 = last ? nB : cB + (size_t)(t + 2) * kstep;
            const char* a3 = a2 + kstep; const char* b3 = b2 + kstep;
            if (last && has_next) S.a_ready(nxt);
            PG8_LDB(B0, 0, 0); PG8_SCHED; PG8_LDA(At, 0, 0); PG8_STAGE(PG8_SA(1, 1), a1 + hstep, voffA);
            PG8_WAIT_L(8); PG8_BAR; PG8_WAIT_L(0); PG8_MMA(0, 0, At, B0); PG8_BAR; PG8_SCHED;
            PG8_LDB(B1, 0, 1); PG8_STAGE(PG8_SB(0, 0), b2, voffB);
            PG8_BAR; PG8_WAIT_L(0); PG8_MMA(0, 1, At, B1); PG8_BAR;
            PG8_LDA(At, 0, 1); PG8_STAGE(PG8_SA(0, 0), a2, voffA);
            PG8_BAR; PG8_WAIT_L(0); PG8_MMA(1, 0, At, B0); PG8_BAR; PG8_SCHED;
            PG8_STAGE(PG8_SB(0, 1), b2 + hstep, voffB);
            PG8_WAIT_V(6); PG8_BAR; PG8_MMA(1, 1, At, B1); PG8_BAR;
            PG8_LDB(B0, 1, 0); PG8_SCHED; PG8_LDA(At, 1, 0); PG8_STAGE(PG8_SA(0, 1), a2 + hstep, voffA);
            PG8_WAIT_L(8); PG8_BAR; PG8_WAIT_L(0); PG8_MMA(0, 0, At, B0); PG8_BAR; PG8_SCHED;
            PG8_LDB(B1, 1, 1); PG8_STAGE(PG8_SB(1, 0), b3, voffB);
            PG8_BAR; PG8_WAIT_L(0); PG8_MMA(0, 1, At, B1); PG8_BAR;
            PG8_LDA(At, 1, 1); PG8_STAGE(PG8_SA(1, 0), a3, voffA);
            PG8_BAR; PG8_WAIT_L(0); PG8_MMA(1, 0, At, B0); PG8_BAR; PG8_SCHED;
            PG8_STAGE(PG8_SB(1, 1), b3 + hstep, voffB);
            PG8_WAIT_V(6); PG8_BAR; PG8_MMA(1, 1, At, B1); PG8_BAR;
        }
        PG8_STAMP();
        if constexpr (!Epi::AFTER_DRAIN) { E(acc, cur, wr, wc, fr, fq); S.done(cur); }
        PG8_STAMP();
        if (!has_next) break;
#pragma unroll
        for (int a = 0; a < 2; ++a)
#pragma unroll
            for (int b = 0; b < 2; ++b)
#pragma unroll
                for (int m = 0; m < 4; ++m)
#pragma unroll
                    for (int n = 0; n < 2; ++n) acc[a][b][m][n] = (f32x4){0.f, 0.f, 0.f, 0.f};
        cur = nxt; cA = nA; cB = nB; ++ui;
    }
    PG8_WAIT_V(0);
    if (wr == 0) PG8_BAR;
    PG8_BAR;
    if constexpr (Epi::AFTER_DRAIN) { E.fused(acc, cur, wr, wc, fr, fq, lds, wid, lane); S.done(cur); }
    PG8_STAMP();
    if (STAMP && wid == 0) { stamps[lane] = lane < nts ? (((unsigned long long)(unsigned)ts_hi << 32) | (unsigned)ts_lo) : 0ull;
        if (lane == 62) stamps[62] = rt_entry; if (lane == 63) stamps[63] = (unsigned long long)wall_clock64(); }
#undef PG8_STAMP
#undef PG8_SA
#undef PG8_SB
#undef PG8_STAGE
#undef PG8_LDA
#undef PG8_LDB
#undef PG8_MMA
#undef PG8_WAIT_V
#undef PG8_WAIT_L
#undef PG8_BAR
#undef PG8_SCHED
}
}
#define XB_TMO      128
#define XB_XCNT(j)  (256  + 64 * (j))
#define XB_XSUB(j)  (1280 + 64 * (j))
#define XB_XGEN(j)  (2304 + 64 * (j))
#define XB_TOP      3328
#define XB_TOPGEN   3392
#define XCD_BAR_WORDS 3456
#define XB_SPIN_CAP (1u << 18)
#define LAS __attribute__((address_space(3)))

__device__ __forceinline__ unsigned xb_ld(unsigned* p)              { return __hip_atomic_load(p, __ATOMIC_RELAXED, __HIP_MEMORY_SCOPE_AGENT); }
__device__ __forceinline__ unsigned xb_add(unsigned* p, unsigned v) { return __hip_atomic_fetch_add(p, v, __ATOMIC_RELAXED, __HIP_MEMORY_SCOPE_AGENT); }
__device__ __forceinline__ unsigned xb_xcc_id() { return (unsigned)__builtin_amdgcn_s_getreg((3 << 11) | 20) & 0xFu; }
#define XB_SPIN(cond, bar) do { unsigned _sp = 0; while (cond) { __builtin_amdgcn_s_sleep(1); \
    if ((++_sp & 255u) == 0u) { if (xb_ld(&(bar)[XB_TMO])) break; if (_sp > XB_SPIN_CAP) { atomicAdd(&(bar)[XB_TMO], 1u); break; } } } } while (0)

struct XcdBarrier {
    unsigned* bar; unsigned x;
    volatile LAS unsigned* st;
};

__device__ __forceinline__ XcdBarrier xcd_barrier_post(unsigned* bar, volatile LAS unsigned* st) {
    XcdBarrier b; b.bar = bar; b.x = (unsigned)__builtin_amdgcn_readfirstlane((int)xb_xcc_id()); b.st = st;
    if (threadIdx.x == 0) (void)xb_add(&bar[XB_XCNT(b.x)], 1u);
    return b;
}
__device__ __forceinline__ void xcd_barrier_complete(unsigned* bar, unsigned x, unsigned& nloc, unsigned& nx) {
    const unsigned G = gridDim.x * gridDim.y * gridDim.z;
    unsigned sum, cnt, mine, sp = 0u;
    for (;;) {
        sum = 0u; cnt = 0u; mine = 0u;
#pragma unroll
        for (unsigned j = 0; j < 16; ++j) { const unsigned c = xb_ld(&bar[XB_XCNT(j)]); sum += c; cnt += (c > 0u) ? 1u : 0u; mine = (j == x) ? c : mine; }
        if (sum == G) break;
        __builtin_amdgcn_s_sleep(1);
        if ((++sp & 255u) == 0u) { if (xb_ld(&bar[XB_TMO])) break; if (sp > XB_SPIN_CAP) { atomicAdd(&bar[XB_TMO], 1u); break; } }
    }
    nloc = mine > 0u ? mine : 1u; nx = cnt > 0u ? cnt : 1u;
}

__device__ __forceinline__ void xcd_barrier(const XcdBarrier& b) {
    asm volatile("s_waitcnt vmcnt(0)" ::: "memory");
    __syncthreads();
    if (threadIdx.x == 0) {
        unsigned* bar = b.bar; unsigned bx = b.x; asm volatile("" : "+s"(bx));
        __builtin_amdgcn_s_waitcnt(0);
        unsigned nloc = b.st[0], nx = b.st[1];
        if (nloc == 0u) { xcd_barrier_complete(bar, bx, nloc, nx); b.st[0] = nloc; b.st[1] = nx; }
        const unsigned old = xb_add(&bar[XB_XSUB(bx)], 1u);
        const unsigned gen = old / nloc;
        if (old + 1u == (gen + 1u) * nloc) {
            __builtin_amdgcn_fence(__ATOMIC_RELEASE, "agent");
            asm volatile("s_waitcnt vmcnt(0)" ::: "memory");
            const unsigned og = xb_add(&bar[XB_TOP], 1u);
            const unsigned tg = og / nx;
            if (og + 1u == (tg + 1u) * nx) xb_add(&bar[XB_TOPGEN], 1u);
            else XB_SPIN(xb_ld(&bar[XB_TOPGEN]) == tg, bar);
            __builtin_amdgcn_fence(__ATOMIC_ACQUIRE, "agent");
            xb_add(&bar[XB_XGEN(bx)], 1u);
            asm volatile("s_waitcnt vmcnt(0)" ::: "memory");
        } else {
            XB_SPIN(xb_ld(&bar[XB_XGEN(bx)]) == gen, bar);
            __builtin_amdgcn_fence(__ATOMIC_ACQUIRE, "agent");
            asm volatile("s_waitcnt vmcnt(0)" ::: "memory");
        }
    }
    __syncthreads();
}

extern __shared__ __attribute__((aligned(16))) unsigned char smem[];

DI void convT_tile(const float* __restrict__ src, int ldsrc, bf16_t* __restrict__ dst, int K  , int tile, int ntn, bool inmap) {
    float* t = (float*)smem;
    const int tid = ltid(), tk = tile / ntn, tn = tile % ntn, k0 = tk * 64, n0 = tn * 64;
    __syncthreads();
#pragma unroll
    for (int r = 0; r < 8; ++r) {
        const int i = (tid >> 6) + 8 * r, j = tid & 63, n = n0 + j;
        int sn = n; bool z = false;
        if (inmap) { if (n >= 3104 && n < C_NQ) z = true; else if (n >= C_NQ) sn = n - 224; }
        t[i * 65 + j] = z ? 0.f : src[(size_t)(k0 + i) * ldsrc + sn];
    }
    __syncthreads();
    const int j = tid >> 3, i8 = (tid & 7) * 8;
    u32x4 w;
    w.x = pk2(t[(i8 + 0) * 65 + j], t[(i8 + 1) * 65 + j]); w.y = pk2(t[(i8 + 2) * 65 + j], t[(i8 + 3) * 65 + j]);
    w.z = pk2(t[(i8 + 4) * 65 + j], t[(i8 + 5) * 65 + j]); w.w = pk2(t[(i8 + 6) * 65 + j], t[(i8 + 7) * 65 + j]);
    *(u32x4*)(dst + (size_t)(n0 + j) * K + k0 + i8) = w;
}
DI void phase_convert(const Params& p, int bid, int nb) {
    for (int l = 0; l < DEPTH; ++l) {
        { const int ntn = NP / 64, nt = (DM / 64) * ntn; bf16_t* d = (bf16_t*)(lws(p) + OFF_WIN) + (size_t)l * NP * DM;
          for (int t = bid; t < nt; t += nb) convT_tile(p.w_in + (size_t)l * DM * IN_TOTAL, IN_TOTAL, d, DM, t, ntn, true); }
        for (int br = 0; br < 3; ++br) { const float* s = (br == 0 ? p.w_br_a : br == 1 ? p.w_br_b : p.w_br_c) + (size_t)l * 1024 * DM;
          const int ntn = DM / 64, nt = (1024 / 64) * ntn; bf16_t* d = (bf16_t*)(lws(p) + OFF_WBR) + (size_t)l * DM * 3072 + br * 1024;
          for (int t = bid; t < nt; t += nb) convT_tile(s, DM, d, 3072, t, ntn, false); }
        { const int ntn = DM / 64, nt = (DM / 64) * ntn; bf16_t* d = (bf16_t*)(lws(p) + OFF_WOUT) + (size_t)l * DM * DM;
          for (int t = bid; t < nt; t += nb) convT_tile(p.w_out + (size_t)l * DM * DM, DM, d, DM, t, ntn, false); }
        { const int ntn = DFF / 64, nt = (DM / 64) * ntn; bf16_t* d = (bf16_t*)(lws(p) + OFF_W1) + (size_t)l * DFF * DM;
          for (int t = bid; t < nt; t += nb) convT_tile(p.w_mlp1 + (size_t)l * DM * DFF, DFF, d, DM, t, ntn, false); }
        { const int ntn = DM / 64, nt = (DFF / 64) * ntn; bf16_t* d = (bf16_t*)(lws(p) + OFF_W2) + (size_t)l * DM * DFF;
          for (int t = bid; t < nt; t += nb) convT_tile(p.w_mlp2 + (size_t)l * DFF * DM, DM, d, DFF, t, ntn, false); }
    }
}

DI void phase_adaln(const Params& p, int bid, int nb) {
    float* sc = (float*)smem;
    float* red = sc + NCOND * DM;
    const int tid = ltid();
    __syncthreads();
    for (int i = tid; i < NCOND * DM; i += 512) { const int r = i / DM, k = i % DM; const float v = r == 0 ? p.c_ctx[k] : p.c[(size_t)(r - 1) * DM + k]; sc[i] = v * sigmoidf_(v); }
    __syncthreads();
    const int nun = DEPTH * (NMOD * DM / 64);
    for (int u = bid; u < nun; u += nb) {
        const int l = u / (NMOD * DM / 64), j0 = (u % (NMOD * DM / 64)) * 64, j = tid & 63, ks = tid >> 6;
        const float* w = p.w_mod + (size_t)l * DM * (NMOD * DM) + j0 + j;
        float acc[NCOND];
#pragma unroll
        for (int r = 0; r < NCOND; ++r) acc[r] = 0.f;
        for (int k = ks * 256; k < ks * 256 + 256; ++k) { const float wv = w[(size_t)k * (NMOD * DM)];
#pragma unroll
            for (int r = 0; r < NCOND; ++r) acc[r] += sc[r * DM + k] * wv; }
#pragma unroll
        for (int r = 0; r < NCOND; ++r) red[(ks * NCOND + r) * 64 + j] = acc[r];
        __syncthreads();
        for (int i = tid; i < NCOND * 64; i += 512) { const int r = i / 64, jj = i % 64; float s = p.b_mod[(size_t)l * NMOD * DM + j0 + jj];
#pragma unroll
            for (int q = 0; q < 8; ++q) s += red[(q * NCOND + r) * 64 + jj];
            ((float*)(lws(p) + OFF_MOD))[((size_t)l * NCOND + r) * (NMOD * DM) + j0 + jj] = s; }
        __syncthreads();
    }
}

DI void phase_hyena_hid(const Params& p, int bid, int nb) {
    float* zf = (float*)smem;
    float* h1 = zf + 8 * 36;
    const int tid = ltid(), tt = tid >> 6, j = tid & 63;
    const int nun = DEPTH * (256 / 8 + 4096 / 8);
    for (int u = bid; u < nun; u += nb) {
        const int l = u / 544, r = u % 544, ls = r < 32 ? 0 : 1, tb = ls ? r - 32 : r, L = ls ? 4096 : 256, t = tb * 8 + tt;
        const float tn = (float)t / (float)L;
        __syncthreads();
        if (j < 33) { float v; if (j == 0) v = tn; else { const int band = j <= 16 ? j : j - 16; const float ang = 6.283185307179586f * tn * (float)band; v = j <= 16 ? cosf(ang) : sinf(ang); } zf[tt * 36 + j] = v; }
        __syncthreads();
        const float fr = p.hy_freq[l * 64 + j];
        float a = p.hy_f1_b[l * 64 + j];
        for (int i = 0; i < 33; ++i) a += zf[tt * 36 + i] * p.hy_f1_w[((size_t)l * 33 + i) * 64 + j];
        h1[tt * 64 + j] = sinf(fr * a);
        __syncthreads();
        float b = p.hy_f2_b[l * 64 + j];
        for (int i = 0; i < 64; ++i) b += h1[tt * 64 + i] * p.hy_f2_w[((size_t)l * 64 + i) * 64 + j];
        ((float*)(lws(p) + OFF_HID))[(((size_t)l * 2 + ls) * 4096 + t) * 64 + j] = sinf(fr * b);
    }
}
DI bf16_t* filt_ptr(unsigned char* ws, int l, int ls) { return (bf16_t*)(ws + OFF_FILT + (size_t)l * FILT_L) + (ls ? (size_t)2 * 1024 * (256 + 232) : 0); }
DI void phase_filters(const Params& p, int bid, int nb) {
    float* f3s = (float*)smem;
    float* red = f3s + 256;
    const int tid = ltid();
    const int nun = DEPTH * 2 * 512;
    const int tid0 = tid;
    for (int u = bid; u < nun; u += nb) {
        int tid = tid0; asm volatile("" : "+v"(tid));
        const int lane = tid & 63, wid = tid >> 6;
        const int l = u / 1024, ls = (u / 512) & 1, cg = u % 512, L = ls ? 4096 : 256, col0 = cg * 4;
        __syncthreads();
        if (tid < 256) f3s[tid] = p.hy_f3_w[((size_t)l * 64 + (tid >> 2)) * 2048 + col0 + (tid & 3)];
        __syncthreads();
        const float* hid = (const float*)(lws(p) + OFF_HID) + ((size_t)l * 2 + ls) * 4096 * 64;
        float val[8][4]; float ss[4] = {0.f, 0.f, 0.f, 0.f};
        float delta[4];
#pragma unroll
        for (int cc = 0; cc < 4; ++cc) { const int c = (col0 + cc) & 1023; const float a = -3.0701134573253943f, b = -15.350567286626972f; delta[cc] = fabsf(a + (b - a) * ((float)c / 1023.0f)); }
#pragma unroll
        for (int i = 0; i < 8; ++i) {
            const int t = tid + 512 * i;
#pragma unroll
            for (int cc = 0; cc < 4; ++cc) val[i][cc] = 0.f;
            if (t < L) {
                const f32x4* hr = (const f32x4*)(hid + (size_t)t * 64);
                float a0 = 0.f, a1 = 0.f, a2 = 0.f, a3 = 0.f;
#pragma unroll
                for (int q = 0; q < 16; ++q) { const f32x4 hv = hr[q];
#pragma unroll
                    for (int e = 0; e < 4; ++e) { const f32x4 w = *(const f32x4*)(f3s + (q * 4 + e) * 4); a0 += hv[e] * w[0]; a1 += hv[e] * w[1]; a2 += hv[e] * w[2]; a3 += hv[e] * w[3]; } }
                const float dist = fabsf((float)t - (float)(L / 2)) * (2.0f / (float)L);
                val[i][0] = a0 * expf(-dist * delta[0]); val[i][1] = a1 * expf(-dist * delta[1]); val[i][2] = a2 * expf(-dist * delta[2]); val[i][3] = a3 * expf(-dist * delta[3]);
#pragma unroll
                for (int cc = 0; cc < 4; ++cc) ss[cc] += val[i][cc] * val[i][cc];
            }
        }
#pragma unroll
        for (int cc = 0; cc < 4; ++cc) { ss[cc] = wave_sum(ss[cc], lane); if (lane == 0) red[wid * 4 + cc] = ss[cc]; }
        __syncthreads();
        float sc[4];
#pragma unroll
        for (int cc = 0; cc < 4; ++cc) { float s = 0.f;
#pragma unroll
            for (int q = 0; q < 8; ++q) s += red[q * 4 + cc]; sc[cc] = rsqrtf(s + EPS); }
        bf16_t* fo = filt_ptr(lws(p), l, ls);
        const int LF = L + 232;
        int tid2 = tid; asm volatile("" : "+v"(tid2));
#pragma unroll
        for (int i = 0; i < 8; ++i) { const int t = tid2 + 512 * i; if (t < L) {
#pragma unroll
            for (int cc = 0; cc < 4; ++cc) { const int col = col0 + cc; fo[((size_t)(col >> 10) * 1024 + (col & 1023)) * LF + (L + 87 - t)] = f2bf(val[i][cc] * sc[cc]); } } }
        if (tid < 232) { const int xx = tid < 88 ? tid : L + tid;
#pragma unroll
            for (int cc = 0; cc < 4; ++cc) { const int col = col0 + cc; fo[((size_t)(col >> 10) * 1024 + (col & 1023)) * LF + xx] = (bf16_t)0; } }
    }
}

DI int cond_row(int grp, int row) { return grp == 0 ? 0 : 1 + 2 * (grp - 1) + (row >> 12); }
DI void phase_norm(const Params& p, const float* x, const float* g, int l, int grp, int shoff, int scoff, int bid, int nb) {
    const int tid = ltid(), lane = tid & 63, wid = tid >> 6;
    bf16_t* h = (bf16_t*)(lws(p) + OFF_H);
    for (int row = bid * 8 + wid; row < GT; row += nb * 8) {
        const float* xr = x + (size_t)row * DM;
        f32x4 v[8]; float ss = 0.f;
#pragma unroll
        for (int i = 0; i < 8; ++i) { v[i] = *(const f32x4*)(xr + i * 256 + lane * 4); ss += v[i][0] * v[i][0] + v[i][1] * v[i][1] + v[i][2] * v[i][2] + v[i][3] * v[i][3]; }
        ss = wave_sum(ss, lane);
        const float rs = rsqrtf(ss * (1.0f / DM) + EPS);
        const float* md = (const float*)(lws(p) + OFF_MOD) + ((size_t)l * NCOND + cond_row(grp, row)) * (NMOD * DM);
#pragma unroll
        for (int i = 0; i < 8; ++i) { const int c = i * 256 + lane * 4; const f32x4 gv = *(const f32x4*)(g + c), sh = *(const f32x4*)(md + shoff + c), sc = *(const f32x4*)(md + scoff + c);
            f32x4 o = v[i] * rs * gv * (sc + 1.0f) + sh; u32x2 w; w.x = pk2(o[0], o[1]); w.y = pk2(o[2], o[3]); *(u32x2*)(h + (size_t)row * DM + c) = w; }
    }
}
using pg8::Unit; using pg8::cvt_pk_bf16;
template <int ACT> struct EpiStoreBf16 {
    static constexpr bool PERM = true, AFTER_DRAIN = false, KHOOK = false;
    bf16_t* O; int ldc; int pad;
    __device__ __forceinline__ void operator()(const f32x4 (&acc)[2][2][4][2], const Unit& u, int wr, int wc, int fr, int fq) const {
        const int row0 = u.pm * 256 + wr * 64 + fr, col0 = u.pn * 256 + wc * 32 + 8 * fq;
#pragma unroll
        for (int ai = 0; ai < 2; ++ai)
#pragma unroll
            for (int m = 0; m < 4; ++m) { bf16_t* rowp = O + (size_t)(row0 + ai * 128 + m * 16) * ldc + col0;
#pragma unroll
                for (int bj = 0; bj < 2; ++bj) { f32x4 v0 = acc[ai][bj][m][0], v1 = acc[ai][bj][m][1];
                    if (ACT == 1) {
#pragma unroll
                        for (int j = 0; j < 4; ++j) { const float a = fmaxf(v0[j], 0.f), b = fmaxf(v1[j], 0.f); v0[j] = a * a; v1[j] = b * b; } }
                    u32x4 w; w.x = cvt_pk_bf16(v0[0], v0[1]); w.y = cvt_pk_bf16(v0[2], v0[3]); w.z = cvt_pk_bf16(v1[0], v1[1]); w.w = cvt_pk_bf16(v1[2], v1[3]);
                    *(u32x4*)(rowp + bj * 128) = w; } }
    }
};
struct EpiGate3 {
    static constexpr bool PERM = true, AFTER_DRAIN = false, KHOOK = true;
    static constexpr int kh0 = 16, kh1 = 32;
    const bf16_t* gate; bf16_t* mbf; int ldg; int pad;
    __device__ __forceinline__ void khook(f32x4 (&acc)[2][2][4][2], const Unit& u, int t, int wr, int wc, int fr, int fq) const {
        typedef const __attribute__((address_space(1))) unsigned char* gptr;
        typedef const __attribute__((address_space(1))) u32x4* gvec;
        const gptr gb = (gptr)gate;
        int fr_ = fr, fq_ = fq; asm volatile("" : "+v"(fr_), "+v"(fq_));
        const int bn = (t == kh0) ? 0 : DM;
        const unsigned off0 = (unsigned)(((u.pm * 256 + wr * 64 + fr_) * NP + bn + u.pn * 256 + wc * 32 + 8 * fq_) * 2);
#pragma unroll
        for (int ai = 0; ai < 2; ++ai)
#pragma unroll
            for (int m = 0; m < 4; ++m) {
#pragma unroll
                for (int bj = 0; bj < 2; ++bj) { const unsigned off = off0 + (unsigned)((ai * 128 + m * 16) * NP * 2 + bj * 256);
                    const u32x4 nw = *(gvec)(gb + off), dw = *(gvec)(gb + off + DM * 2);
                    float r[8];
#pragma unroll
                    for (int j = 0; j < 4; ++j) { r[2 * j] = (1.0f + __expf(-bflo(dw[j]))) / (1.0f + __expf(-bflo(nw[j]))); r[2 * j + 1] = (1.0f + __expf(-bfhi(dw[j]))) / (1.0f + __expf(-bfhi(nw[j]))); }
                    acc[ai][bj][m][0] *= (f32x4){r[0], r[1], r[2], r[3]}; acc[ai][bj][m][1] *= (f32x4){r[4], r[5], r[6], r[7]}; }
                asm volatile("" ::: "memory"); }
    }
    __device__ __forceinline__ void operator()(const f32x4 (&acc)[2][2][4][2], const Unit& u, int wr, int wc, int fr, int fq) const {
        const int row0 = u.pm * 256 + wr * 64 + fr, col0 = u.pn * 256 + wc * 32 + 8 * fq;
#pragma unroll
        for (int ai = 0; ai < 2; ++ai)
#pragma unroll
            for (int m = 0; m < 4; ++m) { const size_t row = (size_t)(row0 + ai * 128 + m * 16);
#pragma unroll
                for (int bj = 0; bj < 2; ++bj) { const int col = col0 + bj * 128;
                    const u32x4 gw = *(const u32x4*)(gate + row * ldg + 2 * DM + col);
                    f32x4 s0, s1;
                    s0[0] = sigmoidf_(bflo(gw.x)); s0[1] = sigmoidf_(bfhi(gw.x)); s0[2] = sigmoidf_(bflo(gw.y)); s0[3] = sigmoidf_(bfhi(gw.y));
                    s1[0] = sigmoidf_(bflo(gw.z)); s1[1] = sigmoidf_(bfhi(gw.z)); s1[2] = sigmoidf_(bflo(gw.w)); s1[3] = sigmoidf_(bfhi(gw.w));
                    const f32x4 v0 = acc[ai][bj][m][0] * s0, v1 = acc[ai][bj][m][1] * s1;
                    u32x4 w; w.x = cvt_pk_bf16(v0[0], v0[1]); w.y = cvt_pk_bf16(v0[2], v0[3]); w.z = cvt_pk_bf16(v1[0], v1[1]); w.w = cvt_pk_bf16(v1[2], v1[3]);
                    *(u32x4*)(mbf + row * DM + col) = w; } }
    }
};
struct EpiResid {
    static constexpr bool PERM = true, AFTER_DRAIN = false, KHOOK = false;
    const float* xin; float* xout; const float* gA; const float* gB;
    __device__ __forceinline__ void operator()(const f32x4 (&acc)[2][2][4][2], const Unit& u, int wr, int wc, int fr, int fq) const {
        const int row0 = u.pm * 256 + wr * 64 + fr, col0 = u.pn * 256 + wc * 32 + 8 * fq;
        const float* gv = (u.pm * 256 < 4096) ? gA : gB;
#pragma unroll
        for (int bj = 0; bj < 2; ++bj) { const int col = col0 + bj * 128; const f32x4 g0 = *(const f32x4*)(gv + col), g1 = *(const f32x4*)(gv + col + 4);
#pragma unroll
            for (int ai = 0; ai < 2; ++ai)
#pragma unroll
                for (int m = 0; m < 4; ++m) { const size_t o = (size_t)(row0 + ai * 128 + m * 16) * DM + col;
                    const f32x4 a0 = *(const f32x4*)(xin + o), a1 = *(const f32x4*)(xin + o + 4);
                    *(f32x4*)(xout + o) = a0 + g0 * acc[ai][bj][m][0]; *(f32x4*)(xout + o + 4) = a1 + g1 * acc[ai][bj][m][1]; } }
    }
};

struct GrpInfo { int grp, l, L, nseq, latent; };
DI GrpInfo grp_info(int grp, int l) { GrpInfo g; g.grp = grp; g.l = l; g.latent = grp > 0; g.L = grp ? 4096 : 256; g.nseq = grp ? 2 : 32; return g; }

template <bool WITH_OI> DI void phase_gla_post(const Params& p, GrpInfo gi, int bid, int nb) {
    const int tid = ltid(), lane = tid & 63, wid = tid >> 6;
    const bf16_t* P = (const bf16_t*)(lws(p) + OFF_P);
    const float* Of = (const float*)(lws(p) + OFF_OF); const float* Ob = (const float*)(lws(p) + OFF_OB); const float* Oi = (const float*)(lws(p) + OFF_OI);
    bf16_t* OA = (bf16_t*)(lws(p) + OFF_OABC);
    const f32x4 g = *(const f32x4*)(p.gla_norm_g + gi.l * 256 + lane * 4);
    for (int u = bid * 8 + wid; u < GT * 4; u += nb * 8) {
        const int row = u >> 2, h = u & 3; const size_t o = (size_t)row * 1024 + h * 256 + lane * 4, oa = (size_t)row * 3072 + h * 256 + lane * 4;
        f32x4 v = *(const f32x4*)(Of + o) + *(const f32x4*)(Ob + o); if (WITH_OI) v += *(const f32x4*)(Oi + o);
        const float rs = rsqrtf(wave_sum(v[0] * v[0] + v[1] * v[1] + v[2] * v[2] + v[3] * v[3], lane) * (1.0f / 256) + EPS);
        const u32x2 gw = *(const u32x2*)(P + (size_t)row * NP + C_GG + h * 256 + lane * 4);
        const float g0 = bflo(gw.x), g1 = bfhi(gw.x), g2 = bflo(gw.y), g3 = bfhi(gw.y);
        u32x2 w; w.x = pk2(v[0] * rs * g[0] * (g0 * sigmoidf_(g0)), v[1] * rs * g[1] * (g1 * sigmoidf_(g1)));
        w.y = pk2(v[2] * rs * g[2] * (g2 * sigmoidf_(g2)), v[3] * rs * g[3] * (g3 * sigmoidf_(g3)));
        *(u32x2*)(OA + oa) = w;
    }
}

typedef short bf16x8 __attribute__((ext_vector_type(8)));
typedef short bf16x4 __attribute__((ext_vector_type(4)));
#define MFMA16(a, b, c) __builtin_amdgcn_mfma_f32_16x16x32_bf16((a), (b), (c), 0, 0, 0)
constexpr int QKP = 136;
constexpr int TP = 80;
DI float log_sigmoid_fast(float x) { return fminf(x, 0.f) - __logf(1.0f + __expf(-fabsf(x))); }
DI bf16x8 pack8(const f32x4& a, const f32x4& b) { u32x4 w; w.x = pk2(a[0], a[1]); w.y = pk2(a[2], a[3]); w.z = pk2(b[0], b[1]); w.w = pk2(b[2], b[3]); return __builtin_bit_cast(bf16x8, w); }

DI void gla_prep_unit(const Params& p, const GrpInfo gi, int unit, int tid_in) {
    int tid = tid_in; asm volatile("" : "+v"(tid));
    const int cg = unit >> 2, h = unit & 3, row0 = cg * 64, t0 = row0 & (gi.L - 1), l = gi.l;
    const int lane = tid & 63, wid = tid >> 6, r16 = lane & 15, q4 = lane >> 4;
    float* laf = (float*)smem; float* lab = laf + 8192;
    bf16_t* QFs = (bf16_t*)(smem + 65536); bf16_t* KFs = QFs + 64 * QKP; bf16_t* QBs = KFs + 64 * QKP; bf16_t* KBs = QBs + 64 * QKP;
    bf16_t* VTs = (bf16_t*)smem; bf16_t* As = (bf16_t*)(smem + 40960);
    const bf16_t* P = (const bf16_t*)(lws(p) + OFF_P);
    __syncthreads();
    {
        const int t = tid >> 3, d0 = (tid & 7) * 16;
        const bf16_t* pr = P + (size_t)(row0 + t) * NP + C_GA;
        float ga[32];
#pragma unroll
        for (int i = 0; i < 4; ++i) { const u32x4 w = *(const u32x4*)(pr + 8 * i); ga[8 * i] = bflo(w.x); ga[8 * i + 1] = bfhi(w.x); ga[8 * i + 2] = bflo(w.y); ga[8 * i + 3] = bfhi(w.y); ga[8 * i + 4] = bflo(w.z); ga[8 * i + 5] = bfhi(w.z); ga[8 * i + 6] = bflo(w.w); ga[8 * i + 7] = bfhi(w.w); }
#pragma unroll
        for (int dir = 0; dir < 2; ++dir) {
            const float* wa = p.gla_wa2 + (((size_t)l * 2 + dir) * 16) * 512 + h * 128 + d0;
            const float* ba = p.gla_ba2 + ((size_t)l * 2 + dir) * 512 + h * 128 + d0;
            float* dst = (dir ? lab : laf) + t * 128 + d0;
#pragma unroll
            for (int j4 = 0; j4 < 4; ++j4) {
                f32x4 x = *(const f32x4*)(ba + 4 * j4);
#pragma unroll
                for (int r = 0; r < 16; ++r) x += *(const f32x4*)(wa + (size_t)r * 512 + 4 * j4) * ga[dir * 16 + r];
                f32x4 o; o[0] = log_sigmoid_fast(x[0]) * 0.0625f; o[1] = log_sigmoid_fast(x[1]) * 0.0625f; o[2] = log_sigmoid_fast(x[2]) * 0.0625f; o[3] = log_sigmoid_fast(x[3]) * 0.0625f;
                *(f32x4*)(dst + 4 * j4) = o;
            }
        }
    }
    __syncthreads();
    {
        const int d = tid & 127, dirc = (tid >> 7) & 1, hf = tid >> 8;
        float* col = (dirc ? lab : laf) + d;
        float a = 0.f;
        if (dirc == 0) { for (int t = 32 * hf; t < 32 * hf + 32; ++t) { a += col[t * 128]; col[t * 128] = a; } }
        else { for (int t = 63 - 32 * hf; t > 31 - 32 * hf; --t) { a += col[t * 128]; col[t * 128] = a; } }
        __syncthreads();
        if (hf == 1) { const float carry = dirc == 0 ? col[31 * 128] : col[32 * 128];
            if (dirc == 0) { for (int t = 32; t < 64; ++t) col[t * 128] += carry; } else { for (int t = 31; t >= 0; --t) col[t * 128] += carry; } }
    }
    __syncthreads();
    {
        const int t = tid >> 3, dlo = (tid & 7) * 8, ta = t0 + t;
        const bf16_t* pr = P + (size_t)(row0 + t) * NP + h * 128;
        const u32x4 qlw = *(const u32x4*)(pr + C_GQ + dlo), qhw = *(const u32x4*)(pr + C_GQ + 64 + dlo), klw = *(const u32x4*)(pr + C_GK + dlo), khw = *(const u32x4*)(pr + C_GK + 64 + dlo);
        float ql[8], qh[8], kl[8], kh[8];
#pragma unroll
        for (int j = 0; j < 4; ++j) { ql[2 * j] = bflo(qlw[j]); ql[2 * j + 1] = bfhi(qlw[j]); qh[2 * j] = bflo(qhw[j]); qh[2 * j + 1] = bfhi(qhw[j]); kl[2 * j] = bflo(klw[j]); kl[2 * j + 1] = bfhi(klw[j]); kh[2 * j] = bflo(khw[j]); kh[2 * j + 1] = bfhi(khw[j]); }
#pragma unroll
        for (int j = 0; j < 8; ++j) {
            ql[j] *= 0.08838834764831845f; qh[j] *= 0.08838834764831845f;
            if (gi.latent) {
                const int ii = dlo + j, f = ii & 31; const float pos = (float)(ii < 32 ? (ta >> 6) : (ta & 63));
                const float ang = pos * exp2f(-(float)f * 0.41524101186092029f); const float sn = __sinf(ang), cs = __cosf(ang);
                const float a = ql[j] * cs - qh[j] * sn, b = ql[j] * sn + qh[j] * cs; ql[j] = a; qh[j] = b;
                const float c = kl[j] * cs - kh[j] * sn, e = kl[j] * sn + kh[j] * cs; kl[j] = c; kh[j] = e;
            }
        }
        float* DEC = (float*)(lws(p) + OFF_DEC);
#pragma unroll
        for (int dir = 0; dir < 2; ++dir) {
            const float* bb = dir ? lab : laf;
            bf16_t* Qs = dir ? QBs : QFs; bf16_t* Ks = dir ? KBs : KFs;
            bf16_t* Qg = (bf16_t*)(lws(p) + (dir ? OFF_QB : OFF_QF)) + (size_t)(row0 + t) * 512 + h * 128;
#pragma unroll
            for (int half = 0; half < 2; ++half) {
                const int d = dlo + 64 * half;
                const f32x4 b0 = *(const f32x4*)(bb + t * 128 + d), b1 = *(const f32x4*)(bb + t * 128 + d + 4);
                float qo[8], ko[8];
#pragma unroll
                for (int j = 0; j < 8; ++j) { const float bv = j < 4 ? b0[j] : b1[j - 4]; const float qv = half ? qh[j] : ql[j], kv = half ? kh[j] : kl[j]; qo[j] = qv * __expf(bv); ko[j] = kv * __expf(-bv); }
                u32x4 qw, kw; qw.x = pk2(qo[0], qo[1]); qw.y = pk2(qo[2], qo[3]); qw.z = pk2(qo[4], qo[5]); qw.w = pk2(qo[6], qo[7]);
                kw.x = pk2(ko[0], ko[1]); kw.y = pk2(ko[2], ko[3]); kw.z = pk2(ko[4], ko[5]); kw.w = pk2(ko[6], ko[7]);
                *(u32x4*)(Qs + t * QKP + d) = qw; *(u32x4*)(Ks + t * QKP + d) = kw; *(u32x4*)(Qg + d) = qw;
                if (t == 0) { const int te = dir ? 0 : 63; const f32x4 e0 = *(const f32x4*)(bb + te * 128 + d), e1 = *(const f32x4*)(bb + te * 128 + d + 4);
                    f32x4 x0, x1;
#pragma unroll
                    for (int j = 0; j < 4; ++j) { x0[j] = __expf(e0[j]); x1[j] = __expf(e1[j]); }
                    float* dp = DEC + ((size_t)dir * 128 + cg) * 512 + h * 128 + d; *(f32x4*)dp = x0; *(f32x4*)(dp + 4) = x1; }
            }
        }
    }
    __syncthreads();
    {
        const int s = tid >> 3, e0 = (tid & 7) * 32;
        const bf16_t* pv = P + (size_t)(row0 + s) * NP + C_GV + h * 256 + e0;
#pragma unroll
        for (int i = 0; i < 4; ++i) { const u32x4 w = *(const u32x4*)(pv + 8 * i);
#pragma unroll
            for (int j = 0; j < 4; ++j) { VTs[(e0 + 8 * i + 2 * j) * TP + s] = (bf16_t)(w[j] & 0xffffu); VTs[(e0 + 8 * i + 2 * j + 1) * TP + s] = (bf16_t)(w[j] >> 16); } }
        const int mt = wid >> 1, nt0 = 2 * (wid & 1);
        f32x4 acc[2][2];
#pragma unroll
        for (int dir = 0; dir < 2; ++dir) { const bf16_t* Qs = dir ? QBs : QFs; const bf16_t* Ks = dir ? KBs : KFs;
#pragma unroll
            for (int n = 0; n < 2; ++n) acc[dir][n] = (f32x4){0.f, 0.f, 0.f, 0.f};
#pragma unroll
            for (int ks = 0; ks < 4; ++ks) { const bf16x8 a = *(const bf16x8*)(Qs + (16 * mt + r16) * QKP + 32 * ks + 8 * q4);
#pragma unroll
                for (int n = 0; n < 2; ++n) { const bf16x8 b = *(const bf16x8*)(Ks + (16 * (nt0 + n) + r16) * QKP + 32 * ks + 8 * q4); acc[dir][n] = MFMA16(a, b, acc[dir][n]); } } }
#pragma unroll
        for (int n = 0; n < 2; ++n)
#pragma unroll
            for (int i = 0; i < 4; ++i) { const int t = 16 * mt + 4 * q4 + i, s2 = 16 * (nt0 + n) + r16;
                const float v = (s2 <= t ? acc[0][n][i] : 0.f) + (s2 >= t ? acc[1][n][i] : 0.f); As[t * TP + s2] = f2bf(v); }
        const int d = tid >> 2, sq = tid & 3;
#pragma unroll
        for (int dir = 0; dir < 2; ++dir) { const bf16_t* Ks = dir ? KBs : KFs; unsigned w[8];
#pragma unroll
            for (int j = 0; j < 8; ++j) w[j] = (unsigned)Ks[(sq * 16 + 2 * j) * QKP + d] | ((unsigned)Ks[(sq * 16 + 2 * j + 1) * QKP + d] << 16);
            bf16_t* kg = (bf16_t*)(lws(p) + (dir ? OFF_KBT : OFF_KFT)) + (((size_t)cg * 4 + h) * 128 + d) * 64 + sq * 16;
            *(u32x4*)kg = (u32x4){w[0], w[1], w[2], w[3]}; *(u32x4*)(kg + 8) = (u32x4){w[4], w[5], w[6], w[7]}; }
    }
    __syncthreads();
    {
        const int e = tid >> 1, hf = tid & 1;
        bf16_t* vg = (bf16_t*)(lws(p) + OFF_VT) + (((size_t)cg * 4 + h) * 256 + e) * 64 + hf * 32;
#pragma unroll
        for (int i = 0; i < 4; ++i) *(u32x4*)(vg + 8 * i) = *(const u32x4*)(VTs + e * TP + hf * 32 + 8 * i);
        float* OI = (float*)(lws(p) + OFF_OI);
#pragma unroll
        for (int n = 0; n < 2; ++n) { const int nt = 2 * wid + n;
            bf16x8 b[2];
#pragma unroll
            for (int ks = 0; ks < 2; ++ks) b[ks] = *(const bf16x8*)(VTs + (16 * nt + r16) * TP + 32 * ks + 8 * q4);
#pragma unroll
            for (int mt = 0; mt < 4; ++mt) { f32x4 acc = (f32x4){0.f, 0.f, 0.f, 0.f};
#pragma unroll
                for (int ks = 0; ks < 2; ++ks) { const bf16x8 a = *(const bf16x8*)(As + (16 * mt + r16) * TP + 32 * ks + 8 * q4); acc = MFMA16(a, b[ks], acc); }
#pragma unroll
                for (int i = 0; i < 4; ++i) OI[(size_t)(row0 + 16 * mt + 4 * q4 + i) * 1024 + h * 256 + 16 * nt + r16] = acc[i]; } }
    }
}
DI void phase_gla_prep(const Params& p, const GrpInfo gi, int bid, int nb) {
    const int tid = ltid();
    for (int u = bid; u < 512; u += nb) gla_prep_unit(p, gi, u, tid);
}

constexpr int SC_Q = 0, SC_K = 64 * QKP * 2, SC_V = SC_K + 128 * TP * 2, SC_D = SC_V + 128 * TP * 2, SC_BUF = SC_D + 512;
DI void gla_scan_unit(const Params& p, const GrpInfo gi, int unit, int tid_in) {
    int tid = tid_in; asm volatile("" : "+v"(tid));
    const int sl = unit >> 4, h = (unit >> 2) & 3, dir = (unit >> 1) & 1, eh = unit & 1, L = gi.L, NC = L >> 6, l = gi.l;
    const int lane = tid & 63, wid = tid >> 6, r16 = lane & 15, q4 = lane >> 4;
    const int ecol = eh * 128 + 16 * wid + r16;
    f32x4 S[8];
    if (gi.latent) { const int bs = 2 * (gi.grp - 1) + sl; const float* s0 = p.state_gla + ((((size_t)bs * DEPTH + l) * 2 + dir) * 4 + h) * 128 * 256 + ecol;
#pragma unroll
        for (int T = 0; T < 8; ++T)
#pragma unroll
            for (int i = 0; i < 4; ++i) S[T][i] = s0[(size_t)(16 * T + 4 * q4 + i) * 256]; }
    else {
#pragma unroll
        for (int T = 0; T < 8; ++T) S[T] = (f32x4){0.f, 0.f, 0.f, 0.f}; }
    const bf16_t* Qg = (const bf16_t*)(lws(p) + (dir ? OFF_QB : OFF_QF)); const bf16_t* Kg = (const bf16_t*)(lws(p) + (dir ? OFF_KBT : OFF_KFT)); const bf16_t* Vg = (const bf16_t*)(lws(p) + OFF_VT);
    const float* Dg = (const float*)(lws(p) + OFF_DEC) + (size_t)dir * 128 * 512;
    float* Og = (float*)(lws(p) + (dir ? OFF_OB : OFF_OF));
    u32x4 rq[2], rk[2], rv[2]; float rd = 0.f;
    const int qt0 = tid >> 4, qd = (tid & 15) * 8;
    const int kd0 = tid >> 3, ks8 = (tid & 7) * 8;
#define GLA_LOAD(c) do { const int cg_ = sl * NC + (c); const size_t r0_ = (size_t)cg_ * 64; \
        rq[0] = *(const u32x4*)(Qg + (r0_ + qt0) * 512 + h * 128 + qd); rq[1] = *(const u32x4*)(Qg + (r0_ + qt0 + 32) * 512 + h * 128 + qd); \
        rk[0] = *(const u32x4*)(Kg + (((size_t)cg_ * 4 + h) * 128 + kd0) * 64 + ks8); rk[1] = *(const u32x4*)(Kg + (((size_t)cg_ * 4 + h) * 128 + kd0 + 64) * 64 + ks8); \
        rv[0] = *(const u32x4*)(Vg + (((size_t)cg_ * 4 + h) * 256 + eh * 128 + kd0) * 64 + ks8); rv[1] = *(const u32x4*)(Vg + (((size_t)cg_ * 4 + h) * 256 + eh * 128 + kd0 + 64) * 64 + ks8); \
        if (tid < 128) rd = Dg[(size_t)cg_ * 512 + h * 128 + tid]; } while (0)
#define GLA_STORE(bufp) do { unsigned char* b_ = (bufp); \
        *(u32x4*)(b_ + SC_Q + (qt0 * QKP + qd) * 2) = rq[0]; *(u32x4*)(b_ + SC_Q + ((qt0 + 32) * QKP + qd) * 2) = rq[1]; \
        *(u32x4*)(b_ + SC_K + (kd0 * TP + ks8) * 2) = rk[0]; *(u32x4*)(b_ + SC_K + ((kd0 + 64) * TP + ks8) * 2) = rk[1]; \
        *(u32x4*)(b_ + SC_V + (kd0 * TP + ks8) * 2) = rv[0]; *(u32x4*)(b_ + SC_V + ((kd0 + 64) * TP + ks8) * 2) = rv[1]; \
        if (tid < 128) *(float*)(b_ + SC_D + tid * 4) = rd; } while (0)
    __syncthreads();
    GLA_LOAD(dir ? NC - 1 : 0);
    GLA_STORE(smem);
    __syncthreads();
    for (int ci = 0; ci < NC; ++ci) {
        const int c = dir ? NC - 1 - ci : ci;
        if (ci + 1 < NC) GLA_LOAD(dir ? c - 1 : c + 1);
        const unsigned char* buf = smem + (ci & 1) * SC_BUF;
        const bf16_t* Qs = (const bf16_t*)(buf + SC_Q); const bf16_t* Kt = (const bf16_t*)(buf + SC_K); const bf16_t* Vt = (const bf16_t*)(buf + SC_V); const float* Dv = (const float*)(buf + SC_D);
        bf16x8 bS[4];
#pragma unroll
        for (int ks = 0; ks < 4; ++ks) bS[ks] = pack8(S[2 * ks], S[2 * ks + 1]);
        const size_t orow0 = ((size_t)(sl * NC + c) * 64);
#pragma unroll
        for (int mt = 0; mt < 4; ++mt) { f32x4 acc = (f32x4){0.f, 0.f, 0.f, 0.f};
#pragma unroll
            for (int ks = 0; ks < 4; ++ks) { const bf16_t* qp = Qs + (16 * mt + r16) * QKP + 32 * ks + 4 * q4;
                const bf16x4 a0 = *(const bf16x4*)qp, a1 = *(const bf16x4*)(qp + 16);
                const bf16x8 a = (bf16x8){a0[0], a0[1], a0[2], a0[3], a1[0], a1[1], a1[2], a1[3]};
                acc = MFMA16(a, bS[ks], acc); }
#pragma unroll
            for (int i = 0; i < 4; ++i) Og[(orow0 + 16 * mt + 4 * q4 + i) * 1024 + h * 256 + ecol] = acc[i]; }
        bf16x8 bv[2];
#pragma unroll
        for (int ks = 0; ks < 2; ++ks) bv[ks] = *(const bf16x8*)(Vt + (16 * wid + r16) * TP + 32 * ks + 8 * q4);
#pragma unroll
        for (int T = 0; T < 8; ++T) {
#pragma unroll
            for (int ks = 0; ks < 2; ++ks) { const bf16x8 a = *(const bf16x8*)(Kt + (16 * T + r16) * TP + 32 * ks + 8 * q4); S[T] = MFMA16(a, bv[ks], S[T]); }
            const f32x4 dv = *(const f32x4*)(Dv + 16 * T + 4 * q4); S[T] *= dv; }
        if (ci + 1 < NC) GLA_STORE(smem + ((ci + 1) & 1) * SC_BUF);
        __syncthreads();
    }
#undef GLA_LOAD
#undef GLA_STORE
    if (!gi.latent) { float* so = lout(p) + OUT_ST + ((((size_t)sl * DEPTH + l) * 2 + dir) * 4 + h) * 128 * 256 + ecol;
#pragma unroll
        for (int T = 0; T < 8; ++T)
#pragma unroll
            for (int i = 0; i < 4; ++i) so[(size_t)(16 * T + 4 * q4 + i) * 256] = S[T][i]; }
}
DI void phase_gla_scan(const Params& p, const GrpInfo gi, int bid, int nb) {
    const int tid = ltid();
    for (int u = bid; u < gi.nseq * 16; u += nb) gla_scan_unit(p, gi, u, tid);
}
typedef float f32x16 __attribute__((ext_vector_type(16)));
#define MFMA32(a, b, c) __builtin_amdgcn_mfma_f32_32x32x16_bf16((a), (b), (c), 0, 0, 0)

DI void phase_hy_prep(const Params& p, const GrpInfo gi, int bid, int nb) {
    const int tid = ltid(), L = gi.L;
    bf16_t* T = (bf16_t*)smem;
    const bf16_t* P = (const bf16_t*)(lws(p) + OFF_P);
    bf16_t* UcT = (bf16_t*)(lws(p) + OFF_UCT);
    const float* cw = p.hy_conv_w + (size_t)gi.l * 3 * 3072; const float* cb = p.hy_conv_b + (size_t)gi.l * 3072;
    for (int u = bid; u < 128 * 12; u += nb) {
        const int rt = u / 12, ct = u % 12, row0 = rt * 64, j0 = ct * 256;
        const int t = tid >> 3, js = tid & 7, row = row0 + t, tpos = row & (L - 1);
        const u32x4 z4 = (u32x4){0u, 0u, 0u, 0u};
        u32x4 um[4], u0[4], up[4];
#pragma unroll
        for (int q4 = 0; q4 < 4; ++q4) { const bf16_t* pr = P + (size_t)row * NP + C_HY + j0 + 64 * q4 + js * 8;
            um[q4] = tpos > 0 ? *(const u32x4*)(pr - NP) : z4; u0[q4] = *(const u32x4*)pr; up[q4] = tpos < L - 1 ? *(const u32x4*)(pr + NP) : z4; }
        __syncthreads();
#pragma unroll
        for (int q4 = 0; q4 < 4; ++q4) { const int j = j0 + 64 * q4 + js * 8;
            const f32x4 b0 = *(const f32x4*)(cb + j), b1 = *(const f32x4*)(cb + j + 4), wa0 = *(const f32x4*)(cw + j), wa1 = *(const f32x4*)(cw + j + 4),
                        wb0 = *(const f32x4*)(cw + 3072 + j), wb1 = *(const f32x4*)(cw + 3072 + j + 4), wc0 = *(const f32x4*)(cw + 6144 + j), wc1 = *(const f32x4*)(cw + 6144 + j + 4);
#pragma unroll
            for (int q = 0; q < 4; ++q) {
                const float ba = q < 2 ? b0[2 * q] : b1[2 * q - 4], bb = q < 2 ? b0[2 * q + 1] : b1[2 * q - 3];
                const float a0 = q < 2 ? wa0[2 * q] : wa1[2 * q - 4], a1 = q < 2 ? wa0[2 * q + 1] : wa1[2 * q - 3];
                const float c0 = q < 2 ? wb0[2 * q] : wb1[2 * q - 4], c1 = q < 2 ? wb0[2 * q + 1] : wb1[2 * q - 3];
                const float e0 = q < 2 ? wc0[2 * q] : wc1[2 * q - 4], e1 = q < 2 ? wc0[2 * q + 1] : wc1[2 * q - 3];
                const float o0 = ba + a0 * bflo(um[q4][q]) + c0 * bflo(u0[q4][q]) + e0 * bflo(up[q4][q]);
                const float o1 = bb + a1 * bfhi(um[q4][q]) + c1 * bfhi(u0[q4][q]) + e1 * bfhi(up[q4][q]);
                T[(64 * q4 + js * 8 + 2 * q) * TP + t] = f2bf(o0); T[(64 * q4 + js * 8 + 2 * q + 1) * TP + t] = f2bf(o1);
            }
        }
        __syncthreads();
#pragma unroll
        for (int q4 = 0; q4 < 4; ++q4) { const int jj = 64 * q4 + (tid >> 3), ts = tid & 7;
            *(u32x4*)(UcT + (size_t)(j0 + jj) * GT + row0 + ts * 8) = *(const u32x4*)(T + jj * TP + ts * 8); }
    }
}
DI void phase_hy_post(const Params& p, const GrpInfo gi, int bid, int nb) {
    const int tid = ltid();
    bf16_t* T = (bf16_t*)smem;
    const bf16_t* OcT = (const bf16_t*)(lws(p) + OFF_OCT);
    bf16_t* OC = (bf16_t*)(lws(p) + OFF_OABC) + 2048;
    for (int u = bid; u < 128 * 16; u += nb) {
        const int rt = u >> 4, ct = u & 15, row0 = rt * 64, c0 = ct * 64;
        const int c = tid >> 3, ts = tid & 7;
        const u32x4 w = *(const u32x4*)(OcT + (size_t)(c0 + c) * GT + row0 + ts * 8);
        __syncthreads();
#pragma unroll
        for (int q = 0; q < 4; ++q) { T[(ts * 8 + 2 * q) * TP + c] = (bf16_t)(w[q] & 0xffffu); T[(ts * 8 + 2 * q + 1) * TP + c] = (bf16_t)(w[q] >> 16); }
        __syncthreads();
        const int t = tid >> 3, cs = tid & 7;
        *(u32x4*)(OC + (size_t)(row0 + t) * 3072 + c0 + cs * 8) = *(const u32x4*)(T + t * TP + cs * 8);
    }
}

constexpr int HY_HF = 0;
constexpr int HY_Z = 16384;
constexpr int HY_ZERO = HY_Z + 20480;
constexpr int HY_HC = HY_ZERO + 64;
DI int hy_pitch(int L) { return (L + 224) * 2; }
DI int hy_zoff(int s) { return (s >> 5) * 80 + (s & 31) * 2; }
DI void hy_build_copies(int L, int tid) {
    const unsigned* fr = (const unsigned*)(smem + HY_HF);
    const int nch = (L + 224) / 8, pitch = hy_pitch(L), e = __builtin_amdgcn_readfirstlane(tid >> 6), lane = tid & 63, sh = (e & 1) * 16;
    for (int ch = lane; ch < nch; ch += 64) {
        const unsigned* d = fr + ((8 * ch + e) >> 1);
        const unsigned d0 = d[0], d1 = d[1], d2 = d[2], d3 = d[3], d4 = d[4];
        u32x4 w; w.x = __builtin_amdgcn_alignbit(d1, d0, sh); w.y = __builtin_amdgcn_alignbit(d2, d1, sh); w.z = __builtin_amdgcn_alignbit(d3, d2, sh); w.w = __builtin_amdgcn_alignbit(d4, d3, sh);
        *(u32x4*)(smem + HY_HC + e * pitch + ch * 16) = w;
    }
}
DI f32x16 hy_conv(int L, int lane, int tb_row0  , int t0, int trip_lo, int trip_hi) {
    const int m = lane & 31, kh = lane >> 5, e = (7 - (m & 7)) & 7, pitch = hy_pitch(L);
    const int NTRIP = (L / 16 + 2 + 6) / 8;
    int delta = -(L / 2) - 16 - 48 + 128 * trip_lo;
    int aoff = HY_HC + e * pitch + (L / 2 - 1 - delta - m + 8 * kh - e + 88) * 2;
    f32x16 acc[4];
#pragma unroll
    for (int c = 0; c < 4; ++c)
#pragma unroll
        for (int i = 0; i < 16; ++i) acc[c][i] = 0.f;
#define HY_LDB(dlt) ({ const int s0_ = t0 - (dlt); const bool inr_ = (unsigned)s0_ <= (unsigned)(L - 16); \
        const int zo_ = inr_ ? HY_Z + hy_zoff(tb_row0 - (dlt)) + 16 * kh : HY_ZERO; *(const bf16x8*)(smem + zo_); })
    bf16x8 a0[4], b0[4], a1[4], b1[4];
#pragma unroll
    for (int j = 0; j < 4; ++j) { a0[j] = *(const bf16x8*)(smem + aoff - 32 * j); b0[j] = HY_LDB(delta + 16 * j); a1[j] = *(const bf16x8*)(smem + aoff - 32 * (j + 4)); b1[j] = HY_LDB(delta + 16 * (j + 4)); }
    (void)NTRIP;
    for (int trip = trip_lo; trip < trip_hi; ++trip) {
        delta += 128; aoff -= 256;
#pragma unroll
        for (int j = 0; j < 4; ++j) acc[j] = MFMA32(a0[j], b0[j], acc[j]);
#pragma unroll
        for (int j = 0; j < 4; ++j) { a0[j] = *(const bf16x8*)(smem + aoff - 32 * j); b0[j] = HY_LDB(delta + 16 * j); }
#pragma unroll
        for (int j = 0; j < 4; ++j) acc[j] = MFMA32(a1[j], b1[j], acc[j]);
#pragma unroll
        for (int j = 0; j < 4; ++j) { a1[j] = *(const bf16x8*)(smem + aoff - 32 * (j + 4)); b1[j] = HY_LDB(delta + 16 * (j + 4)); }
    }
#undef HY_LDB
    return (acc[0] + acc[1]) + (acc[2] + acc[3]);
}
DI void hy_conv_unit(const Params& p, const GrpInfo gi, int c, int tid_in) {
    int tid = tid_in; asm volatile("" : "+v"(tid));
    const int L = gi.L, lane = tid & 63, wid = __builtin_amdgcn_readfirstlane(tid >> 6), n = lane & 31, hi = lane >> 5, LF = L + 232;
    const int g = 32 * wid + n, tpl = L >> 5, b = g / tpl, t0 = (g % tpl) * 32, frow = b * L + t0;
    const bf16_t* UcT = (const bf16_t*)(lws(p) + OFF_UCT);
    bf16_t* OcT = (bf16_t*)(lws(p) + OFF_OCT);
    const bf16_t* f0 = filt_ptr(lws(p), gi.l, gi.latent ? 1 : 0) + (size_t)c * LF;
    const bf16_t* f1 = f0 + (size_t)1024 * LF;
    int trip_lo = 0, trip_hi = (L / 16 + 8) / 8;
    if (L == 4096) { const int T0 = (wid & 3) * 1024; const int slo = (T0 - L / 2 + 80) / 16, shi = (T0 + L / 2 + 1056) / 16; trip_lo = slo > 0 ? slo / 8 : 0; trip_hi = min(trip_hi, shi / 8 + 1); }
    const int npc = LF / 8;
    __syncthreads();
    u32x4 f1r[2];
    {
        const bf16_t* zg = UcT + (size_t)(2048 + c) * GT;
#pragma unroll
        for (int i = 0; i < 2; ++i) { const int s = (tid + 512 * i) * 8; *(u32x4*)(smem + HY_Z + hy_zoff(s)) = *(const u32x4*)(zg + s); }
        if (tid < 4) *(unsigned*)(smem + HY_ZERO + 4 * tid) = 0u;
#pragma unroll
        for (int i = 0; i < 2; ++i) { const int pc = tid + 512 * i; if (pc < npc) { *(u32x4*)(smem + HY_HF + pc * 16) = *(const u32x4*)(f0 + pc * 8); f1r[i] = *(const u32x4*)(f1 + pc * 8); } }
    }
    u32x2 x1w[4], x2w[4];
#pragma unroll
    for (int gq = 0; gq < 4; ++gq) { const int fr = frow + 8 * gq + 4 * hi; x1w[gq] = *(const u32x2*)(UcT + (size_t)c * GT + fr); x2w[gq] = *(const u32x2*)(UcT + (size_t)(1024 + c) * GT + fr); }
    const float bias0 = p.hy_bias[((size_t)gi.l * 2 + 0) * 1024 + c], bias1 = p.hy_bias[((size_t)gi.l * 2 + 1) * 1024 + c];
    __syncthreads();
    hy_build_copies(L, tid);
    __syncthreads();
    f32x16 acc = hy_conv(L, lane, frow, t0, trip_lo, trip_hi);
    u32x2 z1w[4];
#pragma unroll
    for (int gq = 0; gq < 4; ++gq) {
        const int fr = frow + 8 * gq + 4 * hi;
        const u32x2 xw = x1w[gq];
        const u32x2 zw = *(const u32x2*)(smem + HY_Z + hy_zoff(fr));
        const float o0 = bflo(xw.x) * (acc[4 * gq] + bias0 * bflo(zw.x)), o1 = bfhi(xw.x) * (acc[4 * gq + 1] + bias0 * bfhi(zw.x));
        const float o2 = bflo(xw.y) * (acc[4 * gq + 2] + bias0 * bflo(zw.y)), o3 = bfhi(xw.y) * (acc[4 * gq + 3] + bias0 * bfhi(zw.y));
        z1w[gq].x = pk2(o0, o1); z1w[gq].y = pk2(o2, o3);
    }
    __syncthreads();
#pragma unroll
    for (int gq = 0; gq < 4; ++gq) *(u32x2*)(smem + HY_Z + hy_zoff(frow + 8 * gq + 4 * hi)) = z1w[gq];
#pragma unroll
    for (int i = 0; i < 2; ++i) { const int pc = tid + 512 * i; if (pc < npc) *(u32x4*)(smem + HY_HF + pc * 16) = f1r[i]; }
    __syncthreads();
    hy_build_copies(L, tid);
    __syncthreads();
    acc = hy_conv(L, lane, frow, t0, trip_lo, trip_hi);
#pragma unroll
    for (int gq = 0; gq < 4; ++gq) {
        const int fr = frow + 8 * gq + 4 * hi;
        const u32x2 xw = x2w[gq];
        const float o0 = bflo(xw.x) * (acc[4 * gq] + bias1 * bflo(z1w[gq].x)), o1 = bfhi(xw.x) * (acc[4 * gq + 1] + bias1 * bfhi(z1w[gq].x));
        const float o2 = bflo(xw.y) * (acc[4 * gq + 2] + bias1 * bflo(z1w[gq].y)), o3 = bfhi(xw.y) * (acc[4 * gq + 3] + bias1 * bfhi(z1w[gq].y));
        u32x2 w; w.x = pk2(o0, o1); w.y = pk2(o2, o3);
        *(u32x2*)(OcT + (size_t)c * GT + fr) = w;
    }
}
DI void phase_hy_conv(const Params& p, const GrpInfo gi, int bid, int nb) {
    const int tid = ltid();
    for (int c = bid; c < 1024; c += nb) hy_conv_unit(p, gi, c, tid);
}
constexpr float NA_QSCALE = 0.12751743074602468f;
constexpr float LOG2E = 1.4426950408889634f;

DI void phase_cache_cvt(const Params& p, int bid, int nb) {
    const int tid = ltid();
    bf16_t* T = (bf16_t*)smem;
    bf16_t* CK = (bf16_t*)(lws(p) + OFF_CK); bf16_t* CVT = (bf16_t*)(lws(p) + OFF_CVT);
    for (int u = bid; u < 8 * 2 * 8 * 4; u += nb) {
        const int bh = u >> 2, k0 = (u & 3) * 64;
        const int key = tid >> 3, ds = (tid & 7) * 16;
        const size_t src = ((size_t)bh * 256 + k0 + key) * 128 + ds;
        f32x4 kv[4], vv[4];
#pragma unroll
        for (int i = 0; i < 4; ++i) { kv[i] = *(const f32x4*)(p.cache_k + src + 4 * i); vv[i] = *(const f32x4*)(p.cache_v + src + 4 * i); }
        u32x4 w0, w1; w0.x = pk2(kv[0][0], kv[0][1]); w0.y = pk2(kv[0][2], kv[0][3]); w0.z = pk2(kv[1][0], kv[1][1]); w0.w = pk2(kv[1][2], kv[1][3]);
        w1.x = pk2(kv[2][0], kv[2][1]); w1.y = pk2(kv[2][2], kv[2][3]); w1.z = pk2(kv[3][0], kv[3][1]); w1.w = pk2(kv[3][2], kv[3][3]);
        *(u32x4*)(CK + src) = w0; *(u32x4*)(CK + src + 8) = w1;
        __syncthreads();
#pragma unroll
        for (int i = 0; i < 4; ++i)
#pragma unroll
            for (int j = 0; j < 4; ++j) T[(ds + 4 * i + j) * TP + key] = f2bf(vv[i][j]);
        __syncthreads();
        const int d = tid >> 2, ks = (tid & 3) * 16;
        bf16_t* dst = CVT + ((size_t)bh * 128 + d) * 256 + k0 + ks;
        *(u32x4*)dst = *(const u32x4*)(T + d * TP + ks); *(u32x4*)(dst + 8) = *(const u32x4*)(T + d * TP + ks + 8);
    }
}
DI void phase_na_prep2(const Params& p, const GrpInfo gi, int bid, int nb) {
    const int tid = ltid(), lane = tid & 63, wid = tid >> 6;
    const bf16_t* P = (const bf16_t*)(lws(p) + OFF_P);
    bf16_t* QN = (bf16_t*)(lws(p) + OFF_QN); bf16_t* KN = (bf16_t*)(lws(p) + OFF_KN); bf16_t* VTN = (bf16_t*)(lws(p) + OFF_VTN);
    {
        const int d0 = (lane & 15) * 8;
        float gq[8], gk[8];
#pragma unroll
        for (int j = 0; j < 8; ++j) { gq[j] = p.na_qnorm_g[gi.l * 128 + d0 + j] * NA_QSCALE; gk[j] = p.na_knorm_g[gi.l * 128 + d0 + j]; }
        for (int row = bid * 8 + wid; row < GT; row += nb * 8) {
            const bf16_t* pr = P + (size_t)row * NP + lane * 8;
            u32x4 qw[2], kw[2], vw[2];
#pragma unroll
            for (int hf = 0; hf < 2; ++hf) { qw[hf] = *(const u32x4*)(pr + C_NQ + 512 * hf); kw[hf] = *(const u32x4*)(pr + C_NK + 512 * hf); if (!gi.latent) vw[hf] = *(const u32x4*)(pr + C_NV + 512 * hf); }
#pragma unroll
            for (int hf = 0; hf < 2; ++hf) {
                float q[8], k[8]; float sq = 0.f, sk = 0.f;
#pragma unroll
                for (int j = 0; j < 4; ++j) { q[2 * j] = bflo(qw[hf][j]); q[2 * j + 1] = bfhi(qw[hf][j]); k[2 * j] = bflo(kw[hf][j]); k[2 * j + 1] = bfhi(kw[hf][j]); }
#pragma unroll
                for (int j = 0; j < 8; ++j) { sq += q[j] * q[j]; sk += k[j] * k[j]; }
#pragma unroll
                for (int o = 8; o >= 1; o >>= 1) { sq += __int_as_float(__builtin_amdgcn_ds_bpermute((lane ^ o) << 2, __float_as_int(sq))); sk += __int_as_float(__builtin_amdgcn_ds_bpermute((lane ^ o) << 2, __float_as_int(sk))); }
                const float qs = rsqrtf(sq * (1.0f / 128) + EPS), ks = rsqrtf(sk * (1.0f / 128) + EPS);
                float kn[8];
#pragma unroll
                for (int j = 0; j < 8; ++j) { q[j] = q[j] * qs * gq[j]; kn[j] = k[j] * ks * gk[j]; }
                u32x4 qo, ko; qo.x = pk2(q[0], q[1]); qo.y = pk2(q[2], q[3]); qo.z = pk2(q[4], q[5]); qo.w = pk2(q[6], q[7]);
                ko.x = pk2(kn[0], kn[1]); ko.y = pk2(kn[2], kn[3]); ko.z = pk2(kn[4], kn[5]); ko.w = pk2(kn[6], kn[7]);
                *(u32x4*)(QN + (size_t)row * 1024 + 512 * hf + lane * 8) = qo; *(u32x4*)(KN + (size_t)row * 1024 + 512 * hf + lane * 8) = ko;
                if (!gi.latent) { const int b = row >> 8, t = row & 255, h = 4 * hf + (lane >> 4); const size_t o = ((((size_t)b * DEPTH + gi.l) * 8 + h) * 256 + t) * 128 + d0;
                    float* ok = lout(p) + OUT_CK + o; float* ov = lout(p) + OUT_CV + o;
                    *(f32x4*)ok = (f32x4){kn[0], kn[1], kn[2], kn[3]}; *(f32x4*)(ok + 4) = (f32x4){kn[4], kn[5], kn[6], kn[7]};
                    *(f32x4*)ov = (f32x4){bflo(vw[hf][0]), bfhi(vw[hf][0]), bflo(vw[hf][1]), bfhi(vw[hf][1])}; *(f32x4*)(ov + 4) = (f32x4){bflo(vw[hf][2]), bfhi(vw[hf][2]), bflo(vw[hf][3]), bfhi(vw[hf][3])}; }
            }
        }
    }
    bf16_t* T = (bf16_t*)smem;
    const int L = gi.L;
    for (int u = bid; u < 128 * 8; u += nb) {
        const int cg = u >> 3, h = u & 7, row0 = cg * 64, seq = row0 / L, t0 = row0 & (L - 1);
        const int s = tid >> 3, ds = (tid & 7) * 16;
        const bf16_t* pv = P + (size_t)(row0 + s) * NP + C_NV + h * 128 + ds;
        const u32x4 w0 = *(const u32x4*)pv, w1 = *(const u32x4*)(pv + 8);
        __syncthreads();
#pragma unroll
        for (int j = 0; j < 4; ++j) { T[(ds + 2 * j) * TP + s] = (bf16_t)(w0[j] & 0xffffu); T[(ds + 2 * j + 1) * TP + s] = (bf16_t)(w0[j] >> 16);
                                      T[(ds + 8 + 2 * j) * TP + s] = (bf16_t)(w1[j] & 0xffffu); T[(ds + 8 + 2 * j + 1) * TP + s] = (bf16_t)(w1[j] >> 16); }
        __syncthreads();
        const int d = tid >> 2, sq = (tid & 3) * 16;
        bf16_t* dst = VTN + ((size_t)(seq * 8 + h) * 128 + d) * L + t0 + sq;
        *(u32x4*)dst = *(const u32x4*)(T + d * TP + sq); *(u32x4*)(dst + 8) = *(const u32x4*)(T + d * TP + sq + 8);
    }
}

typedef const __attribute__((address_space(1))) bf16_t* gbfp;
template <bool LOCAL> DI void na_block(const bf16_t* kb0, int kstride, int kA, const bf16_t* vb0, int vstride, int vA, const bf16x8 (&qB)[4], f32x4 (&O)[8], float& mrun, float& lrun,
                                       int lane, int r16, int q4, const float* rpb  , int rowoff0  , int wc0, int c, int cs) {
    const gbfp kb = (gbfp)kb0, vb = (gbfp)vb0;
    f32x4 st[8];
    const unsigned kvo = (unsigned)(r16 * kstride + 8 * q4), vvo = (unsigned)(r16 * vstride + 4 * q4);
    bf16x8 kbuf[2][4];
#define NA_LOADK(T_, slot) do { const gbfp kp_ = kb + (size_t)(((T_) >> 1) * kA + ((T_) & 1) * 16) * kstride; \
        _Pragma("unroll") for (int ks_ = 0; ks_ < 4; ++ks_) kbuf[slot][ks_] = *(const __attribute__((address_space(1))) bf16x8*)(kp_ + kvo + 32 * ks_); } while (0)
    NA_LOADK(0, 0);
#pragma unroll
    for (int T = 0; T < 8; ++T) {
        if (T < 7) NA_LOADK(T + 1, (T + 1) & 1);
        st[T] = (f32x4){0.f, 0.f, 0.f, 0.f};
#pragma unroll
        for (int ks = 0; ks < 4; ++ks) st[T] = MFMA16(kbuf[T & 1][ks], qB[ks], st[T]);
        __builtin_amdgcn_sched_barrier(0);
    }
#undef NA_LOADK
    float mx = -INFINITY;
#pragma unroll
    for (int T = 0; T < 8; ++T)
#pragma unroll
        for (int i = 0; i < 4; ++i) {
            if (LOCAL) { const int wr = T >> 1, gcol = wc0 + 16 * (T & 1) + 4 * q4 + i;
                const bool ok = gcol >= cs && gcol < cs + 16;
                const float bias = rpb[(rowoff0 + wr) * 31 + min(max(gcol - c + 15, 0), 30)];
                st[T][i] = ok ? st[T][i] + bias : -INFINITY; }
            mx = fmaxf(mx, st[T][i]);
        }
    mx = fmaxf(mx, __int_as_float(__builtin_amdgcn_ds_bpermute((lane ^ 16) << 2, __float_as_int(mx))));
    mx = fmaxf(mx, __int_as_float(__builtin_amdgcn_ds_bpermute((lane ^ 32) << 2, __float_as_int(mx))));
    const float mnew = fmaxf(mrun, mx), alpha = __builtin_amdgcn_exp2f(mrun - mnew);
    float ls = 0.f;
#pragma unroll
    for (int T = 0; T < 8; ++T)
#pragma unroll
        for (int i = 0; i < 4; ++i) { const float e = __builtin_amdgcn_exp2f(st[T][i] - mnew); st[T][i] = e; ls += e; }
    ls += __int_as_float(__builtin_amdgcn_ds_bpermute((lane ^ 16) << 2, __float_as_int(ls)));
    ls += __int_as_float(__builtin_amdgcn_ds_bpermute((lane ^ 32) << 2, __float_as_int(ls)));
    lrun = lrun * alpha + ls; mrun = mnew;
#pragma unroll
    for (int dT = 0; dT < 8; ++dT) O[dT] *= alpha;
    bf16x4 vbuf[2][8][2];
#define NA_LOADV(t_, slot) do { _Pragma("unroll") for (int dT_ = 0; dT_ < 8; ++dT_) { const gbfp vp_ = vb + (size_t)(16 * dT_) * vstride + (t_) * vA; \
        vbuf[slot][dT_][0] = *(const __attribute__((address_space(1))) bf16x4*)(vp_ + vvo); vbuf[slot][dT_][1] = *(const __attribute__((address_space(1))) bf16x4*)(vp_ + vvo + 16); } } while (0)
    NA_LOADV(0, 0);
#pragma unroll
    for (int t = 0; t < 4; ++t) {
        if (t < 3) NA_LOADV(t + 1, (t + 1) & 1);
        const bf16x8 bP = pack8(st[2 * t], st[2 * t + 1]);
#pragma unroll
        for (int dT = 0; dT < 8; ++dT) { const bf16x4 a0 = vbuf[t & 1][dT][0], a1 = vbuf[t & 1][dT][1];
            const bf16x8 a = (bf16x8){a0[0], a0[1], a0[2], a0[3], a1[0], a1[1], a1[2], a1[3]};
            O[dT] = MFMA16(a, bP, O[dT]); }
        __builtin_amdgcn_sched_barrier(0);
    }
#undef NA_LOADV
}
constexpr int LDS_RPB_OFF = 139264 + 512;
DI void na_load_rpb(const Params& p, int l, int tid) {
    float* rp = (float*)(smem + LDS_RPB_OFF);
    for (int i = tid; i < 8 * 465; i += 512) rp[i] = p.na_rpb[(size_t)l * 8 * 465 + i] * LOG2E;
}
constexpr int NA_KP = 144, NA_VP = 72;
constexpr int NA_KS = 0, NA_VS = 64 * NA_KP * 2, NA_BUF = NA_VS + 128 * NA_VP * 2;
template <int NT, bool LOCAL> DI void na_chunk(const unsigned char* buf, int koff, const bf16x8 (&qB)[4], f32x4 (&O)[8], float& mrun, float& lrun, int lane, int r16, int q4,
                                               const float* rpb, int rowoff, int wc0, int c, int cs) {
    const bf16_t* Ks = (const bf16_t*)(buf + NA_KS); const bf16_t* Vs = (const bf16_t*)(buf + NA_VS);
    f32x4 st[NT];
#pragma unroll
    for (int T = 0; T < NT; ++T) { st[T] = (f32x4){0.f, 0.f, 0.f, 0.f};
#pragma unroll
        for (int ks = 0; ks < 4; ++ks) { const bf16x8 a = *(const bf16x8*)(Ks + (koff + 16 * T + r16) * NA_KP + 32 * ks + 8 * q4); st[T] = MFMA16(a, qB[ks], st[T]); } }
    float mx = -INFINITY;
#pragma unroll
    for (int T = 0; T < NT; ++T)
#pragma unroll
        for (int i = 0; i < 4; ++i) {
            if (LOCAL) { const int gcol = wc0 + 16 * T + 4 * q4 + i; const bool ok = gcol >= cs && gcol < cs + 16;
                const float bias = rpb[rowoff * 31 + min(max(gcol - c + 15, 0), 30)];
                st[T][i] = ok ? st[T][i] + bias : -INFINITY; }
            mx = fmaxf(mx, st[T][i]);
        }
    mx = fmaxf(mx, __int_as_float(__builtin_amdgcn_ds_bpermute((lane ^ 16) << 2, __float_as_int(mx))));
    mx = fmaxf(mx, __int_as_float(__builtin_amdgcn_ds_bpermute((lane ^ 32) << 2, __float_as_int(mx))));
    const float mnew = fmaxf(mrun, mx);
    const float alpha = (mnew == -INFINITY) ? 1.0f : __builtin_amdgcn_exp2f(mrun - mnew);
    const float msafe = (mnew == -INFINITY) ? 0.0f : mnew;
    float ls = 0.f;
#pragma unroll
    for (int T = 0; T < NT; ++T)
#pragma unroll
        for (int i = 0; i < 4; ++i) { const float e = __builtin_amdgcn_exp2f(st[T][i] - msafe); st[T][i] = e; ls += e; }
    ls += __int_as_float(__builtin_amdgcn_ds_bpermute((lane ^ 16) << 2, __float_as_int(ls)));
    ls += __int_as_float(__builtin_amdgcn_ds_bpermute((lane ^ 32) << 2, __float_as_int(ls)));
    lrun = lrun * alpha + ls; mrun = mnew;
#pragma unroll
    for (int dT = 0; dT < 8; ++dT) O[dT] *= alpha;
#pragma unroll
    for (int t = 0; t < NT / 2; ++t) {
        const bf16x8 bP = pack8(st[2 * t], st[2 * t + 1]);
#pragma unroll
        for (int dT = 0; dT < 8; ++dT) { const bf16_t* vp = Vs + (16 * dT + r16) * NA_VP + koff + 32 * t + 4 * q4;
            const bf16x4 a0 = *(const bf16x4*)vp, a1 = *(const bf16x4*)(vp + 16);
            const bf16x8 a = (bf16x8){a0[0], a0[1], a0[2], a0[3], a1[0], a1[1], a1[2], a1[3]};
            O[dT] = MFMA16(a, bP, O[dT]); }
    }
}
DI void na_attn_unit(const Params& p, const GrpInfo gi, int u, int tid_in) {
    int tid = tid_in; asm volatile("" : "+v"(tid));
    const int lane = tid & 63, wid = __builtin_amdgcn_readfirstlane(tid >> 6), l = gi.l, r16 = lane & 15, q4 = lane >> 4;
    const float* rp = (const float*)(smem + LDS_RPB_OFF);
    const bf16_t* QN = (const bf16_t*)(lws(p) + OFF_QN); const bf16_t* KN = (const bf16_t*)(lws(p) + OFF_KN); const bf16_t* VTN = (const bf16_t*)(lws(p) + OFF_VTN);
    bf16_t* OB = (bf16_t*)(lws(p) + OFF_OABC) + 1024;
    int qrow0, h, seq, r = 0, c0 = 0, r0 = 0;
    if (gi.latent) { const int sl = u >> 8, rp2 = u & 31; h = (u >> 5) & 7; seq = sl; r0 = 2 * rp2; r = r0 + (wid >> 2); c0 = 16 * (wid & 3); qrow0 = sl * 4096 + r * 64 + c0; }
    else { const int b = u >> 4, half = u & 1; h = (u >> 1) & 7; seq = b; qrow0 = b * 256 + (half * 8 + wid) * 16; }
    const int g0 = min(max(r0 - 4, 0), 56), g1 = min(max(r0 + 1 - 4, 0), 56) + 8, nch = gi.latent ? 4 + (g1 - g0) : 4;
    const bf16_t* ck; const bf16_t* cv; int ckst, cvst;
    if (gi.latent) { const size_t cb = ((size_t)(2 * (gi.grp - 1) + seq) * DEPTH + l) * 8 + h; ck = (const bf16_t*)(lws(p) + OFF_CK) + cb * 256 * 128; ckst = 128; cv = (const bf16_t*)(lws(p) + OFF_CVT) + cb * 128 * 256; cvst = 256; }
    else { ck = KN + (size_t)(seq * 256) * 1024 + h * 128; ckst = 1024; cv = VTN + (size_t)(seq * 8 + h) * 128 * 256; cvst = 256; }
    const bf16_t* lk = KN + (size_t)(seq * 4096) * 1024 + h * 128;
    const bf16_t* lv = VTN + (size_t)(seq * 8 + h) * 128 * 4096;
    const int kkey = tid >> 4, kds = (tid & 15) * 8, vd = tid >> 3, vks = (tid & 7) * 8;
    u32x4 pk[2][2], pv[2][2];
#define NA_LOAD(c_, s_) do { const int cc_ = (c_); const bf16_t* kb_; const bf16_t* vb_; int kst_, vst_; \
        if (cc_ < 4) { kb_ = ck + (size_t)(64 * cc_) * ckst; kst_ = ckst; vb_ = cv + 64 * cc_; vst_ = cvst; } else { const int g_ = g0 + cc_ - 4; kb_ = lk + (size_t)(64 * g_) * 1024; kst_ = 1024; vb_ = lv + 64 * g_; vst_ = 4096; } \
        pk[s_][0] = *(const u32x4*)(kb_ + (size_t)kkey * kst_ + kds); pk[s_][1] = *(const u32x4*)(kb_ + (size_t)(kkey + 32) * kst_ + kds); \
        pv[s_][0] = *(const u32x4*)(vb_ + (size_t)vd * vst_ + vks); pv[s_][1] = *(const u32x4*)(vb_ + (size_t)(vd + 64) * vst_ + vks); } while (0)
#define NA_STORE(bufp, s_) do { unsigned char* b_ = (bufp); \
        *(u32x4*)(b_ + NA_KS + (kkey * NA_KP + kds) * 2) = pk[s_][0]; *(u32x4*)(b_ + NA_KS + ((kkey + 32) * NA_KP + kds) * 2) = pk[s_][1]; \
        *(u32x4*)(b_ + NA_VS + (vd * NA_VP + vks) * 2) = pv[s_][0]; *(u32x4*)(b_ + NA_VS + ((vd + 64) * NA_VP + vks) * 2) = pv[s_][1]; } while (0)
    bf16x8 qB[4];
#pragma unroll
    for (int ks = 0; ks < 4; ++ks) qB[ks] = *(const bf16x8*)(QN + (size_t)(qrow0 + r16) * 1024 + h * 128 + 32 * ks + 8 * q4);
    f32x4 O[8];
#pragma unroll
    for (int dT = 0; dT < 8; ++dT) O[dT] = (f32x4){0.f, 0.f, 0.f, 0.f};
    float mrun = -INFINITY, lrun = 0.f;
    const int rs = min(max(r - 4, 0), 56), wc0 = min(max(c0 - 8, 0), 32), c = c0 + r16, cs = min(max(c - 8, 0), 48);
    __syncthreads();
    NA_LOAD(0, 0); NA_STORE(smem, 0);
    NA_LOAD(1, 1);
    __syncthreads();
    for (int ci = 0; ci < nch; ci += 2) {
        if (ci + 2 < nch) NA_LOAD(ci + 2, 0);
        if (ci < 4) na_chunk<4, false>(smem, 0, qB, O, mrun, lrun, lane, r16, q4, rp, 0, 0, 0, 0);
        else { const int g = g0 + ci - 4, wr = g - rs; if (wr >= 0 && wr < 8) na_chunk<2, true>(smem, wc0, qB, O, mrun, lrun, lane, r16, q4, rp + h * 465, g - r + 7, wc0, c, cs); }
        if (ci + 1 < nch) NA_STORE(smem + NA_BUF, 1);
        __syncthreads();
        if (ci + 1 < nch) {
            if (ci + 3 < nch) NA_LOAD(ci + 3, 1);
            if (ci + 1 < 4) na_chunk<4, false>(smem + NA_BUF, 0, qB, O, mrun, lrun, lane, r16, q4, rp, 0, 0, 0, 0);
            else { const int g = g0 + ci + 1 - 4, wr = g - rs; if (wr >= 0 && wr < 8) na_chunk<2, true>(smem + NA_BUF, wc0, qB, O, mrun, lrun, lane, r16, q4, rp + h * 465, g - r + 7, wc0, c, cs); }
            if (ci + 2 < nch) NA_STORE(smem, 0);
        }
        __syncthreads();
    }
#undef NA_LOAD
#undef NA_STORE
    const float inv = 1.0f / lrun;
#pragma unroll
    for (int dT = 0; dT < 8; ++dT) { u32x2 w; w.x = pk2(O[dT][0] * inv, O[dT][1] * inv); w.y = pk2(O[dT][2] * inv, O[dT][3] * inv);
        *(u32x2*)(OB + (size_t)(qrow0 + r16) * 3072 + h * 128 + 16 * dT + 4 * q4) = w; }
}
#define LAS3 __attribute__((address_space(3)))
#ifndef REPMASK
#define REPMASK 0
#endif
constexpr int LDS_MAIN = 139264, LDS_PARAMS = LDS_MAIN + 64, LDS_UNIT = LDS_MAIN + 32, LDS_BYTES = LDS_MAIN + 512 + 8 * 465 * 4;
static_assert(LDS_RPB_OFF == LDS_MAIN + 512 && LDS_BYTES <= 163840, "LDS map");
constexpr int CTR_WORD0 = XCD_BAR_WORDS, CTR_WORDS = 64 * 16;

DI Params lp() {
    ParamsU u;
#pragma unroll
    for (int i = 0; i < NPARAM; ++i) {
        const unsigned long long v = *(const LAS3 unsigned long long*)((LAS3 unsigned char*)smem + LDS_PARAMS + 8 * i);
        const unsigned lo = (unsigned)__builtin_amdgcn_readfirstlane((int)(unsigned)v), hi = (unsigned)__builtin_amdgcn_readfirstlane((int)(unsigned)(v >> 32));
        u.a[i] = ((unsigned long long)hi << 32) | lo;
    }
    return u.s;
}
DI const float* x_in_ptr(const Params& p, int grp, int l) {
    if (l == 0) return grp == 0 ? p.x_prompt : p.x_sample + (size_t)(grp - 1) * GT * DM;
    return grp == 0 ? p.out + OUT_YP : p.out + OUT_YS + (size_t)(grp - 1) * GT * DM;
}
DI float* x_out_ptr(const Params& p, int grp) { return grp == 0 ? p.out + OUT_YP : p.out + OUT_YS + (size_t)(grp - 1) * GT * DM; }

template <class Epi> DI void gemm_ph(const bf16_t* A, const bf16_t* Bt, int M, int N, int K, const Epi& E) {
    pg8::Gemm g; g.A = A; g.Bt = Bt; g.M = M; g.N = N; g.K = K; g.pad = 0;
    pg8::StaticOrder S; S.init(M, N, (int)gridDim.x, (int)blockIdx.x);
    pg8::gemm_phase<Epi, pg8::StaticOrder, false>((LAS3 unsigned char*)smem, g, S, E, nullptr);
}
struct ModPtrs { const float* mA; const float* mB; };
DI ModPtrs mod_ptrs(const Params& q, int grp, int l) {
    const int crA = grp == 0 ? 0 : 1 + 2 * (grp - 1), crB = grp == 0 ? 0 : crA + 1;
    const float* mod = (const float*)(q.ws + OFF_MOD);
    ModPtrs m; m.mA = mod + ((size_t)l * NCOND + crA) * (NMOD * DM); m.mB = mod + ((size_t)l * NCOND + crB) * (NMOD * DM); return m;
}

__global__ __launch_bounds__(512, 2) void k_mega(Params p) {
    const int bid = blockIdx.x, nb = gridDim.x;
    volatile LAS unsigned* xbw = (volatile LAS unsigned*)((LAS3 unsigned char*)smem + LDS_MAIN);
    if (threadIdx.x == 0) {
        xbw[0] = 0u; xbw[1] = 0u; xbw[2] = 0u; xbw[3] = 0u;
        ParamsU u; u.s = p;
#pragma unroll
        for (int i = 0; i < NPARAM; ++i) *(LAS3 unsigned long long*)((LAS3 unsigned char*)smem + LDS_PARAMS + 8 * i) = u.a[i];
    }
    __syncthreads();
    XcdBarrier bar;
    { const Params q = lp(); bar = xcd_barrier_post((unsigned*)(q.ws + OFF_BAR), xbw); }
    for (int rep_ = 0; rep_ < 1 + ((REPMASK >> 8) & 1); ++rep_) { const Params q = lp(); phase_convert(q, bid, nb); }
    { const Params q = lp(); phase_adaln(q, bid, nb); }
    { const Params q = lp(); phase_hyena_hid(q, bid, nb); }
    { const Params q = lp(); phase_cache_cvt(q, bid, nb); }
    xcd_barrier(bar);
    { const Params q = lp(); phase_filters(q, bid, nb); }
    xcd_barrier(bar);
    for (int l0 = 0; l0 < DEPTH; ++l0) for (int grp0 = 0; grp0 < NGRP; ++grp0) {
        int l = l0, grp = grp0; asm volatile("" : "+s"(l), "+s"(grp));
        const GrpInfo gi = grp_info(grp, l);
        for (int rep_ = 0; rep_ < 1 + ((REPMASK >> 0) & 1); ++rep_) { const Params q = lp(); phase_norm(q, x_in_ptr(q, grp, l), q.norm1_g + l * DM, l, grp, 0, DM, bid, nb); }
        xcd_barrier(bar);
        if ((REPMASK >> 9) & 1) { xcd_barrier(bar); xcd_barrier(bar); xcd_barrier(bar); xcd_barrier(bar); }
        for (int rep_ = 0; rep_ < 1 + ((REPMASK >> 1) & 1); ++rep_) { const Params q = lp(); gemm_ph((const bf16_t*)(q.ws + OFF_H), (const bf16_t*)(q.ws + OFF_WIN) + (size_t)l * NP * DM, GT, NP, DM, EpiStoreBf16<0>{(bf16_t*)(q.ws + OFF_P), NP, 0}); }
        xcd_barrier(bar);
        for (int rep_ = 0; rep_ < 1 + ((REPMASK >> 2) & 1); ++rep_) { const Params q = lp(); phase_gla_prep(q, gi, bid, nb); }
        for (int rep_ = 0; rep_ < 1 + ((REPMASK >> 2) & 1); ++rep_) { const Params q = lp(); phase_na_prep2(q, gi, bid, nb); }
        for (int rep_ = 0; rep_ < 1 + ((REPMASK >> 2) & 1); ++rep_) { const Params q = lp(); phase_hy_prep(q, gi, bid, nb); }
        xcd_barrier(bar);
        for (int rep_ = 0; rep_ < 1 + ((REPMASK >> 3) & 1); ++rep_) {
            const Params q = lp(); const int tid = ltid();
            na_load_rpb(q, l, tid);
            unsigned* head = (unsigned*)(q.ws + OFF_BAR) + CTR_WORD0 + 64 * (l * NGRP + grp) + 16 * rep_;
            volatile LAS3 int* su = (volatile LAS3 int*)((LAS3 unsigned char*)smem + LDS_UNIT);
            const int nscan = gi.nseq * 16, nhy = 1024, nna = 512, ntot = nscan + nhy + nna;
            for (;;) {
                __syncthreads();
                if (tid == 0) *su = (int)__hip_atomic_fetch_add(head, 1u, __ATOMIC_RELAXED, __HIP_MEMORY_SCOPE_AGENT);
                __syncthreads();
                const int u = __builtin_amdgcn_readfirstlane(*su);
                if (u >= ntot) break;
                if (u < nscan) { for (int r2 = 0; r2 < 1 + ((REPMASK >> 10) & 1); ++r2) gla_scan_unit(q, gi, u, tid); }
                else if (u < nscan + nhy) { for (int r2 = 0; r2 < 1 + ((REPMASK >> 4) & 1); ++r2) hy_conv_unit(q, gi, u - nscan, tid); }
                else { for (int r2 = 0; r2 < 1 + ((REPMASK >> 5) & 1); ++r2) na_attn_unit(q, gi, u - nscan - nhy, tid); }
            }
        }
        xcd_barrier(bar);
        for (int rep_ = 0; rep_ < 1 + ((REPMASK >> 6) & 1); ++rep_) { const Params q = lp(); phase_gla_post<true>(q, gi, bid, nb); }
        for (int rep_ = 0; rep_ < 1 + ((REPMASK >> 6) & 1); ++rep_) { const Params q = lp(); phase_hy_post(q, gi, bid, nb); }
        xcd_barrier(bar);
        { const Params q = lp();
          gemm_ph((const bf16_t*)(q.ws + OFF_OABC), (const bf16_t*)(q.ws + OFF_WBR) + (size_t)l * DM * 3072, GT, DM, 3072, EpiGate3{(const bf16_t*)(q.ws + OFF_P) + C_GATE, (bf16_t*)(q.ws + OFF_MBF), NP, 0}); }
        xcd_barrier(bar);
        { const Params q = lp(); const ModPtrs m = mod_ptrs(q, grp, l);
          gemm_ph((const bf16_t*)(q.ws + OFF_MBF), (const bf16_t*)(q.ws + OFF_WOUT) + (size_t)l * DM * DM, GT, DM, DM, EpiResid{x_in_ptr(q, grp, l), x_out_ptr(q, grp), m.mA + 2 * DM, m.mB + 2 * DM}); }
        xcd_barrier(bar);
        { const Params q = lp(); phase_norm(q, x_out_ptr(q, grp), q.norm2_g + l * DM, l, grp, 3 * DM, 4 * DM, bid, nb); }
        xcd_barrier(bar);
        for (int rep_ = 0; rep_ < 1 + ((REPMASK >> 7) & 1); ++rep_) { const Params q = lp(); gemm_ph((const bf16_t*)(q.ws + OFF_H), (const bf16_t*)(q.ws + OFF_W1) + (size_t)l * DFF * DM, GT, DFF, DM, EpiStoreBf16<1>{(bf16_t*)(q.ws + OFF_P), DFF, 0}); }
        xcd_barrier(bar);
        { const Params q = lp(); const ModPtrs m = mod_ptrs(q, grp, l);
          gemm_ph((const bf16_t*)(q.ws + OFF_P), (const bf16_t*)(q.ws + OFF_W2) + (size_t)l * DM * DFF, GT, DM, DFF, EpiResid{x_out_ptr(q, grp), x_out_ptr(q, grp), m.mA + 5 * DM, m.mB + 5 * DM}); }
        xcd_barrier(bar);
    }
}

extern "C" void kernel_launch(void* const* d_in, const int* in_sizes, int n_in, void* d_out, int out_size, void* d_ws, size_t ws_size, hipStream_t stream) {
    Params p{};
    const float** f = (const float**)&p;
    for (int i = 0; i < 33; ++i) f[i] = (const float*)d_in[i];
    p.out = (float*)d_out; p.ws = (unsigned char*)d_ws;
    if (ws_size < WS_END) { fprintf(stderr, "workspace too small: %zu < %zu\n", ws_size, (size_t)WS_END); return; }
    static int grid = 0;
    if (!grid) {
        int dev = 0, cus = 0, per_cu = 0;
        (void)hipGetDevice(&dev);
        (void)hipDeviceGetAttribute(&cus, hipDeviceAttributeMultiprocessorCount, dev);
        (void)hipFuncSetAttribute((const void*)k_mega, hipFuncAttributeMaxDynamicSharedMemorySize, LDS_BYTES);
        (void)hipOccupancyMaxActiveBlocksPerMultiprocessor(&per_cu, k_mega, 512, LDS_BYTES);
        grid = cus * (per_cu < 1 ? per_cu : 1);
        if (grid <= 0) { fprintf(stderr, "occupancy query failed: cus %d per_cu %d\n", cus, per_cu); grid = 0; return; }
    }
    (void)hipMemsetAsync(p.ws + OFF_BAR, 0, (XCD_BAR_WORDS + CTR_WORDS) * sizeof(unsigned), stream);
    hipLaunchKernelGGL(k_mega, dim3(grid), dim3(512), LDS_BYTES, stream, p);
}
```

```cpp
#define REPMASK 0
#include <hip/hip_runtime.h>
#include <stdint.h>
#include <stdio.h>

constexpr int DM = 2048, DFF = 8192, NMOD = 6, NCOND = 9;
constexpr int GT = 8192;
constexpr int NGRP = 5, DEPTH = 2;
constexpr int C_GQ = 0, C_GK = 512, C_GV = 1024, C_GG = 2048, C_GA = 3072, C_NQ = 3328, C_NK = 4352, C_NV = 5376, C_HY = 6400, C_GATE = 9472, NP = 15616;
constexpr int IN_TOTAL = 15392;
constexpr float EPS = 1e-6f;

typedef unsigned short bf16_t;
typedef float f32x4 __attribute__((ext_vector_type(4)));
typedef float f32x2 __attribute__((ext_vector_type(2)));
typedef unsigned u32x4 __attribute__((ext_vector_type(4)));
typedef unsigned u32x2 __attribute__((ext_vector_type(2)));
#define DI __device__ __forceinline__

DI int ltid() { int t = threadIdx.x; asm volatile("" : "+v"(t)); return t; }
DI float bf2f(bf16_t b) { return __uint_as_float(((unsigned)b) << 16); }
DI float bflo(unsigned w) { return __uint_as_float(w << 16); }
DI float bfhi(unsigned w) { return __uint_as_float(w & 0xffff0000u); }
DI bf16_t f2bf(float f) { unsigned u = __float_as_uint(f); u += 0x7FFFu + ((u >> 16) & 1u); return (bf16_t)(u >> 16); }
DI unsigned pk2(float lo, float hi) { return (unsigned)f2bf(lo) | ((unsigned)f2bf(hi) << 16); }
DI float sigmoidf_(float x) { return 1.0f / (1.0f + __expf(-x)); }
DI float wave_sum(float v, int lane) {
#pragma unroll
    for (int o = 32; o >= 1; o >>= 1) v += __int_as_float(__builtin_amdgcn_ds_bpermute((lane ^ o) << 2, __float_as_int(v))); return v; }
DI float wave_max(float v, int lane) {
#pragma unroll
    for (int o = 32; o >= 1; o >>= 1) v = fmaxf(v, __int_as_float(__builtin_amdgcn_ds_bpermute((lane ^ o) << 2, __float_as_int(v)))); return v; }

constexpr size_t al256(size_t x) { return (x + 255) & ~(size_t)255; }
constexpr size_t OFF_BAR  = 0;
constexpr size_t OFF_MOD  = 65536;
constexpr size_t OFF_HID  = OFF_MOD  + al256((size_t)DEPTH * NCOND * 12288 * 4);
constexpr size_t OFF_FILT = OFF_HID  + (size_t)DEPTH * 2 * 4096 * 64 * 4;
constexpr size_t FILT_L   = (size_t)2 * 1024 * ((256 + 232) + (4096 + 232)) * 2;
constexpr size_t OFF_WIN  = OFF_FILT + DEPTH * FILT_L;
constexpr size_t OFF_WBR  = OFF_WIN  + (size_t)DEPTH * NP * DM * 2;
constexpr size_t OFF_WOUT = OFF_WBR  + (size_t)DEPTH * 3 * DM * 1024 * 2;
constexpr size_t OFF_W1   = OFF_WOUT + (size_t)DEPTH * DM * DM * 2;
constexpr size_t OFF_W2   = OFF_W1   + (size_t)DEPTH * DFF * DM * 2;
constexpr size_t OFF_H    = OFF_W2   + (size_t)DEPTH * DFF * DM * 2;
constexpr size_t OFF_P    = OFF_H    + (size_t)GT * DM * 2;
constexpr size_t OFF_OF   = OFF_P    + (size_t)GT * NP * 2;
constexpr size_t OFF_OB   = OFF_OF   + (size_t)GT * 1024 * 4;
constexpr size_t OFF_OABC = OFF_OB   + (size_t)GT * 1024 * 4;
constexpr size_t OFF_M32  = OFF_OABC + (size_t)3 * GT * 1024 * 2;
constexpr size_t OFF_MBF  = OFF_M32  + (size_t)GT * DM * 4;
constexpr size_t OFF_QN   = OFF_MBF  + (size_t)GT * DM * 2;
constexpr size_t OFF_KN   = OFF_QN   + (size_t)GT * 1024 * 2;
constexpr size_t OFF_QF   = OFF_KN   + (size_t)GT * 1024 * 2;
constexpr size_t OFF_QB   = OFF_QF   + (size_t)GT * 512 * 2;
constexpr size_t OFF_KFT  = OFF_QB   + (size_t)GT * 512 * 2;
constexpr size_t OFF_KBT  = OFF_KFT  + (size_t)GT * 512 * 2;
constexpr size_t OFF_VT   = OFF_KBT  + (size_t)GT * 512 * 2;
constexpr size_t OFF_DEC  = OFF_VT   + (size_t)GT * 1024 * 2;
constexpr size_t OFF_OI   = OFF_DEC  + (size_t)2 * 128 * 512 * 4;
constexpr size_t OFF_UCT  = OFF_OI   + (size_t)GT * 1024 * 4;
constexpr size_t OFF_OCT  = OFF_UCT  + (size_t)3072 * GT * 2;
constexpr size_t OFF_VTN  = OFF_OCT  + (size_t)1024 * GT * 2;
constexpr size_t OFF_CK   = OFF_VTN  + (size_t)GT * 1024 * 2;
constexpr size_t OFF_CVT  = OFF_CK   + (size_t)8 * 2 * 8 * 256 * 128 * 2;
constexpr size_t OFF_WA2T = OFF_CVT  + (size_t)8 * 2 * 8 * 256 * 128 * 2;
constexpr size_t WS_END   = OFF_WA2T + (size_t)DEPTH * 2 * 512 * 16 * 2;
static_assert(WS_END < (size_t)1190000000, "workspace too large");

constexpr size_t OUT_YP = 0, OUT_YS = (size_t)32 * 256 * DM, OUT_ST = OUT_YS + (size_t)8 * 4096 * DM,
                 OUT_CK = OUT_ST + (size_t)32 * 2 * 2 * 4 * 128 * 256, OUT_CV = OUT_CK + (size_t)32 * 2 * 8 * 256 * 128;

struct Params {
    const float *x_prompt, *x_sample, *state_gla, *cache_k, *cache_v, *c, *c_ctx, *w_mod, *b_mod, *norm1_g, *norm2_g, *w_in, *gla_wa2, *gla_ba2, *gla_norm_g,
                *na_qnorm_g, *na_knorm_g, *na_rpb, *hy_conv_w, *hy_conv_b, *hy_f1_w, *hy_f1_b, *hy_f2_w, *hy_f2_b, *hy_f3_w, *hy_freq, *hy_bias,
                *w_br_a, *w_br_b, *w_br_c, *w_out, *w_mlp1, *w_mlp2;
    float* out; unsigned char* ws;
};
constexpr int NPARAM = 35;
union ParamsU { Params s; unsigned long long a[NPARAM]; };
static_assert(sizeof(Params) == NPARAM * 8, "Params must be 35 pointers");
DI unsigned char* lws(const Params& p) { unsigned char* w = p.ws; asm volatile("" : "+s"(w)); return w; }
DI float* lout(const Params& p) { float* w = p.out; asm volatile("" : "+s"(w)); return w; }
namespace pg8 {
#define PG8_LAS __attribute__((address_space(3)))
typedef unsigned short bf16_t;
typedef short bf16x8 __attribute__((ext_vector_type(8)));
typedef float f32x4 __attribute__((ext_vector_type(4)));
typedef unsigned u32x4 __attribute__((ext_vector_type(4)));
constexpr int BM = 256, BK = 64, HALF = 128, HTB = HALF * BK * 2  , STAGE_BYTES = 8 * HTB, NXCD = 8, WGM = 8;
__host__ __device__ __forceinline__ int lds_byte(int r, int c) { const int st = (r >> 4) * 2 + (c >> 5), rr = r & 15, cc = c & 31, ob = rr * 64 + cc * 2; return st * 1024 + (ob ^ (((ob >> 9) & 1) << 5)); }
__host__ __device__ __forceinline__ void stage_rc(int b, int& R, int& C) { const int st = b / 1024, sb = b % 1024, swz = sb ^ (((sb >> 9) & 1) << 5); R = (st >> 1) * 16 + swz / 64; C = (st & 1) * 32 + (swz % 64) / 2; }
__host__ __device__ __forceinline__ int perm32(int rho) { const int n = rho >> 4, i = rho & 15; return 8 * (i >> 2) + 4 * n + (i & 3); }
struct Unit { int pm, pn; };
struct Gemm { const bf16_t* A; const bf16_t* Bt; int M, N, K, pad; };
struct StaticOrder {
    int nM, nN, nwg, G, c;
    __host__ __device__ void init(int M, int N, int G_, int c_) { nM = M / BM; nN = N / BM; nwg = nM * nN; G = G_; c = c_; }
    __host__ __device__ bool next(int i, Unit& u) const {
        const long L = (long)i * G + c; if (L >= nwg) return false;
        int wgid = (int)L; { const int q = nwg / NXCD, r = nwg % NXCD, xcd = wgid % NXCD, off = wgid / NXCD; wgid = (xcd < r ? xcd * (q + 1) : r * (q + 1) + (xcd - r) * q) + off; }
        const int nig = WGM * nN, gid = wgid / nig, fm = gid * WGM, gsz = (nM - fm) < WGM ? (nM - fm) : WGM;
        u.pm = fm + ((wgid % nig) % gsz); u.pn = (wgid % nig) / gsz; return true;
    }
    __device__ __forceinline__ void a_ready(const Unit&) const {}
    __device__ __forceinline__ void done(const Unit&) const {}
};
__device__ __forceinline__ unsigned cvt_pk_bf16(float lo, float hi) { unsigned r; asm volatile("v_cvt_pk_bf16_f32 %0, %1, %2" : "=v"(r) : "v"(lo), "v"(hi)); return r; }
template <class Epi, class Sched, bool STAMP = false>
__device__ __forceinline__ void gemm_phase(PG8_LAS unsigned char* lds, const Gemm g, const Sched& S, const Epi& E, unsigned long long* stamps) {
    int tid_ = threadIdx.x; asm volatile("" : "+v"(tid_));
    const int tid = tid_, wid = __builtin_amdgcn_readfirstlane(tid >> 6), lane = tid & 63, wr = wid >> 2, wc = wid & 3, fr = lane & 15, fq = lane >> 4;
    const int K = g.K, nt = K / BK;
    int ts_lo = 0, ts_hi = 0, nts = 0; const unsigned long long rt_entry = STAMP ? (unsigned long long)wall_clock64() : 0ull;
#define PG8_STAMP() do { if (STAMP && wid == 0 && nts < 64) { const unsigned long long _c = (unsigned long long)clock64(); \
        ts_lo = (lane == nts) ? (int)(unsigned)_c : ts_lo; ts_hi = (lane == nts) ? (int)(unsigned)(_c >> 32) : ts_hi; ++nts; } } while (0)
    PG8_STAMP();
    unsigned voffA[2], voffB[2];
#pragma unroll
    for (int i = 0; i < 2; ++i) { int R, C; stage_rc(tid * 16 + i * 8192, R, C); const int Rb = Epi::PERM ? ((R & ~31) + perm32(R & 31)) : R;
        voffA[i] = (unsigned)(R * K + C) * 2u; voffB[i] = (unsigned)(Rb * K + C) * 2u; }
    const size_t kstep = (size_t)(BK * 2);
    const size_t hstep = (size_t)HALF * K * 2;
    const size_t tstep = 2 * hstep;
    const unsigned ldsw = (unsigned)wid * 1024u;
    const int aoff = lds_byte(wr * 64 + fr, fq * 8), boff = lds_byte(wc * 32 + fr, fq * 8);
#define PG8_SA(b, h) (((b) * 2 + (h)) * HTB)
#define PG8_SB(b, h) ((4 + (b) * 2 + (h)) * HTB)
#define PG8_STAGE(bufoff, gbase, voff) do { _Pragma("unroll") for (int _i = 0; _i < 2; ++_i) \
        __builtin_amdgcn_global_load_lds((const unsigned*)((const char*)(gbase) + (voff)[_i]), (PG8_LAS unsigned*)(lds + (bufoff) + ldsw + _i * 8192), 16, 0, 0); } while (0)
#define PG8_LDA(dst, b, h) do { _Pragma("unroll") for (int m = 0; m < 4; ++m) _Pragma("unroll") for (int k = 0; k < 2; ++k) dst[m][k] = *(const PG8_LAS bf16x8*)(lds + PG8_SA(b, h) + aoff + m * 2048 + k * 1024); } while (0)
#define PG8_LDB(dst, b, h) do { _Pragma("unroll") for (int n = 0; n < 2; ++n) _Pragma("unroll") for (int k = 0; k < 2; ++k) dst[n][k] = *(const PG8_LAS bf16x8*)(lds + PG8_SB(b, h) + boff + n * 2048 + k * 1024); } while (0)
#define PG8_MMA(ai, bj, At, Bt) do { __builtin_amdgcn_s_setprio(1); _Pragma("unroll") for (int m = 0; m < 4; ++m) _Pragma("unroll") for (int n = 0; n < 2; ++n) _Pragma("unroll") for (int k = 0; k < 2; ++k) \
        acc[ai][bj][m][n] = __builtin_amdgcn_mfma_f32_16x16x32_bf16(Bt[n][k], At[m][k], acc[ai][bj][m][n], 0, 0, 0); __builtin_amdgcn_s_setprio(0); } while (0)
#define PG8_WAIT_V(n) asm volatile("s_waitcnt vmcnt(" #n ")" ::: "memory")
#define PG8_WAIT_L(n) asm volatile("s_waitcnt lgkmcnt(" #n ")" ::: "memory")
#define PG8_BAR __builtin_amdgcn_s_barrier()
#define PG8_SCHED __builtin_amdgcn_sched_barrier(0)
    Unit cur, nxt; int ui = 0;
    if (!S.next(0, cur)) return;
    f32x4 acc[2][2][4][2];
#pragma unroll
    for (int a = 0; a < 2; ++a)
#pragma unroll
        for (int b = 0; b < 2; ++b)
#pragma unroll
            for (int m = 0; m < 4; ++m)
#pragma unroll
                for (int n = 0; n < 2; ++n) acc[a][b][m][n] = (f32x4){0.f, 0.f, 0.f, 0.f};
    bf16x8 At[4][2], B0[2][2], B1[2][2];
    const char* cA = (const char*)g.A + (size_t)cur.pm * tstep; const char* cB = (const char*)g.Bt + (size_t)cur.pn * tstep;
    S.a_ready(cur);
    PG8_STAGE(PG8_SB(0, 0), cB, voffB); PG8_STAGE(PG8_SA(0, 0), cA, voffA); PG8_STAGE(PG8_SB(0, 1), cB + hstep, voffB); PG8_STAGE(PG8_SA(0, 1), cA + hstep, voffA);
    if (wr == 1) PG8_BAR;
    PG8_WAIT_V(4); PG8_BAR;
    PG8_STAGE(PG8_SB(1, 0), cB + kstep, voffB); PG8_STAGE(PG8_SA(1, 0), cA + kstep, voffA); PG8_STAGE(PG8_SB(1, 1), cB + hstep + kstep, voffB);
    PG8_WAIT_V(6); PG8_BAR;
    PG8_STAMP();
    for (;;) {
        const bool has_next = S.next(ui + 1, nxt);
        const char* nA = has_next ? (const char*)g.A + (size_t)nxt.pm * tstep : cA; const char* nB = has_next ? (const char*)g.Bt + (size_t)nxt.pn * tstep : cB;
        for (int t = 0; t < nt; t += 2) {
            if constexpr (Epi::KHOOK) { if (t == E.kh0 || t == E.kh1) E.khook(acc, cur, t, wr, wc, fr, fq); }
            const bool last = (t == nt - 2);
            const char* a1 = cA + (size_t)(t + 1) * kstep;
            const char* a2 = last ? nA : cA + (size_t)(t + 2) * kstep; const char* b2 = last ? nB : cB + (size_t)(t + 2) * kstep;
            const char* a3 = a2 + kstep; const char* b3 = b2 + kstep;
            if (last && has_next) S.a_ready(nxt);
            PG8_LDB(B0, 0, 0); PG8_SCHED; PG8_LDA(At, 0, 0); PG8_STAGE(PG8_SA(1, 1), a1 + hstep, voffA);
            PG8_WAIT_L(8); PG8_BAR; PG8_WAIT_L(0); PG8_MMA(0, 0, At, B0); PG8_BAR; PG8_SCHED;
            PG8_LDB(B1, 0, 1); PG8_STAGE(PG8_SB(0, 0), b2, voffB);
            PG8_BAR; PG8_WAIT_L(0); PG8_MMA(0, 1, At, B1); PG8_BAR;
            PG8_LDA(At, 0, 1); PG8_STAGE(PG8_SA(0, 0), a2, voffA);
            PG8_BAR; PG8_WAIT_L(0); PG8_MMA(1, 0, At, B0); PG8_BAR; PG8_SCHED;
            PG8_STAGE(PG8_SB(0, 1), b2 + hstep, voffB);
            PG8_WAIT_V(6); PG8_BAR; PG8_MMA(1, 1, At, B1); PG8_BAR;
            PG8_LDB(B0, 1, 0); PG8_SCHED; PG8_LDA(At, 1, 0); PG8_STAGE(PG8_SA(0, 1), a2 + hstep, voffA);
            PG8_WAIT_L(8); PG8_BAR; PG8_WAIT_L(0); PG8_MMA(0, 0, At, B0); PG8_BAR; PG8_SCHED;
            PG8_LDB(B1, 1, 1); PG8_STAGE(PG8_SB(1, 0), b3, voffB);
            PG8_BAR; PG8_WAIT_L(0); PG8_MMA(0, 1, At, B1); PG8_BAR;
            PG8_LDA(At, 1, 1); PG8_STAGE(PG8_SA(1, 0), a3, voffA);
            PG8_BAR; PG8_WAIT_L(0); PG8_MMA(1, 0, At, B0); PG8_BAR; PG8_SCHED;
            PG8_STAGE(PG8_SB(1, 1), b3 + hstep, voffB);
            PG8_WAIT_V(6); PG8_BAR; PG8_MMA(1, 1, At, B1); PG8_BAR;
        }
        PG8_STAMP();
        if constexpr (!Epi::AFTER_DRAIN) { E(acc, cur, wr, wc, fr, fq); S.done(cur); }
        PG8_STAMP();
        if (!has_next) break;
#pragma unroll
        for (int a = 0; a < 2; ++a)
#pragma unroll
            for (int b = 0; b < 2; ++b)
#pragma unroll
                for (int m = 0; m < 4; ++m)
#pragma unroll
                    for (int n = 0; n < 2; ++n) acc[a][b][m][n] = (f32x4){0.f, 0.f, 0.f, 0.f};
        cur = nxt; cA = nA; cB = nB; ++ui;
    }
    PG8_WAIT_V(0);
    if (wr == 0) PG8_BAR;
    PG8_BAR;
    if constexpr (Epi::AFTER_DRAIN) { E.fused(acc, cur, wr, wc, fr, fq, lds, wid, lane); S.done(cur); }
    PG8_STAMP();
    if (STAMP && wid == 0) { stamps[lane] = lane < nts ? (((unsigned long long)(unsigned)ts_hi << 32) | (unsigned)ts_lo) : 0ull;
        if (lane == 62) stamps[62] = rt_entry; if (lane == 63) stamps[63] = (unsigned long long)wall_clock64(); }
#undef PG8_STAMP
#undef PG8_SA
#undef PG8_SB
#undef PG8_STAGE
#undef PG8_LDA
#undef PG8_LDB
#undef PG8_MMA
#undef PG8_WAIT_V
#undef PG8_WAIT_L
#undef PG8_BAR
#undef PG8_SCHED
}
}
#define XB_TMO      128
#define XB_XCNT(j)  (256  + 64 * (j))
#define XB_XSUB(j)  (1280 + 64 * (j))
#define XB_XGEN(j)  (2304 + 64 * (j))
#define XB_TOP      3328
#define XB_TOPGEN   3392
#define XCD_BAR_WORDS 3456
#define XB_SPIN_CAP (1u << 18)
#define LAS __attribute__((address_space(3)))

__device__ __forceinline__ unsigned xb_ld(unsigned* p)              { return __hip_atomic_load(p, __ATOMIC_RELAXED, __HIP_MEMORY_SCOPE_AGENT); }
__device__ __forceinline__ unsigned xb_add(unsigned* p, unsigned v) { return __hip_atomic_fetch_add(p, v, __ATOMIC_RELAXED, __HIP_MEMORY_SCOPE_AGENT); }
__device__ __forceinline__ unsigned xb_xcc_id() { return (unsigned)__builtin_amdgcn_s_getreg((3 << 11) | 20) & 0xFu; }
#define XB_SPIN(cond, bar) do { unsigned _sp = 0; while (cond) { __builtin_amdgcn_s_sleep(1); \
    if ((++_sp & 255u) == 0u) { if (xb_ld(&(bar)[XB_TMO])) break; if (_sp > XB_SPIN_CAP) { atomicAdd(&(bar)[XB_TMO], 1u); break; } } } } while (0)

struct XcdBarrier {
    unsigned* bar; unsigned x;
    volatile LAS unsigned* st;
};

__device__ __forceinline__ XcdBarrier xcd_barrier_post(unsigned* bar, volatile LAS unsigned* st) {
    XcdBarrier b; b.bar = bar; b.x = (unsigned)__builtin_amdgcn_readfirstlane((int)xb_xcc_id()); b.st = st;
    if (threadIdx.x == 0) (void)xb_add(&bar[XB_XCNT(b.x)], 1u);
    return b;
}
__device__ __forceinline__ void xcd_barrier_complete(unsigned* bar, unsigned x, unsigned& nloc, unsigned& nx) {
    const unsigned G = gridDim.x * gridDim.y * gridDim.z;
    unsigned sum, cnt, mine, sp = 0u;
    for (;;) {
        sum = 0u; cnt = 0u; mine = 0u;
#pragma unroll
        for (unsigned j = 0; j < 16; ++j) { const unsigned c = xb_ld(&bar[XB_XCNT(j)]); sum += c; cnt += (c > 0u) ? 1u : 0u; mine = (j == x) ? c : mine; }
        if (sum == G) break;
        __builtin_amdgcn_s_sleep(1);
        if ((++sp & 255u) == 0u) { if (xb_ld(&bar[XB_TMO])) break; if (sp > XB_SPIN_CAP) { atomicAdd(&bar[XB_TMO], 1u); break; } }
    }
    nloc = mine > 0u ? mine : 1u; nx = cnt > 0u ? cnt : 1u;
}

__device__ __forceinline__ void xcd_barrier(const XcdBarrier& b) {
    asm volatile("s_waitcnt vmcnt(0)" ::: "memory");
    __syncthreads();
    if (threadIdx.x == 0) {
        unsigned* bar = b.bar; unsigned bx = b.x; asm volatile("" : "+s"(bx));
        __builtin_amdgcn_s_waitcnt(0);
        unsigned nloc = b.st[0], nx = b.st[1];
        if (nloc == 0u) { xcd_barrier_complete(bar, bx, nloc, nx); b.st[0] = nloc; b.st[1] = nx; }
        const unsigned old = xb_add(&bar[XB_XSUB(bx)], 1u);
        const unsigned gen = old / nloc;
        if (old + 1u == (gen + 1u) * nloc) {
            __builtin_amdgcn_fence(__ATOMIC_RELEASE, "agent");
            asm volatile("s_waitcnt vmcnt(0)" ::: "memory");
            const unsigned og = xb_add(&bar[XB_TOP], 1u);
            const unsigned tg = og / nx;
            if (og + 1u == (tg + 1u) * nx) xb_add(&bar[XB_TOPGEN], 1u);
            else XB_SPIN(xb_ld(&bar[XB_TOPGEN]) == tg, bar);
            __builtin_amdgcn_fence(__ATOMIC_ACQUIRE, "agent");
            xb_add(&bar[XB_XGEN(bx)], 1u);
            asm volatile("s_waitcnt vmcnt(0)" ::: "memory");
        } else {
            XB_SPIN(xb_ld(&bar[XB_XGEN(bx)]) == gen, bar);
            __builtin_amdgcn_fence(__ATOMIC_ACQUIRE, "agent");
            asm volatile("s_waitcnt vmcnt(0)" ::: "memory");
        }
    }
    __syncthreads();
}

extern __shared__ __attribute__((aligned(16))) unsigned char smem[];

DI void convT_tile(const float* __restrict__ src, int ldsrc, bf16_t* __restrict__ dst, int K  , int tile, int ntn, bool inmap) {
    float* t = (float*)smem;
    const int tid = ltid(), tk = tile / ntn, tn = tile % ntn, k0 = tk * 64, n0 = tn * 64;
    __syncthreads();
#pragma unroll
    for (int r = 0; r < 8; ++r) {
        const int i = (tid >> 6) + 8 * r, j = tid & 63, n = n0 + j;
        int sn = n; bool z = false;
        if (inmap) { if (n >= 3104 && n < C_NQ) z = true; else if (n >= C_NQ) sn = n - 224; }
        t[i * 65 + j] = z ? 0.f : src[(size_t)(k0 + i) * ldsrc + sn];
    }
    __syncthreads();
    const int j = tid >> 3, i8 = (tid & 7) * 8;
    u32x4 w;
    w.x = pk2(t[(i8 + 0) * 65 + j], t[(i8 + 1) * 65 + j]); w.y = pk2(t[(i8 + 2) * 65 + j], t[(i8 + 3) * 65 + j]);
    w.z = pk2(t[(i8 + 4) * 65 + j], t[(i8 + 5) * 65 + j]); w.w = pk2(t[(i8 + 6) * 65 + j], t[(i8 + 7) * 65 + j]);
    *(u32x4*)(dst + (size_t)(n0 + j) * K + k0 + i8) = w;
}
DI void phase_convert(const Params& p, int bid, int nb) {
    { bf16_t* wt = (bf16_t*)(lws(p) + OFF_WA2T);
      for (int i = bid * 512 + (int)threadIdx.x; i < DEPTH * 2 * 512 * 16; i += nb * 512) { const int r = i & 15, hd = (i >> 4) & 511, ld = i >> 13; wt[i] = f2bf(p.gla_wa2[((size_t)ld * 16 + r) * 512 + hd]); } }
    for (int l = 0; l < DEPTH; ++l) {
        { const int ntn = NP / 64, nt = (DM / 64) * ntn; bf16_t* d = (bf16_t*)(lws(p) + OFF_WIN) + (size_t)l * NP * DM;
          for (int t = bid; t < nt; t += nb) convT_tile(p.w_in + (size_t)l * DM * IN_TOTAL, IN_TOTAL, d, DM, t, ntn, true); }
        for (int br = 0; br < 3; ++br) { const float* s = (br == 0 ? p.w_br_a : br == 1 ? p.w_br_b : p.w_br_c) + (size_t)l * 1024 * DM;
          const int ntn = DM / 64, nt = (1024 / 64) * ntn; bf16_t* d = (bf16_t*)(lws(p) + OFF_WBR) + (size_t)l * DM * 3072 + br * 1024;
          for (int t = bid; t < nt; t += nb) convT_tile(s, DM, d, 3072, t, ntn, false); }
        { const int ntn = DM / 64, nt = (DM / 64) * ntn; bf16_t* d = (bf16_t*)(lws(p) + OFF_WOUT) + (size_t)l * DM * DM;
          for (int t = bid; t < nt; t += nb) convT_tile(p.w_out + (size_t)l * DM * DM, DM, d, DM, t, ntn, false); }
        { const int ntn = DFF / 64, nt = (DM / 64) * ntn; bf16_t* d = (bf16_t*)(lws(p) + OFF_W1) + (size_t)l * DFF * DM;
          for (int t = bid; t < nt; t += nb) convT_tile(p.w_mlp1 + (size_t)l * DM * DFF, DFF, d, DM, t, ntn, false); }
        { const int ntn = DM / 64, nt = (DFF / 64) * ntn; bf16_t* d = (bf16_t*)(lws(p) + OFF_W2) + (size_t)l * DM * DFF;
          for (int t = bid; t < nt; t += nb) convT_tile(p.w_mlp2 + (size_t)l * DFF * DM, DM, d, DFF, t, ntn, false); }
    }
}

DI void phase_adaln(const Params& p, int bid, int nb) {
    float* sc = (float*)smem;
    float* red = sc + NCOND * DM;
    const int tid = ltid();
    __syncthreads();
    for (int i = tid; i < NCOND * DM; i += 512) { const int r = i / DM, k = i % DM; const float v = r == 0 ? p.c_ctx[k] : p.c[(size_t)(r - 1) * DM + k]; sc[i] = v * sigmoidf_(v); }
    __syncthreads();
    const int nun = DEPTH * (NMOD * DM / 64);
    for (int u = bid; u < nun; u += nb) {
        const int l = u / (NMOD * DM / 64), j0 = (u % (NMOD * DM / 64)) * 64, j = tid & 63, ks = tid >> 6;
        const float* w = p.w_mod + (size_t)l * DM * (NMOD * DM) + j0 + j;
        float acc[NCOND];
#pragma unroll
        for (int r = 0; r < NCOND; ++r) acc[r] = 0.f;
        for (int k = ks * 256; k < ks * 256 + 256; ++k) { const float wv = w[(size_t)k * (NMOD * DM)];
#pragma unroll
            for (int r = 0; r < NCOND; ++r) acc[r] += sc[r * DM + k] * wv; }
#pragma unroll
        for (int r = 0; r < NCOND; ++r) red[(ks * NCOND + r) * 64 + j] = acc[r];
        __syncthreads();
        for (int i = tid; i < NCOND * 64; i += 512) { const int r = i / 64, jj = i % 64; float s = p.b_mod[(size_t)l * NMOD * DM + j0 + jj];
#pragma unroll
            for (int q = 0; q < 8; ++q) s += red[(q * NCOND + r) * 64 + jj];
            ((float*)(lws(p) + OFF_MOD))[((size_t)l * NCOND + r) * (NMOD * DM) + j0 + jj] = s; }
        __syncthreads();
    }
}

DI void phase_hyena_hid(const Params& p, int bid, int nb) {
    float* zf = (float*)smem;
    float* h1 = zf + 8 * 36;
    const int tid = ltid(), tt = tid >> 6, j = tid & 63;
    const int nun = DEPTH * (256 / 8 + 4096 / 8);
    for (int u = bid; u < nun; u += nb) {
        const int l = u / 544, r = u % 544, ls = r < 32 ? 0 : 1, tb = ls ? r - 32 : r, L = ls ? 4096 : 256, t = tb * 8 + tt;
        const float tn = (float)t / (float)L;
        __syncthreads();
        if (j < 33) { float v; if (j == 0) v = tn; else { const int band = j <= 16 ? j : j - 16; const float ang = 6.283185307179586f * tn * (float)band; v = j <= 16 ? cosf(ang) : sinf(ang); } zf[tt * 36 + j] = v; }
        __syncthreads();
        const float fr = p.hy_freq[l * 64 + j];
        float a = p.hy_f1_b[l * 64 + j];
        for (int i = 0; i < 33; ++i) a += zf[tt * 36 + i] * p.hy_f1_w[((size_t)l * 33 + i) * 64 + j];
        h1[tt * 64 + j] = sinf(fr * a);
        __syncthreads();
        float b = p.hy_f2_b[l * 64 + j];
        for (int i = 0; i < 64; ++i) b += h1[tt * 64 + i] * p.hy_f2_w[((size_t)l * 64 + i) * 64 + j];
        ((float*)(lws(p) + OFF_HID))[(((size_t)l * 2 + ls) * 4096 + t) * 64 + j] = sinf(fr * b);
    }
}
DI bf16_t* filt_ptr(unsigned char* ws, int l, int ls) { return (bf16_t*)(ws + OFF_FILT + (size_t)l * FILT_L) + (ls ? (size_t)2 * 1024 * (256 + 232) : 0); }
DI void phase_filters(const Params& p, int bid, int nb) {
    float* f3s = (float*)smem;
    float* red = f3s + 256;
    const int tid = ltid();
    const int nun = DEPTH * 2 * 512;
    const int tid0 = tid;
    for (int u = bid; u < nun; u += nb) {
        int tid = tid0; asm volatile("" : "+v"(tid));
        const int lane = tid & 63, wid = tid >> 6;
        const int l = u / 1024, ls = (u / 512) & 1, cg = u % 512, L = ls ? 4096 : 256, col0 = cg * 4;
        __syncthreads();
        if (tid < 256) f3s[tid] = p.hy_f3_w[((size_t)l * 64 + (tid >> 2)) * 2048 + col0 + (tid & 3)];
        __syncthreads();
        const float* hid = (const float*)(lws(p) + OFF_HID) + ((size_t)l * 2 + ls) * 4096 * 64;
        float val[8][4]; float ss[4] = {0.f, 0.f, 0.f, 0.f};
        float delta[4];
#pragma unroll
        for (int cc = 0; cc < 4; ++cc) { const int c = (col0 + cc) & 1023; const float a = -3.0701134573253943f, b = -15.350567286626972f; delta[cc] = fabsf(a + (b - a) * ((float)c / 1023.0f)); }
#pragma unroll
        for (int i = 0; i < 8; ++i) {
            const int t = tid + 512 * i;
#pragma unroll
            for (int cc = 0; cc < 4; ++cc) val[i][cc] = 0.f;
            if (t < L) {
                const f32x4* hr = (const f32x4*)(hid + (size_t)t * 64);
                float a0 = 0.f, a1 = 0.f, a2 = 0.f, a3 = 0.f;
#pragma unroll
                for (int q = 0; q < 16; ++q) { const f32x4 hv = hr[q];
#pragma unroll
                    for (int e = 0; e < 4; ++e) { const f32x4 w = *(const f32x4*)(f3s + (q * 4 + e) * 4); a0 += hv[e] * w[0]; a1 += hv[e] * w[1]; a2 += hv[e] * w[2]; a3 += hv[e] * w[3]; } }
                const float dist = fabsf((float)t - (float)(L / 2)) * (2.0f / (float)L);
                val[i][0] = a0 * expf(-dist * delta[0]); val[i][1] = a1 * expf(-dist * delta[1]); val[i][2] = a2 * expf(-dist * delta[2]); val[i][3] = a3 * expf(-dist * delta[3]);
#pragma unroll
                for (int cc = 0; cc < 4; ++cc) ss[cc] += val[i][cc] * val[i][cc];
            }
        }
#pragma unroll
        for (int cc = 0; cc < 4; ++cc) { ss[cc] = wave_sum(ss[cc], lane); if (lane == 0) red[wid * 4 + cc] = ss[cc]; }
        __syncthreads();
        float sc[4];
#pragma unroll
        for (int cc = 0; cc < 4; ++cc) { float s = 0.f;
#pragma unroll
            for (int q = 0; q < 8; ++q) s += red[q * 4 + cc]; sc[cc] = rsqrtf(s + EPS); }
        bf16_t* fo = filt_ptr(lws(p), l, ls);
        const int LF = L + 232;
        int tid2 = tid; asm volatile("" : "+v"(tid2));
#pragma unroll
        for (int i = 0; i < 8; ++i) { const int t = tid2 + 512 * i; if (t < L) {
#pragma unroll
            for (int cc = 0; cc < 4; ++cc) { const int col = col0 + cc; fo[((size_t)(col >> 10) * 1024 + (col & 1023)) * LF + (L + 87 - t)] = f2bf(val[i][cc] * sc[cc]); } } }
        if (tid < 232) { const int xx = tid < 88 ? tid : L + tid;
#pragma unroll
            for (int cc = 0; cc < 4; ++cc) { const int col = col0 + cc; fo[((size_t)(col >> 10) * 1024 + (col & 1023)) * LF + xx] = (bf16_t)0; } }
    }
}

DI int cond_row(int grp, int row) { return grp == 0 ? 0 : 1 + 2 * (grp - 1) + (row >> 12); }
DI void phase_norm(const Params& p, const float* x, const float* g, int l, int grp, int shoff, int scoff, int bid, int nb) {
    const int tid = ltid(), lane = tid & 63, wid = tid >> 6;
    bf16_t* h = (bf16_t*)(lws(p) + OFF_H);
    for (int row = bid * 8 + wid; row < GT; row += nb * 8) {
        const float* xr = x + (size_t)row * DM;
        f32x4 v[8]; float ss = 0.f;
#pragma unroll
        for (int i = 0; i < 8; ++i) { v[i] = *(const f32x4*)(xr + i * 256 + lane * 4); ss += v[i][0] * v[i][0] + v[i][1] * v[i][1] + v[i][2] * v[i][2] + v[i][3] * v[i][3]; }
        ss = wave_sum(ss, lane);
        const float rs = rsqrtf(ss * (1.0f / DM) + EPS);
        const float* md = (const float*)(lws(p) + OFF_MOD) + ((size_t)l * NCOND + cond_row(grp, row)) * (NMOD * DM);
#pragma unroll
        for (int i = 0; i < 8; ++i) { const int c = i * 256 + lane * 4; const f32x4 gv = *(const f32x4*)(g + c), sh = *(const f32x4*)(md + shoff + c), sc = *(const f32x4*)(md + scoff + c);
            f32x4 o = v[i] * rs * gv * (sc + 1.0f) + sh; u32x2 w; w.x = pk2(o[0], o[1]); w.y = pk2(o[2], o[3]); *(u32x2*)(h + (size_t)row * DM + c) = w; }
    }
}
using pg8::Unit; using pg8::cvt_pk_bf16;
template <int ACT> struct EpiStoreBf16 {
    static constexpr bool PERM = true, AFTER_DRAIN = false, KHOOK = false;
    bf16_t* O; int ldc; int pad;
    __device__ __forceinline__ void operator()(const f32x4 (&acc)[2][2][4][2], const Unit& u, int wr, int wc, int fr, int fq) const {
        const int row0 = u.pm * 256 + wr * 64 + fr, col0 = u.pn * 256 + wc * 32 + 8 * fq;
#pragma unroll
        for (int ai = 0; ai < 2; ++ai)
#pragma unroll
            for (int m = 0; m < 4; ++m) { bf16_t* rowp = O + (size_t)(row0 + ai * 128 + m * 16) * ldc + col0;
#pragma unroll
                for (int bj = 0; bj < 2; ++bj) { f32x4 v0 = acc[ai][bj][m][0], v1 = acc[ai][bj][m][1];
                    if (ACT == 1) {
#pragma unroll
                        for (int j = 0; j < 4; ++j) { const float a = fmaxf(v0[j], 0.f), b = fmaxf(v1[j], 0.f); v0[j] = a * a; v1[j] = b * b; } }
                    u32x4 w; w.x = cvt_pk_bf16(v0[0], v0[1]); w.y = cvt_pk_bf16(v0[2], v0[3]); w.z = cvt_pk_bf16(v1[0], v1[1]); w.w = cvt_pk_bf16(v1[2], v1[3]);
                    *(u32x4*)(rowp + bj * 128) = w; } }
    }
};
struct EpiGate3 {
    static constexpr bool PERM = true, AFTER_DRAIN = false, KHOOK = true;
    static constexpr int kh0 = 16, kh1 = 32;
    const bf16_t* gate; bf16_t* mbf; int ldg; int pad;
    __device__ __forceinline__ void khook(f32x4 (&acc)[2][2][4][2], const Unit& u, int t, int wr, int wc, int fr, int fq) const {
        typedef const __attribute__((address_space(1))) unsigned char* gptr;
        typedef const __attribute__((address_space(1))) u32x4* gvec;
        const gptr gb = (gptr)gate;
        int fr_ = fr, fq_ = fq; asm volatile("" : "+v"(fr_), "+v"(fq_));
        const int bn = (t == kh0) ? 0 : DM;
        const unsigned off0 = (unsigned)(((u.pm * 256 + wr * 64 + fr_) * NP + bn + u.pn * 256 + wc * 32 + 8 * fq_) * 2);
#pragma unroll
        for (int ai = 0; ai < 2; ++ai) {
            u32x4 nw[4][2], dw[4][2];
#pragma unroll
            for (int m = 0; m < 4; ++m)
#pragma unroll
                for (int bj = 0; bj < 2; ++bj) { const unsigned off = off0 + (unsigned)((ai * 128 + m * 16) * NP * 2 + bj * 256);
                    nw[m][bj] = *(gvec)(gb + off); dw[m][bj] = *(gvec)(gb + off + DM * 2); }
#pragma unroll
            for (int m = 0; m < 4; ++m)
#pragma unroll
                for (int bj = 0; bj < 2; ++bj) {
                    float r[8];
#pragma unroll
                    for (int j = 0; j < 4; ++j) { r[2 * j] = (1.0f + __expf(-bflo(dw[m][bj][j]))) * __builtin_amdgcn_rcpf(1.0f + __expf(-bflo(nw[m][bj][j])));
                                                  r[2 * j + 1] = (1.0f + __expf(-bfhi(dw[m][bj][j]))) * __builtin_amdgcn_rcpf(1.0f + __expf(-bfhi(nw[m][bj][j]))); }
                    acc[ai][bj][m][0] *= (f32x4){r[0], r[1], r[2], r[3]}; acc[ai][bj][m][1] *= (f32x4){r[4], r[5], r[6], r[7]}; }
            asm volatile("" ::: "memory");
        }
    }
    __device__ __forceinline__ void operator()(const f32x4 (&acc)[2][2][4][2], const Unit& u, int wr, int wc, int fr, int fq) const {
        const int row0 = u.pm * 256 + wr * 64 + fr, col0 = u.pn * 256 + wc * 32 + 8 * fq;
#pragma unroll
        for (int ai = 0; ai < 2; ++ai)
#pragma unroll
            for (int m = 0; m < 4; ++m) { const size_t row = (size_t)(row0 + ai * 128 + m * 16);
#pragma unroll
                for (int bj = 0; bj < 2; ++bj) { const int col = col0 + bj * 128;
                    const u32x4 gw = *(const u32x4*)(gate + row * ldg + 2 * DM + col);
                    f32x4 s0, s1;
                    s0[0] = sigmoidf_(bflo(gw.x)); s0[1] = sigmoidf_(bfhi(gw.x)); s0[2] = sigmoidf_(bflo(gw.y)); s0[3] = sigmoidf_(bfhi(gw.y));
                    s1[0] = sigmoidf_(bflo(gw.z)); s1[1] = sigmoidf_(bfhi(gw.z)); s1[2] = sigmoidf_(bflo(gw.w)); s1[3] = sigmoidf_(bfhi(gw.w));
                    const f32x4 v0 = acc[ai][bj][m][0] * s0, v1 = acc[ai][bj][m][1] * s1;
                    u32x4 w; w.x = cvt_pk_bf16(v0[0], v0[1]); w.y = cvt_pk_bf16(v0[2], v0[3]); w.z = cvt_pk_bf16(v1[0], v1[1]); w.w = cvt_pk_bf16(v1[2], v1[3]);
                    *(u32x4*)(mbf + row * DM + col) = w; } }
    }
};
struct EpiResid {
    static constexpr bool PERM = true, AFTER_DRAIN = false, KHOOK = false;
    const float* xin; float* xout; const float* gA; const float* gB;
    __device__ __forceinline__ void operator()(const f32x4 (&acc)[2][2][4][2], const Unit& u, int wr, int wc, int fr, int fq) const {
        const int row0 = u.pm * 256 + wr * 64 + fr, col0 = u.pn * 256 + wc * 32 + 8 * fq;
        const float* gv = (u.pm * 256 < 4096) ? gA : gB;
#pragma unroll
        for (int bj = 0; bj < 2; ++bj) { const int col = col0 + bj * 128; const f32x4 g0 = *(const f32x4*)(gv + col), g1 = *(const f32x4*)(gv + col + 4);
#pragma unroll
            for (int ai = 0; ai < 2; ++ai)
#pragma unroll
                for (int m = 0; m < 4; ++m) { const size_t o = (size_t)(row0 + ai * 128 + m * 16) * DM + col;
                    const f32x4 a0 = *(const f32x4*)(xin + o), a1 = *(const f32x4*)(xin + o + 4);
                    *(f32x4*)(xout + o) = a0 + g0 * acc[ai][bj][m][0]; *(f32x4*)(xout + o + 4) = a1 + g1 * acc[ai][bj][m][1]; } }
    }
};

struct GrpInfo { int grp, l, L, nseq, latent; };
DI GrpInfo grp_info(int grp, int l) { GrpInfo g; g.grp = grp; g.l = l; g.latent = grp > 0; g.L = grp ? 4096 : 256; g.nseq = grp ? 2 : 32; return g; }

template <bool WITH_OI> DI void phase_gla_post(const Params& p, GrpInfo gi, int bid, int nb) {
    const int tid = ltid(), lane = tid & 63, wid = tid >> 6;
    const bf16_t* P = (const bf16_t*)(lws(p) + OFF_P);
    const float* Of = (const float*)(lws(p) + OFF_OF); const float* Ob = (const float*)(lws(p) + OFF_OB); const float* Oi = (const float*)(lws(p) + OFF_OI);
    bf16_t* OA = (bf16_t*)(lws(p) + OFF_OABC);
    const int e0 = (lane & 15) * 16;
    f32x4 g[4];
#pragma unroll
    for (int i = 0; i < 4; ++i) g[i] = *(const f32x4*)(p.gla_norm_g + gi.l * 256 + e0 + 4 * i);
    for (int row = bid * 8 + wid; row < GT; row += nb * 8) {
        const size_t o = (size_t)row * 1024 + lane * 16;
        f32x4 v[4]; u32x4 gw[2];
#pragma unroll
        for (int i = 0; i < 4; ++i) { v[i] = *(const f32x4*)(Of + o + 4 * i) + *(const f32x4*)(Ob + o + 4 * i); if (WITH_OI) v[i] += *(const f32x4*)(Oi + o + 4 * i); }
#pragma unroll
        for (int i = 0; i < 2; ++i) gw[i] = *(const u32x4*)(P + (size_t)row * NP + C_GG + lane * 16 + 8 * i);
        float ss = 0.f;
#pragma unroll
        for (int i = 0; i < 4; ++i) ss += v[i][0] * v[i][0] + v[i][1] * v[i][1] + v[i][2] * v[i][2] + v[i][3] * v[i][3];
#pragma unroll
        for (int x = 8; x >= 1; x >>= 1) ss += __int_as_float(__builtin_amdgcn_ds_bpermute((lane ^ x) << 2, __float_as_int(ss)));
        const float rs = rsqrtf(ss * (1.0f / 256) + EPS);
        u32x4 w[2];
#pragma unroll
        for (int i = 0; i < 4; ++i) {
            const unsigned ga = gw[i >> 1][2 * (i & 1)], gb = gw[i >> 1][2 * (i & 1) + 1];
            const float g0 = bflo(ga), g1 = bfhi(ga), g2 = bflo(gb), g3 = bfhi(gb);
            w[i >> 1][2 * (i & 1)] = pk2(v[i][0] * rs * g[i][0] * (g0 * sigmoidf_(g0)), v[i][1] * rs * g[i][1] * (g1 * sigmoidf_(g1)));
            w[i >> 1][2 * (i & 1) + 1] = pk2(v[i][2] * rs * g[i][2] * (g2 * sigmoidf_(g2)), v[i][3] * rs * g[i][3] * (g3 * sigmoidf_(g3)));
        }
        bf16_t* oa = OA + (size_t)row * 3072 + lane * 16;
        *(u32x4*)oa = w[0]; *(u32x4*)(oa + 8) = w[1];
    }
}
typedef short bf16x8 __attribute__((ext_vector_type(8)));
typedef short bf16x4 __attribute__((ext_vector_type(4)));
#define MFMA16(a, b, c) __builtin_amdgcn_mfma_f32_16x16x32_bf16((a), (b), (c), 0, 0, 0)
constexpr int QKP = 136;
constexpr int TP = 80;
DI float log_sigmoid_fast(float x) { return fminf(x, 0.f) - __logf(1.0f + __expf(-fabsf(x))); }
DI bf16x8 pack8(const f32x4& a, const f32x4& b) { u32x4 w; w.x = pk2(a[0], a[1]); w.y = pk2(a[2], a[3]); w.z = pk2(b[0], b[1]); w.w = pk2(b[2], b[3]); return __builtin_bit_cast(bf16x8, w); }

DI void gla_prep_unit(const Params& p, const GrpInfo gi, int unit, int tid_in) {
    int tid = tid_in; asm volatile("" : "+v"(tid));
    const int cg = unit >> 2, h = unit & 3, row0 = cg * 64, t0 = row0 & (gi.L - 1), l = gi.l;
    const int lane = tid & 63, wid = tid >> 6, r16 = lane & 15, q4 = lane >> 4;
    float* laf = (float*)smem; float* lab = laf + 8192;
    bf16_t* QFs = (bf16_t*)(smem + 65536); bf16_t* KFs = QFs + 64 * QKP; bf16_t* QBs = KFs + 64 * QKP; bf16_t* KBs = QBs + 64 * QKP;
    bf16_t* VTs = (bf16_t*)smem; bf16_t* As = (bf16_t*)(smem + 40960);
    const bf16_t* P = (const bf16_t*)(lws(p) + OFF_P);
    u32x4 pq[4], pvv[4];
    { const int t = tid >> 3, dlo = (tid & 7) * 8; const bf16_t* pr = P + (size_t)(row0 + t) * NP + h * 128;
      pq[0] = *(const u32x4*)(pr + C_GQ + dlo); pq[1] = *(const u32x4*)(pr + C_GQ + 64 + dlo); pq[2] = *(const u32x4*)(pr + C_GK + dlo); pq[3] = *(const u32x4*)(pr + C_GK + 64 + dlo);
      const bf16_t* pv = P + (size_t)(row0 + t) * NP + C_GV + h * 256 + (tid & 7) * 32;
#pragma unroll
      for (int i = 0; i < 4; ++i) pvv[i] = *(const u32x4*)(pv + 8 * i); }
    bf16_t* laT = (bf16_t*)(smem + 65536);
    __syncthreads();
    {
        const int dir = wid >> 2;
        const bf16_t* wt = (const bf16_t*)(lws(p) + OFF_WA2T) + ((((size_t)l * 2 + dir) * 4 + h) * 128) * 16;
        bf16x8 bfr[2]; float bav[2];
#pragma unroll
        for (int n = 0; n < 2; ++n) { const int d = 16 * (2 * (wid & 3) + n) + r16;
            const u32x4 w = ((q4 >> 1) == dir) ? *(const u32x4*)(wt + (size_t)d * 16 + 8 * (q4 & 1)) : (u32x4){0u, 0u, 0u, 0u};
            bfr[n] = __builtin_bit_cast(bf16x8, w); bav[n] = p.gla_ba2[((size_t)l * 2 + dir) * 512 + h * 128 + d]; }
#pragma unroll
        for (int mt = 0; mt < 4; ++mt) {
            const bf16x8 af = *(const bf16x8*)(P + (size_t)(row0 + 16 * mt + r16) * NP + C_GA + 8 * q4);
#pragma unroll
            for (int n = 0; n < 2; ++n) { const int d = 16 * (2 * (wid & 3) + n) + r16;
                const f32x4 x = MFMA16(af, bfr[n], ((f32x4){0.f, 0.f, 0.f, 0.f}));
                u32x2 w; w.x = pk2(log_sigmoid_fast(x[0] + bav[n]) * 0.0625f, log_sigmoid_fast(x[1] + bav[n]) * 0.0625f); w.y = pk2(log_sigmoid_fast(x[2] + bav[n]) * 0.0625f, log_sigmoid_fast(x[3] + bav[n]) * 0.0625f);
                *(u32x2*)(laT + ((size_t)(dir * 128 + d)) * TP + 16 * mt + 4 * q4) = w; }
        }
    }
    __syncthreads();
    {
        const int dir = wid >> 2;
        float* bdst = dir ? lab : laf;
#pragma unroll
        for (int n = 0; n < 2; ++n) { const int d = 16 * (2 * (wid & 3) + n) + r16;
            bf16x8 bl[2];
#pragma unroll
            for (int ks = 0; ks < 2; ++ks) bl[ks] = *(const bf16x8*)(laT + ((size_t)(dir * 128 + d)) * TP + 32 * ks + 8 * q4);
#pragma unroll
            for (int mt = 0; mt < 4; ++mt) { f32x4 acc = (f32x4){0.f, 0.f, 0.f, 0.f};
#pragma unroll
                for (int ks = 0; ks < 2; ++ks) { const int t = 16 * mt + r16; bf16x8 tri;
#pragma unroll
                    for (int j = 0; j < 8; ++j) { const int s2 = 32 * ks + 8 * q4 + j; tri[j] = (short)((dir ? (s2 >= t) : (s2 <= t)) ? 0x3F80 : 0); }
                    acc = MFMA16(tri, bl[ks], acc); }
#pragma unroll
                for (int i = 0; i < 4; ++i) bdst[(16 * mt + 4 * q4 + i) * 128 + d] = acc[i]; }
        }
    }
    __syncthreads();
    {
        const int t = tid >> 3, dlo = (tid & 7) * 8, ta = t0 + t;
        const u32x4 qlw = pq[0], qhw = pq[1], klw = pq[2], khw = pq[3];
        float ql[8], qh[8], kl[8], kh[8];
#pragma unroll
        for (int j = 0; j < 4; ++j) { ql[2 * j] = bflo(qlw[j]); ql[2 * j + 1] = bfhi(qlw[j]); qh[2 * j] = bflo(qhw[j]); qh[2 * j + 1] = bfhi(qhw[j]); kl[2 * j] = bflo(klw[j]); kl[2 * j + 1] = bfhi(klw[j]); kh[2 * j] = bflo(khw[j]); kh[2 * j + 1] = bfhi(khw[j]); }
#pragma unroll
        for (int j = 0; j < 8; ++j) {
            ql[j] *= 0.08838834764831845f; qh[j] *= 0.08838834764831845f;
            if (gi.latent) {
                const int ii = dlo + j, f = ii & 31; const float pos = (float)(ii < 32 ? (ta >> 6) : (ta & 63));
                const float ang = pos * exp2f(-(float)f * 0.41524101186092029f); const float sn = __sinf(ang), cs = __cosf(ang);
                const float a = ql[j] * cs - qh[j] * sn, b = ql[j] * sn + qh[j] * cs; ql[j] = a; qh[j] = b;
                const float c = kl[j] * cs - kh[j] * sn, e = kl[j] * sn + kh[j] * cs; kl[j] = c; kh[j] = e;
            }
        }
        float* DEC = (float*)(lws(p) + OFF_DEC);
#pragma unroll
        for (int dir = 0; dir < 2; ++dir) {
            const float* bb = dir ? lab : laf;
            bf16_t* Qs = dir ? QBs : QFs; bf16_t* Ks = dir ? KBs : KFs;
            bf16_t* Qg = (bf16_t*)(lws(p) + (dir ? OFF_QB : OFF_QF)) + (size_t)(row0 + t) * 512 + h * 128;
#pragma unroll
            for (int half = 0; half < 2; ++half) {
                const int d = dlo + 64 * half;
                const f32x4 b0 = *(const f32x4*)(bb + t * 128 + d), b1 = *(const f32x4*)(bb + t * 128 + d + 4);
                float qo[8], ko[8];
#pragma unroll
                for (int j = 0; j < 8; ++j) { const float bv = j < 4 ? b0[j] : b1[j - 4]; const float qv = half ? qh[j] : ql[j], kv = half ? kh[j] : kl[j]; qo[j] = qv * __expf(bv); ko[j] = kv * __expf(-bv); }
                u32x4 qw, kw; qw.x = pk2(qo[0], qo[1]); qw.y = pk2(qo[2], qo[3]); qw.z = pk2(qo[4], qo[5]); qw.w = pk2(qo[6], qo[7]);
                kw.x = pk2(ko[0], ko[1]); kw.y = pk2(ko[2], ko[3]); kw.z = pk2(ko[4], ko[5]); kw.w = pk2(ko[6], ko[7]);
                *(u32x4*)(Qs + t * QKP + d) = qw; *(u32x4*)(Ks + t * QKP + d) = kw; *(u32x4*)(Qg + d) = qw;
                if (t == 0) { const int te = dir ? 0 : 63; const f32x4 e0 = *(const f32x4*)(bb + te * 128 + d), e1 = *(const f32x4*)(bb + te * 128 + d + 4);
                    f32x4 x0, x1;
#pragma unroll
                    for (int j = 0; j < 4; ++j) { x0[j] = __expf(e0[j]); x1[j] = __expf(e1[j]); }
                    float* dp = DEC + ((size_t)dir * 128 + cg) * 512 + h * 128 + d; *(f32x4*)dp = x0; *(f32x4*)(dp + 4) = x1; }
            }
        }
    }
    __syncthreads();
    {
        const int s = tid >> 3, e0 = (tid & 7) * 32;
#pragma unroll
        for (int i = 0; i < 4; ++i) { const u32x4 w = pvv[i];
#pragma unroll
            for (int j = 0; j < 4; ++j) { VTs[(e0 + 8 * i + 2 * j) * TP + s] = (bf16_t)(w[j] & 0xffffu); VTs[(e0 + 8 * i + 2 * j + 1) * TP + s] = (bf16_t)(w[j] >> 16); } }
        const int mt = wid >> 1, nt0 = 2 * (wid & 1);
        f32x4 acc[2][2];
#pragma unroll
        for (int dir = 0; dir < 2; ++dir) { const bf16_t* Qs = dir ? QBs : QFs; const bf16_t* Ks = dir ? KBs : KFs;
#pragma unroll
            for (int n = 0; n < 2; ++n) acc[dir][n] = (f32x4){0.f, 0.f, 0.f, 0.f};
#pragma unroll
            for (int ks = 0; ks < 4; ++ks) { const bf16x8 a = *(const bf16x8*)(Qs + (16 * mt + r16) * QKP + 32 * ks + 8 * q4);
#pragma unroll
                for (int n = 0; n < 2; ++n) { const bf16x8 b = *(const bf16x8*)(Ks + (16 * (nt0 + n) + r16) * QKP + 32 * ks + 8 * q4); acc[dir][n] = MFMA16(a, b, acc[dir][n]); } } }
#pragma unroll
        for (int n = 0; n < 2; ++n)
#pragma unroll
            for (int i = 0; i < 4; ++i) { const int t = 16 * mt + 4 * q4 + i, s2 = 16 * (nt0 + n) + r16;
                const float v = (s2 <= t ? acc[0][n][i] : 0.f) + (s2 >= t ? acc[1][n][i] : 0.f); As[t * TP + s2] = f2bf(v); }
        const int d = tid >> 2, sq = tid & 3;
#pragma unroll
        for (int dir = 0; dir < 2; ++dir) { const bf16_t* Ks = dir ? KBs : KFs; unsigned w[8];
#pragma unroll
            for (int j = 0; j < 8; ++j) w[j] = (unsigned)Ks[(sq * 16 + 2 * j) * QKP + d] | ((unsigned)Ks[(sq * 16 + 2 * j + 1) * QKP + d] << 16);
            bf16_t* kg = (bf16_t*)(lws(p) + (dir ? OFF_KBT : OFF_KFT)) + (((size_t)cg * 4 + h) * 128 + d) * 64 + sq * 16;
            *(u32x4*)kg = (u32x4){w[0], w[1], w[2], w[3]}; *(u32x4*)(kg + 8) = (u32x4){w[4], w[5], w[6], w[7]}; }
    }
    __syncthreads();
    {
        const int e = tid >> 1, hf = tid & 1;
        bf16_t* vg = (bf16_t*)(lws(p) + OFF_VT) + (((size_t)cg * 4 + h) * 256 + e) * 64 + hf * 32;
#pragma unroll
        for (int i = 0; i < 4; ++i) *(u32x4*)(vg + 8 * i) = *(const u32x4*)(VTs + e * TP + hf * 32 + 8 * i);
        float* OI = (float*)(lws(p) + OFF_OI);
#pragma unroll
        for (int n = 0; n < 2; ++n) { const int nt = 2 * wid + n;
            bf16x8 b[2];
#pragma unroll
            for (int ks = 0; ks < 2; ++ks) b[ks] = *(const bf16x8*)(VTs + (16 * nt + r16) * TP + 32 * ks + 8 * q4);
#pragma unroll
            for (int mt = 0; mt < 4; ++mt) { f32x4 acc = (f32x4){0.f, 0.f, 0.f, 0.f};
#pragma unroll
                for (int ks = 0; ks < 2; ++ks) { const bf16x8 a = *(const bf16x8*)(As + (16 * mt + r16) * TP + 32 * ks + 8 * q4); acc = MFMA16(a, b[ks], acc); }
#pragma unroll
                for (int i = 0; i < 4; ++i) OI[(size_t)(row0 + 16 * mt + 4 * q4 + i) * 1024 + h * 256 + 16 * nt + r16] = acc[i]; } }
    }
}
DI void phase_gla_prep(const Params& p, const GrpInfo gi, int bid, int nb) {
    const int tid = ltid();
    for (int u = bid; u < 512; u += nb) gla_prep_unit(p, gi, u, tid);
}

constexpr int SC_Q = 0, SC_K = 64 * QKP * 2, SC_V = SC_K + 128 * TP * 2, SC_D = SC_V + 128 * TP * 2, SC_BUF = SC_D + 512;
DI void gla_scan_unit(const Params& p, const GrpInfo gi, int unit, int tid_in) {
    int tid = tid_in; asm volatile("" : "+v"(tid));
    const int sl = unit >> 4, h = (unit >> 2) & 3, dir = (unit >> 1) & 1, eh = unit & 1, L = gi.L, NC = L >> 6, l = gi.l;
    const int lane = tid & 63, wid = tid >> 6, r16 = lane & 15, q4 = lane >> 4;
    const int ecol = eh * 128 + 16 * wid + r16;
    f32x4 S[8];
    if (gi.latent) { const int bs = 2 * (gi.grp - 1) + sl; const float* s0 = p.state_gla + ((((size_t)bs * DEPTH + l) * 2 + dir) * 4 + h) * 128 * 256 + ecol;
#pragma unroll
        for (int T = 0; T < 8; ++T)
#pragma unroll
            for (int i = 0; i < 4; ++i) S[T][i] = s0[(size_t)(16 * T + 4 * q4 + i) * 256]; }
    else {
#pragma unroll
        for (int T = 0; T < 8; ++T) S[T] = (f32x4){0.f, 0.f, 0.f, 0.f}; }
    const bf16_t* Qg = (const bf16_t*)(lws(p) + (dir ? OFF_QB : OFF_QF)); const bf16_t* Kg = (const bf16_t*)(lws(p) + (dir ? OFF_KBT : OFF_KFT)); const bf16_t* Vg = (const bf16_t*)(lws(p) + OFF_VT);
    const float* Dg = (const float*)(lws(p) + OFF_DEC) + (size_t)dir * 128 * 512;
    float* Og = (float*)(lws(p) + (dir ? OFF_OB : OFF_OF));
    u32x4 rq[2], rk[2], rv[2]; float rd = 0.f;
    const int qt0 = tid >> 4, qd = (tid & 15) * 8;
    const int kd0 = tid >> 3, ks8 = (tid & 7) * 8;
#define GLA_LOAD(c) do { const int cg_ = sl * NC + (c); const size_t r0_ = (size_t)cg_ * 64; \
        rq[0] = *(const u32x4*)(Qg + (r0_ + qt0) * 512 + h * 128 + qd); rq[1] = *(const u32x4*)(Qg + (r0_ + qt0 + 32) * 512 + h * 128 + qd); \
        rk[0] = *(const u32x4*)(Kg + (((size_t)cg_ * 4 + h) * 128 + kd0) * 64 + ks8); rk[1] = *(const u32x4*)(Kg + (((size_t)cg_ * 4 + h) * 128 + kd0 + 64) * 64 + ks8); \
        rv[0] = *(const u32x4*)(Vg + (((size_t)cg_ * 4 + h) * 256 + eh * 128 + kd0) * 64 + ks8); rv[1] = *(const u32x4*)(Vg + (((size_t)cg_ * 4 + h) * 256 + eh * 128 + kd0 + 64) * 64 + ks8); \
        if (tid < 128) rd = Dg[(size_t)cg_ * 512 + h * 128 + tid]; } while (0)
#define GLA_STORE(bufp) do { unsigned char* b_ = (bufp); \
        *(u32x4*)(b_ + SC_Q + (qt0 * QKP + qd) * 2) = rq[0]; *(u32x4*)(b_ + SC_Q + ((qt0 + 32) * QKP + qd) * 2) = rq[1]; \
        *(u32x4*)(b_ + SC_K + (kd0 * TP + ks8) * 2) = rk[0]; *(u32x4*)(b_ + SC_K + ((kd0 + 64) * TP + ks8) * 2) = rk[1]; \
        *(u32x4*)(b_ + SC_V + (kd0 * TP + ks8) * 2) = rv[0]; *(u32x4*)(b_ + SC_V + ((kd0 + 64) * TP + ks8) * 2) = rv[1]; \
        if (tid < 128) *(float*)(b_ + SC_D + tid * 4) = rd; } while (0)
    __syncthreads();
    GLA_LOAD(dir ? NC - 1 : 0);
    GLA_STORE(smem);
    __syncthreads();
    for (int ci = 0; ci < NC; ++ci) {
        const int c = dir ? NC - 1 - ci : ci;
        if (ci + 1 < NC) GLA_LOAD(dir ? c - 1 : c + 1);
        const unsigned char* buf = smem + (ci & 1) * SC_BUF;
        const bf16_t* Qs = (const bf16_t*)(buf + SC_Q); const bf16_t* Kt = (const bf16_t*)(buf + SC_K); const bf16_t* Vt = (const bf16_t*)(buf + SC_V); const float* Dv = (const float*)(buf + SC_D);
        bf16x8 bS[4];
#pragma unroll
        for (int ks = 0; ks < 4; ++ks) bS[ks] = pack8(S[2 * ks], S[2 * ks + 1]);
        const size_t orow0 = ((size_t)(sl * NC + c) * 64);
#pragma unroll
        for (int mt = 0; mt < 4; ++mt) { f32x4 acc = (f32x4){0.f, 0.f, 0.f, 0.f};
#pragma unroll
            for (int ks = 0; ks < 4; ++ks) { const bf16_t* qp = Qs + (16 * mt + r16) * QKP + 32 * ks + 4 * q4;
                const bf16x4 a0 = *(const bf16x4*)qp, a1 = *(const bf16x4*)(qp + 16);
                const bf16x8 a = (bf16x8){a0[0], a0[1], a0[2], a0[3], a1[0], a1[1], a1[2], a1[3]};
                acc = MFMA16(a, bS[ks], acc); }
#pragma unroll
            for (int i = 0; i < 4; ++i) Og[(orow0 + 16 * mt + 4 * q4 + i) * 1024 + h * 256 + ecol] = acc[i]; }
        bf16x8 bv[2];
#pragma unroll
        for (int ks = 0; ks < 2; ++ks) bv[ks] = *(const bf16x8*)(Vt + (16 * wid + r16) * TP + 32 * ks + 8 * q4);
#pragma unroll
        for (int T = 0; T < 8; ++T) {
#pragma unroll
            for (int ks = 0; ks < 2; ++ks) { const bf16x8 a = *(const bf16x8*)(Kt + (16 * T + r16) * TP + 32 * ks + 8 * q4); S[T] = MFMA16(a, bv[ks], S[T]); }
            const f32x4 dv = *(const f32x4*)(Dv + 16 * T + 4 * q4); S[T] *= dv; }
        if (ci + 1 < NC) GLA_STORE(smem + ((ci + 1) & 1) * SC_BUF);
        __syncthreads();
    }
#undef GLA_LOAD
#undef GLA_STORE
    if (!gi.latent) { float* so = lout(p) + OUT_ST + ((((size_t)sl * DEPTH + l) * 2 + dir) * 4 + h) * 128 * 256 + ecol;
#pragma unroll
        for (int T = 0; T < 8; ++T)
#pragma unroll
            for (int i = 0; i < 4; ++i) so[(size_t)(16 * T + 4 * q4 + i) * 256] = S[T][i]; }
}
DI void phase_gla_scan(const Params& p, const GrpInfo gi, int bid, int nb) {
    const int tid = ltid();
    for (int u = bid; u < gi.nseq * 16; u += nb) gla_scan_unit(p, gi, u, tid);
}
typedef float f32x16 __attribute__((ext_vector_type(16)));
#define MFMA32(a, b, c) __builtin_amdgcn_mfma_f32_32x32x16_bf16((a), (b), (c), 0, 0, 0)

DI void phase_hy_prep(const Params& p, const GrpInfo gi, int bid, int nb) {
    const int tid = ltid(), L = gi.L;
    bf16_t* T = (bf16_t*)smem;
    const bf16_t* P = (const bf16_t*)(lws(p) + OFF_P);
    bf16_t* UcT = (bf16_t*)(lws(p) + OFF_UCT);
    const float* cw = p.hy_conv_w + (size_t)gi.l * 3 * 3072; const float* cb = p.hy_conv_b + (size_t)gi.l * 3072;
    for (int u = bid; u < 128 * 12; u += nb) {
        const int rt = u / 12, ct = u % 12, row0 = rt * 64, j0 = ct * 256;
        const int t = tid >> 3, js = tid & 7, row = row0 + t, tpos = row & (L - 1);
        const u32x4 z4 = (u32x4){0u, 0u, 0u, 0u};
        u32x4 um[4], u0[4], up[4];
#pragma unroll
        for (int q4 = 0; q4 < 4; ++q4) { const bf16_t* pr = P + (size_t)row * NP + C_HY + j0 + 64 * q4 + js * 8;
            um[q4] = tpos > 0 ? *(const u32x4*)(pr - NP) : z4; u0[q4] = *(const u32x4*)pr; up[q4] = tpos < L - 1 ? *(const u32x4*)(pr + NP) : z4; }
        __syncthreads();
#pragma unroll
        for (int q4 = 0; q4 < 4; ++q4) { const int j = j0 + 64 * q4 + js * 8;
            const f32x4 b0 = *(const f32x4*)(cb + j), b1 = *(const f32x4*)(cb + j + 4), wa0 = *(const f32x4*)(cw + j), wa1 = *(const f32x4*)(cw + j + 4),
                        wb0 = *(const f32x4*)(cw + 3072 + j), wb1 = *(const f32x4*)(cw + 3072 + j + 4), wc0 = *(const f32x4*)(cw + 6144 + j), wc1 = *(const f32x4*)(cw + 6144 + j + 4);
#pragma unroll
            for (int q = 0; q < 4; ++q) {
                const float ba = q < 2 ? b0[2 * q] : b1[2 * q - 4], bb = q < 2 ? b0[2 * q + 1] : b1[2 * q - 3];
                const float a0 = q < 2 ? wa0[2 * q] : wa1[2 * q - 4], a1 = q < 2 ? wa0[2 * q + 1] : wa1[2 * q - 3];
                const float c0 = q < 2 ? wb0[2 * q] : wb1[2 * q - 4], c1 = q < 2 ? wb0[2 * q + 1] : wb1[2 * q - 3];
                const float e0 = q < 2 ? wc0[2 * q] : wc1[2 * q - 4], e1 = q < 2 ? wc0[2 * q + 1] : wc1[2 * q - 3];
                const float o0 = ba + a0 * bflo(um[q4][q]) + c0 * bflo(u0[q4][q]) + e0 * bflo(up[q4][q]);
                const float o1 = bb + a1 * bfhi(um[q4][q]) + c1 * bfhi(u0[q4][q]) + e1 * bfhi(up[q4][q]);
                T[(64 * q4 + js * 8 + 2 * q) * TP + t] = f2bf(o0); T[(64 * q4 + js * 8 + 2 * q + 1) * TP + t] = f2bf(o1);
            }
        }
        __syncthreads();
#pragma unroll
        for (int q4 = 0; q4 < 4; ++q4) { const int jj = 64 * q4 + (tid >> 3), ts = tid & 7;
            *(u32x4*)(UcT + (size_t)(j0 + jj) * GT + row0 + ts * 8) = *(const u32x4*)(T + jj * TP + ts * 8); }
    }
}
DI void phase_hy_post(const Params& p, const GrpInfo gi, int bid, int nb) {
    const int tid = ltid();
    bf16_t* T = (bf16_t*)smem;
    constexpr int PT = 264;
    const bf16_t* OcT = (const bf16_t*)(lws(p) + OFF_OCT);
    bf16_t* OC = (bf16_t*)(lws(p) + OFF_OABC) + 2048;
    for (int u = bid; u < 128 * 4; u += nb) {
        const int rt = u >> 2, ct = u & 3, row0 = rt * 64, c0 = ct * 256;
        const int cl = tid >> 3, ts = tid & 7;
        u32x4 w[4];
#pragma unroll
        for (int q4 = 0; q4 < 4; ++q4) w[q4] = *(const u32x4*)(OcT + (size_t)(c0 + 64 * q4 + cl) * GT + row0 + ts * 8);
        __syncthreads();
#pragma unroll
        for (int q4 = 0; q4 < 4; ++q4)
#pragma unroll
            for (int q = 0; q < 4; ++q) { T[(ts * 8 + 2 * q) * PT + 64 * q4 + cl] = (bf16_t)(w[q4][q] & 0xffffu); T[(ts * 8 + 2 * q + 1) * PT + 64 * q4 + cl] = (bf16_t)(w[q4][q] >> 16); }
        __syncthreads();
        const int t = tid >> 3, cs = tid & 7;
#pragma unroll
        for (int q4 = 0; q4 < 4; ++q4) *(u32x4*)(OC + (size_t)(row0 + t) * 3072 + c0 + 64 * q4 + cs * 8) = *(const u32x4*)(T + t * PT + 64 * q4 + cs * 8);
    }
}

constexpr int HY_HF = 0;
constexpr int HY_Z = 16384;
constexpr int HY_ZERO = HY_Z + 20480;
constexpr int HY_HC = HY_ZERO + 64;
DI int hy_pitch(int L) { return (L + 224) * 2; }
DI int hy_zoff(int s) { return (s >> 5) * 80 + (s & 31) * 2; }
DI void hy_build_copies(int L, int tid) {
    const unsigned* fr = (const unsigned*)(smem + HY_HF);
    const int nch = (L + 224) / 8, pitch = hy_pitch(L), e = __builtin_amdgcn_readfirstlane(tid >> 6), lane = tid & 63, sh = (e & 1) * 16;
    for (int ch = lane; ch < nch; ch += 64) {
        const unsigned* d = fr + ((8 * ch + e) >> 1);
        const unsigned d0 = d[0], d1 = d[1], d2 = d[2], d3 = d[3], d4 = d[4];
        u32x4 w; w.x = __builtin_amdgcn_alignbit(d1, d0, sh); w.y = __builtin_amdgcn_alignbit(d2, d1, sh); w.z = __builtin_amdgcn_alignbit(d3, d2, sh); w.w = __builtin_amdgcn_alignbit(d4, d3, sh);
        *(u32x4*)(smem + HY_HC + e * pitch + ch * 16) = w;
    }
}
DI f32x16 hy_conv(int L, int lane, int tb_row0  , int t0, int trip_lo, int trip_hi) {
    const int m = lane & 31, kh = lane >> 5, e = (7 - (m & 7)) & 7, pitch = hy_pitch(L);
    const int NTRIP = (L / 16 + 2 + 6) / 8;
    int delta = -(L / 2) - 16 - 48 + 128 * trip_lo;
    int aoff = HY_HC + e * pitch + (L / 2 - 1 - delta - m + 8 * kh - e + 88) * 2;
    f32x16 acc[4];
#pragma unroll
    for (int c = 0; c < 4; ++c)
#pragma unroll
        for (int i = 0; i < 16; ++i) acc[c][i] = 0.f;
#define HY_LDB(dlt) ({ const int s0_ = t0 - (dlt); const bool inr_ = (unsigned)s0_ <= (unsigned)(L - 16); \
        const int zo_ = inr_ ? HY_Z + hy_zoff(tb_row0 - (dlt)) + 16 * kh : HY_ZERO; *(const bf16x8*)(smem + zo_); })
    bf16x8 a0[4], b0[4], a1[4], b1[4];
#pragma unroll
    for (int j = 0; j < 4; ++j) { a0[j] = *(const bf16x8*)(smem + aoff - 32 * j); b0[j] = HY_LDB(delta + 16 * j); a1[j] = *(const bf16x8*)(smem + aoff - 32 * (j + 4)); b1[j] = HY_LDB(delta + 16 * (j + 4)); }
    (void)NTRIP;
    for (int trip = trip_lo; trip < trip_hi; ++trip) {
        delta += 128; aoff -= 256;
#pragma unroll
        for (int j = 0; j < 4; ++j) acc[j] = MFMA32(a0[j], b0[j], acc[j]);
#pragma unroll
        for (int j = 0; j < 4; ++j) { a0[j] = *(const bf16x8*)(smem + aoff - 32 * j); b0[j] = HY_LDB(delta + 16 * j); }
#pragma unroll
        for (int j = 0; j < 4; ++j) acc[j] = MFMA32(a1[j], b1[j], acc[j]);
#pragma unroll
        for (int j = 0; j < 4; ++j) { a1[j] = *(const bf16x8*)(smem + aoff - 32 * (j + 4)); b1[j] = HY_LDB(delta + 16 * (j + 4)); }
    }
#undef HY_LDB
    return (acc[0] + acc[1]) + (acc[2] + acc[3]);
}
DI void hy_conv_unit(const Params& p, const GrpInfo gi, int c, int tid_in) {
    int tid = tid_in; asm volatile("" : "+v"(tid));
    const int L = gi.L, lane = tid & 63, wid = __builtin_amdgcn_readfirstlane(tid >> 6), n = lane & 31, hi = lane >> 5, LF = L + 232;
    const int g = 32 * wid + n, tpl = L >> 5, b = g / tpl, t0 = (g % tpl) * 32, frow = b * L + t0;
    const bf16_t* UcT = (const bf16_t*)(lws(p) + OFF_UCT);
    bf16_t* OcT = (bf16_t*)(lws(p) + OFF_OCT);
    const bf16_t* f0 = filt_ptr(lws(p), gi.l, gi.latent ? 1 : 0) + (size_t)c * LF;
    const bf16_t* f1 = f0 + (size_t)1024 * LF;
    int trip_lo = 0, trip_hi = (L / 16 + 8) / 8;
    if (L == 4096) { const int T0 = (wid & 3) * 1024; const int slo = (T0 - L / 2 + 80) / 16, shi = (T0 + L / 2 + 1056) / 16; trip_lo = slo > 0 ? slo / 8 : 0; trip_hi = min(trip_hi, shi / 8 + 1); }
    const int npc = LF / 8;
    __syncthreads();
    u32x4 f1r[2];
    {
        const bf16_t* zg = UcT + (size_t)(2048 + c) * GT;
#pragma unroll
        for (int i = 0; i < 2; ++i) { const int s = (tid + 512 * i) * 8; *(u32x4*)(smem + HY_Z + hy_zoff(s)) = *(const u32x4*)(zg + s); }
        if (tid < 4) *(unsigned*)(smem + HY_ZERO + 4 * tid) = 0u;
#pragma unroll
        for (int i = 0; i < 2; ++i) { const int pc = tid + 512 * i; if (pc < npc) { *(u32x4*)(smem + HY_HF + pc * 16) = *(const u32x4*)(f0 + pc * 8); f1r[i] = *(const u32x4*)(f1 + pc * 8); } }
    }
    u32x2 x1w[4], x2w[4];
#pragma unroll
    for (int gq = 0; gq < 4; ++gq) { const int fr = frow + 8 * gq + 4 * hi; x1w[gq] = *(const u32x2*)(UcT + (size_t)c * GT + fr); x2w[gq] = *(const u32x2*)(UcT + (size_t)(1024 + c) * GT + fr); }
    const float bias0 = p.hy_bias[((size_t)gi.l * 2 + 0) * 1024 + c], bias1 = p.hy_bias[((size_t)gi.l * 2 + 1) * 1024 + c];
    __syncthreads();
    hy_build_copies(L, tid);
    __syncthreads();
    f32x16 acc = hy_conv(L, lane, frow, t0, trip_lo, trip_hi);
    u32x2 z1w[4];
#pragma unroll
    for (int gq = 0; gq < 4; ++gq) {
        const int fr = frow + 8 * gq + 4 * hi;
        const u32x2 xw = x1w[gq];
        const u32x2 zw = *(const u32x2*)(smem + HY_Z + hy_zoff(fr));
        const float o0 = bflo(xw.x) * (acc[4 * gq] + bias0 * bflo(zw.x)), o1 = bfhi(xw.x) * (acc[4 * gq + 1] + bias0 * bfhi(zw.x));
        const float o2 = bflo(xw.y) * (acc[4 * gq + 2] + bias0 * bflo(zw.y)), o3 = bfhi(xw.y) * (acc[4 * gq + 3] + bias0 * bfhi(zw.y));
        z1w[gq].x = pk2(o0, o1); z1w[gq].y = pk2(o2, o3);
    }
    __syncthreads();
#pragma unroll
    for (int gq = 0; gq < 4; ++gq) *(u32x2*)(smem + HY_Z + hy_zoff(frow + 8 * gq + 4 * hi)) = z1w[gq];
#pragma unroll
    for (int i = 0; i < 2; ++i) { const int pc = tid + 512 * i; if (pc < npc) *(u32x4*)(smem + HY_HF + pc * 16) = f1r[i]; }
    __syncthreads();
    hy_build_copies(L, tid);
    __syncthreads();
    acc = hy_conv(L, lane, frow, t0, trip_lo, trip_hi);
#pragma unroll
    for (int gq = 0; gq < 4; ++gq) {
        const int fr = frow + 8 * gq + 4 * hi;
        const u32x2 xw = x2w[gq];
        const float o0 = bflo(xw.x) * (acc[4 * gq] + bias1 * bflo(z1w[gq].x)), o1 = bfhi(xw.x) * (acc[4 * gq + 1] + bias1 * bfhi(z1w[gq].x));
        const float o2 = bflo(xw.y) * (acc[4 * gq + 2] + bias1 * bflo(z1w[gq].y)), o3 = bfhi(xw.y) * (acc[4 * gq + 3] + bias1 * bfhi(z1w[gq].y));
        u32x2 w; w.x = pk2(o0, o1); w.y = pk2(o2, o3);
        *(u32x2*)(OcT + (size_t)c * GT + fr) = w;
    }
}
DI void phase_hy_conv(const Params& p, const GrpInfo gi, int bid, int nb) {
    const int tid = ltid();
    for (int c = bid; c < 1024; c += nb) hy_conv_unit(p, gi, c, tid);
}
constexpr float NA_QSCALE = 0.12751743074602468f;
constexpr float LOG2E = 1.4426950408889634f;

DI void phase_cache_cvt(const Params& p, int bid, int nb) {
    const int tid = ltid();
    bf16_t* T = (bf16_t*)smem;
    bf16_t* CK = (bf16_t*)(lws(p) + OFF_CK); bf16_t* CVT = (bf16_t*)(lws(p) + OFF_CVT);
    for (int u = bid; u < 8 * 2 * 8 * 4; u += nb) {
        const int bh = u >> 2, k0 = (u & 3) * 64;
        const int key = tid >> 3, ds = (tid & 7) * 16;
        const size_t src = ((size_t)bh * 256 + k0 + key) * 128 + ds;
        f32x4 kv[4], vv[4];
#pragma unroll
        for (int i = 0; i < 4; ++i) { kv[i] = *(const f32x4*)(p.cache_k + src + 4 * i); vv[i] = *(const f32x4*)(p.cache_v + src + 4 * i); }
        u32x4 w0, w1; w0.x = pk2(kv[0][0], kv[0][1]); w0.y = pk2(kv[0][2], kv[0][3]); w0.z = pk2(kv[1][0], kv[1][1]); w0.w = pk2(kv[1][2], kv[1][3]);
        w1.x = pk2(kv[2][0], kv[2][1]); w1.y = pk2(kv[2][2], kv[2][3]); w1.z = pk2(kv[3][0], kv[3][1]); w1.w = pk2(kv[3][2], kv[3][3]);
        *(u32x4*)(CK + src) = w0; *(u32x4*)(CK + src + 8) = w1;
        __syncthreads();
#pragma unroll
        for (int i = 0; i < 4; ++i)
#pragma unroll
            for (int j = 0; j < 4; ++j) T[(ds + 4 * i + j) * TP + key] = f2bf(vv[i][j]);
        __syncthreads();
        const int d = tid >> 2, ks = (tid & 3) * 16;
        bf16_t* dst = CVT + ((size_t)bh * 128 + d) * 256 + k0 + ks;
        *(u32x4*)dst = *(const u32x4*)(T + d * TP + ks); *(u32x4*)(dst + 8) = *(const u32x4*)(T + d * TP + ks + 8);
    }
}
DI void phase_na_prep2(const Params& p, const GrpInfo gi, int bid, int nb) {
    const int tid = ltid(), lane = tid & 63, wid = tid >> 6;
    const bf16_t* P = (const bf16_t*)(lws(p) + OFF_P);
    bf16_t* QN = (bf16_t*)(lws(p) + OFF_QN); bf16_t* KN = (bf16_t*)(lws(p) + OFF_KN); bf16_t* VTN = (bf16_t*)(lws(p) + OFF_VTN);
    {
        const int d0 = (lane & 15) * 8;
        float gq[8], gk[8];
#pragma unroll
        for (int j = 0; j < 8; ++j) { gq[j] = p.na_qnorm_g[gi.l * 128 + d0 + j] * NA_QSCALE; gk[j] = p.na_knorm_g[gi.l * 128 + d0 + j]; }
        for (int row = bid * 8 + wid; row < GT; row += nb * 8) {
            const bf16_t* pr = P + (size_t)row * NP + lane * 8;
            u32x4 qw[2], kw[2], vw[2];
#pragma unroll
            for (int hf = 0; hf < 2; ++hf) { qw[hf] = *(const u32x4*)(pr + C_NQ + 512 * hf); kw[hf] = *(const u32x4*)(pr + C_NK + 512 * hf); if (!gi.latent) vw[hf] = *(const u32x4*)(pr + C_NV + 512 * hf); }
#pragma unroll
            for (int hf = 0; hf < 2; ++hf) {
                float q[8], k[8]; float sq = 0.f, sk = 0.f;
#pragma unroll
                for (int j = 0; j < 4; ++j) { q[2 * j] = bflo(qw[hf][j]); q[2 * j + 1] = bfhi(qw[hf][j]); k[2 * j] = bflo(kw[hf][j]); k[2 * j + 1] = bfhi(kw[hf][j]); }
#pragma unroll
                for (int j = 0; j < 8; ++j) { sq += q[j] * q[j]; sk += k[j] * k[j]; }
#pragma unroll
                for (int o = 8; o >= 1; o >>= 1) { sq += __int_as_float(__builtin_amdgcn_ds_bpermute((lane ^ o) << 2, __float_as_int(sq))); sk += __int_as_float(__builtin_amdgcn_ds_bpermute((lane ^ o) << 2, __float_as_int(sk))); }
                const float qs = rsqrtf(sq * (1.0f / 128) + EPS), ks = rsqrtf(sk * (1.0f / 128) + EPS);
                float kn[8];
#pragma unroll
                for (int j = 0; j < 8; ++j) { q[j] = q[j] * qs * gq[j]; kn[j] = k[j] * ks * gk[j]; }
                u32x4 qo, ko; qo.x = pk2(q[0], q[1]); qo.y = pk2(q[2], q[3]); qo.z = pk2(q[4], q[5]); qo.w = pk2(q[6], q[7]);
                ko.x = pk2(kn[0], kn[1]); ko.y = pk2(kn[2], kn[3]); ko.z = pk2(kn[4], kn[5]); ko.w = pk2(kn[6], kn[7]);
                *(u32x4*)(QN + (size_t)row * 1024 + 512 * hf + lane * 8) = qo; *(u32x4*)(KN + (size_t)row * 1024 + 512 * hf + lane * 8) = ko;
                if (!gi.latent) { const int b = row >> 8, t = row & 255, h = 4 * hf + (lane >> 4); const size_t o = ((((size_t)b * DEPTH + gi.l) * 8 + h) * 256 + t) * 128 + d0;
                    float* ok = lout(p) + OUT_CK + o; float* ov = lout(p) + OUT_CV + o;
                    *(f32x4*)ok = (f32x4){kn[0], kn[1], kn[2], kn[3]}; *(f32x4*)(ok + 4) = (f32x4){kn[4], kn[5], kn[6], kn[7]};
                    *(f32x4*)ov = (f32x4){bflo(vw[hf][0]), bfhi(vw[hf][0]), bflo(vw[hf][1]), bfhi(vw[hf][1])}; *(f32x4*)(ov + 4) = (f32x4){bflo(vw[hf][2]), bfhi(vw[hf][2]), bflo(vw[hf][3]), bfhi(vw[hf][3])}; }
            }
        }
    }
    bf16_t* T = (bf16_t*)smem;
    const int L = gi.L;
    for (int u = bid; u < 128 * 8; u += nb) {
        const int cg = u >> 3, h = u & 7, row0 = cg * 64, seq = row0 / L, t0 = row0 & (L - 1);
        const int s = tid >> 3, ds = (tid & 7) * 16;
        const bf16_t* pv = P + (size_t)(row0 + s) * NP + C_NV + h * 128 + ds;
        const u32x4 w0 = *(const u32x4*)pv, w1 = *(const u32x4*)(pv + 8);
        __syncthreads();
#pragma unroll
        for (int j = 0; j < 4; ++j) { T[(ds + 2 * j) * TP + s] = (bf16_t)(w0[j] & 0xffffu); T[(ds + 2 * j + 1) * TP + s] = (bf16_t)(w0[j] >> 16);
                                      T[(ds + 8 + 2 * j) * TP + s] = (bf16_t)(w1[j] & 0xffffu); T[(ds + 8 + 2 * j + 1) * TP + s] = (bf16_t)(w1[j] >> 16); }
        __syncthreads();
        const int d = tid >> 2, sq = (tid & 3) * 16;
        bf16_t* dst = VTN + ((size_t)(seq * 8 + h) * 128 + d) * L + t0 + sq;
        *(u32x4*)dst = *(const u32x4*)(T + d * TP + sq); *(u32x4*)(dst + 8) = *(const u32x4*)(T + d * TP + sq + 8);
    }
}

typedef const __attribute__((address_space(1))) bf16_t* gbfp;
template <bool LOCAL> DI void na_block(const bf16_t* kb0, int kstride, int kA, const bf16_t* vb0, int vstride, int vA, const bf16x8 (&qB)[4], f32x4 (&O)[8], float& mrun, float& lrun,
                                       int lane, int r16, int q4, const float* rpb  , int rowoff0  , int wc0, int c, int cs) {
    const gbfp kb = (gbfp)kb0, vb = (gbfp)vb0;
    f32x4 st[8];
    const unsigned kvo = (unsigned)(r16 * kstride + 8 * q4), vvo = (unsigned)(r16 * vstride + 4 * q4);
    bf16x8 kbuf[2][4];
#define NA_LOADK(T_, slot) do { const gbfp kp_ = kb + (size_t)(((T_) >> 1) * kA + ((T_) & 1) * 16) * kstride; \
        _Pragma("unroll") for (int ks_ = 0; ks_ < 4; ++ks_) kbuf[slot][ks_] = *(const __attribute__((address_space(1))) bf16x8*)(kp_ + kvo + 32 * ks_); } while (0)
    NA_LOADK(0, 0);
#pragma unroll
    for (int T = 0; T < 8; ++T) {
        if (T < 7) NA_LOADK(T + 1, (T + 1) & 1);
        st[T] = (f32x4){0.f, 0.f, 0.f, 0.f};
#pragma unroll
        for (int ks = 0; ks < 4; ++ks) st[T] = MFMA16(kbuf[T & 1][ks], qB[ks], st[T]);
        __builtin_amdgcn_sched_barrier(0);
    }
#undef NA_LOADK
    float mx = -INFINITY;
#pragma unroll
    for (int T = 0; T < 8; ++T)
#pragma unroll
        for (int i = 0; i < 4; ++i) {
            if (LOCAL) { const int wr = T >> 1, gcol = wc0 + 16 * (T & 1) + 4 * q4 + i;
                const bool ok = gcol >= cs && gcol < cs + 16;
                const float bias = rpb[(rowoff0 + wr) * 31 + min(max(gcol - c + 15, 0), 30)];
                st[T][i] = ok ? st[T][i] + bias : -INFINITY; }
            mx = fmaxf(mx, st[T][i]);
        }
    mx = fmaxf(mx, __int_as_float(__builtin_amdgcn_ds_bpermute((lane ^ 16) << 2, __float_as_int(mx))));
    mx = fmaxf(mx, __int_as_float(__builtin_amdgcn_ds_bpermute((lane ^ 32) << 2, __float_as_int(mx))));
    const float mnew = fmaxf(mrun, mx), alpha = __builtin_amdgcn_exp2f(mrun - mnew);
    float ls = 0.f;
#pragma unroll
    for (int T = 0; T < 8; ++T)
#pragma unroll
        for (int i = 0; i < 4; ++i) { const float e = __builtin_amdgcn_exp2f(st[T][i] - mnew); st[T][i] = e; ls += e; }
    ls += __int_as_float(__builtin_amdgcn_ds_bpermute((lane ^ 16) << 2, __float_as_int(ls)));
    ls += __int_as_float(__builtin_amdgcn_ds_bpermute((lane ^ 32) << 2, __float_as_int(ls)));
    lrun = lrun * alpha + ls; mrun = mnew;
#pragma unroll
    for (int dT = 0; dT < 8; ++dT) O[dT] *= alpha;
    bf16x4 vbuf[2][8][2];
#define NA_LOADV(t_, slot) do { _Pragma("unroll") for (int dT_ = 0; dT_ < 8; ++dT_) { const gbfp vp_ = vb + (size_t)(16 * dT_) * vstride + (t_) * vA; \
        vbuf[slot][dT_][0] = *(const __attribute__((address_space(1))) bf16x4*)(vp_ + vvo); vbuf[slot][dT_][1] = *(const __attribute__((address_space(1))) bf16x4*)(vp_ + vvo + 16); } } while (0)
    NA_LOADV(0, 0);
#pragma unroll
    for (int t = 0; t < 4; ++t) {
        if (t < 3) NA_LOADV(t + 1, (t + 1) & 1);
        const bf16x8 bP = pack8(st[2 * t], st[2 * t + 1]);
#pragma unroll
        for (int dT = 0; dT < 8; ++dT) { const bf16x4 a0 = vbuf[t & 1][dT][0], a1 = vbuf[t & 1][dT][1];
            const bf16x8 a = (bf16x8){a0[0], a0[1], a0[2], a0[3], a1[0], a1[1], a1[2], a1[3]};
            O[dT] = MFMA16(a, bP, O[dT]); }
        __builtin_amdgcn_sched_barrier(0);
    }
#undef NA_LOADV
}
constexpr int LDS_RPB_OFF = 139264 + 512;
DI void na_load_rpb(const Params& p, int l, int tid) {
    float* rp = (float*)(smem + LDS_RPB_OFF);
    for (int i = tid; i < 8 * 465; i += 512) rp[i] = p.na_rpb[(size_t)l * 8 * 465 + i] * LOG2E;
}
constexpr int NA_KP = 144, NA_VP = 72;
constexpr int NA_KS = 0, NA_VS = 64 * NA_KP * 2, NA_BUF = NA_VS + 128 * NA_VP * 2;
template <int NT, bool LOCAL> DI void na_chunk(const unsigned char* buf, int koff, const bf16x8 (&qB)[4], f32x4 (&O)[8], float& mrun, float& lrun, int lane, int r16, int q4,
                                               const float* rpb, int rowoff, int wc0, int c, int cs) {
    const bf16_t* Ks = (const bf16_t*)(buf + NA_KS); const bf16_t* Vs = (const bf16_t*)(buf + NA_VS);
    f32x4 st[NT];
#pragma unroll
    for (int T = 0; T < NT; ++T) { st[T] = (f32x4){0.f, 0.f, 0.f, 0.f};
#pragma unroll
        for (int ks = 0; ks < 4; ++ks) { const bf16x8 a = *(const bf16x8*)(Ks + (koff + 16 * T + r16) * NA_KP + 32 * ks + 8 * q4); st[T] = MFMA16(a, qB[ks], st[T]); } }
    float mx = -INFINITY;
#pragma unroll
    for (int T = 0; T < NT; ++T)
#pragma unroll
        for (int i = 0; i < 4; ++i) {
            if (LOCAL) { const int gcol = wc0 + 16 * T + 4 * q4 + i; const bool ok = gcol >= cs && gcol < cs + 16;
                const float bias = rpb[rowoff * 31 + min(max(gcol - c + 15, 0), 30)];
                st[T][i] = ok ? st[T][i] + bias : -INFINITY; }
            mx = fmaxf(mx, st[T][i]);
        }
    mx = fmaxf(mx, __int_as_float(__builtin_amdgcn_ds_bpermute((lane ^ 16) << 2, __float_as_int(mx))));
    mx = fmaxf(mx, __int_as_float(__builtin_amdgcn_ds_bpermute((lane ^ 32) << 2, __float_as_int(mx))));
    const float mnew = fmaxf(mrun, mx);
    const float alpha = (mnew == -INFINITY) ? 1.0f : __builtin_amdgcn_exp2f(mrun - mnew);
    const float msafe = (mnew == -INFINITY) ? 0.0f : mnew;
    float ls = 0.f;
#pragma unroll
    for (int T = 0; T < NT; ++T)
#pragma unroll
        for (int i = 0; i < 4; ++i) { const float e = __builtin_amdgcn_exp2f(st[T][i] - msafe); st[T][i] = e; ls += e; }
    ls += __int_as_float(__builtin_amdgcn_ds_bpermute((lane ^ 16) << 2, __float_as_int(ls)));
    ls += __int_as_float(__builtin_amdgcn_ds_bpermute((lane ^ 32) << 2, __float_as_int(ls)));
    lrun = lrun * alpha + ls; mrun = mnew;
#pragma unroll
    for (int dT = 0; dT < 8; ++dT) O[dT] *= alpha;
#pragma unroll
    for (int t = 0; t < NT / 2; ++t) {
        const bf16x8 bP = pack8(st[2 * t], st[2 * t + 1]);
#pragma unroll
        for (int dT = 0; dT < 8; ++dT) { const bf16_t* vp = Vs + (16 * dT + r16) * NA_VP + koff + 32 * t + 4 * q4;
            const bf16x4 a0 = *(const bf16x4*)vp, a1 = *(const bf16x4*)(vp + 16);
            const bf16x8 a = (bf16x8){a0[0], a0[1], a0[2], a0[3], a1[0], a1[1], a1[2], a1[3]};
            O[dT] = MFMA16(a, bP, O[dT]); }
    }
}
DI void na_attn_unit(const Params& p, const GrpInfo gi, int u, int tid_in) {
    int tid = tid_in; asm volatile("" : "+v"(tid));
    const int lane = tid & 63, wid = __builtin_amdgcn_readfirstlane(tid >> 6), l = gi.l, r16 = lane & 15, q4 = lane >> 4;
    const float* rp = (const float*)(smem + LDS_RPB_OFF);
    const bf16_t* QN = (const bf16_t*)(lws(p) + OFF_QN); const bf16_t* KN = (const bf16_t*)(lws(p) + OFF_KN); const bf16_t* VTN = (const bf16_t*)(lws(p) + OFF_VTN);
    bf16_t* OB = (bf16_t*)(lws(p) + OFF_OABC) + 1024;
    int qrow0, h, seq, r = 0, c0 = 0, r0 = 0;
    if (gi.latent) { const int sl = u >> 8, rp2 = u & 31; h = (u >> 5) & 7; seq = sl; r0 = 2 * rp2; r = r0 + (wid >> 2); c0 = 16 * (wid & 3); qrow0 = sl * 4096 + r * 64 + c0; }
    else { const int b = u >> 4, half = u & 1; h = (u >> 1) & 7; seq = b; qrow0 = b * 256 + (half * 8 + wid) * 16; }
    const int g0 = min(max(r0 - 4, 0), 56), g1 = min(max(r0 + 1 - 4, 0), 56) + 8, nch = gi.latent ? 4 + (g1 - g0) : 4;
    const bf16_t* ck; const bf16_t* cv; int ckst, cvst;
    if (gi.latent) { const size_t cb = ((size_t)(2 * (gi.grp - 1) + seq) * DEPTH + l) * 8 + h; ck = (const bf16_t*)(lws(p) + OFF_CK) + cb * 256 * 128; ckst = 128; cv = (const bf16_t*)(lws(p) + OFF_CVT) + cb * 128 * 256; cvst = 256; }
    else { ck = KN + (size_t)(seq * 256) * 1024 + h * 128; ckst = 1024; cv = VTN + (size_t)(seq * 8 + h) * 128 * 256; cvst = 256; }
    const bf16_t* lk = KN + (size_t)(seq * 4096) * 1024 + h * 128;
    const bf16_t* lv = VTN + (size_t)(seq * 8 + h) * 128 * 4096;
    const int kkey = tid >> 4, kds = (tid & 15) * 8, vd = tid >> 3, vks = (tid & 7) * 8;
    u32x4 pk[2][2], pv[2][2];
#define NA_LOAD(c_, s_) do { const int cc_ = (c_); const bf16_t* kb_; const bf16_t* vb_; int kst_, vst_; \
        if (cc_ < 4) { kb_ = ck + (size_t)(64 * cc_) * ckst; kst_ = ckst; vb_ = cv + 64 * cc_; vst_ = cvst; } else { const int g_ = g0 + cc_ - 4; kb_ = lk + (size_t)(64 * g_) * 1024; kst_ = 1024; vb_ = lv + 64 * g_; vst_ = 4096; } \
        pk[s_][0] = *(const u32x4*)(kb_ + (size_t)kkey * kst_ + kds); pk[s_][1] = *(const u32x4*)(kb_ + (size_t)(kkey + 32) * kst_ + kds); \
        pv[s_][0] = *(const u32x4*)(vb_ + (size_t)vd * vst_ + vks); pv[s_][1] = *(const u32x4*)(vb_ + (size_t)(vd + 64) * vst_ + vks); } while (0)
#define NA_STORE(bufp, s_) do { unsigned char* b_ = (bufp); \
        *(u32x4*)(b_ + NA_KS + (kkey * NA_KP + kds) * 2) = pk[s_][0]; *(u32x4*)(b_ + NA_KS + ((kkey + 32) * NA_KP + kds) * 2) = pk[s_][1]; \
        *(u32x4*)(b_ + NA_VS + (vd * NA_VP + vks) * 2) = pv[s_][0]; *(u32x4*)(b_ + NA_VS + ((vd + 64) * NA_VP + vks) * 2) = pv[s_][1]; } while (0)
    bf16x8 qB[4];
#pragma unroll
    for (int ks = 0; ks < 4; ++ks) qB[ks] = *(const bf16x8*)(QN + (size_t)(qrow0 + r16) * 1024 + h * 128 + 32 * ks + 8 * q4);
    f32x4 O[8];
#pragma unroll
    for (int dT = 0; dT < 8; ++dT) O[dT] = (f32x4){0.f, 0.f, 0.f, 0.f};
    float mrun = -INFINITY, lrun = 0.f;
    const int rs = min(max(r - 4, 0), 56), wc0 = min(max(c0 - 8, 0), 32), c = c0 + r16, cs = min(max(c - 8, 0), 48);
    __syncthreads();
    NA_LOAD(0, 0); NA_STORE(smem, 0);
    NA_LOAD(1, 1);
    __syncthreads();
    for (int ci = 0; ci < nch; ci += 2) {
        if (ci + 2 < nch) NA_LOAD(ci + 2, 0);
        if (ci < 4) na_chunk<4, false>(smem, 0, qB, O, mrun, lrun, lane, r16, q4, rp, 0, 0, 0, 0);
        else { const int g = g0 + ci - 4, wr = g - rs; if (wr >= 0 && wr < 8) na_chunk<2, true>(smem, wc0, qB, O, mrun, lrun, lane, r16, q4, rp + h * 465, g - r + 7, wc0, c, cs); }
        if (ci + 1 < nch) NA_STORE(smem + NA_BUF, 1);
        __syncthreads();
        if (ci + 1 < nch) {
            if (ci + 3 < nch) NA_LOAD(ci + 3, 1);
            if (ci + 1 < 4) na_chunk<4, false>(smem + NA_BUF, 0, qB, O, mrun, lrun, lane, r16, q4, rp, 0, 0, 0, 0);
            else { const int g = g0 + ci + 1 - 4, wr = g - rs; if (wr >= 0 && wr < 8) na_chunk<2, true>(smem + NA_BUF, wc0, qB, O, mrun, lrun, lane, r16, q4, rp + h * 465, g - r + 7, wc0, c, cs); }
            if (ci + 2 < nch) NA_STORE(smem, 0);
        }
        __syncthreads();
    }
#undef NA_LOAD
#undef NA_STORE
    const float inv = 1.0f / lrun;
#pragma unroll
    for (int dT = 0; dT < 8; ++dT) { u32x2 w; w.x = pk2(O[dT][0] * inv, O[dT][1] * inv); w.y = pk2(O[dT][2] * inv, O[dT][3] * inv);
        *(u32x2*)(OB + (size_t)(qrow0 + r16) * 3072 + h * 128 + 16 * dT + 4 * q4) = w; }
}
#define LAS3 __attribute__((address_space(3)))
#ifndef REPMASK
#define REPMASK 0
#endif
constexpr int LDS_MAIN = 139264, LDS_PARAMS = LDS_MAIN + 64, LDS_UNIT = LDS_MAIN + 32, LDS_BYTES = LDS_MAIN + 512 + 8 * 465 * 4;
static_assert(LDS_RPB_OFF == LDS_MAIN + 512 && LDS_BYTES <= 163840, "LDS map");
constexpr int CTR_WORD0 = XCD_BAR_WORDS, CTR_WORDS = 64 * 16;

DI Params lp() {
    ParamsU u;
#pragma unroll
    for (int i = 0; i < NPARAM; ++i) {
        const unsigned long long v = *(const LAS3 unsigned long long*)((LAS3 unsigned char*)smem + LDS_PARAMS + 8 * i);
        const unsigned lo = (unsigned)__builtin_amdgcn_readfirstlane((int)(unsigned)v), hi = (unsigned)__builtin_amdgcn_readfirstlane((int)(unsigned)(v >> 32));
        u.a[i] = ((unsigned long long)hi << 32) | lo;
    }
    return u.s;
}
DI const float* x_in_ptr(const Params& p, int grp, int l) {
    if (l == 0) return grp == 0 ? p.x_prompt : p.x_sample + (size_t)(grp - 1) * GT * DM;
    return grp == 0 ? p.out + OUT_YP : p.out + OUT_YS + (size_t)(grp - 1) * GT * DM;
}
DI float* x_out_ptr(const Params& p, int grp) { return grp == 0 ? p.out + OUT_YP : p.out + OUT_YS + (size_t)(grp - 1) * GT * DM; }

template <class Epi> DI void gemm_ph(const bf16_t* A, const bf16_t* Bt, int M, int N, int K, const Epi& E) {
    pg8::Gemm g; g.A = A; g.Bt = Bt; g.M = M; g.N = N; g.K = K; g.pad = 0;
    pg8::StaticOrder S; S.init(M, N, (int)gridDim.x, (int)blockIdx.x);
    pg8::gemm_phase<Epi, pg8::StaticOrder, false>((LAS3 unsigned char*)smem, g, S, E, nullptr);
}
struct ModPtrs { const float* mA; const float* mB; };
DI ModPtrs mod_ptrs(const Params& q, int grp, int l) {
    const int crA = grp == 0 ? 0 : 1 + 2 * (grp - 1), crB = grp == 0 ? 0 : crA + 1;
    const float* mod = (const float*)(q.ws + OFF_MOD);
    ModPtrs m; m.mA = mod + ((size_t)l * NCOND + crA) * (NMOD * DM); m.mB = mod + ((size_t)l * NCOND + crB) * (NMOD * DM); return m;
}

__global__ __launch_bounds__(512, 2) void k_mega(Params p) {
    const int bid = blockIdx.x, nb = gridDim.x;
    volatile LAS unsigned* xbw = (volatile LAS unsigned*)((LAS3 unsigned char*)smem + LDS_MAIN);
    if (threadIdx.x == 0) {
        xbw[0] = 0u; xbw[1] = 0u; xbw[2] = 0u; xbw[3] = 0u;
        ParamsU u; u.s = p;
#pragma unroll
        for (int i = 0; i < NPARAM; ++i) *(LAS3 unsigned long long*)((LAS3 unsigned char*)smem + LDS_PARAMS + 8 * i) = u.a[i];
    }
    __syncthreads();
    XcdBarrier bar;
    { const Params q = lp(); bar = xcd_barrier_post((unsigned*)(q.ws + OFF_BAR), xbw); }
    for (int rep_ = 0; rep_ < 1 + ((REPMASK >> 8) & 1); ++rep_) { const Params q = lp(); phase_convert(q, bid, nb); }
    for (int rep_ = 0; rep_ < 1 + ((REPMASK >> 17) & 1); ++rep_) { const Params q = lp(); phase_adaln(q, bid, nb); }
    { const Params q = lp(); phase_hyena_hid(q, bid, nb); }
    { const Params q = lp(); phase_cache_cvt(q, bid, nb); }
    xcd_barrier(bar);
    for (int rep_ = 0; rep_ < 1 + ((REPMASK >> 19) & 1); ++rep_) { const Params q = lp(); phase_filters(q, bid, nb); }
    xcd_barrier(bar);
    for (int l0 = 0; l0 < DEPTH; ++l0) for (int grp0 = 0; grp0 < NGRP; ++grp0) {
        int l = l0, grp = grp0; asm volatile("" : "+s"(l), "+s"(grp));
        const GrpInfo gi = grp_info(grp, l);
        for (int rep_ = 0; rep_ < 1 + ((REPMASK >> 0) & 1); ++rep_) { const Params q = lp(); phase_norm(q, x_in_ptr(q, grp, l), q.norm1_g + l * DM, l, grp, 0, DM, bid, nb); }
        xcd_barrier(bar);
        if ((REPMASK >> 9) & 1) { xcd_barrier(bar); xcd_barrier(bar); xcd_barrier(bar); xcd_barrier(bar); }
        for (int rep_ = 0; rep_ < 1 + ((REPMASK >> 1) & 1); ++rep_) { const Params q = lp(); gemm_ph((const bf16_t*)(q.ws + OFF_H), (const bf16_t*)(q.ws + OFF_WIN) + (size_t)l * NP * DM, GT, NP, DM, EpiStoreBf16<0>{(bf16_t*)(q.ws + OFF_P), NP, 0}); }
        xcd_barrier(bar);
        for (int rep_ = 0; rep_ < 1 + ((REPMASK >> 2) & 1); ++rep_) { const Params q = lp(); phase_gla_prep(q, gi, bid, nb); }
        for (int rep_ = 0; rep_ < 1 + ((REPMASK >> 13) & 1); ++rep_) { const Params q = lp(); phase_na_prep2(q, gi, bid, nb); }
        for (int rep_ = 0; rep_ < 1 + ((REPMASK >> 14) & 1); ++rep_) { const Params q = lp(); phase_hy_prep(q, gi, bid, nb); }
        xcd_barrier(bar);
        for (int rep_ = 0; rep_ < 1 + ((REPMASK >> 3) & 1); ++rep_) {
            const Params q = lp(); const int tid = ltid();
            na_load_rpb(q, l, tid);
            unsigned* head = (unsigned*)(q.ws + OFF_BAR) + CTR_WORD0 + 64 * (l * NGRP + grp) + 16 * rep_;
            volatile LAS3 int* su = (volatile LAS3 int*)((LAS3 unsigned char*)smem + LDS_UNIT);
            const int nscan = gi.nseq * 16, nhy = 1024, nna = 512, ntot = nscan + nhy + nna;
            __syncthreads();
            if (tid == 0) *su = (int)__hip_atomic_fetch_add(head, 1u, __ATOMIC_RELAXED, __HIP_MEMORY_SCOPE_AGENT);
            __syncthreads();
            for (;;) {
                const int u = __builtin_amdgcn_readfirstlane(*su);
                if (u >= ntot) break;
                int nxt = 0;
                if (tid == 0) nxt = (int)__hip_atomic_fetch_add(head, 1u, __ATOMIC_RELAXED, __HIP_MEMORY_SCOPE_AGENT);
                if (u < nscan) { for (int r2 = 0; r2 < 1 + ((REPMASK >> 10) & 1); ++r2) gla_scan_unit(q, gi, u, tid); }
                else if (u < nscan + nhy) { for (int r2 = 0; r2 < 1 + ((REPMASK >> 4) & 1); ++r2) hy_conv_unit(q, gi, u - nscan, tid); }
                else { for (int r2 = 0; r2 < 1 + ((REPMASK >> 5) & 1); ++r2) na_attn_unit(q, gi, u - nscan - nhy, tid); }
                __syncthreads();
                if (tid == 0) *su = nxt;
                __syncthreads();
            }
        }
        xcd_barrier(bar);
        for (int rep_ = 0; rep_ < 1 + ((REPMASK >> 6) & 1); ++rep_) { const Params q = lp(); phase_gla_post<true>(q, gi, bid, nb); }
        for (int rep_ = 0; rep_ < 1 + ((REPMASK >> 6) & 1); ++rep_) { const Params q = lp(); phase_hy_post(q, gi, bid, nb); }
        xcd_barrier(bar);
        for (int rep_ = 0; rep_ < 1 + ((REPMASK >> 16) & 1); ++rep_)
        { const Params q = lp();
          gemm_ph((const bf16_t*)(q.ws + OFF_OABC), (const bf16_t*)(q.ws + OFF_WBR) + (size_t)l * DM * 3072, GT, DM, 3072, EpiGate3{(const bf16_t*)(q.ws + OFF_P) + C_GATE, (bf16_t*)(q.ws + OFF_MBF), NP, 0}); }
        xcd_barrier(bar);
        for (int rep_ = 0; rep_ < 1 + ((REPMASK >> 12) & 1); ++rep_)
        { const Params q = lp(); const ModPtrs m = mod_ptrs(q, grp, l);
          gemm_ph((const bf16_t*)(q.ws + OFF_MBF), (const bf16_t*)(q.ws + OFF_WOUT) + (size_t)l * DM * DM, GT, DM, DM, EpiResid{x_in_ptr(q, grp, l), (float*)(q.ws + OFF_M32), m.mA + 2 * DM, m.mB + 2 * DM}); }
        xcd_barrier(bar);
        { const Params q = lp(); phase_norm(q, (const float*)(q.ws + OFF_M32), q.norm2_g + l * DM, l, grp, 3 * DM, 4 * DM, bid, nb); }
        xcd_barrier(bar);
        for (int rep_ = 0; rep_ < 1 + ((REPMASK >> 7) & 1); ++rep_) { const Params q = lp(); gemm_ph((const bf16_t*)(q.ws + OFF_H), (const bf16_t*)(q.ws + OFF_W1) + (size_t)l * DFF * DM, GT, DFF, DM, EpiStoreBf16<1>{(bf16_t*)(q.ws + OFF_P), DFF, 0}); }
        xcd_barrier(bar);
        for (int rep_ = 0; rep_ < 1 + ((REPMASK >> 15) & 1); ++rep_)
        { const Params q = lp(); const ModPtrs m = mod_ptrs(q, grp, l);
          gemm_ph((const bf16_t*)(q.ws + OFF_P), (const bf16_t*)(q.ws + OFF_W2) + (size_t)l * DM * DFF, GT, DM, DFF, EpiResid{(const float*)(q.ws + OFF_M32), x_out_ptr(q, grp), m.mA + 5 * DM, m.mB + 5 * DM}); }
        xcd_barrier(bar);
    }
}

extern "C" void kernel_launch(void* const* d_in, const int* in_sizes, int n_in, void* d_out, int out_size, void* d_ws, size_t ws_size, hipStream_t stream) {
    Params p{};
    const float** f = (const float**)&p;
    for (int i = 0; i < 33; ++i) f[i] = (const float*)d_in[i];
    p.out = (float*)d_out; p.ws = (unsigned char*)d_ws;
    if (ws_size < WS_END) { fprintf(stderr, "workspace too small: %zu < %zu\n", ws_size, (size_t)WS_END); return; }
    static int grid = 0;
    if (!grid) {
        int dev = 0, cus = 0, per_cu = 0;
        (void)hipGetDevice(&dev);
        (void)hipDeviceGetAttribute(&cus, hipDeviceAttributeMultiprocessorCount, dev);
        (void)hipFuncSetAttribute((const void*)k_mega, hipFuncAttributeMaxDynamicSharedMemorySize, LDS_BYTES);
        (void)hipOccupancyMaxActiveBlocksPerMultiprocessor(&per_cu, k_mega, 512, LDS_BYTES);
        grid = cus * (per_cu < 1 ? per_cu : 1);
        if (grid <= 0) { fprintf(stderr, "occupancy query failed: cus %d per_cu %d\n", cus, per_cu); grid = 0; return; }
    }
    (void)hipMemsetAsync(p.ws + OFF_BAR, 0, (XCD_BAR_WORDS + CTR_WORDS) * sizeof(unsigned), stream);
    hipLaunchKernelGGL(k_mega, dim3(grid), dim3(512), LDS_BYTES, stream, p);
}
```

```cpp
#include <hip/hip_runtime.h>
#include <stdint.h>
#include <stdio.h>

constexpr int DM = 2048, DFF = 8192, NMOD = 6, NCOND = 9;
constexpr int GT = 8192;
constexpr int NGRP = 5, DEPTH = 2;
constexpr int C_GQ = 0, C_GK = 512, C_GV = 1024, C_GG = 2048, C_GA = 3072, C_NQ = 3328, C_NK = 4352, C_NV = 5376, C_HY = 6400, C_GATE = 9472, NP = 15616;
constexpr int IN_TOTAL = 15392;
constexpr float EPS = 1e-6f;

typedef unsigned short bf16_t;
typedef float f32x4 __attribute__((ext_vector_type(4)));
typedef float f32x2 __attribute__((ext_vector_type(2)));
typedef unsigned u32x4 __attribute__((ext_vector_type(4)));
typedef unsigned u32x2 __attribute__((ext_vector_type(2)));
#define DI __device__ __forceinline__

DI int ltid() { int t = threadIdx.x; asm volatile("" : "+v"(t)); return t; }
DI float bf2f(bf16_t b) { return __uint_as_float(((unsigned)b) << 16); }
DI float bflo(unsigned w) { return __uint_as_float(w << 16); }
DI float bfhi(unsigned w) { return __uint_as_float(w & 0xffff0000u); }
DI bf16_t f2bf(float f) { unsigned u = __float_as_uint(f); u += 0x7FFFu + ((u >> 16) & 1u); return (bf16_t)(u >> 16); }
DI unsigned pk2(float lo, float hi) { return (unsigned)f2bf(lo) | ((unsigned)f2bf(hi) << 16); }
DI float sigmoidf_(float x) { return 1.0f / (1.0f + __expf(-x)); }
DI float wave_sum(float v, int lane) {
#pragma unroll
    for (int o = 32; o >= 1; o >>= 1) v += __int_as_float(__builtin_amdgcn_ds_bpermute((lane ^ o) << 2, __float_as_int(v))); return v; }
DI float wave_max(float v, int lane) {
#pragma unroll
    for (int o = 32; o >= 1; o >>= 1) v = fmaxf(v, __int_as_float(__builtin_amdgcn_ds_bpermute((lane ^ o) << 2, __float_as_int(v)))); return v; }

constexpr size_t al256(size_t x) { return (x + 255) & ~(size_t)255; }
constexpr size_t OFF_BAR  = 0;
constexpr size_t OFF_MOD  = 65536;
constexpr size_t OFF_HID  = OFF_MOD  + al256((size_t)DEPTH * NCOND * 12288 * 4);
constexpr size_t OFF_FILT = OFF_HID  + (size_t)DEPTH * 2 * 4096 * 64 * 4;
constexpr size_t FILT_L   = (size_t)2 * 1024 * ((256 + 232) + (4096 + 232)) * 2;
constexpr size_t OFF_WIN  = OFF_FILT + DEPTH * FILT_L;
constexpr size_t OFF_WBR  = OFF_WIN  + (size_t)DEPTH * NP * DM * 2;
constexpr size_t OFF_WOUT = OFF_WBR  + (size_t)DEPTH * 3 * DM * 1024 * 2;
constexpr size_t OFF_W1   = OFF_WOUT + (size_t)DEPTH * DM * DM * 2;
constexpr size_t OFF_W2   = OFF_W1   + (size_t)DEPTH * DFF * DM * 2;
constexpr size_t OFF_H    = OFF_W2   + (size_t)DEPTH * DFF * DM * 2;
constexpr size_t OFF_P    = OFF_H    + (size_t)GT * DM * 2;
constexpr size_t OFF_OF   = OFF_P    + (size_t)GT * NP * 2;
constexpr size_t OFF_OB   = OFF_OF   + (size_t)GT * 1024 * 4;
constexpr size_t OFF_OABC = OFF_OB   + (size_t)GT * 1024 * 4;
constexpr size_t OFF_M32  = OFF_OABC + (size_t)3 * GT * 1024 * 2;
constexpr size_t OFF_MBF  = OFF_M32  + (size_t)GT * DM * 4;
constexpr size_t OFF_QN   = OFF_MBF  + (size_t)GT * DM * 2;
constexpr size_t OFF_KN   = OFF_QN   + (size_t)GT * 1024 * 2;
constexpr size_t OFF_QF   = OFF_KN   + (size_t)GT * 1024 * 2;
constexpr size_t OFF_QB   = OFF_QF   + (size_t)GT * 512 * 2;
constexpr size_t OFF_KFT  = OFF_QB   + (size_t)GT * 512 * 2;
constexpr size_t OFF_KBT  = OFF_KFT  + (size_t)GT * 512 * 2;
constexpr size_t OFF_VT   = OFF_KBT  + (size_t)GT * 512 * 2;
constexpr size_t OFF_DEC  = OFF_VT   + (size_t)GT * 1024 * 2;
constexpr size_t OFF_OI   = OFF_DEC  + (size_t)2 * 128 * 512 * 4;
constexpr size_t OFF_UCT  = OFF_OI   + (size_t)GT * 1024 * 4;
constexpr size_t OFF_OCT  = OFF_UCT  + (size_t)3072 * GT * 2;
constexpr size_t OFF_VTN  = OFF_OCT  + (size_t)1024 * GT * 2;
constexpr size_t OFF_CK   = OFF_VTN  + (size_t)GT * 1024 * 2;
constexpr size_t OFF_CVT  = OFF_CK   + (size_t)8 * 2 * 8 * 256 * 128 * 2;
constexpr size_t OFF_WA2T = OFF_CVT  + (size_t)8 * 2 * 8 * 256 * 128 * 2;
constexpr size_t WS_END   = OFF_WA2T + (size_t)DEPTH * 2 * 512 * 16 * 2;
static_assert(WS_END < (size_t)1190000000, "workspace too large");

constexpr size_t OUT_YP = 0, OUT_YS = (size_t)32 * 256 * DM, OUT_ST = OUT_YS + (size_t)8 * 4096 * DM,
                 OUT_CK = OUT_ST + (size_t)32 * 2 * 2 * 4 * 128 * 256, OUT_CV = OUT_CK + (size_t)32 * 2 * 8 * 256 * 128;

struct Params {
    const float *x_prompt, *x_sample, *state_gla, *cache_k, *cache_v, *c, *c_ctx, *w_mod, *b_mod, *norm1_g, *norm2_g, *w_in, *gla_wa2, *gla_ba2, *gla_norm_g,
                *na_qnorm_g, *na_knorm_g, *na_rpb, *hy_conv_w, *hy_conv_b, *hy_f1_w, *hy_f1_b, *hy_f2_w, *hy_f2_b, *hy_f3_w, *hy_freq, *hy_bias,
                *w_br_a, *w_br_b, *w_br_c, *w_out, *w_mlp1, *w_mlp2;
    float* out; unsigned char* ws;
};
constexpr int NPARAM = 35;
union ParamsU { Params s; unsigned long long a[NPARAM]; };
static_assert(sizeof(Params) == NPARAM * 8, "Params must be 35 pointers");
DI unsigned char* lws(const Params& p) { unsigned char* w = p.ws; asm volatile("" : "+s"(w)); return w; }
DI float* lout(const Params& p) { float* w = p.out; asm volatile("" : "+s"(w)); return w; }
namespace pg8 {
#define PG8_LAS __attribute__((address_space(3)))
typedef unsigned short bf16_t;
typedef short bf16x8 __attribute__((ext_vector_type(8)));
typedef float f32x4 __attribute__((ext_vector_type(4)));
typedef unsigned u32x4 __attribute__((ext_vector_type(4)));
constexpr int BM = 256, BK = 64, HALF = 128, HTB = HALF * BK * 2  , STAGE_BYTES = 8 * HTB, NXCD = 8, WGM = 8;
__host__ __device__ __forceinline__ int lds_byte(int r, int c) { const int st = (r >> 4) * 2 + (c >> 5), rr = r & 15, cc = c & 31, ob = rr * 64 + cc * 2; return st * 1024 + (ob ^ (((ob >> 9) & 1) << 5)); }
__host__ __device__ __forceinline__ void stage_rc(int b, int& R, int& C) { const int st = b / 1024, sb = b % 1024, swz = sb ^ (((sb >> 9) & 1) << 5); R = (st >> 1) * 16 + swz / 64; C = (st & 1) * 32 + (swz % 64) / 2; }
__host__ __device__ __forceinline__ int perm32(int rho) { const int n = rho >> 4, i = rho & 15; return 8 * (i >> 2) + 4 * n + (i & 3); }
struct Unit { int pm, pn; };
struct Gemm { const bf16_t* A; const bf16_t* Bt; int M, N, K, pad; };
struct StaticOrder {
    int nM, nN, nwg, G, c;
    __host__ __device__ void init(int M, int N, int G_, int c_) { nM = M / BM; nN = N / BM; nwg = nM * nN; G = G_; c = c_; }
    __host__ __device__ bool next(int i, Unit& u) const {
        const long L = (long)i * G + c; if (L >= nwg) return false;
        int wgid = (int)L; { const int q = nwg / NXCD, r = nwg % NXCD, xcd = wgid % NXCD, off = wgid / NXCD; wgid = (xcd < r ? xcd * (q + 1) : r * (q + 1) + (xcd - r) * q) + off; }
        const int nig = WGM * nN, gid = wgid / nig, fm = gid * WGM, gsz = (nM - fm) < WGM ? (nM - fm) : WGM;
        u.pm = fm + ((wgid % nig) % gsz); u.pn = (wgid % nig) / gsz; return true;
    }
    __device__ __forceinline__ void a_ready(const Unit&) const {}
    __device__ __forceinline__ void done(const Unit&) const {}
};
__device__ __forceinline__ unsigned cvt_pk_bf16(float lo, float hi) { unsigned r; asm volatile("v_cvt_pk_bf16_f32 %0, %1, %2" : "=v"(r) : "v"(lo), "v"(hi)); return r; }
template <class Epi, class Sched, bool STAMP = false>
__device__ __forceinline__ void gemm_phase(PG8_LAS unsigned char* lds, const Gemm g, const Sched& S, const Epi& E, unsigned long long* stamps) {
    int tid_ = threadIdx.x; asm volatile("" : "+v"(tid_));
    const int tid = tid_, wid = __builtin_amdgcn_readfirstlane(tid >> 6), lane = tid & 63, wr = wid >> 2, wc = wid & 3, fr = lane & 15, fq = lane >> 4;
    const int K = g.K, nt = K / BK;
    int ts_lo = 0, ts_hi = 0, nts = 0; const unsigned long long rt_entry = STAMP ? (unsigned long long)wall_clock64() : 0ull;
#define PG8_STAMP() do { if (STAMP && wid == 0 && nts < 64) { const unsigned long long _c = (unsigned long long)clock64(); \
        ts_lo = (lane == nts) ? (int)(unsigned)_c : ts_lo; ts_hi = (lane == nts) ? (int)(unsigned)(_c >> 32) : ts_hi; ++nts; } } while (0)
    PG8_STAMP();
    unsigned voffA[2], voffB[2];
#pragma unroll
    for (int i = 0; i < 2; ++i) { int R, C; stage_rc(tid * 16 + i * 8192, R, C); const int Rb = Epi::PERM ? ((R & ~31) + perm32(R & 31)) : R;
        voffA[i] = (unsigned)(R * K + C) * 2u; voffB[i] = (unsigned)(Rb * K + C) * 2u; }
    const size_t kstep = (size_t)(BK * 2);
    const size_t hstep = (size_t)HALF * K * 2;
    const size_t tstep = 2 * hstep;
    const unsigned ldsw = (unsigned)wid * 1024u;
    const int aoff = lds_byte(wr * 64 + fr, fq * 8), boff = lds_byte(wc * 32 + fr, fq * 8);
#define PG8_SA(b, h) (((b) * 2 + (h)) * HTB)
#define PG8_SB(b, h) ((4 + (b) * 2 + (h)) * HTB)
#define PG8_STAGE(bufoff, gbase, voff) do { _Pragma("unroll") for (int _i = 0; _i < 2; ++_i) \
        __builtin_amdgcn_global_load_lds((const unsigned*)((const char*)(gbase) + (voff)[_i]), (PG8_LAS unsigned*)(lds + (bufoff) + ldsw + _i * 8192), 16, 0, 0); } while (0)
#define PG8_LDA(dst, b, h) do { _Pragma("unroll") for (int m = 0; m < 4; ++m) _Pragma("unroll") for (int k = 0; k < 2; ++k) dst[m][k] = *(const PG8_LAS bf16x8*)(lds + PG8_SA(b, h) + aoff + m * 2048 + k * 1024); } while (0)
#define PG8_LDB(dst, b, h) do { _Pragma("unroll") for (int n = 0; n < 2; ++n) _Pragma("unroll") for (int k = 0; k < 2; ++k) dst[n][k] = *(const PG8_LAS bf16x8*)(lds + PG8_SB(b, h) + boff + n * 2048 + k * 1024); } while (0)
#define PG8_MMA(ai, bj, At, Bt) do { __builtin_amdgcn_s_setprio(1); _Pragma("unroll") for (int m = 0; m < 4; ++m) _Pragma("unroll") for (int n = 0; n < 2; ++n) _Pragma("unroll") for (int k = 0; k < 2; ++k) \
        acc[ai][bj][m][n] = __builtin_amdgcn_mfma_f32_16x16x32_bf16(Bt[n][k], At[m][k], acc[ai][bj][m][n], 0, 0, 0); __builtin_amdgcn_s_setprio(0); } while (0)
#define PG8_WAIT_V(n) asm volatile("s_waitcnt vmcnt(" #n ")" ::: "memory")
#define PG8_WAIT_L(n) asm volatile("s_waitcnt lgkmcnt(" #n ")" ::: "memory")
#define PG8_BAR __builtin_amdgcn_s_barrier()
#define PG8_SCHED __builtin_amdgcn_sched_barrier(0)
    Unit cur, nxt; int ui = 0;
    if (!S.next(0, cur)) return;
    f32x4 acc[2][2][4][2];
#pragma unroll
    for (int a = 0; a < 2; ++a)
#pragma unroll
        for (int b = 0; b < 2; ++b)
#pragma unroll
            for (int m = 0; m < 4; ++m)
#pragma unroll
                for (int n = 0; n < 2; ++n) acc[a][b][m][n] = (f32x4){0.f, 0.f, 0.f, 0.f};
    bf16x8 At[4][2], B0[2][2], B1[2][2];
    const char* cA = (const char*)g.A + (size_t)cur.pm * tstep; const char* cB = (const char*)g.Bt + (size_t)cur.pn * tstep;
    S.a_ready(cur);
    PG8_STAGE(PG8_SB(0, 0), cB, voffB); PG8_STAGE(PG8_SA(0, 0), cA, voffA); PG8_STAGE(PG8_SB(0, 1), cB + hstep, voffB); PG8_STAGE(PG8_SA(0, 1), cA + hstep, voffA);
    if (wr == 1) PG8_BAR;
    PG8_WAIT_V(4); PG8_BAR;
    PG8_STAGE(PG8_SB(1, 0), cB + kstep, voffB); PG8_STAGE(PG8_SA(1, 0), cA + kstep, voffA); PG8_STAGE(PG8_SB(1, 1), cB + hstep + kstep, voffB);
    PG8_WAIT_V(6); PG8_BAR;
    PG8_STAMP();
    for (;;) {
        const bool has_next = S.next(ui + 1, nxt);
        const char* nA = has_next ? (const char*)g.A + (size_t)nxt.pm * tstep : cA; const char* nB = has_next ? (const char*)g.Bt + (size_t)nxt.pn * tstep : cB;
        for (int t = 0; t < nt; t += 2) {
            if constexpr (Epi::KHOOK) { if (t == E.kh0 || t == E.kh1) E.khook(acc, cur, t, wr, wc, fr, fq); }
            const bool last = (t == nt - 2);
            const char* a1 = cA + (size_t)(t + 1) * kstep;
            const char* a2 = last ? nA : cA + (size_t)(t + 2) * kstep; const char* b2 = last ? nB : cB + (size_t)(t + 2) * kstep;
            const char* a3 = a2 + kstep; const char* b3 = b2 + kstep;
            if (last && has_next) S.a_ready(nxt);
            PG8_LDB(B0, 0, 0); PG8_SCHED; PG8_LDA(At, 0, 0); PG8_STAGE(PG8_SA(1, 1), a1 + hstep, voffA);
            PG8_WAIT_L(8); PG8_BAR; PG8_WAIT_L(0); PG8_MMA(0, 0, At, B0); PG8_BAR; PG8_SCHED;
            PG8_LDB(B1, 0, 1); PG8_STAGE(PG8_SB(0, 0), b2, voffB);
            PG8_BAR; PG8_WAIT_L(0); PG8_MMA(0, 1, At, B1); PG8_BAR;
            PG8_LDA(At, 0, 1); PG8_STAGE(PG8_SA(0, 0), a2, voffA);
            PG8_BAR; PG8_WAIT_L(0); PG8_MMA(1, 0, At, B0); PG8_BAR; PG8_SCHED;
            PG8_STAGE(PG8_SB(0, 1), b2 + hstep, voffB);
            PG8_WAIT_V(6); PG8_BAR; PG8_MMA(1, 1, At, B1); PG8_BAR;
            PG8_LDB(B0, 1, 0); PG8_SCHED; PG8_LDA(At, 1, 0); PG8_STAGE(PG8_SA(0, 1), a2 + hstep, voffA);
            PG8_WAIT_L(8); PG8_BAR; PG8_WAIT_L(0); PG8_MMA(0, 0, At, B0); PG8_BAR; PG8_SCHED;
            PG8_LDB(B1, 1, 1); PG8_STAGE(PG8_SB(1, 0), b3, voffB);
            PG8_BAR; PG8_WAIT_L(0); PG8_MMA(0, 1, At, B1); PG8_BAR;
            PG8_LDA(At, 1, 1); PG8_STAGE(PG8_SA(1, 0), a3, voffA);
            PG8_BAR; PG8_WAIT_L(0); PG8_MMA(1, 0, At, B0); PG8_BAR; PG8_SCHED;
            PG8_STAGE(PG8_SB(1, 1), b3 + hstep, voffB);
            PG8_WAIT_V(6); PG8_BAR; PG8_MMA(1, 1, At, B1); PG8_BAR;
        }
        PG8_STAMP();
        if constexpr (!Epi::AFTER_DRAIN) { E(acc, cur, wr, wc, fr, fq); S.done(cur); }
        PG8_STAMP();
        if (!has_next) break;
#pragma unroll
        for (int a = 0; a < 2; ++a)
#pragma unroll
            for (int b = 0; b < 2; ++b)
#pragma unroll
                for (int m = 0; m < 4; ++m)
#pragma unroll
                    for (int n = 0; n < 2; ++n) acc[a][b][m][n] = (f32x4){0.f, 0.f, 0.f, 0.f};
        cur = nxt; cA = nA; cB = nB; ++ui;
    }
    PG8_WAIT_V(0);
    if (wr == 0) PG8_BAR;
    PG8_BAR;
    if constexpr (Epi::AFTER_DRAIN) { E.fused(acc, cur, wr, wc, fr, fq, lds, wid, lane); S.done(cur); }
    PG8_STAMP();
    if (STAMP && wid == 0) { stamps[lane] = lane < nts ? (((unsigned long long)(unsigned)ts_hi << 32) | (unsigned)ts_lo) : 0ull;
        if (lane == 62) stamps[62] = rt_entry; if (lane == 63) stamps[63] = (unsigned long long)wall_clock64(); }
#undef PG8_STAMP
#undef PG8_SA
#undef PG8_SB
#undef PG8_STAGE
#undef PG8_LDA
#undef PG8_LDB
#undef PG8_MMA
#undef PG8_WAIT_V
#undef PG8_WAIT_L
#undef PG8_BAR
#undef PG8_SCHED
}
}
#define XB_TMO      128
#define XB_XCNT(j)  (256  + 64 * (j))
#define XB_XSUB(j)  (1280 + 64 * (j))
#define XB_XGEN(j)  (2304 + 64 * (j))
#define XB_TOP      3328
#define XB_TOPGEN   3392
#define XCD_BAR_WORDS 3456
#define XB_SPIN_CAP (1u << 18)
#define LAS __attribute__((address_space(3)))

__device__ __forceinline__ unsigned xb_ld(unsigned* p)              { return __hip_atomic_load(p, __ATOMIC_RELAXED, __HIP_MEMORY_SCOPE_AGENT); }
__device__ __forceinline__ unsigned xb_add(unsigned* p, unsigned v) { return __hip_atomic_fetch_add(p, v, __ATOMIC_RELAXED, __HIP_MEMORY_SCOPE_AGENT); }
__device__ __forceinline__ unsigned xb_xcc_id() { return (unsigned)__builtin_amdgcn_s_getreg((3 << 11) | 20) & 0xFu; }
#define XB_SPIN(cond, bar) do { unsigned _sp = 0; while (cond) { __builtin_amdgcn_s_sleep(1); \
    if ((++_sp & 255u) == 0u) { if (xb_ld(&(bar)[XB_TMO])) break; if (_sp > XB_SPIN_CAP) { atomicAdd(&(bar)[XB_TMO], 1u); break; } } } } while (0)

struct XcdBarrier {
    unsigned* bar; unsigned x;
    volatile LAS unsigned* st;
};

__device__ __forceinline__ XcdBarrier xcd_barrier_post(unsigned* bar, volatile LAS unsigned* st) {
    XcdBarrier b; b.bar = bar; b.x = (unsigned)__builtin_amdgcn_readfirstlane((int)xb_xcc_id()); b.st = st;
    if (threadIdx.x == 0) (void)xb_add(&bar[XB_XCNT(b.x)], 1u);
    return b;
}
__device__ __forceinline__ void xcd_barrier_complete(unsigned* bar, unsigned x, unsigned& nloc, unsigned& nx) {
    const unsigned G = gridDim.x * gridDim.y * gridDim.z;
    unsigned sum, cnt, mine, sp = 0u;
    for (;;) {
        sum = 0u; cnt = 0u; mine = 0u;
#pragma unroll
        for (unsigned j = 0; j < 16; ++j) { const unsigned c = xb_ld(&bar[XB_XCNT(j)]); sum += c; cnt += (c > 0u) ? 1u : 0u; mine = (j == x) ? c : mine; }
        if (sum == G) break;
        __builtin_amdgcn_s_sleep(1);
        if ((++sp & 255u) == 0u) { if (xb_ld(&bar[XB_TMO])) break; if (sp > XB_SPIN_CAP) { atomicAdd(&bar[XB_TMO], 1u); break; } }
    }
    nloc = mine > 0u ? mine : 1u; nx = cnt > 0u ? cnt : 1u;
}

__device__ __forceinline__ void xcd_barrier(const XcdBarrier& b) {
    asm volatile("s_waitcnt vmcnt(0)" ::: "memory");
    __syncthreads();
    if (threadIdx.x == 0) {
        unsigned* bar = b.bar; unsigned bx = b.x; asm volatile("" : "+s"(bx));
        __builtin_amdgcn_s_waitcnt(0);
        unsigned nloc = b.st[0], nx = b.st[1];
        if (nloc == 0u) { xcd_barrier_complete(bar, bx, nloc, nx); b.st[0] = nloc; b.st[1] = nx; }
        const unsigned old = xb_add(&bar[XB_XSUB(bx)], 1u);
        const unsigned gen = old / nloc;
        if (old + 1u == (gen + 1u) * nloc) {
            __builtin_amdgcn_fence(__ATOMIC_RELEASE, "agent");
            asm volatile("s_waitcnt vmcnt(0)" ::: "memory");
            const unsigned og = xb_add(&bar[XB_TOP], 1u);
            const unsigned tg = og / nx;
            if (og + 1u == (tg + 1u) * nx) xb_add(&bar[XB_TOPGEN], 1u);
            else XB_SPIN(xb_ld(&bar[XB_TOPGEN]) == tg, bar);
            __builtin_amdgcn_fence(__ATOMIC_ACQUIRE, "agent");
            xb_add(&bar[XB_XGEN(bx)], 1u);
            asm volatile("s_waitcnt vmcnt(0)" ::: "memory");
        } else {
            XB_SPIN(xb_ld(&bar[XB_XGEN(bx)]) == gen, bar);
            __builtin_amdgcn_fence(__ATOMIC_ACQUIRE, "agent");
            asm volatile("s_waitcnt vmcnt(0)" ::: "memory");
        }
    }
    __syncthreads();
}

extern __shared__ __attribute__((aligned(16))) unsigned char smem[];

DI void convT_tile(const float* __restrict__ src, int ldsrc, bf16_t* __restrict__ dst, int K  , int tile, int ntn, bool inmap) {
    float* t = (float*)smem;
    const int tid = ltid(), tk = tile / ntn, tn = tile % ntn, k0 = tk * 64, n0 = tn * 64;
    __syncthreads();
#pragma unroll
    for (int r = 0; r < 8; ++r) {
        const int i = (tid >> 6) + 8 * r, j = tid & 63, n = n0 + j;
        int sn = n; bool z = false;
        if (inmap) { if (n >= 3104 && n < C_NQ) z = true; else if (n >= C_NQ) sn = n - 224; }
        t[i * 65 + j] = z ? 0.f : src[(size_t)(k0 + i) * ldsrc + sn];
    }
    __syncthreads();
    const int j = tid >> 3, i8 = (tid & 7) * 8;
    u32x4 w;
    w.x = pk2(t[(i8 + 0) * 65 + j], t[(i8 + 1) * 65 + j]); w.y = pk2(t[(i8 + 2) * 65 + j], t[(i8 + 3) * 65 + j]);
    w.z = pk2(t[(i8 + 4) * 65 + j], t[(i8 + 5) * 65 + j]); w.w = pk2(t[(i8 + 6) * 65 + j], t[(i8 + 7) * 65 + j]);
    *(u32x4*)(dst + (size_t)(n0 + j) * K + k0 + i8) = w;
}
DI void phase_convert(const Params& p, int bid, int nb) {
    { bf16_t* wt = (bf16_t*)(lws(p) + OFF_WA2T);
      for (int i = bid * 512 + (int)threadIdx.x; i < DEPTH * 2 * 512 * 16; i += nb * 512) { const int r = i & 15, hd = (i >> 4) & 511, ld = i >> 13; wt[i] = f2bf(p.gla_wa2[((size_t)ld * 16 + r) * 512 + hd]); } }
    for (int l = 0; l < DEPTH; ++l) {
        { const int ntn = NP / 64, nt = (DM / 64) * ntn; bf16_t* d = (bf16_t*)(lws(p) + OFF_WIN) + (size_t)l * NP * DM;
          for (int t = bid; t < nt; t += nb) convT_tile(p.w_in + (size_t)l * DM * IN_TOTAL, IN_TOTAL, d, DM, t, ntn, true); }
        for (int br = 0; br < 3; ++br) { const float* s = (br == 0 ? p.w_br_a : br == 1 ? p.w_br_b : p.w_br_c) + (size_t)l * 1024 * DM;
          const int ntn = DM / 64, nt = (1024 / 64) * ntn; bf16_t* d = (bf16_t*)(lws(p) + OFF_WBR) + (size_t)l * DM * 3072 + br * 1024;
          for (int t = bid; t < nt; t += nb) convT_tile(s, DM, d, 3072, t, ntn, false); }
        { const int ntn = DM / 64, nt = (DM / 64) * ntn; bf16_t* d = (bf16_t*)(lws(p) + OFF_WOUT) + (size_t)l * DM * DM;
          for (int t = bid; t < nt; t += nb) convT_tile(p.w_out + (size_t)l * DM * DM, DM, d, DM, t, ntn, false); }
        { const int ntn = DFF / 64, nt = (DM / 64) * ntn; bf16_t* d = (bf16_t*)(lws(p) + OFF_W1) + (size_t)l * DFF * DM;
          for (int t = bid; t < nt; t += nb) convT_tile(p.w_mlp1 + (size_t)l * DM * DFF, DFF, d, DM, t, ntn, false); }
        { const int ntn = DM / 64, nt = (DFF / 64) * ntn; bf16_t* d = (bf16_t*)(lws(p) + OFF_W2) + (size_t)l * DM * DFF;
          for (int t = bid; t < nt; t += nb) convT_tile(p.w_mlp2 + (size_t)l * DFF * DM, DM, d, DFF, t, ntn, false); }
    }
}

DI void phase_adaln(const Params& p, int bid, int nb) {
    float* sc = (float*)smem;
    float* red = sc + NCOND * DM;
    const int tid = ltid();
    __syncthreads();
    for (int i = tid; i < NCOND * DM; i += 512) { const int r = i / DM, k = i % DM; const float v = r == 0 ? p.c_ctx[k] : p.c[(size_t)(r - 1) * DM + k]; sc[i] = v * sigmoidf_(v); }
    __syncthreads();
    const int nun = DEPTH * (NMOD * DM / 64);
    for (int u = bid; u < nun; u += nb) {
        const int l = u / (NMOD * DM / 64), j0 = (u % (NMOD * DM / 64)) * 64, j = tid & 63, ks = tid >> 6;
        const float* w = p.w_mod + (size_t)l * DM * (NMOD * DM) + j0 + j;
        float acc[NCOND];
#pragma unroll
        for (int r = 0; r < NCOND; ++r) acc[r] = 0.f;
        for (int k = ks * 256; k < ks * 256 + 256; ++k) { const float wv = w[(size_t)k * (NMOD * DM)];
#pragma unroll
            for (int r = 0; r < NCOND; ++r) acc[r] += sc[r * DM + k] * wv; }
#pragma unroll
        for (int r = 0; r < NCOND; ++r) red[(ks * NCOND + r) * 64 + j] = acc[r];
        __syncthreads();
        for (int i = tid; i < NCOND * 64; i += 512) { const int r = i / 64, jj = i % 64; float s = p.b_mod[(size_t)l * NMOD * DM + j0 + jj];
#pragma unroll
            for (int q = 0; q < 8; ++q) s += red[(q * NCOND + r) * 64 + jj];
            ((float*)(lws(p) + OFF_MOD))[((size_t)l * NCOND + r) * (NMOD * DM) + j0 + jj] = s; }
        __syncthreads();
    }
}

DI void phase_hyena_hid(const Params& p, int bid, int nb) {
    float* zf = (float*)smem;
    float* h1 = zf + 8 * 36;
    const int tid = ltid(), tt = tid >> 6, j = tid & 63;
    const int nun = DEPTH * (256 / 8 + 4096 / 8);
    for (int u = bid; u < nun; u += nb) {
        const int l = u / 544, r = u % 544, ls = r < 32 ? 0 : 1, tb = ls ? r - 32 : r, L = ls ? 4096 : 256, t = tb * 8 + tt;
        const float tn = (float)t / (float)L;
        __syncthreads();
        if (j < 33) { float v; if (j == 0) v = tn; else { const int band = j <= 16 ? j : j - 16; const float ang = 6.283185307179586f * tn * (float)band; v = j <= 16 ? cosf(ang) : sinf(ang); } zf[tt * 36 + j] = v; }
        __syncthreads();
        const float fr = p.hy_freq[l * 64 + j];
        float a = p.hy_f1_b[l * 64 + j];
        for (int i = 0; i < 33; ++i) a += zf[tt * 36 + i] * p.hy_f1_w[((size_t)l * 33 + i) * 64 + j];
        h1[tt * 64 + j] = sinf(fr * a);
        __syncthreads();
        float b = p.hy_f2_b[l * 64 + j];
        for (int i = 0; i < 64; ++i) b += h1[tt * 64 + i] * p.hy_f2_w[((size_t)l * 64 + i) * 64 + j];
        ((float*)(lws(p) + OFF_HID))[(((size_t)l * 2 + ls) * 4096 + t) * 64 + j] = sinf(fr * b);
    }
}
DI bf16_t* filt_ptr(unsigned char* ws, int l, int ls) { return (bf16_t*)(ws + OFF_FILT + (size_t)l * FILT_L) + (ls ? (size_t)2 * 1024 * (256 + 232) : 0); }
DI void phase_filters(const Params& p, int bid, int nb) {
    float* f3s = (float*)smem;
    float* red = f3s + 256;
    const int tid = ltid();
    const int nun = DEPTH * 2 * 512;
    const int tid0 = tid;
    for (int u = bid; u < nun; u += nb) {
        int tid = tid0; asm volatile("" : "+v"(tid));
        const int lane = tid & 63, wid = tid >> 6;
        const int l = u / 1024, ls = (u / 512) & 1, cg = u % 512, L = ls ? 4096 : 256, col0 = cg * 4;
        __syncthreads();
        if (tid < 256) f3s[tid] = p.hy_f3_w[((size_t)l * 64 + (tid >> 2)) * 2048 + col0 + (tid & 3)];
        __syncthreads();
        const float* hid = (const float*)(lws(p) + OFF_HID) + ((size_t)l * 2 + ls) * 4096 * 64;
        float val[8][4]; float ss[4] = {0.f, 0.f, 0.f, 0.f};
        float delta[4];
#pragma unroll
        for (int cc = 0; cc < 4; ++cc) { const int c = (col0 + cc) & 1023; const float a = -3.0701134573253943f, b = -15.350567286626972f; delta[cc] = fabsf(a + (b - a) * ((float)c / 1023.0f)); }
#pragma unroll
        for (int i = 0; i < 8; ++i) {
            const int t = tid + 512 * i;
#pragma unroll
            for (int cc = 0; cc < 4; ++cc) val[i][cc] = 0.f;
            if (t < L) {
                const f32x4* hr = (const f32x4*)(hid + (size_t)t * 64);
                float a0 = 0.f, a1 = 0.f, a2 = 0.f, a3 = 0.f;
#pragma unroll
                for (int q = 0; q < 16; ++q) { const f32x4 hv = hr[q];
#pragma unroll
                    for (int e = 0; e < 4; ++e) { const f32x4 w = *(const f32x4*)(f3s + (q * 4 + e) * 4); a0 += hv[e] * w[0]; a1 += hv[e] * w[1]; a2 += hv[e] * w[2]; a3 += hv[e] * w[3]; } }
                const float dist = fabsf((float)t - (float)(L / 2)) * (2.0f / (float)L);
                val[i][0] = a0 * expf(-dist * delta[0]); val[i][1] = a1 * expf(-dist * delta[1]); val[i][2] = a2 * expf(-dist * delta[2]); val[i][3] = a3 * expf(-dist * delta[3]);
#pragma unroll
                for (int cc = 0; cc < 4; ++cc) ss[cc] += val[i][cc] * val[i][cc];
            }
        }
#pragma unroll
        for (int cc = 0; cc < 4; ++cc) { ss[cc] = wave_sum(ss[cc], lane); if (lane == 0) red[wid * 4 + cc] = ss[cc]; }
        __syncthreads();
        float sc[4];
#pragma unroll
        for (int cc = 0; cc < 4; ++cc) { float s = 0.f;
#pragma unroll
            for (int q = 0; q < 8; ++q) s += red[q * 4 + cc]; sc[cc] = rsqrtf(s + EPS); }
        bf16_t* fo = filt_ptr(lws(p), l, ls);
        const int LF = L + 232;
        int tid2 = tid; asm volatile("" : "+v"(tid2));
#pragma unroll
        for (int i = 0; i < 8; ++i) { const int t = tid2 + 512 * i; if (t < L) {
#pragma unroll
            for (int cc = 0; cc < 4; ++cc) { const int col = col0 + cc; fo[((size_t)(col >> 10) * 1024 + (col & 1023)) * LF + (L + 87 - t)] = f2bf(val[i][cc] * sc[cc]); } } }
        if (tid < 232) { const int xx = tid < 88 ? tid : L + tid;
#pragma unroll
            for (int cc = 0; cc < 4; ++cc) { const int col = col0 + cc; fo[((size_t)(col >> 10) * 1024 + (col & 1023)) * LF + xx] = (bf16_t)0; } }
    }
}

DI int cond_row(int grp, int row) { return grp == 0 ? 0 : 1 + 2 * (grp - 1) + (row >> 12); }
DI void phase_norm(const Params& p, const float* x, const float* g, int l, int grp, int shoff, int scoff, int bid, int nb) {
    const int tid = ltid(), lane = tid & 63, wid = tid >> 6;
    bf16_t* h = (bf16_t*)(lws(p) + OFF_H);
    for (int row = bid * 8 + wid; row < GT; row += nb * 8) {
        const float* xr = x + (size_t)row * DM;
        f32x4 v[8]; float ss = 0.f;
#pragma unroll
        for (int i = 0; i < 8; ++i) { v[i] = *(const f32x4*)(xr + i * 256 + lane * 4); ss += v[i][0] * v[i][0] + v[i][1] * v[i][1] + v[i][2] * v[i][2] + v[i][3] * v[i][3]; }
        ss = wave_sum(ss, lane);
        const float rs = rsqrtf(ss * (1.0f / DM) + EPS);
        const float* md = (const float*)(lws(p) + OFF_MOD) + ((size_t)l * NCOND + cond_row(grp, row)) * (NMOD * DM);
#pragma unroll
        for (int i = 0; i < 8; ++i) { const int c = i * 256 + lane * 4; const f32x4 gv = *(const f32x4*)(g + c), sh = *(const f32x4*)(md + shoff + c), sc = *(const f32x4*)(md + scoff + c);
            f32x4 o = v[i] * rs * gv * (sc + 1.0f) + sh; u32x2 w; w.x = pk2(o[0], o[1]); w.y = pk2(o[2], o[3]); *(u32x2*)(h + (size_t)row * DM + c) = w; }
    }
}
using pg8::Unit; using pg8::cvt_pk_bf16;
template <int ACT> struct EpiStoreBf16 {
    static constexpr bool PERM = true, AFTER_DRAIN = false, KHOOK = false;
    bf16_t* O; int ldc; int pad;
    __device__ __forceinline__ void operator()(const f32x4 (&acc)[2][2][4][2], const Unit& u, int wr, int wc, int fr, int fq) const {
        const int row0 = u.pm * 256 + wr * 64 + fr, col0 = u.pn * 256 + wc * 32 + 8 * fq;
#pragma unroll
        for (int ai = 0; ai < 2; ++ai)
#pragma unroll
            for (int m = 0; m < 4; ++m) { bf16_t* rowp = O + (size_t)(row0 + ai * 128 + m * 16) * ldc + col0;
#pragma unroll
                for (int bj = 0; bj < 2; ++bj) { f32x4 v0 = acc[ai][bj][m][0], v1 = acc[ai][bj][m][1];
                    if (ACT == 1) {
#pragma unroll
                        for (int j = 0; j < 4; ++j) { const float a = fmaxf(v0[j], 0.f), b = fmaxf(v1[j], 0.f); v0[j] = a * a; v1[j] = b * b; } }
                    u32x4 w; w.x = cvt_pk_bf16(v0[0], v0[1]); w.y = cvt_pk_bf16(v0[2], v0[3]); w.z = cvt_pk_bf16(v1[0], v1[1]); w.w = cvt_pk_bf16(v1[2], v1[3]);
                    *(u32x4*)(rowp + bj * 128) = w; } }
    }
};
struct EpiGate3 {
    static constexpr bool PERM = true, AFTER_DRAIN = false, KHOOK = true;
    static constexpr int kh0 = 16, kh1 = 32;
    const bf16_t* gate; bf16_t* mbf; int ldg; int pad;
    __device__ __forceinline__ void khook(f32x4 (&acc)[2][2][4][2], const Unit& u, int t, int wr, int wc, int fr, int fq) const {
        typedef const __attribute__((address_space(1))) unsigned char* gptr;
        typedef const __attribute__((address_space(1))) u32x4* gvec;
        const gptr gb = (gptr)gate;
        int fr_ = fr, fq_ = fq; asm volatile("" : "+v"(fr_), "+v"(fq_));
        const int bn = (t == kh0) ? 0 : DM;
        const unsigned off0 = (unsigned)(((u.pm * 256 + wr * 64 + fr_) * NP + bn + u.pn * 256 + wc * 32 + 8 * fq_) * 2);
#pragma unroll
        for (int ai = 0; ai < 2; ++ai) {
            u32x4 nw[4][2], dw[4][2];
#pragma unroll
            for (int m = 0; m < 4; ++m)
#pragma unroll
                for (int bj = 0; bj < 2; ++bj) { const unsigned off = off0 + (unsigned)((ai * 128 + m * 16) * NP * 2 + bj * 256);
                    nw[m][bj] = *(gvec)(gb + off); dw[m][bj] = *(gvec)(gb + off + DM * 2); }
#pragma unroll
            for (int m = 0; m < 4; ++m)
#pragma unroll
                for (int bj = 0; bj < 2; ++bj) {
                    float r[8];
#pragma unroll
                    for (int j = 0; j < 4; ++j) { r[2 * j] = (1.0f + __expf(-bflo(dw[m][bj][j]))) * __builtin_amdgcn_rcpf(1.0f + __expf(-bflo(nw[m][bj][j])));
                                                  r[2 * j + 1] = (1.0f + __expf(-bfhi(dw[m][bj][j]))) * __builtin_amdgcn_rcpf(1.0f + __expf(-bfhi(nw[m][bj][j]))); }
                    acc[ai][bj][m][0] *= (f32x4){r[0], r[1], r[2], r[3]}; acc[ai][bj][m][1] *= (f32x4){r[4], r[5], r[6], r[7]}; }
            asm volatile("" ::: "memory");
        }
    }
    __device__ __forceinline__ void operator()(const f32x4 (&acc)[2][2][4][2], const Unit& u, int wr, int wc, int fr, int fq) const {
        const int row0 = u.pm * 256 + wr * 64 + fr, col0 = u.pn * 256 + wc * 32 + 8 * fq;
#pragma unroll
        for (int ai = 0; ai < 2; ++ai)
#pragma unroll
            for (int m = 0; m < 4; ++m) { const size_t row = (size_t)(row0 + ai * 128 + m * 16);
#pragma unroll
                for (int bj = 0; bj < 2; ++bj) { const int col = col0 + bj * 128;
                    const u32x4 gw = *(const u32x4*)(gate + row * ldg + 2 * DM + col);
                    f32x4 s0, s1;
                    s0[0] = sigmoidf_(bflo(gw.x)); s0[1] = sigmoidf_(bfhi(gw.x)); s0[2] = sigmoidf_(bflo(gw.y)); s0[3] = sigmoidf_(bfhi(gw.y));
                    s1[0] = sigmoidf_(bflo(gw.z)); s1[1] = sigmoidf_(bfhi(gw.z)); s1[2] = sigmoidf_(bflo(gw.w)); s1[3] = sigmoidf_(bfhi(gw.w));
                    const f32x4 v0 = acc[ai][bj][m][0] * s0, v1 = acc[ai][bj][m][1] * s1;
                    u32x4 w; w.x = cvt_pk_bf16(v0[0], v0[1]); w.y = cvt_pk_bf16(v0[2], v0[3]); w.z = cvt_pk_bf16(v1[0], v1[1]); w.w = cvt_pk_bf16(v1[2], v1[3]);
                    *(u32x4*)(mbf + row * DM + col) = w; } }
    }
};
struct EpiResid {
    static constexpr bool PERM = true, AFTER_DRAIN = false, KHOOK = false;
    const float* xin; float* xout; const float* gA; const float* gB;
    __device__ __forceinline__ void operator()(const f32x4 (&acc)[2][2][4][2], const Unit& u, int wr, int wc, int fr, int fq) const {
        const int row0 = u.pm * 256 + wr * 64 + fr, col0 = u.pn * 256 + wc * 32 + 8 * fq;
        const float* gv = (u.pm * 256 < 4096) ? gA : gB;
#pragma unroll
        for (int bj = 0; bj < 2; ++bj) { const int col = col0 + bj * 128; const f32x4 g0 = *(const f32x4*)(gv + col), g1 = *(const f32x4*)(gv + col + 4);
#pragma unroll
            for (int ai = 0; ai < 2; ++ai)
#pragma unroll
                for (int m = 0; m < 4; ++m) { const size_t o = (size_t)(row0 + ai * 128 + m * 16) * DM + col;
                    const f32x4 a0 = *(const f32x4*)(xin + o), a1 = *(const f32x4*)(xin + o + 4);
                    *(f32x4*)(xout + o) = a0 + g0 * acc[ai][bj][m][0]; *(f32x4*)(xout + o + 4) = a1 + g1 * acc[ai][bj][m][1]; } }
    }
};

struct GrpInfo { int grp, l, L, nseq, latent; };
DI GrpInfo grp_info(int grp, int l) { GrpInfo g; g.grp = grp; g.l = l; g.latent = grp > 0; g.L = grp ? 4096 : 256; g.nseq = grp ? 2 : 32; return g; }

template <bool WITH_OI> DI void phase_gla_post(const Params& p, GrpInfo gi, int bid, int nb) {
    const int tid = ltid(), lane = tid & 63, wid = tid >> 6;
    const bf16_t* P = (const bf16_t*)(lws(p) + OFF_P);
    const float* Of = (const float*)(lws(p) + OFF_OF); const float* Ob = (const float*)(lws(p) + OFF_OB); const float* Oi = (const float*)(lws(p) + OFF_OI);
    bf16_t* OA = (bf16_t*)(lws(p) + OFF_OABC);
    const int e0 = (lane & 15) * 16;
    f32x4 g[4];
#pragma unroll
    for (int i = 0; i < 4; ++i) g[i] = *(const f32x4*)(p.gla_norm_g + gi.l * 256 + e0 + 4 * i);
    for (int row = bid * 8 + wid; row < GT; row += nb * 8) {
        const size_t o = (size_t)row * 1024 + lane * 16;
        f32x4 v[4]; u32x4 gw[2];
#pragma unroll
        for (int i = 0; i < 4; ++i) { v[i] = *(const f32x4*)(Of + o + 4 * i) + *(const f32x4*)(Ob + o + 4 * i); if (WITH_OI) v[i] += *(const f32x4*)(Oi + o + 4 * i); }
#pragma unroll
        for (int i = 0; i < 2; ++i) gw[i] = *(const u32x4*)(P + (size_t)row * NP + C_GG + lane * 16 + 8 * i);
        float ss = 0.f;
#pragma unroll
        for (int i = 0; i < 4; ++i) ss += v[i][0] * v[i][0] + v[i][1] * v[i][1] + v[i][2] * v[i][2] + v[i][3] * v[i][3];
#pragma unroll
        for (int x = 8; x >= 1; x >>= 1) ss += __int_as_float(__builtin_amdgcn_ds_bpermute((lane ^ x) << 2, __float_as_int(ss)));
        const float rs = rsqrtf(ss * (1.0f / 256) + EPS);
        u32x4 w[2];
#pragma unroll
        for (int i = 0; i < 4; ++i) {
            const unsigned ga = gw[i >> 1][2 * (i & 1)], gb = gw[i >> 1][2 * (i & 1) + 1];
            const float g0 = bflo(ga), g1 = bfhi(ga), g2 = bflo(gb), g3 = bfhi(gb);
            w[i >> 1][2 * (i & 1)] = pk2(v[i][0] * rs * g[i][0] * (g0 * sigmoidf_(g0)), v[i][1] * rs * g[i][1] * (g1 * sigmoidf_(g1)));
            w[i >> 1][2 * (i & 1) + 1] = pk2(v[i][2] * rs * g[i][2] * (g2 * sigmoidf_(g2)), v[i][3] * rs * g[i][3] * (g3 * sigmoidf_(g3)));
        }
        bf16_t* oa = OA + (size_t)row * 3072 + lane * 16;
        *(u32x4*)oa = w[0]; *(u32x4*)(oa + 8) = w[1];
    }
}
typedef short bf16x8 __attribute__((ext_vector_type(8)));
typedef short bf16x4 __attribute__((ext_vector_type(4)));
#define MFMA16(a, b, c) __builtin_amdgcn_mfma_f32_16x16x32_bf16((a), (b), (c), 0, 0, 0)
constexpr int QKP = 136;
constexpr int TP = 80;
DI float log_sigmoid_fast(float x) { return fminf(x, 0.f) - __logf(1.0f + __expf(-fabsf(x))); }
DI bf16x8 pack8(const f32x4& a, const f32x4& b) { u32x4 w; w.x = pk2(a[0], a[1]); w.y = pk2(a[2], a[3]); w.z = pk2(b[0], b[1]); w.w = pk2(b[2], b[3]); return __builtin_bit_cast(bf16x8, w); }

DI void gla_prep_unit(const Params& p, const GrpInfo gi, int unit, int tid_in) {
    int tid = tid_in; asm volatile("" : "+v"(tid));
    const int cg = unit >> 2, h = unit & 3, row0 = cg * 64, t0 = row0 & (gi.L - 1), l = gi.l;
    const int lane = tid & 63, wid = tid >> 6, r16 = lane & 15, q4 = lane >> 4;
    float* laf = (float*)smem; float* lab = laf + 8192;
    bf16_t* QFs = (bf16_t*)(smem + 65536); bf16_t* KFs = QFs + 64 * QKP; bf16_t* QBs = KFs + 64 * QKP; bf16_t* KBs = QBs + 64 * QKP;
    bf16_t* VTs = (bf16_t*)smem; bf16_t* As = (bf16_t*)(smem + 40960);
    const bf16_t* P = (const bf16_t*)(lws(p) + OFF_P);
    u32x4 pq[4], pvv[4];
    { const int t = tid >> 3, dlo = (tid & 7) * 8; const bf16_t* pr = P + (size_t)(row0 + t) * NP + h * 128;
      pq[0] = *(const u32x4*)(pr + C_GQ + dlo); pq[1] = *(const u32x4*)(pr + C_GQ + 64 + dlo); pq[2] = *(const u32x4*)(pr + C_GK + dlo); pq[3] = *(const u32x4*)(pr + C_GK + 64 + dlo);
      const bf16_t* pv = P + (size_t)(row0 + t) * NP + C_GV + h * 256 + (tid & 7) * 32;
#pragma unroll
      for (int i = 0; i < 4; ++i) pvv[i] = *(const u32x4*)(pv + 8 * i); }
    bf16_t* laT = (bf16_t*)(smem + 65536);
    __syncthreads();
    {
        const int dir = wid >> 2;
        const bf16_t* wt = (const bf16_t*)(lws(p) + OFF_WA2T) + ((((size_t)l * 2 + dir) * 4 + h) * 128) * 16;
        bf16x8 bfr[2]; float bav[2];
#pragma unroll
        for (int n = 0; n < 2; ++n) { const int d = 16 * (2 * (wid & 3) + n) + r16;
            const u32x4 w = ((q4 >> 1) == dir) ? *(const u32x4*)(wt + (size_t)d * 16 + 8 * (q4 & 1)) : (u32x4){0u, 0u, 0u, 0u};
            bfr[n] = __builtin_bit_cast(bf16x8, w); bav[n] = p.gla_ba2[((size_t)l * 2 + dir) * 512 + h * 128 + d]; }
#pragma unroll
        for (int mt = 0; mt < 4; ++mt) {
            const bf16x8 af = *(const bf16x8*)(P + (size_t)(row0 + 16 * mt + r16) * NP + C_GA + 8 * q4);
#pragma unroll
            for (int n = 0; n < 2; ++n) { const int d = 16 * (2 * (wid & 3) + n) + r16;
                const f32x4 x = MFMA16(af, bfr[n], ((f32x4){0.f, 0.f, 0.f, 0.f}));
                u32x2 w; w.x = pk2(log_sigmoid_fast(x[0] + bav[n]) * 0.0625f, log_sigmoid_fast(x[1] + bav[n]) * 0.0625f); w.y = pk2(log_sigmoid_fast(x[2] + bav[n]) * 0.0625f, log_sigmoid_fast(x[3] + bav[n]) * 0.0625f);
                *(u32x2*)(laT + ((size_t)(dir * 128 + d)) * TP + 16 * mt + 4 * q4) = w; }
        }
    }
    __syncthreads();
    {
        const int dir = wid >> 2;
        float* bdst = dir ? lab : laf;
#pragma unroll
        for (int n = 0; n < 2; ++n) { const int d = 16 * (2 * (wid & 3) + n) + r16;
            bf16x8 bl[2];
#pragma unroll
            for (int ks = 0; ks < 2; ++ks) bl[ks] = *(const bf16x8*)(laT + ((size_t)(dir * 128 + d)) * TP + 32 * ks + 8 * q4);
#pragma unroll
            for (int mt = 0; mt < 4; ++mt) { f32x4 acc = (f32x4){0.f, 0.f, 0.f, 0.f};
#pragma unroll
                for (int ks = 0; ks < 2; ++ks) { const int t = 16 * mt + r16; bf16x8 tri;
#pragma unroll
                    for (int j = 0; j < 8; ++j) { const int s2 = 32 * ks + 8 * q4 + j; tri[j] = (short)((dir ? (s2 >= t) : (s2 <= t)) ? 0x3F80 : 0); }
                    acc = MFMA16(tri, bl[ks], acc); }
#pragma unroll
                for (int i = 0; i < 4; ++i) bdst[(16 * mt + 4 * q4 + i) * 128 + d] = acc[i]; }
        }
    }
    __syncthreads();
    {
        const int t = tid >> 3, dlo = (tid & 7) * 8, ta = t0 + t;
        const u32x4 qlw = pq[0], qhw = pq[1], klw = pq[2], khw = pq[3];
        float ql[8], qh[8], kl[8], kh[8];
#pragma unroll
        for (int j = 0; j < 4; ++j) { ql[2 * j] = bflo(qlw[j]); ql[2 * j + 1] = bfhi(qlw[j]); qh[2 * j] = bflo(qhw[j]); qh[2 * j + 1] = bfhi(qhw[j]); kl[2 * j] = bflo(klw[j]); kl[2 * j + 1] = bfhi(klw[j]); kh[2 * j] = bflo(khw[j]); kh[2 * j + 1] = bfhi(khw[j]); }
#pragma unroll
        for (int j = 0; j < 8; ++j) {
            ql[j] *= 0.08838834764831845f; qh[j] *= 0.08838834764831845f;
            if (gi.latent) {
                const int ii = dlo + j, f = ii & 31; const float pos = (float)(ii < 32 ? (ta >> 6) : (ta & 63));
                const float ang = pos * exp2f(-(float)f * 0.41524101186092029f); const float sn = __sinf(ang), cs = __cosf(ang);
                const float a = ql[j] * cs - qh[j] * sn, b = ql[j] * sn + qh[j] * cs; ql[j] = a; qh[j] = b;
                const float c = kl[j] * cs - kh[j] * sn, e = kl[j] * sn + kh[j] * cs; kl[j] = c; kh[j] = e;
            }
        }
        float* DEC = (float*)(lws(p) + OFF_DEC);
#pragma unroll
        for (int dir = 0; dir < 2; ++dir) {
            const float* bb = dir ? lab : laf;
            bf16_t* Qs = dir ? QBs : QFs; bf16_t* Ks = dir ? KBs : KFs;
            bf16_t* Qg = (bf16_t*)(lws(p) + (dir ? OFF_QB : OFF_QF)) + (size_t)(row0 + t) * 512 + h * 128;
#pragma unroll
            for (int half = 0; half < 2; ++half) {
                const int d = dlo + 64 * half;
                const f32x4 b0 = *(const f32x4*)(bb + t * 128 + d), b1 = *(const f32x4*)(bb + t * 128 + d + 4);
                float qo[8], ko[8];
#pragma unroll
                for (int j = 0; j < 8; ++j) { const float bv = j < 4 ? b0[j] : b1[j - 4]; const float qv = half ? qh[j] : ql[j], kv = half ? kh[j] : kl[j]; qo[j] = qv * __expf(bv); ko[j] = kv * __expf(-bv); }
                u32x4 qw, kw; qw.x = pk2(qo[0], qo[1]); qw.y = pk2(qo[2], qo[3]); qw.z = pk2(qo[4], qo[5]); qw.w = pk2(qo[6], qo[7]);
                kw.x = pk2(ko[0], ko[1]); kw.y = pk2(ko[2], ko[3]); kw.z = pk2(ko[4], ko[5]); kw.w = pk2(ko[6], ko[7]);
                *(u32x4*)(Qs + t * QKP + d) = qw; *(u32x4*)(Ks + t * QKP + d) = kw; *(u32x4*)(Qg + d) = qw;
                if (t == 0) { const int te = dir ? 0 : 63; const f32x4 e0 = *(const f32x4*)(bb + te * 128 + d), e1 = *(const f32x4*)(bb + te * 128 + d + 4);
                    f32x4 x0, x1;
#pragma unroll
                    for (int j = 0; j < 4; ++j) { x0[j] = __expf(e0[j]); x1[j] = __expf(e1[j]); }
                    float* dp = DEC + ((size_t)dir * 128 + cg) * 512 + h * 128 + d; *(f32x4*)dp = x0; *(f32x4*)(dp + 4) = x1; }
            }
        }
    }
    __syncthreads();
    {
        const int s = tid >> 3, e0 = (tid & 7) * 32;
#pragma unroll
        for (int i = 0; i < 4; ++i) { const u32x4 w = pvv[i];
#pragma unroll
            for (int j = 0; j < 4; ++j) { VTs[(e0 + 8 * i + 2 * j) * TP + s] = (bf16_t)(w[j] & 0xffffu); VTs[(e0 + 8 * i + 2 * j + 1) * TP + s] = (bf16_t)(w[j] >> 16); } }
        const int mt = wid >> 1, nt0 = 2 * (wid & 1);
        f32x4 acc[2][2];
#pragma unroll
        for (int dir = 0; dir < 2; ++dir) { const bf16_t* Qs = dir ? QBs : QFs; const bf16_t* Ks = dir ? KBs : KFs;
#pragma unroll
            for (int n = 0; n < 2; ++n) acc[dir][n] = (f32x4){0.f, 0.f, 0.f, 0.f};
#pragma unroll
            for (int ks = 0; ks < 4; ++ks) { const bf16x8 a = *(const bf16x8*)(Qs + (16 * mt + r16) * QKP + 32 * ks + 8 * q4);
#pragma unroll
                for (int n = 0; n < 2; ++n) { const bf16x8 b = *(const bf16x8*)(Ks + (16 * (nt0 + n) + r16) * QKP + 32 * ks + 8 * q4); acc[dir][n] = MFMA16(a, b, acc[dir][n]); } } }
#pragma unroll
        for (int n = 0; n < 2; ++n)
#pragma unroll
            for (int i = 0; i < 4; ++i) { const int t = 16 * mt + 4 * q4 + i, s2 = 16 * (nt0 + n) + r16;
                const float v = (s2 <= t ? acc[0][n][i] : 0.f) + (s2 >= t ? acc[1][n][i] : 0.f); As[t * TP + s2] = f2bf(v); }
        const int d = tid >> 2, sq = tid & 3;
#pragma unroll
        for (int dir = 0; dir < 2; ++dir) { const bf16_t* Ks = dir ? KBs : KFs; unsigned w[8];
#pragma unroll
            for (int j = 0; j < 8; ++j) w[j] = (unsigned)Ks[(sq * 16 + 2 * j) * QKP + d] | ((unsigned)Ks[(sq * 16 + 2 * j + 1) * QKP + d] << 16);
            bf16_t* kg = (bf16_t*)(lws(p) + (dir ? OFF_KBT : OFF_KFT)) + (((size_t)cg * 4 + h) * 128 + d) * 64 + sq * 16;
            *(u32x4*)kg = (u32x4){w[0], w[1], w[2], w[3]}; *(u32x4*)(kg + 8) = (u32x4){w[4], w[5], w[6], w[7]}; }
    }
    __syncthreads();
    {
        const int e = tid >> 1, hf = tid & 1;
        bf16_t* vg = (bf16_t*)(lws(p) + OFF_VT) + (((size_t)cg * 4 + h) * 256 + e) * 64 + hf * 32;
#pragma unroll
        for (int i = 0; i < 4; ++i) *(u32x4*)(vg + 8 * i) = *(const u32x4*)(VTs + e * TP + hf * 32 + 8 * i);
        float* OI = (float*)(lws(p) + OFF_OI);
#pragma unroll
        for (int n = 0; n < 2; ++n) { const int nt = 2 * wid + n;
            bf16x8 b[2];
#pragma unroll
            for (int ks = 0; ks < 2; ++ks) b[ks] = *(const bf16x8*)(VTs + (16 * nt + r16) * TP + 32 * ks + 8 * q4);
#pragma unroll
            for (int mt = 0; mt < 4; ++mt) { f32x4 acc = (f32x4){0.f, 0.f, 0.f, 0.f};
#pragma unroll
                for (int ks = 0; ks < 2; ++ks) { const bf16x8 a = *(const bf16x8*)(As + (16 * mt + r16) * TP + 32 * ks + 8 * q4); acc = MFMA16(a, b[ks], acc); }
#pragma unroll
                for (int i = 0; i < 4; ++i) OI[(size_t)(row0 + 16 * mt + 4 * q4 + i) * 1024 + h * 256 + 16 * nt + r16] = acc[i]; } }
    }
}
DI void phase_gla_prep(const Params& p, const GrpInfo gi, int bid, int nb) {
    const int tid = ltid();
    for (int u = bid; u < 512; u += nb) gla_prep_unit(p, gi, u, tid);
}

constexpr int SC_Q = 0, SC_K = 64 * QKP * 2, SC_V = SC_K + 128 * TP * 2, SC_D = SC_V + 128 * TP * 2, SC_BUF = SC_D + 512;
DI void gla_scan_unit(const Params& p, const GrpInfo gi, int unit, int tid_in) {
    int tid = tid_in; asm volatile("" : "+v"(tid));
    const int sl = unit >> 4, h = (unit >> 2) & 3, dir = (unit >> 1) & 1, eh = unit & 1, L = gi.L, NC = L >> 6, l = gi.l;
    const int lane = tid & 63, wid = tid >> 6, r16 = lane & 15, q4 = lane >> 4;
    const int ecol = eh * 128 + 16 * wid + r16;
    f32x4 S[8];
    if (gi.latent) { const int bs = 2 * (gi.grp - 1) + sl; const float* s0 = p.state_gla + ((((size_t)bs * DEPTH + l) * 2 + dir) * 4 + h) * 128 * 256 + ecol;
#pragma unroll
        for (int T = 0; T < 8; ++T)
#pragma unroll
            for (int i = 0; i < 4; ++i) S[T][i] = s0[(size_t)(16 * T + 4 * q4 + i) * 256]; }
    else {
#pragma unroll
        for (int T = 0; T < 8; ++T) S[T] = (f32x4){0.f, 0.f, 0.f, 0.f}; }
    const bf16_t* Qg = (const bf16_t*)(lws(p) + (dir ? OFF_QB : OFF_QF)); const bf16_t* Kg = (const bf16_t*)(lws(p) + (dir ? OFF_KBT : OFF_KFT)); const bf16_t* Vg = (const bf16_t*)(lws(p) + OFF_VT);
    const float* Dg = (const float*)(lws(p) + OFF_DEC) + (size_t)dir * 128 * 512;
    float* Og = (float*)(lws(p) + (dir ? OFF_OB : OFF_OF));
    u32x4 rq[2], rk[2], rv[2]; float rd = 0.f;
    const int qt0 = tid >> 4, qd = (tid & 15) * 8;
    const int kd0 = tid >> 3, ks8 = (tid & 7) * 8;
#define GLA_LOAD(c) do { const int cg_ = sl * NC + (c); const size_t r0_ = (size_t)cg_ * 64; \
        rq[0] = *(const u32x4*)(Qg + (r0_ + qt0) * 512 + h * 128 + qd); rq[1] = *(const u32x4*)(Qg + (r0_ + qt0 + 32) * 512 + h * 128 + qd); \
        rk[0] = *(const u32x4*)(Kg + (((size_t)cg_ * 4 + h) * 128 + kd0) * 64 + ks8); rk[1] = *(const u32x4*)(Kg + (((size_t)cg_ * 4 + h) * 128 + kd0 + 64) * 64 + ks8); \
        rv[0] = *(const u32x4*)(Vg + (((size_t)cg_ * 4 + h) * 256 + eh * 128 + kd0) * 64 + ks8); rv[1] = *(const u32x4*)(Vg + (((size_t)cg_ * 4 + h) * 256 + eh * 128 + kd0 + 64) * 64 + ks8); \
        if (tid < 128) rd = Dg[(size_t)cg_ * 512 + h * 128 + tid]; } while (0)
#define GLA_STORE(bufp) do { unsigned char* b_ = (bufp); \
        *(u32x4*)(b_ + SC_Q + (qt0 * QKP + qd) * 2) = rq[0]; *(u32x4*)(b_ + SC_Q + ((qt0 + 32) * QKP + qd) * 2) = rq[1]; \
        *(u32x4*)(b_ + SC_K + (kd0 * TP + ks8) * 2) = rk[0]; *(u32x4*)(b_ + SC_K + ((kd0 + 64) * TP + ks8) * 2) = rk[1]; \
        *(u32x4*)(b_ + SC_V + (kd0 * TP + ks8) * 2) = rv[0]; *(u32x4*)(b_ + SC_V + ((kd0 + 64) * TP + ks8) * 2) = rv[1]; \
        if (tid < 128) *(float*)(b_ + SC_D + tid * 4) = rd; } while (0)
    __syncthreads();
    GLA_LOAD(dir ? NC - 1 : 0);
    GLA_STORE(smem);
    __syncthreads();
    for (int ci = 0; ci < NC; ++ci) {
        const int c = dir ? NC - 1 - ci : ci;
        if (ci + 1 < NC) GLA_LOAD(dir ? c - 1 : c + 1);
        const unsigned char* buf = smem + (ci & 1) * SC_BUF;
        const bf16_t* Qs = (const bf16_t*)(buf + SC_Q); const bf16_t* Kt = (const bf16_t*)(buf + SC_K); const bf16_t* Vt = (const bf16_t*)(buf + SC_V); const float* Dv = (const float*)(buf + SC_D);
        bf16x8 bS[4];
#pragma unroll
        for (int ks = 0; ks < 4; ++ks) bS[ks] = pack8(S[2 * ks], S[2 * ks + 1]);
        const size_t orow0 = ((size_t)(sl * NC + c) * 64);
#pragma unroll
        for (int mt = 0; mt < 4; ++mt) { f32x4 acc = (f32x4){0.f, 0.f, 0.f, 0.f};
#pragma unroll
            for (int ks = 0; ks < 4; ++ks) { const bf16_t* qp = Qs + (16 * mt + r16) * QKP + 32 * ks + 4 * q4;
                const bf16x4 a0 = *(const bf16x4*)qp, a1 = *(const bf16x4*)(qp + 16);
                const bf16x8 a = (bf16x8){a0[0], a0[1], a0[2], a0[3], a1[0], a1[1], a1[2], a1[3]};
                acc = MFMA16(a, bS[ks], acc); }
#pragma unroll
            for (int i = 0; i < 4; ++i) Og[(orow0 + 16 * mt + 4 * q4 + i) * 1024 + h * 256 + ecol] = acc[i]; }
        bf16x8 bv[2];
#pragma unroll
        for (int ks = 0; ks < 2; ++ks) bv[ks] = *(const bf16x8*)(Vt + (16 * wid + r16) * TP + 32 * ks + 8 * q4);
#pragma unroll
        for (int T = 0; T < 8; ++T) {
#pragma unroll
            for (int ks = 0; ks < 2; ++ks) { const bf16x8 a = *(const bf16x8*)(Kt + (16 * T + r16) * TP + 32 * ks + 8 * q4); S[T] = MFMA16(a, bv[ks], S[T]); }
            const f32x4 dv = *(const f32x4*)(Dv + 16 * T + 4 * q4); S[T] *= dv; }
        if (ci + 1 < NC) GLA_STORE(smem + ((ci + 1) & 1) * SC_BUF);
        __syncthreads();
    }
#undef GLA_LOAD
#undef GLA_STORE
    if (!gi.latent) { float* so = lout(p) + OUT_ST + ((((size_t)sl * DEPTH + l) * 2 + dir) * 4 + h) * 128 * 256 + ecol;
#pragma unroll
        for (int T = 0; T < 8; ++T)
#pragma unroll
            for (int i = 0; i < 4; ++i) so[(size_t)(16 * T + 4 * q4 + i) * 256] = S[T][i]; }
}
DI void phase_gla_scan(const Params& p, const GrpInfo gi, int bid, int nb) {
    const int tid = ltid();
    for (int u = bid; u < gi.nseq * 16; u += nb) gla_scan_unit(p, gi, u, tid);
}
typedef float f32x16 __attribute__((ext_vector_type(16)));
#define MFMA32(a, b, c) __builtin_amdgcn_mfma_f32_32x32x16_bf16((a), (b), (c), 0, 0, 0)

DI void phase_hy_prep(const Params& p, const GrpInfo gi, int bid, int nb) {
    const int tid = ltid(), L = gi.L;
    bf16_t* T = (bf16_t*)smem;
    const bf16_t* P = (const bf16_t*)(lws(p) + OFF_P);
    bf16_t* UcT = (bf16_t*)(lws(p) + OFF_UCT);
    const float* cw = p.hy_conv_w + (size_t)gi.l * 3 * 3072; const float* cb = p.hy_conv_b + (size_t)gi.l * 3072;
    for (int u = bid; u < 128 * 12; u += nb) {
        const int rt = u / 12, ct = u % 12, row0 = rt * 64, j0 = ct * 256;
        const int t = tid >> 3, js = tid & 7, row = row0 + t, tpos = row & (L - 1);
        const u32x4 z4 = (u32x4){0u, 0u, 0u, 0u};
        u32x4 um[4], u0[4], up[4];
#pragma unroll
        for (int q4 = 0; q4 < 4; ++q4) { const bf16_t* pr = P + (size_t)row * NP + C_HY + j0 + 64 * q4 + js * 8;
            um[q4] = tpos > 0 ? *(const u32x4*)(pr - NP) : z4; u0[q4] = *(const u32x4*)pr; up[q4] = tpos < L - 1 ? *(const u32x4*)(pr + NP) : z4; }
        __syncthreads();
#pragma unroll
        for (int q4 = 0; q4 < 4; ++q4) { const int j = j0 + 64 * q4 + js * 8;
            const f32x4 b0 = *(const f32x4*)(cb + j), b1 = *(const f32x4*)(cb + j + 4), wa0 = *(const f32x4*)(cw + j), wa1 = *(const f32x4*)(cw + j + 4),
                        wb0 = *(const f32x4*)(cw + 3072 + j), wb1 = *(const f32x4*)(cw + 3072 + j + 4), wc0 = *(const f32x4*)(cw + 6144 + j), wc1 = *(const f32x4*)(cw + 6144 + j + 4);
#pragma unroll
            for (int q = 0; q < 4; ++q) {
                const float ba = q < 2 ? b0[2 * q] : b1[2 * q - 4], bb = q < 2 ? b0[2 * q + 1] : b1[2 * q - 3];
                const float a0 = q < 2 ? wa0[2 * q] : wa1[2 * q - 4], a1 = q < 2 ? wa0[2 * q + 1] : wa1[2 * q - 3];
                const float c0 = q < 2 ? wb0[2 * q] : wb1[2 * q - 4], c1 = q < 2 ? wb0[2 * q + 1] : wb1[2 * q - 3];
                const float e0 = q < 2 ? wc0[2 * q] : wc1[2 * q - 4], e1 = q < 2 ? wc0[2 * q + 1] : wc1[2 * q - 3];
                const float o0 = ba + a0 * bflo(um[q4][q]) + c0 * bflo(u0[q4][q]) + e0 * bflo(up[q4][q]);
                const float o1 = bb + a1 * bfhi(um[q4][q]) + c1 * bfhi(u0[q4][q]) + e1 * bfhi(up[q4][q]);
                T[(64 * q4 + js * 8 + 2 * q) * TP + t] = f2bf(o0); T[(64 * q4 + js * 8 + 2 * q + 1) * TP + t] = f2bf(o1);
            }
        }
        __syncthreads();
#pragma unroll
        for (int q4 = 0; q4 < 4; ++q4) { const int jj = 64 * q4 + (tid >> 3), ts = tid & 7;
            *(u32x4*)(UcT + (size_t)(j0 + jj) * GT + row0 + ts * 8) = *(const u32x4*)(T + jj * TP + ts * 8); }
    }
}
DI void phase_hy_post(const Params& p, const GrpInfo gi, int bid, int nb) {
    const int tid = ltid();
    bf16_t* T = (bf16_t*)smem;
    constexpr int PT = 264;
    const bf16_t* OcT = (const bf16_t*)(lws(p) + OFF_OCT);
    bf16_t* OC = (bf16_t*)(lws(p) + OFF_OABC) + 2048;
    for (int u = bid; u < 128 * 4; u += nb) {
        const int rt = u >> 2, ct = u & 3, row0 = rt * 64, c0 = ct * 256;
        const int cl = tid >> 3, ts = tid & 7;
        u32x4 w[4];
#pragma unroll
        for (int q4 = 0; q4 < 4; ++q4) w[q4] = *(const u32x4*)(OcT + (size_t)(c0 + 64 * q4 + cl) * GT + row0 + ts * 8);
        __syncthreads();
#pragma unroll
        for (int q4 = 0; q4 < 4; ++q4)
#pragma unroll
            for (int q = 0; q < 4; ++q) { T[(ts * 8 + 2 * q) * PT + 64 * q4 + cl] = (bf16_t)(w[q4][q] & 0xffffu); T[(ts * 8 + 2 * q + 1) * PT + 64 * q4 + cl] = (bf16_t)(w[q4][q] >> 16); }
        __syncthreads();
        const int t = tid >> 3, cs = tid & 7;
#pragma unroll
        for (int q4 = 0; q4 < 4; ++q4) *(u32x4*)(OC + (size_t)(row0 + t) * 3072 + c0 + 64 * q4 + cs * 8) = *(const u32x4*)(T + t * PT + 64 * q4 + cs * 8);
    }
}

constexpr int HY_HF = 0;
constexpr int HY_Z = 16384;
constexpr int HY_ZERO = HY_Z + 20480;
constexpr int HY_HC = HY_ZERO + 64;
DI int hy_pitch(int L) { return (L + 224) * 2; }
DI int hy_zoff(int s) { return (s >> 5) * 80 + (s & 31) * 2; }
DI void hy_build_copies(int L, int tid) {
    const unsigned* fr = (const unsigned*)(smem + HY_HF);
    const int nch = (L + 224) / 8, pitch = hy_pitch(L), e = __builtin_amdgcn_readfirstlane(tid >> 6), lane = tid & 63, sh = (e & 1) * 16;
    for (int ch = lane; ch < nch; ch += 64) {
        const unsigned* d = fr + ((8 * ch + e) >> 1);
        const unsigned d0 = d[0], d1 = d[1], d2 = d[2], d3 = d[3], d4 = d[4];
        u32x4 w; w.x = __builtin_amdgcn_alignbit(d1, d0, sh); w.y = __builtin_amdgcn_alignbit(d2, d1, sh); w.z = __builtin_amdgcn_alignbit(d3, d2, sh); w.w = __builtin_amdgcn_alignbit(d4, d3, sh);
        *(u32x4*)(smem + HY_HC + e * pitch + ch * 16) = w;
    }
}
DI f32x16 hy_conv(int L, int lane, int tb_row0  , int t0, int trip_lo, int trip_hi) {
    const int m = lane & 31, kh = lane >> 5, e = (7 - (m & 7)) & 7, pitch = hy_pitch(L);
    const int NTRIP = (L / 16 + 2 + 6) / 8;
    int delta = -(L / 2) - 16 - 48 + 128 * trip_lo;
    int aoff = HY_HC + e * pitch + (L / 2 - 1 - delta - m + 8 * kh - e + 88) * 2;
    f32x16 acc[4];
#pragma unroll
    for (int c = 0; c < 4; ++c)
#pragma unroll
        for (int i = 0; i < 16; ++i) acc[c][i] = 0.f;
    int zo_e = HY_Z + hy_zoff(tb_row0 - delta) + 16 * kh, zo_o = HY_Z + hy_zoff(tb_row0 - delta - 16) + 16 * kh, s0b = t0 - delta;
#define HY_LDB(st) ({ const int s0_ = s0b - 16 * (st); const int zo_ = (((st) & 1) ? zo_o : zo_e) - 80 * ((st) >> 1); \
        const int ad_ = ((unsigned)s0_ <= (unsigned)(L - 16)) ? zo_ : HY_ZERO; *(const bf16x8*)(smem + ad_); })
    bf16x8 a0[4], b0[4], a1[4], b1[4];
#pragma unroll
    for (int j = 0; j < 4; ++j) { a0[j] = *(const bf16x8*)(smem + aoff - 32 * j); b0[j] = HY_LDB(j); a1[j] = *(const bf16x8*)(smem + aoff - 32 * (j + 4)); b1[j] = HY_LDB(j + 4); }
    (void)NTRIP;
    for (int trip = trip_lo; trip < trip_hi; ++trip) {
        aoff -= 256; zo_e -= 320; zo_o -= 320; s0b -= 128;
#pragma unroll
        for (int j = 0; j < 4; ++j) acc[j] = MFMA32(a0[j], b0[j], acc[j]);
#pragma unroll
        for (int j = 0; j < 4; ++j) { a0[j] = *(const bf16x8*)(smem + aoff - 32 * j); b0[j] = HY_LDB(j); }
#pragma unroll
        for (int j = 0; j < 4; ++j) acc[j] = MFMA32(a1[j], b1[j], acc[j]);
#pragma unroll
        for (int j = 0; j < 4; ++j) { a1[j] = *(const bf16x8*)(smem + aoff - 32 * (j + 4)); b1[j] = HY_LDB(j + 4); }
    }
#undef HY_LDB
    return (acc[0] + acc[1]) + (acc[2] + acc[3]);
}
DI void hy_conv_unit(const Params& p, const GrpInfo gi, int c, int tid_in) {
    int tid = tid_in; asm volatile("" : "+v"(tid));
    const int L = gi.L, lane = tid & 63, wid = __builtin_amdgcn_readfirstlane(tid >> 6), n = lane & 31, hi = lane >> 5, LF = L + 232;
    const int g = 32 * wid + n, tpl = L >> 5, b = g / tpl, t0 = (g % tpl) * 32, frow = b * L + t0;
    const bf16_t* UcT = (const bf16_t*)(lws(p) + OFF_UCT);
    bf16_t* OcT = (bf16_t*)(lws(p) + OFF_OCT);
    const bf16_t* f0 = filt_ptr(lws(p), gi.l, gi.latent ? 1 : 0) + (size_t)c * LF;
    const bf16_t* f1 = f0 + (size_t)1024 * LF;
    int trip_lo = 0, trip_hi = (L / 16 + 8) / 8;
    if (L == 4096) { const int T0 = (wid & 3) * 1024; const int slo = (T0 - L / 2 + 80) / 16, shi = (T0 + L / 2 + 1056) / 16; trip_lo = slo > 0 ? slo / 8 : 0; trip_hi = min(trip_hi, shi / 8 + 1); }
    const int npc = LF / 8;
    __syncthreads();
    u32x4 f1r[2];
    {
        const bf16_t* zg = UcT + (size_t)(2048 + c) * GT;
#pragma unroll
        for (int i = 0; i < 2; ++i) { const int s = (tid + 512 * i) * 8; *(u32x4*)(smem + HY_Z + hy_zoff(s)) = *(const u32x4*)(zg + s); }
        if (tid < 4) *(unsigned*)(smem + HY_ZERO + 4 * tid) = 0u;
#pragma unroll
        for (int i = 0; i < 2; ++i) { const int pc = tid + 512 * i; if (pc < npc) { *(u32x4*)(smem + HY_HF + pc * 16) = *(const u32x4*)(f0 + pc * 8); f1r[i] = *(const u32x4*)(f1 + pc * 8); } }
    }
    u32x2 x1w[4], x2w[4];
#pragma unroll
    for (int gq = 0; gq < 4; ++gq) { const int fr = frow + 8 * gq + 4 * hi; x1w[gq] = *(const u32x2*)(UcT + (size_t)c * GT + fr); x2w[gq] = *(const u32x2*)(UcT + (size_t)(1024 + c) * GT + fr); }
    const float bias0 = p.hy_bias[((size_t)gi.l * 2 + 0) * 1024 + c], bias1 = p.hy_bias[((size_t)gi.l * 2 + 1) * 1024 + c];
    __syncthreads();
    hy_build_copies(L, tid);
    __syncthreads();
    f32x16 acc = hy_conv(L, lane, frow, t0, trip_lo, trip_hi);
    u32x2 z1w[4];
#pragma unroll
    for (int gq = 0; gq < 4; ++gq) {
        const int fr = frow + 8 * gq + 4 * hi;
        const u32x2 xw = x1w[gq];
        const u32x2 zw = *(const u32x2*)(smem + HY_Z + hy_zoff(fr));
        const float o0 = bflo(xw.x) * (acc[4 * gq] + bias0 * bflo(zw.x)), o1 = bfhi(xw.x) * (acc[4 * gq + 1] + bias0 * bfhi(zw.x));
        const float o2 = bflo(xw.y) * (acc[4 * gq + 2] + bias0 * bflo(zw.y)), o3 = bfhi(xw.y) * (acc[4 * gq + 3] + bias0 * bfhi(zw.y));
        z1w[gq].x = pk2(o0, o1); z1w[gq].y = pk2(o2, o3);
    }
    __syncthreads();
#pragma unroll
    for (int gq = 0; gq < 4; ++gq) *(u32x2*)(smem + HY_Z + hy_zoff(frow + 8 * gq + 4 * hi)) = z1w[gq];
#pragma unroll
    for (int i = 0; i < 2; ++i) { const int pc = tid + 512 * i; if (pc < npc) *(u32x4*)(smem + HY_HF + pc * 16) = f1r[i]; }
    __syncthreads();
    hy_build_copies(L, tid);
    __syncthreads();
    acc = hy_conv(L, lane, frow, t0, trip_lo, trip_hi);
#pragma unroll
    for (int gq = 0; gq < 4; ++gq) {
        const int fr = frow + 8 * gq + 4 * hi;
        const u32x2 xw = x2w[gq];
        const float o0 = bflo(xw.x) * (acc[4 * gq] + bias1 * bflo(z1w[gq].x)), o1 = bfhi(xw.x) * (acc[4 * gq + 1] + bias1 * bfhi(z1w[gq].x));
        const float o2 = bflo(xw.y) * (acc[4 * gq + 2] + bias1 * bflo(z1w[gq].y)), o3 = bfhi(xw.y) * (acc[4 * gq + 3] + bias1 * bfhi(z1w[gq].y));
        u32x2 w; w.x = pk2(o0, o1); w.y = pk2(o2, o3);
        *(u32x2*)(OcT + (size_t)c * GT + fr) = w;
    }
}
DI void phase_hy_conv(const Params& p, const GrpInfo gi, int bid, int nb) {
    const int tid = ltid();
    for (int c = bid; c < 1024; c += nb) hy_conv_unit(p, gi, c, tid);
}
constexpr float NA_QSCALE = 0.12751743074602468f;
constexpr float LOG2E = 1.4426950408889634f;

DI void phase_cache_cvt(const Params& p, int bid, int nb) {
    const int tid = ltid();
    bf16_t* T = (bf16_t*)smem;
    bf16_t* CK = (bf16_t*)(lws(p) + OFF_CK); bf16_t* CVT = (bf16_t*)(lws(p) + OFF_CVT);
    for (int u = bid; u < 8 * 2 * 8 * 4; u += nb) {
        const int bh = u >> 2, k0 = (u & 3) * 64;
        const int key = tid >> 3, ds = (tid & 7) * 16;
        const size_t src = ((size_t)bh * 256 + k0 + key) * 128 + ds;
        f32x4 kv[4], vv[4];
#pragma unroll
        for (int i = 0; i < 4; ++i) { kv[i] = *(const f32x4*)(p.cache_k + src + 4 * i); vv[i] = *(const f32x4*)(p.cache_v + src + 4 * i); }
        u32x4 w0, w1; w0.x = pk2(kv[0][0], kv[0][1]); w0.y = pk2(kv[0][2], kv[0][3]); w0.z = pk2(kv[1][0], kv[1][1]); w0.w = pk2(kv[1][2], kv[1][3]);
        w1.x = pk2(kv[2][0], kv[2][1]); w1.y = pk2(kv[2][2], kv[2][3]); w1.z = pk2(kv[3][0], kv[3][1]); w1.w = pk2(kv[3][2], kv[3][3]);
        *(u32x4*)(CK + src) = w0; *(u32x4*)(CK + src + 8) = w1;
        __syncthreads();
#pragma unroll
        for (int i = 0; i < 4; ++i)
#pragma unroll
            for (int j = 0; j < 4; ++j) T[(ds + 4 * i + j) * TP + key] = f2bf(vv[i][j]);
        __syncthreads();
        const int d = tid >> 2, ks = (tid & 3) * 16;
        bf16_t* dst = CVT + ((size_t)bh * 128 + d) * 256 + k0 + ks;
        *(u32x4*)dst = *(const u32x4*)(T + d * TP + ks); *(u32x4*)(dst + 8) = *(const u32x4*)(T + d * TP + ks + 8);
    }
}
DI void phase_na_prep2(const Params& p, const GrpInfo gi, int bid, int nb) {
    const int tid = ltid(), lane = tid & 63, wid = tid >> 6;
    const bf16_t* P = (const bf16_t*)(lws(p) + OFF_P);
    bf16_t* QN = (bf16_t*)(lws(p) + OFF_QN); bf16_t* KN = (bf16_t*)(lws(p) + OFF_KN); bf16_t* VTN = (bf16_t*)(lws(p) + OFF_VTN);
    {
        const int d0 = (lane & 15) * 8;
        float gq[8], gk[8];
#pragma unroll
        for (int j = 0; j < 8; ++j) { gq[j] = p.na_qnorm_g[gi.l * 128 + d0 + j] * NA_QSCALE; gk[j] = p.na_knorm_g[gi.l * 128 + d0 + j]; }
        for (int row = bid * 8 + wid; row < GT; row += nb * 8) {
            const bf16_t* pr = P + (size_t)row * NP + lane * 8;
            u32x4 qw[2], kw[2], vw[2];
#pragma unroll
            for (int hf = 0; hf < 2; ++hf) { qw[hf] = *(const u32x4*)(pr + C_NQ + 512 * hf); kw[hf] = *(const u32x4*)(pr + C_NK + 512 * hf); if (!gi.latent) vw[hf] = *(const u32x4*)(pr + C_NV + 512 * hf); }
#pragma unroll
            for (int hf = 0; hf < 2; ++hf) {
                float q[8], k[8]; float sq = 0.f, sk = 0.f;
#pragma unroll
                for (int j = 0; j < 4; ++j) { q[2 * j] = bflo(qw[hf][j]); q[2 * j + 1] = bfhi(qw[hf][j]); k[2 * j] = bflo(kw[hf][j]); k[2 * j + 1] = bfhi(kw[hf][j]); }
#pragma unroll
                for (int j = 0; j < 8; ++j) { sq += q[j] * q[j]; sk += k[j] * k[j]; }
#pragma unroll
                for (int o = 8; o >= 1; o >>= 1) { sq += __int_as_float(__builtin_amdgcn_ds_bpermute((lane ^ o) << 2, __float_as_int(sq))); sk += __int_as_float(__builtin_amdgcn_ds_bpermute((lane ^ o) << 2, __float_as_int(sk))); }
                const float qs = rsqrtf(sq * (1.0f / 128) + EPS), ks = rsqrtf(sk * (1.0f / 128) + EPS);
                float kn[8];
#pragma unroll
                for (int j = 0; j < 8; ++j) { q[j] = q[j] * qs * gq[j]; kn[j] = k[j] * ks * gk[j]; }
                u32x4 qo, ko; qo.x = pk2(q[0], q[1]); qo.y = pk2(q[2], q[3]); qo.z = pk2(q[4], q[5]); qo.w = pk2(q[6], q[7]);
                ko.x = pk2(kn[0], kn[1]); ko.y = pk2(kn[2], kn[3]); ko.z = pk2(kn[4], kn[5]); ko.w = pk2(kn[6], kn[7]);
                *(u32x4*)(QN + (size_t)row * 1024 + 512 * hf + lane * 8) = qo; *(u32x4*)(KN + (size_t)row * 1024 + 512 * hf + lane * 8) = ko;
                if (!gi.latent) { const int b = row >> 8, t = row & 255, h = 4 * hf + (lane >> 4); const size_t o = ((((size_t)b * DEPTH + gi.l) * 8 + h) * 256 + t) * 128 + d0;
                    float* ok = lout(p) + OUT_CK + o; float* ov = lout(p) + OUT_CV + o;
                    *(f32x4*)ok = (f32x4){kn[0], kn[1], kn[2], kn[3]}; *(f32x4*)(ok + 4) = (f32x4){kn[4], kn[5], kn[6], kn[7]};
                    *(f32x4*)ov = (f32x4){bflo(vw[hf][0]), bfhi(vw[hf][0]), bflo(vw[hf][1]), bfhi(vw[hf][1])}; *(f32x4*)(ov + 4) = (f32x4){bflo(vw[hf][2]), bfhi(vw[hf][2]), bflo(vw[hf][3]), bfhi(vw[hf][3])}; }
            }
        }
    }
    bf16_t* T = (bf16_t*)smem;
    const int L = gi.L;
    for (int u = bid; u < 128 * 8; u += nb) {
        const int cg = u >> 3, h = u & 7, row0 = cg * 64, seq = row0 / L, t0 = row0 & (L - 1);
        const int s = tid >> 3, ds = (tid & 7) * 16;
        const bf16_t* pv = P + (size_t)(row0 + s) * NP + C_NV + h * 128 + ds;
        const u32x4 w0 = *(const u32x4*)pv, w1 = *(const u32x4*)(pv + 8);
        __syncthreads();
#pragma unroll
        for (int j = 0; j < 4; ++j) { T[(ds + 2 * j) * TP + s] = (bf16_t)(w0[j] & 0xffffu); T[(ds + 2 * j + 1) * TP + s] = (bf16_t)(w0[j] >> 16);
                                      T[(ds + 8 + 2 * j) * TP + s] = (bf16_t)(w1[j] & 0xffffu); T[(ds + 8 + 2 * j + 1) * TP + s] = (bf16_t)(w1[j] >> 16); }
        __syncthreads();
        const int d = tid >> 2, sq = (tid & 3) * 16;
        bf16_t* dst = VTN + ((size_t)(seq * 8 + h) * 128 + d) * L + t0 + sq;
        *(u32x4*)dst = *(const u32x4*)(T + d * TP + sq); *(u32x4*)(dst + 8) = *(const u32x4*)(T + d * TP + sq + 8);
    }
}

typedef const __attribute__((address_space(1))) bf16_t* gbfp;
constexpr int LDS_RPB_OFF = 139264 + 512;
DI void na_load_rpb(const Params& p, int l, int tid) {
    float* rp = (float*)(smem + LDS_RPB_OFF);
    for (int i = tid; i < 8 * 465; i += 512) rp[i] = p.na_rpb[(size_t)l * 8 * 465 + i] * LOG2E;
}
constexpr int NA_KP = 144, NA_VP = 72;
constexpr int NA_KS = 0, NA_VS = 64 * NA_KP * 2, NA_BUF = NA_VS + 128 * NA_VP * 2;
template <int NT, bool LOCAL> DI void na_chunk(const unsigned char* buf, int koff, const bf16x8 (&qB)[4], f32x4 (&O)[8], float& mrun, float& lrun, int lane, int r16, int q4,
                                               const float* rpb, int rowoff, int wc0, int c, int cs) {
    const bf16_t* Ks = (const bf16_t*)(buf + NA_KS); const bf16_t* Vs = (const bf16_t*)(buf + NA_VS);
    f32x4 st[NT];
#pragma unroll
    for (int T = 0; T < NT; ++T) { st[T] = (f32x4){0.f, 0.f, 0.f, 0.f};
#pragma unroll
        for (int ks = 0; ks < 4; ++ks) { const bf16x8 a = *(const bf16x8*)(Ks + (koff + 16 * T + r16) * NA_KP + 32 * ks + 8 * q4); st[T] = MFMA16(a, qB[ks], st[T]); } }
    float mx = -INFINITY;
#pragma unroll
    for (int T = 0; T < NT; ++T)
#pragma unroll
        for (int i = 0; i < 4; ++i) {
            if (LOCAL) { const int gcol = wc0 + 16 * T + 4 * q4 + i; const bool ok = gcol >= cs && gcol < cs + 16;
                const float bias = rpb[rowoff * 31 + min(max(gcol - c + 15, 0), 30)];
                st[T][i] = ok ? st[T][i] + bias : -INFINITY; }
            mx = fmaxf(mx, st[T][i]);
        }
    mx = fmaxf(mx, __int_as_float(__builtin_amdgcn_ds_bpermute((lane ^ 16) << 2, __float_as_int(mx))));
    mx = fmaxf(mx, __int_as_float(__builtin_amdgcn_ds_bpermute((lane ^ 32) << 2, __float_as_int(mx))));
    const float mnew = fmaxf(mrun, mx);
    const float alpha = (mnew == -INFINITY) ? 1.0f : __builtin_amdgcn_exp2f(mrun - mnew);
    const float msafe = (mnew == -INFINITY) ? 0.0f : mnew;
    float ls = 0.f;
#pragma unroll
    for (int T = 0; T < NT; ++T)
#pragma unroll
        for (int i = 0; i < 4; ++i) { const float e = __builtin_amdgcn_exp2f(st[T][i] - msafe); st[T][i] = e; ls += e; }
    ls += __int_as_float(__builtin_amdgcn_ds_bpermute((lane ^ 16) << 2, __float_as_int(ls)));
    ls += __int_as_float(__builtin_amdgcn_ds_bpermute((lane ^ 32) << 2, __float_as_int(ls)));
    lrun = lrun * alpha + ls; mrun = mnew;
#pragma unroll
    for (int dT = 0; dT < 8; ++dT) O[dT] *= alpha;
#pragma unroll
    for (int t = 0; t < NT / 2; ++t) {
        const bf16x8 bP = pack8(st[2 * t], st[2 * t + 1]);
#pragma unroll
        for (int dT = 0; dT < 8; ++dT) { const bf16_t* vp = Vs + (16 * dT + r16) * NA_VP + koff + 32 * t + 4 * q4;
            const bf16x4 a0 = *(const bf16x4*)vp, a1 = *(const bf16x4*)(vp + 16);
            const bf16x8 a = (bf16x8){a0[0], a0[1], a0[2], a0[3], a1[0], a1[1], a1[2], a1[3]};
            O[dT] = MFMA16(a, bP, O[dT]); }
    }
}
DI void na_attn_unit(const Params& p, const GrpInfo gi, int u, int tid_in) {
    int tid = tid_in; asm volatile("" : "+v"(tid));
    const int lane = tid & 63, wid = __builtin_amdgcn_readfirstlane(tid >> 6), l = gi.l, r16 = lane & 15, q4 = lane >> 4;
    const float* rp = (const float*)(smem + LDS_RPB_OFF);
    const bf16_t* QN = (const bf16_t*)(lws(p) + OFF_QN); const bf16_t* KN = (const bf16_t*)(lws(p) + OFF_KN); const bf16_t* VTN = (const bf16_t*)(lws(p) + OFF_VTN);
    bf16_t* OB = (bf16_t*)(lws(p) + OFF_OABC) + 1024;
    int qrow0, h, seq, r = 0, c0 = 0, r0 = 0;
    if (gi.latent) { const int sl = u >> 8, rp2 = u & 31; h = (u >> 5) & 7; seq = sl; r0 = 2 * rp2; r = r0 + (wid >> 2); c0 = 16 * (wid & 3); qrow0 = sl * 4096 + r * 64 + c0; }
    else { const int b = u >> 4, half = u & 1; h = (u >> 1) & 7; seq = b; qrow0 = b * 256 + (half * 8 + wid) * 16; }
    const int g0 = min(max(r0 - 4, 0), 56), g1 = min(max(r0 + 1 - 4, 0), 56) + 8, nch = gi.latent ? 4 + (g1 - g0) : 4;
    const bf16_t* ck; const bf16_t* cv; int ckst, cvst;
    if (gi.latent) { const size_t cb = ((size_t)(2 * (gi.grp - 1) + seq) * DEPTH + l) * 8 + h; ck = (const bf16_t*)(lws(p) + OFF_CK) + cb * 256 * 128; ckst = 128; cv = (const bf16_t*)(lws(p) + OFF_CVT) + cb * 128 * 256; cvst = 256; }
    else { ck = KN + (size_t)(seq * 256) * 1024 + h * 128; ckst = 1024; cv = VTN + (size_t)(seq * 8 + h) * 128 * 256; cvst = 256; }
    const bf16_t* lk = KN + (size_t)(seq * 4096) * 1024 + h * 128;
    const bf16_t* lv = VTN + (size_t)(seq * 8 + h) * 128 * 4096;
    const int kkey = tid >> 4, kds = (tid & 15) * 8, vd = tid >> 3, vks = (tid & 7) * 8;
    u32x4 pk[4][2], pv[4][2];
#define NA_LOAD(c_, s_) do { const int cc_ = (c_); const bf16_t* kb_; const bf16_t* vb_; int kst_, vst_; \
        if (cc_ < 4) { kb_ = ck + (size_t)(64 * cc_) * ckst; kst_ = ckst; vb_ = cv + 64 * cc_; vst_ = cvst; } else { const int g_ = g0 + cc_ - 4; kb_ = lk + (size_t)(64 * g_) * 1024; kst_ = 1024; vb_ = lv + 64 * g_; vst_ = 4096; } \
        pk[s_][0] = *(const u32x4*)(kb_ + (size_t)kkey * kst_ + kds); pk[s_][1] = *(const u32x4*)(kb_ + (size_t)(kkey + 32) * kst_ + kds); \
        pv[s_][0] = *(const u32x4*)(vb_ + (size_t)vd * vst_ + vks); pv[s_][1] = *(const u32x4*)(vb_ + (size_t)(vd + 64) * vst_ + vks); } while (0)
#define NA_STORE(bufp, s_) do { unsigned char* b_ = (bufp); \
        *(u32x4*)(b_ + NA_KS + (kkey * NA_KP + kds) * 2) = pk[s_][0]; *(u32x4*)(b_ + NA_KS + ((kkey + 32) * NA_KP + kds) * 2) = pk[s_][1]; \
        *(u32x4*)(b_ + NA_VS + (vd * NA_VP + vks) * 2) = pv[s_][0]; *(u32x4*)(b_ + NA_VS + ((vd + 64) * NA_VP + vks) * 2) = pv[s_][1]; } while (0)
    bf16x8 qB[4];
#pragma unroll
    for (int ks = 0; ks < 4; ++ks) qB[ks] = *(const bf16x8*)(QN + (size_t)(qrow0 + r16) * 1024 + h * 128 + 32 * ks + 8 * q4);
    f32x4 O[8];
#pragma unroll
    for (int dT = 0; dT < 8; ++dT) O[dT] = (f32x4){0.f, 0.f, 0.f, 0.f};
    float mrun = -INFINITY, lrun = 0.f;
    const int rs = min(max(r - 4, 0), 56), wc0 = min(max(c0 - 8, 0), 32), c = c0 + r16, cs = min(max(c - 8, 0), 48);
    __syncthreads();
    NA_LOAD(0, 0); NA_LOAD(1, 1); NA_LOAD(2, 2); NA_LOAD(3, 3);
    NA_STORE(smem, 0);
    __syncthreads();
    for (int ci = 0; ci < nch; ci += 4) {
#pragma unroll
        for (int j = 0; j < 4; ++j) {
            const int cc = ci + j;
            if (cc < nch) {
                if (cc + 4 < nch) NA_LOAD(cc + 4, j);
                const unsigned char* buf = smem + (j & 1) * NA_BUF;
                if (cc < 4) na_chunk<4, false>(buf, 0, qB, O, mrun, lrun, lane, r16, q4, rp, 0, 0, 0, 0);
                else { const int g = g0 + cc - 4, wr = g - rs; if (wr >= 0 && wr < 8) na_chunk<2, true>(buf, wc0, qB, O, mrun, lrun, lane, r16, q4, rp + h * 465, g - r + 7, wc0, c, cs); }
                if (cc + 1 < nch) NA_STORE(smem + ((j + 1) & 1) * NA_BUF, (j + 1) & 3);
            }
            __syncthreads();
        }
    }
#undef NA_LOAD
#undef NA_STORE
    const float inv = 1.0f / lrun;
#pragma unroll
    for (int dT = 0; dT < 8; ++dT) { u32x2 w; w.x = pk2(O[dT][0] * inv, O[dT][1] * inv); w.y = pk2(O[dT][2] * inv, O[dT][3] * inv);
        *(u32x2*)(OB + (size_t)(qrow0 + r16) * 3072 + h * 128 + 16 * dT + 4 * q4) = w; }
}
#define LAS3 __attribute__((address_space(3)))
#ifndef REPMASK
#define REPMASK 0
#endif
constexpr int LDS_MAIN = 139264, LDS_PARAMS = LDS_MAIN + 64, LDS_UNIT = LDS_MAIN + 32, LDS_BYTES = LDS_MAIN + 512 + 8 * 465 * 4;
static_assert(LDS_RPB_OFF == LDS_MAIN + 512 && LDS_BYTES <= 163840, "LDS map");
constexpr int CTR_WORD0 = XCD_BAR_WORDS, CTR_WORDS = 64 * 16;

DI Params lp() {
    ParamsU u;
#pragma unroll
    for (int i = 0; i < NPARAM; ++i) {
        const unsigned long long v = *(const LAS3 unsigned long long*)((LAS3 unsigned char*)smem + LDS_PARAMS + 8 * i);
        const unsigned lo = (unsigned)__builtin_amdgcn_readfirstlane((int)(unsigned)v), hi = (unsigned)__builtin_amdgcn_readfirstlane((int)(unsigned)(v >> 32));
        u.a[i] = ((unsigned long long)hi << 32) | lo;
    }
    return u.s;
}
DI const float* x_in_ptr(const Params& p, int grp, int l) {
    if (l == 0) return grp == 0 ? p.x_prompt : p.x_sample + (size_t)(grp - 1) * GT * DM;
    return grp == 0 ? p.out + OUT_YP : p.out + OUT_YS + (size_t)(grp - 1) * GT * DM;
}
DI float* x_out_ptr(const Params& p, int grp) { return grp == 0 ? p.out + OUT_YP : p.out + OUT_YS + (size_t)(grp - 1) * GT * DM; }

template <class Epi> DI void gemm_ph(const bf16_t* A, const bf16_t* Bt, int M, int N, int K, const Epi& E) {
    pg8::Gemm g; g.A = A; g.Bt = Bt; g.M = M; g.N = N; g.K = K; g.pad = 0;
    pg8::StaticOrder S; S.init(M, N, (int)gridDim.x, (int)blockIdx.x);
    pg8::gemm_phase<Epi, pg8::StaticOrder, false>((LAS3 unsigned char*)smem, g, S, E, nullptr);
}
struct ModPtrs { const float* mA; const float* mB; };
DI ModPtrs mod_ptrs(const Params& q, int grp, int l) {
    const int crA = grp == 0 ? 0 : 1 + 2 * (grp - 1), crB = grp == 0 ? 0 : crA + 1;
    const float* mod = (const float*)(q.ws + OFF_MOD);
    ModPtrs m; m.mA = mod + ((size_t)l * NCOND + crA) * (NMOD * DM); m.mB = mod + ((size_t)l * NCOND + crB) * (NMOD * DM); return m;
}

#ifndef TIMECLASS
#define TIMECLASS (-1)
#endif
#define TBAR(k) do { xcd_barrier(bar); if (TIMECLASS >= 0) { const unsigned long long now_ = __builtin_amdgcn_s_memrealtime(); if ((k) == TIMECLASS) tacc += now_ - tprev; tprev = now_; } } while (0)
__global__ __launch_bounds__(512, 2) void k_mega(Params p) {
    unsigned long long tprev = 0ull, tacc = 0ull;
    const int bid = blockIdx.x, nb = gridDim.x;
    volatile LAS unsigned* xbw = (volatile LAS unsigned*)((LAS3 unsigned char*)smem + LDS_MAIN);
    if (threadIdx.x == 0) {
        xbw[0] = 0u; xbw[1] = 0u; xbw[2] = 0u; xbw[3] = 0u;
        ParamsU u; u.s = p;
#pragma unroll
        for (int i = 0; i < NPARAM; ++i) *(LAS3 unsigned long long*)((LAS3 unsigned char*)smem + LDS_PARAMS + 8 * i) = u.a[i];
    }
    __syncthreads();
    XcdBarrier bar;
    { const Params q = lp(); bar = xcd_barrier_post((unsigned*)(q.ws + OFF_BAR), xbw); }
    for (int rep_ = 0; rep_ < 1 + ((REPMASK >> 8) & 1); ++rep_) { const Params q = lp(); phase_convert(q, bid, nb); }
    for (int rep_ = 0; rep_ < 1 + ((REPMASK >> 17) & 1); ++rep_) { const Params q = lp(); phase_adaln(q, bid, nb); }
    { const Params q = lp(); phase_hyena_hid(q, bid, nb); }
    { const Params q = lp(); phase_cache_cvt(q, bid, nb); }
    xcd_barrier(bar);
    for (int rep_ = 0; rep_ < 1 + ((REPMASK >> 19) & 1); ++rep_) { const Params q = lp(); phase_filters(q, bid, nb); }
    xcd_barrier(bar);
    if (TIMECLASS >= 0) tprev = __builtin_amdgcn_s_memrealtime();
    for (int l0 = 0; l0 < DEPTH; ++l0) for (int grp0 = 0; grp0 < NGRP; ++grp0) {
        int l = l0, grp = grp0; asm volatile("" : "+s"(l), "+s"(grp));
        const GrpInfo gi = grp_info(grp, l);
        for (int rep_ = 0; rep_ < 1 + ((REPMASK >> 0) & 1); ++rep_) { const Params q = lp(); phase_norm(q, x_in_ptr(q, grp, l), q.norm1_g + l * DM, l, grp, 0, DM, bid, nb); }
        TBAR(0);
        if ((REPMASK >> 9) & 1) { xcd_barrier(bar); xcd_barrier(bar); xcd_barrier(bar); xcd_barrier(bar); }
        for (int rep_ = 0; rep_ < 1 + ((REPMASK >> 1) & 1); ++rep_) { const Params q = lp(); gemm_ph((const bf16_t*)(q.ws + OFF_H), (const bf16_t*)(q.ws + OFF_WIN) + (size_t)l * NP * DM, GT, NP, DM, EpiStoreBf16<0>{(bf16_t*)(q.ws + OFF_P), NP, 0}); }
        TBAR(1);
        for (int rep_ = 0; rep_ < 1 + ((REPMASK >> 2) & 1); ++rep_) { const Params q = lp(); phase_gla_prep(q, gi, bid, nb); }
        for (int rep_ = 0; rep_ < 1 + ((REPMASK >> 13) & 1); ++rep_) { const Params q = lp(); phase_na_prep2(q, gi, bid, nb); }
        for (int rep_ = 0; rep_ < 1 + ((REPMASK >> 14) & 1); ++rep_) { const Params q = lp(); phase_hy_prep(q, gi, bid, nb); }
        TBAR(2);
        for (int rep_ = 0; rep_ < 1 + ((REPMASK >> 3) & 1); ++rep_) {
            const Params q = lp(); const int tid = ltid();
            na_load_rpb(q, l, tid);
            unsigned* head = (unsigned*)(q.ws + OFF_BAR) + CTR_WORD0 + 64 * (l * NGRP + grp) + 16 * rep_;
            volatile LAS3 int* su = (volatile LAS3 int*)((LAS3 unsigned char*)smem + LDS_UNIT);
            const int nscan = gi.nseq * 16, nhy = 1024, nna = 512, ntot = nscan + nhy + nna;
            __syncthreads();
            if (tid == 0) *su = (int)__hip_atomic_fetch_add(head, 1u, __ATOMIC_RELAXED, __HIP_MEMORY_SCOPE_AGENT);
            __syncthreads();
            for (;;) {
                const int u = __builtin_amdgcn_readfirstlane(*su);
                if (u >= ntot) break;
                int nxt = 0;
                if (tid == 0) nxt = (int)__hip_atomic_fetch_add(head, 1u, __ATOMIC_RELAXED, __HIP_MEMORY_SCOPE_AGENT);
                if (u < nscan) { for (int r2 = 0; r2 < 1 + ((REPMASK >> 10) & 1); ++r2) gla_scan_unit(q, gi, u, tid); }
                else if (u < nscan + nhy) { for (int r2 = 0; r2 < 1 + ((REPMASK >> 4) & 1); ++r2) hy_conv_unit(q, gi, u - nscan, tid); }
                else { for (int r2 = 0; r2 < 1 + ((REPMASK >> 5) & 1); ++r2) na_attn_unit(q, gi, u - nscan - nhy, tid); }
                __syncthreads();
                if (tid == 0) *su = nxt;
                __syncthreads();
            }
        }
        TBAR(3);
        for (int rep_ = 0; rep_ < 1 + ((REPMASK >> 6) & 1); ++rep_) { const Params q = lp(); phase_gla_post<true>(q, gi, bid, nb); }
        for (int rep_ = 0; rep_ < 1 + ((REPMASK >> 6) & 1); ++rep_) { const Params q = lp(); phase_hy_post(q, gi, bid, nb); }
        TBAR(4);
        for (int rep_ = 0; rep_ < 1 + ((REPMASK >> 16) & 1); ++rep_)
        { const Params q = lp();
          gemm_ph((const bf16_t*)(q.ws + OFF_OABC), (const bf16_t*)(q.ws + OFF_WBR) + (size_t)l * DM * 3072, GT, DM, 3072, EpiGate3{(const bf16_t*)(q.ws + OFF_P) + C_GATE, (bf16_t*)(q.ws + OFF_MBF), NP, 0}); }
        TBAR(5);
        for (int rep_ = 0; rep_ < 1 + ((REPMASK >> 12) & 1); ++rep_)
        { const Params q = lp(); const ModPtrs m = mod_ptrs(q, grp, l);
          gemm_ph((const bf16_t*)(q.ws + OFF_MBF), (const bf16_t*)(q.ws + OFF_WOUT) + (size_t)l * DM * DM, GT, DM, DM, EpiResid{x_in_ptr(q, grp, l), (float*)(q.ws + OFF_M32), m.mA + 2 * DM, m.mB + 2 * DM}); }
        TBAR(6);
        { const Params q = lp(); phase_norm(q, (const float*)(q.ws + OFF_M32), q.norm2_g + l * DM, l, grp, 3 * DM, 4 * DM, bid, nb); }
        TBAR(7);
        for (int rep_ = 0; rep_ < 1 + ((REPMASK >> 7) & 1); ++rep_) { const Params q = lp(); gemm_ph((const bf16_t*)(q.ws + OFF_H), (const bf16_t*)(q.ws + OFF_W1) + (size_t)l * DFF * DM, GT, DFF, DM, EpiStoreBf16<1>{(bf16_t*)(q.ws + OFF_P), DFF, 0}); }
        TBAR(8);
        for (int rep_ = 0; rep_ < 1 + ((REPMASK >> 15) & 1); ++rep_)
        { const Params q = lp(); const ModPtrs m = mod_ptrs(q, grp, l);
          gemm_ph((const bf16_t*)(q.ws + OFF_P), (const bf16_t*)(q.ws + OFF_W2) + (size_t)l * DM * DFF, GT, DM, DFF, EpiResid{(const float*)(q.ws + OFF_M32), x_out_ptr(q, grp), m.mA + 5 * DM, m.mB + 5 * DM}); }
        TBAR(9);
    }
    if (TIMECLASS >= 0 && blockIdx.x == 0) { const unsigned long long t0_ = __builtin_amdgcn_s_memrealtime(); while (__builtin_amdgcn_s_memrealtime() - t0_ < 4ull * tacc) __builtin_amdgcn_s_sleep(8); }
}

extern "C" void kernel_launch(void* const* d_in, const int* in_sizes, int n_in, void* d_out, int out_size, void* d_ws, size_t ws_size, hipStream_t stream) {
    Params p{};
    const float** f = (const float**)&p;
    for (int i = 0; i < 33; ++i) f[i] = (const float*)d_in[i];
    p.out = (float*)d_out; p.ws = (unsigned char*)d_ws;
    if (ws_size < WS_END) { fprintf(stderr, "workspace too small: %zu < %zu\n", ws_size, (size_t)WS_END); return; }
    static int grid = 0;
    if (!grid) {
        int dev = 0, cus = 0, per_cu = 0;
        (void)hipGetDevice(&dev);
        (void)hipDeviceGetAttribute(&cus, hipDeviceAttributeMultiprocessorCount, dev);
        (void)hipFuncSetAttribute((const void*)k_mega, hipFuncAttributeMaxDynamicSharedMemorySize, LDS_BYTES);
        (void)hipOccupancyMaxActiveBlocksPerMultiprocessor(&per_cu, k_mega, 512, LDS_BYTES);
        grid = cus * (per_cu < 1 ? per_cu : 1);
        if (grid <= 0) { fprintf(stderr, "occupancy query failed: cus %d per_cu %d\n", cus, per_cu); grid = 0; return; }
    }
    (void)hipMemsetAsync(p.ws + OFF_BAR, 0, (XCD_BAR_WORDS + CTR_WORDS) * sizeof(unsigned), stream);
    hipLaunchKernelGGL(k_mega, dim3(grid), dim3(512), LDS_BYTES, stream, p);
}
```
